# Optimizing an MI355X kernel written in HIP

```python
import math
import jax, jax.numpy as jnp
from jax import lax
import numpy as np

D_MODEL = 1024
BATCH = 8
SEQ = 4096
DEPTH = 2

GRID_W = 64
CTX_LEN = 256
BLOCK = 128
WINDOW = 128
ROPE_THETA = 10000.0
EPS = 1e-6
NEG_INF = -1e30

HEAD_DIM = 64
A_HEADS = 6
A_KV_HEADS = 2
B_HEADS = 6
B_Q_RANK = 192
B_KV_RANK = 128
B_NOPE = 64
B_ROPE = 32
B_V = 64
C_HEADS = 4
C_KV_HEADS = 2
N_EXPERTS = 16
CAP_FACTOR = 2
D_EXPERT = 1024

IN_SPLITS = (A_HEADS * HEAD_DIM, A_KV_HEADS * HEAD_DIM, A_KV_HEADS * HEAD_DIM,
             B_Q_RANK, B_KV_RANK, B_ROPE,
             C_HEADS * HEAD_DIM, C_KV_HEADS * HEAD_DIM, C_KV_HEADS * HEAD_DIM)
IN_WIDTH = sum(IN_SPLITS)
IN_OFFSETS = [int(v) for v in np.cumsum(IN_SPLITS)[:-1]]
MIX_WIDTH = A_HEADS * HEAD_DIM + B_HEADS * B_V + C_HEADS * HEAD_DIM

kernel_name = "hybrid_dit_gqa_mla_swa_ecmoe"


def rms_norm(x, g):
    xf = x.astype(jnp.float32)
    y = xf * lax.rsqrt(jnp.mean(xf * xf, axis=-1, keepdims=True) + EPS)
    return y.astype(x.dtype) * g


def modulate(x, shift, scale):
    return x * (1 + scale) + shift


def axial_rope_tables(length, dim):
    rows = length // GRID_W
    t = jnp.arange(rows * GRID_W)
    row = jnp.repeat(jnp.arange(rows), GRID_W).astype(jnp.float32)
    col = (t % GRID_W).astype(jnp.float32)
    axis_dim = dim // 2
    inv = ROPE_THETA ** (-jnp.arange(0, axis_dim, 2, dtype=jnp.float32) / axis_dim)
    ang_r = row[:, None] * inv[None, :]
    ang_c = col[:, None] * inv[None, :]
    return (jnp.cos(ang_r), jnp.sin(ang_r), jnp.cos(ang_c), jnp.sin(ang_c))


def _rotate(x, cos, sin):
    half = x.shape[-1] // 2
    x1, x2 = x[..., :half], x[..., half:]
    cos = cos[:, None, :].astype(x.dtype)
    sin = sin[:, None, :].astype(x.dtype)
    return jnp.concatenate([x1 * cos - x2 * sin, x2 * cos + x1 * sin], axis=-1)


def apply_axial_rope(x, tables):
    cos_r, sin_r, cos_c, sin_c = tables
    a = x.shape[-1] // 2
    return jnp.concatenate([_rotate(x[..., :a], cos_r, sin_r), _rotate(x[..., a:], cos_c, sin_c)], axis=-1)


def gqa_heads(pq, pk, pv, gq, gk, n_heads, n_kv, tables):
    b, l, _ = pq.shape
    q = rms_norm(pq.reshape(b, l, n_heads, HEAD_DIM), gq)
    k = rms_norm(pk.reshape(b, l, n_kv, HEAD_DIM), gk)
    v = pv.reshape(b, l, n_kv, HEAD_DIM)
    if tables is not None:
        q = apply_axial_rope(q, tables)
        k = apply_axial_rope(k, tables)
    return q, k, v


def mla_heads(pcq, pckv, pkr, g_cq, g_ckv, w_uq, w_ukv, g_qn, g_kn, g_qr, g_kr, tables):
    b, l, _ = pcq.shape
    q = (rms_norm(pcq, g_cq) @ w_uq).reshape(b, l, B_HEADS, B_NOPE + B_ROPE)
    kv = (rms_norm(pckv, g_ckv) @ w_ukv).reshape(b, l, B_HEADS, B_NOPE + B_V)
    q_nope = rms_norm(q[..., :B_NOPE], g_qn)
    q_pe = rms_norm(q[..., B_NOPE:], g_qr)
    k_nope = rms_norm(kv[..., :B_NOPE], g_kn)
    v = kv[..., B_NOPE:]
    k_pe = rms_norm(pkr.reshape(b, l, 1, B_ROPE), g_kr)
    if tables is not None:
        q_pe = apply_axial_rope(q_pe, tables)
        k_pe = apply_axial_rope(k_pe, tables)
    q = jnp.concatenate([q_nope, q_pe], axis=-1)
    k = jnp.concatenate([k_nope, jnp.broadcast_to(k_pe, (b, l, B_HEADS, B_ROPE))], axis=-1)
    return q, k, v


def attend(q, k, v):
    b, t, h, dq = q.shape
    kvh = k.shape[2]
    qg = q.reshape(b, t, kvh, h // kvh, dq)
    s = jnp.einsum('btkgd,bskd->bkgts', qg, k).astype(jnp.float32) * (dq ** -0.5)
    p = jax.nn.softmax(s, axis=-1).astype(v.dtype)
    o = jnp.einsum('bkgts,bskd->btkgd', p, v)
    return o.reshape(b, t, h * v.shape[-1])


def attend_blocked(q, k, v):
    b, l, h, dq = q.shape
    nb = l // BLOCK
    qb = jnp.swapaxes(q.reshape(b, nb, BLOCK, h, dq), 0, 1)
    ob = lax.map(lambda qi: attend(qi, k, v), qb)
    return jnp.swapaxes(ob, 0, 1).reshape(b, l, -1)


def sink_softmax(s, sink):
    sink = jnp.broadcast_to(sink.astype(jnp.float32), s.shape[:-1] + (1,))
    return jax.nn.softmax(jnp.concatenate([s, sink], axis=-1), axis=-1)[..., :-1]


def attend_sink(q, k, v, sink):
    b, t, h, dq = q.shape
    kvh = k.shape[2]
    g = h // kvh
    s = jnp.einsum('btkgd,bskd->bkgts', q.reshape(b, t, kvh, g, dq), k).astype(jnp.float32) * (dq ** -0.5)
    p = sink_softmax(s, sink.reshape(kvh, g, 1, 1)).astype(v.dtype)
    return jnp.einsum('bkgts,bskd->btkgd', p, v).reshape(b, t, h * v.shape[-1])


def attend_window(q, k, v, k_ctx, v_ctx, sink):
    b, l, h, dq = q.shape
    kvh = k.shape[2]
    g = h // kvh
    nb = l // BLOCK
    n_ctx = k_ctx.shape[1]
    span = BLOCK + 2 * WINDOW
    qb = q.reshape(b, nb, BLOCK, kvh, g, dq)
    pad = ((0, 0), (WINDOW, WINDOW), (0, 0), (0, 0))
    idx = jnp.arange(nb)[:, None] * BLOCK + jnp.arange(span)[None, :]
    kb = jnp.pad(k, pad)[:, idx]
    vb = jnp.pad(v, pad)[:, idx]
    qpos = jnp.arange(nb)[:, None] * BLOCK + jnp.arange(BLOCK)[None, :]
    kpos = (idx - WINDOW)[:, None, :]
    valid = (jnp.abs(qpos[:, :, None] - kpos) <= WINDOW) & (kpos >= 0) & (kpos < l)
    scale = dq ** -0.5
    s_win = jnp.einsum('bntkgd,bnskd->bnkgts', qb, kb).astype(jnp.float32) * scale
    s_win = jnp.where(valid[None, :, None, None], s_win, NEG_INF)
    s_ctx = jnp.einsum('bntkgd,bskd->bnkgts', qb, k_ctx).astype(jnp.float32) * scale
    p = sink_softmax(jnp.concatenate([s_ctx, s_win], axis=-1), sink.reshape(1, 1, kvh, g, 1, 1)).astype(v.dtype)
    o = (jnp.einsum('bnkgts,bskd->bntkgd', p[..., :n_ctx], v_ctx)
         + jnp.einsum('bnkgts,bnskd->bntkgd', p[..., n_ctx:], vb))
    return o.reshape(b, l, h * v.shape[-1])


def expert_choice_ffn(h, w_router, w_gate, w_up, w_down):
    b, n, d = h.shape
    cap = max(1, CAP_FACTOR * n // N_EXPERTS)
    aff = jax.nn.softmax((h @ w_router).astype(jnp.float32), axis=-1)
    gate, idx = lax.top_k(jnp.swapaxes(aff, 1, 2), cap)
    xe = jax.vmap(lambda hb, ib: hb[ib])(h, idx)
    hid = jax.nn.silu(jnp.einsum('becd,edf->becf', xe, w_gate)) * jnp.einsum('becd,edf->becf', xe, w_up)
    ye = jnp.einsum('becf,efd->becd', hid, w_down) * gate[..., None].astype(h.dtype)
    return jax.vmap(lambda ib, yb: jnp.zeros((n, d), yb.dtype).at[ib.reshape(-1)].add(yb.reshape(-1, d)))(idx, ye)


def setup_inputs(seed: int = 0) -> dict:
    key = jax.random.key(seed)
    ks = jax.random.split(key, 32)

    def nrm(k, shape, scale=1.0):
        return jax.random.normal(k, shape, jnp.float32) * scale

    def gain(k, shape):
        return 1.0 + 0.05 * jax.random.normal(k, shape, jnp.float32)

    L, D = DEPTH, D_MODEL
    return {
        "x": nrm(ks[0], (BATCH, SEQ, D)),
        "c": nrm(ks[1], (BATCH, D)),
        "ctx": nrm(ks[2], (BATCH, CTX_LEN, D)),
        "c_ctx": nrm(ks[3], (D,)),
        "w_ada": nrm(ks[4], (L, D, 6 * D), D ** -0.5),
        "b_ada": nrm(ks[5], (L, 6 * D), 0.01),
        "norm1_g": gain(ks[6], (L, D)),
        "norm2_g": gain(ks[7], (L, D)),
        "w_in": nrm(ks[8], (L, D, IN_WIDTH), D ** -0.5),
        "a_q_norm": gain(ks[9], (L, HEAD_DIM)),
        "a_k_norm": gain(ks[10], (L, HEAD_DIM)),
        "b_cq_norm": gain(ks[11], (L, B_Q_RANK)),
        "b_ckv_norm": gain(ks[12], (L, B_KV_RANK)),
        "w_uq": nrm(ks[13], (L, B_Q_RANK, B_HEADS * (B_NOPE + B_ROPE)), B_Q_RANK ** -0.5),
        "w_ukv": nrm(ks[14], (L, B_KV_RANK, B_HEADS * (B_NOPE + B_V)), B_KV_RANK ** -0.5),
        "b_qn_norm": gain(ks[15], (L, B_NOPE)),
        "b_kn_norm": gain(ks[16], (L, B_NOPE)),
        "b_qr_norm": gain(ks[17], (L, B_ROPE)),
        "b_kr_norm": gain(ks[18], (L, B_ROPE)),
        "c_q_norm": gain(ks[19], (L, HEAD_DIM)),
        "c_k_norm": gain(ks[20], (L, HEAD_DIM)),
        "c_sink": nrm(ks[21], (L, C_HEADS), 0.5),
        "w_out": nrm(ks[22], (L, MIX_WIDTH, D), MIX_WIDTH ** -0.5),
        "w_router": nrm(ks[23], (L, D, N_EXPERTS), D ** -0.5),
        "w_e_gate": nrm(ks[24], (L, N_EXPERTS, D, D_EXPERT), D ** -0.5),
        "w_e_up": nrm(ks[25], (L, N_EXPERTS, D, D_EXPERT), D ** -0.5),
        "w_e_down": nrm(ks[26], (L, N_EXPERTS, D_EXPERT, D), D_EXPERT ** -0.5),
    }


def reference(x, c, ctx, c_ctx, w_ada, b_ada, norm1_g, norm2_g, w_in, a_q_norm, a_k_norm,
              b_cq_norm, b_ckv_norm, w_uq, w_ukv, b_qn_norm, b_kn_norm, b_qr_norm, b_kr_norm,
              c_q_norm, c_k_norm, c_sink, w_out, w_router, w_e_gate, w_e_up, w_e_down):
    length = x.shape[1]
    rope_hd = axial_rope_tables(length, HEAD_DIM)
    rope_b = axial_rope_tables(length, B_ROPE)
    for l in range(DEPTH):
        last = l == DEPTH - 1
        mod = (jax.nn.silu(c) @ w_ada[l] + b_ada[l])[:, None, :]
        mod_c = (jax.nn.silu(c_ctx) @ w_ada[l] + b_ada[l])[None, None, :]
        sh1, sc1, g1, sh2, sc2, g2 = jnp.split(mod, 6, axis=-1)
        csh1, csc1, cg1, csh2, csc2, cg2 = jnp.split(mod_c, 6, axis=-1)

        h = modulate(rms_norm(x, norm1_g[l]), sh1, sc1)
        hc = modulate(rms_norm(ctx, norm1_g[l]), csh1, csc1)
        aq, ak, av, bcq, bckv, bkr, cq, ck, cv = jnp.split(h @ w_in[l], IN_OFFSETS, axis=-1)
        aqc, akc, avc, bcqc, bckvc, bkrc, cqc, ckc, cvc = jnp.split(hc @ w_in[l], IN_OFFSETS, axis=-1)

        qa, ka, va = gqa_heads(aq, ak, av, a_q_norm[l], a_k_norm[l], A_HEADS, A_KV_HEADS, rope_hd)
        qac, kac, vac = gqa_heads(aqc, akc, avc, a_q_norm[l], a_k_norm[l], A_HEADS, A_KV_HEADS, None)
        o_a = attend_blocked(qa, jnp.concatenate([kac, ka], axis=1), jnp.concatenate([vac, va], axis=1))

        qb, kb, vb = mla_heads(bcq, bckv, bkr, b_cq_norm[l], b_ckv_norm[l], w_uq[l], w_ukv[l],
                               b_qn_norm[l], b_kn_norm[l], b_qr_norm[l], b_kr_norm[l], rope_b)
        qbc, kbc, vbc = mla_heads(bcqc, bckvc, bkrc, b_cq_norm[l], b_ckv_norm[l], w_uq[l], w_ukv[l],
                                  b_qn_norm[l], b_kn_norm[l], b_qr_norm[l], b_kr_norm[l], None)
        o_b = attend_blocked(qb, jnp.concatenate([kbc, kb], axis=1), jnp.concatenate([vbc, vb], axis=1))

        qc, kc, vc = gqa_heads(cq, ck, cv, c_q_norm[l], c_k_norm[l], C_HEADS, C_KV_HEADS, rope_hd)
        qcc, kcc, vcc = gqa_heads(cqc, ckc, cvc, c_q_norm[l], c_k_norm[l], C_HEADS, C_KV_HEADS, None)
        o_c = attend_window(qc, kc, vc, kcc, vcc, c_sink[l])

        x = x + g1 * (jnp.concatenate([o_a, o_b, o_c], axis=-1) @ w_out[l])
        if not last:
            o_ctx = jnp.concatenate([attend(qac, kac, vac), attend(qbc, kbc, vbc),
                                     attend_sink(qcc, kcc, vcc, c_sink[l])], axis=-1) @ w_out[l]
            ctx = ctx + cg1 * o_ctx

        h2 = modulate(rms_norm(x, norm2_g[l]), sh2, sc2)
        x = x + g2 * expert_choice_ffn(h2, w_router[l], w_e_gate[l], w_e_up[l], w_e_down[l])
        if not last:
            hc2 = modulate(rms_norm(ctx, norm2_g[l]), csh2, csc2)
            ctx = ctx + cg2 * expert_choice_ffn(hc2, w_router[l], w_e_gate[l], w_e_up[l], w_e_down[l])
    return x
```

```cpp
#include <hip/hip_runtime.h>
#include <stdint.h>
#include <stdio.h>
#include <math.h>

constexpr int DEPTH = 2;
namespace nv {

__device__ __forceinline__ float silu_f(float v) { return v / (1.f + expf(-v)); }

__global__ void rope_tab_kernel(float2* tab64, float2* tab32) {
    int i = blockIdx.x * blockDim.x + threadIdx.x;
    if (i < 64 * 16) { int pos = i / 16, f = i % 16; double inv = pow(10000.0, -(double)(2 * f) / 32.0); double a = (double)pos * inv; tab64[i] = make_float2((float)cos(a), (float)sin(a)); }
    if (i < 64 * 8)  { int pos = i / 8,  f = i % 8;  double inv = pow(10000.0, -(double)(2 * f) / 16.0); double a = (double)pos * inv; tab32[i] = make_float2((float)cos(a), (float)sin(a)); }
}

__global__ void mod_kernel(const float* c, const float* c_ctx, const float* w_ada, const float* b_ada, float* mod) {
    int col = blockIdx.x * 256 + threadIdx.x, r = blockIdx.y, l = blockIdx.z;
    const float* cv = r < 8 ? c + r * 1024 : c_ctx;
    const float* w = w_ada + (size_t)l * 1024 * 6144 + col;
    float acc = 0.f;
    for (int k = 0; k < 1024; ++k) acc += silu_f(cv[k]) * w[(size_t)k * 6144];
    mod[((size_t)l * 9 + r) * 6144 + col] = acc + b_ada[l * 6144 + col];
}

__global__ void norm_mod_kernel(const float* xs, const float* cs, const float* g, const float* ml, const float* mc, int sh_off, int sc_off, float* H) {
    int r = blockIdx.x; const float* x = r < 4096 ? xs + (size_t)r * 1024 : cs + (size_t)(r - 4096) * 1024;
    const float* m = r < 4096 ? ml : mc;
    __shared__ float red[256];
    float v[4]; float s = 0.f;
#pragma unroll
    for (int i = 0; i < 4; ++i) { v[i] = x[threadIdx.x + 256 * i]; s += v[i] * v[i]; }
    red[threadIdx.x] = s; __syncthreads();
    for (int o = 128; o > 0; o >>= 1) { if (threadIdx.x < o) red[threadIdx.x] += red[threadIdx.x + o]; __syncthreads(); }
    float rstd = 1.0f / sqrtf(red[0] / 1024.f + 1e-6f);
#pragma unroll
    for (int i = 0; i < 4; ++i) { int cidx = threadIdx.x + 256 * i; H[(size_t)r * 1024 + cidx] = v[i] * rstd * g[cidx] * (1.f + m[sc_off + cidx]) + m[sh_off + cidx]; }
}

__global__ void __launch_bounds__(256) gemm_kernel(const float* A, int lda, const int* gidx, int zrowsA, const float* B, int ldb, size_t strideB, float* C, int ldc, size_t strideC, int M, int N, int K) {
    __shared__ float As[16][65]; __shared__ float Bs[16][65];
    const int tid = threadIdx.x, tx = tid % 16, ty = tid / 16, z = blockIdx.z;
    const int m0 = blockIdx.y * 64, n0 = blockIdx.x * 64;
    B += (size_t)z * strideB; C += (size_t)z * strideC;
    float acc[4][4];
#pragma unroll
    for (int i = 0; i < 4; ++i)
#pragma unroll
        for (int j = 0; j < 4; ++j) acc[i][j] = 0.f;
    for (int k0 = 0; k0 < K; k0 += 16) {
#pragma unroll
        for (int i = 0; i < 4; ++i) { int e = tid + 256 * i, r = e / 16, kk = e % 16, row = m0 + r; float val = 0.f;
            if (row < M) { int src = gidx ? gidx[z * M + row] : z * zrowsA + row; val = A[(size_t)src * lda + k0 + kk]; } As[kk][r] = val; }
#pragma unroll
        for (int i = 0; i < 4; ++i) { int e = tid + 256 * i, kk = e / 64, cc = e % 64; Bs[kk][cc] = (n0 + cc < N) ? B[(size_t)(k0 + kk) * ldb + n0 + cc] : 0.f; }
        __syncthreads();
#pragma unroll
        for (int kk = 0; kk < 16; ++kk) { float a[4], b[4];
#pragma unroll
            for (int i = 0; i < 4; ++i) { a[i] = As[kk][ty * 4 + i]; b[i] = Bs[kk][tx * 4 + i]; }
#pragma unroll
            for (int i = 0; i < 4; ++i)
#pragma unroll
                for (int j = 0; j < 4; ++j) acc[i][j] += a[i] * b[j]; }
        __syncthreads();
    }
#pragma unroll
    for (int i = 0; i < 4; ++i) { int row = m0 + ty * 4 + i; if (row < M)
#pragma unroll
        for (int j = 0; j < 4; ++j) { int col = n0 + tx * 4 + j; if (col < N) C[(size_t)row * ldc + col] = acc[i][j]; } }
}

__global__ void headnorm_kernel(float* P, int ld, int off, int nh, int hstride, int w, const float* gain, int rope, const float2* tab, int nrows) {
    int i = blockIdx.x * blockDim.x + threadIdx.x; if (i >= nrows * nh) return;
    int row = i / nh, h = i % nh; float* v = P + (size_t)row * ld + off + h * hstride;
    float s = 0.f; for (int j = 0; j < w; ++j) s += v[j] * v[j];
    float rstd = 1.0f / sqrtf(s / (float)w + 1e-6f);
    if (rope && row < 4096) {
        int a = w / 2, half = w / 4, pr = row / 64, pc = row % 64;
        for (int ax = 0; ax < 2; ++ax) { int pos = ax == 0 ? pr : pc;
            for (int j = 0; j < half; ++j) { float2 cs = tab[pos * half + j];
                float x1 = v[ax * a + j] * rstd * gain[ax * a + j], x2 = v[ax * a + half + j] * rstd * gain[ax * a + half + j];
                v[ax * a + j] = x1 * cs.x - x2 * cs.y; v[ax * a + half + j] = x2 * cs.x + x1 * cs.y; } }
    } else { for (int j = 0; j < w; ++j) v[j] = v[j] * rstd * gain[j]; }
}

struct AttnArgs { const float* Q; int ldq, qhs; const float* K1; int ldk1, k1hs; const float* K2; int ldk2; const float* V; int ldv, vhs; float* O; int ldo; int nheads, group; const float* sink; float scale; };
template <int DQ, int MODE>
__global__ void __launch_bounds__(256) attn_kernel(AttnArgs a) {
    __shared__ float Ks[32][DQ]; __shared__ float Vs[32][64];
    const int tid = threadIdx.x, h = blockIdx.y, kvh = h / a.group;
    const int qrow = (MODE == 2 ? 4096 : 0) + blockIdx.x * 256 + tid;
    float q[DQ];
#pragma unroll
    for (int d = 0; d < DQ; ++d) q[d] = a.Q[(size_t)qrow * a.ldq + h * a.qhs + d];
    float o[64];
#pragma unroll
    for (int d = 0; d < 64; ++d) o[d] = 0.f;
    float m = -1e30f, l = 0.f;
    const bool has_sink = (a.sink != nullptr);
    if (has_sink) { m = a.sink[h]; l = 1.f; }
    int lo = 0, hi = 0;
    if (MODE == 0) { lo = 0; hi = 4096; }
    if (MODE == 1) { int q0 = blockIdx.x * 256; lo = q0 - 128 < 0 ? 0 : q0 - 128; hi = q0 + 256 + 128 > 4096 ? 4096 : q0 + 256 + 128; }
    for (int seg = 0; seg < 2; ++seg) {
        int kb = seg == 0 ? 4096 : lo, ke = seg == 0 ? 4352 : hi;
        for (int k0 = kb; k0 < ke; k0 += 32) {
            __syncthreads();
            for (int e = tid; e < 32 * DQ; e += 256) { int kk = e / DQ, d = e % DQ; int krow = k0 + kk;
                float val = (d < 64) ? a.K1[(size_t)krow * a.ldk1 + kvh * a.k1hs + d] : a.K2[(size_t)krow * a.ldk2 + (d - 64)]; Ks[kk][d] = val; }
            for (int e = tid; e < 32 * 64; e += 256) { int kk = e / 64, d = e % 64; Vs[kk][d] = a.V[(size_t)(k0 + kk) * a.ldv + kvh * a.vhs + d]; }
            __syncthreads();
            float s[32]; float tm = m;
#pragma unroll
            for (int kk = 0; kk < 32; ++kk) { float acc = 0.f;
#pragma unroll
                for (int d = 0; d < DQ; ++d) acc += q[d] * Ks[kk][d];
                acc *= a.scale;
                if (MODE == 1 && seg == 1) { int dist = (k0 + kk) - qrow; if (dist > 128 || dist < -128) acc = -1e30f; }
                s[kk] = acc; tm = fmaxf(tm, acc); }
            float corr = expf(m - tm); l *= corr;
#pragma unroll
            for (int d = 0; d < 64; ++d) o[d] *= corr;
            m = tm;
#pragma unroll
            for (int kk = 0; kk < 32; ++kk) { float p = (s[kk] <= -1e29f) ? 0.f : expf(s[kk] - m); l += p;
#pragma unroll
                for (int d = 0; d < 64; ++d) o[d] += p * Vs[kk][d]; }
        }
    }
    float inv = 1.f / l;
#pragma unroll
    for (int d = 0; d < 64; ++d) a.O[(size_t)qrow * a.ldo + h * 64 + d] = o[d] * inv;
}

__global__ void resid_kernel(float* xs, float* cs, const float* Y, const float* ml, const float* mc, int g_off, int nrows) {
    size_t i = (size_t)blockIdx.x * 256 + threadIdx.x; if (i >= (size_t)nrows * 1024) return;
    int r = (int)(i / 1024), cidx = (int)(i % 1024);
    if (r < 4096) xs[(size_t)r * 1024 + cidx] += ml[g_off + cidx] * Y[i]; else cs[(size_t)(r - 4096) * 1024 + cidx] += mc[g_off + cidx] * Y[i];
}

__global__ void router_kernel(const float* H, const float* wr, float* aff, int nrows) {
    int r = blockIdx.x * 4 + threadIdx.x / 64, lane = threadIdx.x % 64; if (r >= nrows) return;
    float acc[16];
#pragma unroll
    for (int e = 0; e < 16; ++e) acc[e] = 0.f;
    for (int k = lane; k < 1024; k += 64) { float hv = H[(size_t)r * 1024 + k];
#pragma unroll
        for (int e = 0; e < 16; ++e) acc[e] += hv * wr[k * 16 + e]; }
#pragma unroll
    for (int e = 0; e < 16; ++e) for (int o = 32; o > 0; o >>= 1) acc[e] += __shfl_xor(acc[e], o);
    float mx = acc[0];
#pragma unroll
    for (int e = 1; e < 16; ++e) mx = fmaxf(mx, acc[e]);
    float sum = 0.f;
#pragma unroll
    for (int e = 0; e < 16; ++e) { acc[e] = expf(acc[e] - mx); sum += acc[e]; }
    if (lane == 0) {
#pragma unroll
        for (int e = 0; e < 16; ++e) aff[(size_t)e * 4352 + r] = acc[e] / sum; }
}

__global__ void topk_kernel(const float* aff, int base, int n, int cap, int* idx, float* gate, int* inv) {
    int e = blockIdx.y, t = blockIdx.x * 256 + threadIdx.x; if (t >= n) return;
    const float* a = aff + (size_t)e * 4352 + base; float mine = a[t]; int rank = 0;
    for (int j = 0; j < n; ++j) { float o = a[j]; rank += (o > mine || (o == mine && j < t)) ? 1 : 0; }
    if (rank < cap) { idx[e * cap + rank] = base + t; gate[e * cap + rank] = mine; inv[e * 4352 + base + t] = rank; } else inv[e * 4352 + base + t] = -1;
}

__global__ void swiglu_kernel(float* G, const float* U, size_t n) { size_t i = (size_t)blockIdx.x * 256 + threadIdx.x; if (i < n) { float g = G[i]; G[i] = silu_f(g) * U[i]; } }

__global__ void combine_kernel(float* xs, float* cs, const float* Y2, const float* gate, const int* inv, int base, int cap, const float* mrow, int g_off) {
    int r = base + blockIdx.x; float* x = r < 4096 ? xs + (size_t)r * 1024 : cs + (size_t)(r - 4096) * 1024;
    for (int cidx = threadIdx.x; cidx < 1024; cidx += 256) { float acc = 0.f;
        for (int e = 0; e < 16; ++e) { int s = inv[e * 4352 + r]; if (s >= 0) acc += gate[e * cap + s] * Y2[((size_t)e * cap + s) * 1024 + cidx]; }
        x[cidx] += mrow[g_off + cidx] * acc; }
}

struct Bufs { float *H, *P, *QB, *KVB, *O, *Y, *G, *U, *aff, *gate; int *idx, *inv; float2 *tab64, *tab32; float* mod; };
struct In { const float* p[27]; };

static void layer_sample(const In& in, const Bufs& B, int l, int b, float* xs, float* cs, hipStream_t st) {
    const bool last = (l == DEPTH - 1);
    const float* ml = B.mod + ((size_t)l * 9 + b) * 6144; const float* mc = B.mod + ((size_t)l * 9 + 8) * 6144;
    const int R = 4352, RO = last ? 4096 : 4352;
    norm_mod_kernel<<<R, 256, 0, st>>>(xs, cs, in.p[6] + l * 1024, ml, mc, 0, 1024, B.H);
    gemm_kernel<<<dim3((1504 + 63) / 64, R / 64, 1), 256, 0, st>>>(B.H, 1024, nullptr, 0, in.p[8] + (size_t)l * 1024 * 1504, 1504, 0, B.P, 1504, 0, R, 1504, 1024);
    auto hn = [&](float* P, int ld, int off, int nh, int hs, int w, const float* gain, int rope, const float2* tab) {
        int n = R * nh; headnorm_kernel<<<(n + 255) / 256, 256, 0, st>>>(P, ld, off, nh, hs, w, gain, rope, tab, R); };
    hn(B.P, 1504, 0, 6, 64, 64, in.p[9] + l * 64, 1, B.tab64);
    hn(B.P, 1504, 384, 2, 64, 64, in.p[10] + l * 64, 1, B.tab64);
    hn(B.P, 1504, 992, 4, 64, 64, in.p[19] + l * 64, 1, B.tab64);
    hn(B.P, 1504, 1248, 2, 64, 64, in.p[20] + l * 64, 1, B.tab64);
    hn(B.P, 1504, 960, 1, 32, 32, in.p[18] + l * 32, 1, B.tab32);
    hn(B.P, 1504, 640, 1, 192, 192, in.p[11] + l * 192, 0, nullptr);
    hn(B.P, 1504, 832, 1, 128, 128, in.p[12] + l * 128, 0, nullptr);
    gemm_kernel<<<dim3(576 / 64, R / 64, 1), 256, 0, st>>>(B.P + 640, 1504, nullptr, 0, in.p[13] + (size_t)l * 192 * 576, 576, 0, B.QB, 576, 0, R, 576, 192);
    gemm_kernel<<<dim3(768 / 64, R / 64, 1), 256, 0, st>>>(B.P + 832, 1504, nullptr, 0, in.p[14] + (size_t)l * 128 * 768, 768, 0, B.KVB, 768, 0, R, 768, 128);
    hn(B.QB, 576, 0, 6, 96, 64, in.p[15] + l * 64, 0, nullptr);
    hn(B.QB, 576, 64, 6, 96, 32, in.p[17] + l * 32, 1, B.tab32);
    hn(B.KVB, 768, 0, 6, 128, 64, in.p[16] + l * 64, 0, nullptr);
    AttnArgs aa{B.P + 0, 1504, 64, B.P + 384, 1504, 64, nullptr, 0, B.P + 512, 1504, 64, B.O + 0, 1024, 6, 3, nullptr, 0.125f};
    AttnArgs ab{B.QB, 576, 96, B.KVB, 768, 128, B.P + 960, 1504, B.KVB + 64, 768, 128, B.O + 384, 1024, 6, 1, nullptr, 1.0f / sqrtf(96.f)};
    AttnArgs ac{B.P + 992, 1504, 64, B.P + 1248, 1504, 64, nullptr, 0, B.P + 1376, 1504, 64, B.O + 768, 1024, 4, 2, in.p[21] + l * 4, 0.125f};
    attn_kernel<64, 0><<<dim3(16, 6), 256, 0, st>>>(aa);
    attn_kernel<96, 0><<<dim3(16, 6), 256, 0, st>>>(ab);
    attn_kernel<64, 1><<<dim3(16, 4), 256, 0, st>>>(ac);
    if (!last) {
        AttnArgs ax = aa; attn_kernel<64, 2><<<dim3(1, 6), 256, 0, st>>>(ax);
        AttnArgs bx = ab; attn_kernel<96, 2><<<dim3(1, 6), 256, 0, st>>>(bx);
        AttnArgs cx = ac; attn_kernel<64, 2><<<dim3(1, 4), 256, 0, st>>>(cx);
    }
    gemm_kernel<<<dim3(1024 / 64, RO / 64, 1), 256, 0, st>>>(B.O, 1024, nullptr, 0, in.p[22] + (size_t)l * 1024 * 1024, 1024, 0, B.Y, 1024, 0, RO, 1024, 1024);
    resid_kernel<<<(RO * 1024 + 255) / 256, 256, 0, st>>>(xs, cs, B.Y, ml, mc, 2048, RO);
    norm_mod_kernel<<<RO, 256, 0, st>>>(xs, cs, in.p[7] + l * 1024, ml, mc, 3072, 4096, B.H);
    router_kernel<<<(RO + 3) / 4, 256, 0, st>>>(B.H, in.p[23] + (size_t)l * 1024 * 16, B.aff, RO);
    for (int part = 0; part < (last ? 1 : 2); ++part) {
        const int base = part == 0 ? 0 : 4096, n = part == 0 ? 4096 : 256, cap = n / 8;
        topk_kernel<<<dim3((n + 255) / 256, 16), 256, 0, st>>>(B.aff, base, n, cap, B.idx, B.gate, B.inv);
        const size_t wst = (size_t)1024 * 1024;
        gemm_kernel<<<dim3(16, (cap + 63) / 64, 16), 256, 0, st>>>(B.H, 1024, B.idx, 0, in.p[24] + (size_t)l * 16 * wst, 1024, wst, B.G, 1024, (size_t)cap * 1024, cap, 1024, 1024);
        gemm_kernel<<<dim3(16, (cap + 63) / 64, 16), 256, 0, st>>>(B.H, 1024, B.idx, 0, in.p[25] + (size_t)l * 16 * wst, 1024, wst, B.U, 1024, (size_t)cap * 1024, cap, 1024, 1024);
        size_t ne = (size_t)16 * cap * 1024;
        swiglu_kernel<<<(unsigned)((ne + 255) / 256), 256, 0, st>>>(B.G, B.U, ne);
        gemm_kernel<<<dim3(16, (cap + 63) / 64, 16), 256, 0, st>>>(B.G, 1024, nullptr, cap, in.p[26] + (size_t)l * 16 * wst, 1024, wst, B.U, 1024, (size_t)cap * 1024, cap, 1024, 1024);
        combine_kernel<<<n, 256, 0, st>>>(xs, cs, B.U, B.gate, B.inv, base, cap, part == 0 ? ml : mc, 5120);
    }
}
}

extern "C" void kernel_launch(void* const* d_in, const int* in_sizes, int n_in, void* d_out, int out_size, void* d_ws, size_t ws_size, hipStream_t stream) {
    if (n_in != 27) { fprintf(stderr, "kernel_launch: expected 27 inputs, got %d\n", n_in); return; }
    nv::In in; for (int i = 0; i < 27; ++i) in.p[i] = (const float*)d_in[i];
    float* out = (float*)d_out;
    char* ws = (char*)d_ws; size_t off = 0;
    auto take = [&](size_t bytes) { char* p = ws + off; off += (bytes + 255) & ~(size_t)255; return p; };
    nv::Bufs B;
    B.mod = (float*)take((size_t)2 * 9 * 6144 * 4);
    B.tab64 = (float2*)take(64 * 16 * 8); B.tab32 = (float2*)take(64 * 8 * 8);
    float* ctxs = (float*)take((size_t)8 * 256 * 1024 * 4);
    B.H = (float*)take((size_t)4352 * 1024 * 4); B.P = (float*)take((size_t)4352 * 1504 * 4);
    B.QB = (float*)take((size_t)4352 * 576 * 4); B.KVB = (float*)take((size_t)4352 * 768 * 4);
    B.O = (float*)take((size_t)4352 * 1024 * 4); B.Y = (float*)take((size_t)4352 * 1024 * 4);
    B.G = (float*)take((size_t)8192 * 1024 * 4); B.U = (float*)take((size_t)8192 * 1024 * 4);
    B.aff = (float*)take((size_t)16 * 4352 * 4); B.gate = (float*)take(16 * 512 * 4);
    B.idx = (int*)take(16 * 512 * 4); B.inv = (int*)take((size_t)16 * 4352 * 4);
    if (off > ws_size) { fprintf(stderr, "kernel_launch: workspace too small (%zu > %zu)\n", off, ws_size); return; }
    (void)hipMemcpyAsync(out, in.p[0], (size_t)8 * 4096 * 1024 * 4, hipMemcpyDeviceToDevice, stream);
    (void)hipMemcpyAsync(ctxs, in.p[2], (size_t)8 * 256 * 1024 * 4, hipMemcpyDeviceToDevice, stream);
    nv::rope_tab_kernel<<<4, 256, 0, stream>>>(B.tab64, B.tab32);
    nv::mod_kernel<<<dim3(24, 9, 2), 256, 0, stream>>>(in.p[1], in.p[3], in.p[4], in.p[5], B.mod);
    for (int l = 0; l < DEPTH; ++l)
        for (int b = 0; b < 8; ++b)
            nv::layer_sample(in, B, l, b, out + (size_t)b * 4096 * 1024, ctxs + (size_t)b * 256 * 1024, stream);
}
```

```cpp
#include <hip/hip_runtime.h>
#include <stdint.h>
#include <stdio.h>
#include <math.h>
constexpr int DEPTH = 2;
#define FAST_NB 8
namespace fp {
#define LAS __attribute__((address_space(3)))
#define GAS __attribute__((address_space(1)))
typedef unsigned short bf16_t;
typedef short bf16x8 __attribute__((ext_vector_type(8)));
typedef short s16x4 __attribute__((ext_vector_type(4)));
typedef float f32x4 __attribute__((ext_vector_type(4)));
typedef float f32x16 __attribute__((ext_vector_type(16)));
typedef unsigned u32x4 __attribute__((ext_vector_type(4)));
typedef unsigned u32x2 __attribute__((ext_vector_type(2)));
typedef float f32x2 __attribute__((ext_vector_type(2)));
#define DI __device__ __forceinline__

DI unsigned cvt_pk(float lo, float hi) { typedef float f2 __attribute__((ext_vector_type(2))); typedef __bf16 b2 __attribute__((ext_vector_type(2))); f2 v = {lo, hi}; b2 b = __builtin_convertvector(v, b2); return __builtin_bit_cast(unsigned, b); }
DI float bf_lo(unsigned w) { return __uint_as_float(w << 16); }
DI float bf_hi(unsigned w) { return __uint_as_float(w & 0xffff0000u); }
DI float silu_f(float v) { return v / (1.f + __expf(-v)); }
DI float wave_sum(float v) {
#pragma unroll
    for (int o = 1; o < 64; o <<= 1) v += __shfl_xor(v, o);
    return v; }

constexpr int NB = FAST_NB;
constexpr int LAT = NB * 4096, CTXR = NB * 256, R = LAT + CTXR, MT = R / 256;
constexpr int MOE_LAT = NB * 16 * 512, MOE_ROWS = MOE_LAT + 16 * 256;
constexpr float EPS = 1e-6f, LOG2E = 1.4426950408889634f;
constexpr float QS64 = 0.125f * LOG2E, QS96 = 0.10206207261596575f * LOG2E;
constexpr int NWAVES = 8, NTHR = 512;

constexpr size_t al256(size_t x) { return (x + 255) & ~(size_t)255; }
constexpr size_t WS_CTL = 0, CTL_BYTES = 65536;
constexpr size_t WS_MOD = WS_CTL + CTL_BYTES;
constexpr size_t WS_TAB64 = WS_MOD + al256((size_t)2 * 9 * 6144 * 4);
constexpr size_t WS_TAB32 = WS_TAB64 + 8192;
constexpr size_t WS_WIN = WS_TAB32 + 4096;
constexpr size_t WS_WUP = WS_WIN + (size_t)2 * 1536 * 1024 * 2;
constexpr size_t WS_WOUT = WS_WUP + (size_t)2 * 1536 * 384 * 2;
constexpr size_t WS_W1 = WS_WOUT + (size_t)2 * 1024 * 1024 * 2;
constexpr size_t WS_W2 = WS_W1 + (size_t)2 * 16 * 2048 * 1024 * 2;
constexpr size_t WS_HB = WS_W2 + (size_t)2 * 16 * 1024 * 1024 * 2;
constexpr size_t WS_CTXF = WS_HB + (size_t)R * 1024 * 2;
constexpr size_t WS_SSQ = WS_CTXF + (size_t)CTXR * 1024 * 4;
constexpr size_t WS_AFFL = WS_SSQ + (size_t)R * 8 * 4;
constexpr size_t WS_AFFC = WS_AFFL + (size_t)NB * 16 * 4096 * 4;
constexpr size_t WS_GIDX = WS_AFFC + (size_t)NB * 16 * 256 * 4;
constexpr size_t WS_GATE = WS_GIDX + (size_t)MOE_ROWS * 4;
constexpr size_t WS_INV = WS_GATE + (size_t)MOE_ROWS * 4;
constexpr size_t WS_Z = al256(WS_INV + (size_t)R * 16 * 4);
constexpr size_t Z_QA = WS_Z, Z_KA = Z_QA + (size_t)R * 384 * 2, Z_VA = Z_KA + (size_t)R * 128 * 2, Z_QC = Z_VA + (size_t)R * 128 * 2, Z_KC = Z_QC + (size_t)R * 256 * 2,
                 Z_VC = Z_KC + (size_t)R * 128 * 2, Z_CRAW = Z_VC + (size_t)R * 128 * 2, Z_QB = Z_CRAW + (size_t)R * 384 * 2, Z_KB = Z_QB + (size_t)R * 576 * 2,
                 Z_VB = Z_KB + (size_t)R * 576 * 2, Z_OB = Z_VB + (size_t)R * 384 * 2, Z_END1 = Z_OB + (size_t)R * 1024 * 2;
constexpr size_t Z_HID = WS_Z, Z_YE = Z_HID + (size_t)MOE_ROWS * 1024 * 2, Z_END2 = Z_YE + (size_t)MOE_ROWS * 1024 * 2;
constexpr size_t WS_END = al256(Z_END1 > Z_END2 ? Z_END1 : Z_END2);
constexpr int CW_BAR = 1024;
constexpr int CW_QUEUE = 8192;

constexpr int RING_BYTES = 131072;
constexpr int LDS_TAB64 = RING_BYTES, LDS_TAB32 = LDS_TAB64 + 8192, LDS_MISC = LDS_TAB32 + 4096;
constexpr int LDS_INTAB = LDS_MISC + 256;
constexpr int LDS_BYTES = 147456;

#define XB_TMO      128
#define XB_XCNT(j)  (256  + 64 * (j))
#define XB_XSUB(j)  (1280 + 64 * (j))
#define XB_XGEN(j)  (2304 + 64 * (j))
#define XB_TOP      3328
#define XB_TOPGEN   3392
#define XCD_BAR_WORDS 3456
#define XB_SPIN_CAP (1u << 20)
DI unsigned xb_ld(unsigned* p)              { return __hip_atomic_load(p, __ATOMIC_RELAXED, __HIP_MEMORY_SCOPE_AGENT); }
DI unsigned xb_add(unsigned* p, unsigned v) { return __hip_atomic_fetch_add(p, v, __ATOMIC_RELAXED, __HIP_MEMORY_SCOPE_AGENT); }
DI unsigned xb_xcc_id() { return (unsigned)__builtin_amdgcn_s_getreg((3 << 11) | 20) & 0xFu; }
#define XB_SPIN(cond, bar) do { unsigned _sp = 0; while (cond) { __builtin_amdgcn_s_sleep(1); \
    if ((++_sp & 255u) == 0u) { if (xb_ld(&(bar)[XB_TMO])) break; if (_sp > XB_SPIN_CAP) { atomicAdd(&(bar)[XB_TMO], 1u); break; } } } } while (0)
struct XcdBarrier { unsigned* bar; unsigned x; volatile LAS unsigned* st; };
DI XcdBarrier xcd_barrier_post(unsigned* bar, volatile LAS unsigned* st) {
    XcdBarrier b; b.bar = bar; b.x = xb_xcc_id(); b.st = st;
    if (threadIdx.x == 0) (void)xb_add(&bar[XB_XCNT(b.x)], 1u);
    return b;
}
DI void xcd_barrier_complete(unsigned* bar, unsigned x, unsigned& nloc, unsigned& nx) {
    asm volatile("" : "+s"(x));
    const unsigned G = gridDim.x * gridDim.y * gridDim.z;
    unsigned sum, cnt, mine, sp = 0u;
    for (;;) {
        sum = 0u; cnt = 0u; mine = 0u;
#pragma unroll
        for (unsigned j = 0; j < 16; ++j) { const unsigned c = xb_ld(&bar[XB_XCNT(j)]); sum += c; cnt += (c > 0u) ? 1u : 0u; mine = (j == x) ? c : mine; }
        if (sum == G) break;
        __builtin_amdgcn_s_sleep(1);
        if ((++sp & 255u) == 0u) { if (xb_ld(&bar[XB_TMO])) break; if (sp > XB_SPIN_CAP) { atomicAdd(&bar[XB_TMO], 1u); break; } }
    }
    nloc = mine > 0u ? mine : 1u; nx = cnt > 0u ? cnt : 1u;
}
DI void xcd_barrier(const XcdBarrier& b) {
    asm volatile("s_waitcnt vmcnt(0)" ::: "memory");
    __syncthreads();
    if (threadIdx.x == 0) {
        unsigned* bar = b.bar; asm volatile("" : "+s"(bar));
        __builtin_amdgcn_s_waitcnt(0);
        unsigned nloc = b.st[0], nx = b.st[1];
        if (nloc == 0u) { xcd_barrier_complete(bar, b.x, nloc, nx); b.st[0] = nloc; b.st[1] = nx; }
        const unsigned old = xb_add(&bar[XB_XSUB(b.x)], 1u);
        const unsigned gen = old / nloc;
        if (old + 1u == (gen + 1u) * nloc) {
            __builtin_amdgcn_fence(__ATOMIC_RELEASE, "agent");
            asm volatile("s_waitcnt vmcnt(0)" ::: "memory");
            const unsigned og = xb_add(&bar[XB_TOP], 1u);
            const unsigned tg = og / nx;
            if (og + 1u == (tg + 1u) * nx) xb_add(&bar[XB_TOPGEN], 1u);
            else XB_SPIN(xb_ld(&bar[XB_TOPGEN]) == tg, bar);
            __builtin_amdgcn_fence(__ATOMIC_ACQUIRE, "agent");
            xb_add(&bar[XB_XGEN(b.x)], 1u);
            asm volatile("s_waitcnt vmcnt(0)" ::: "memory");
        } else {
            XB_SPIN(xb_ld(&bar[XB_XGEN(b.x)]) == gen, bar);
            __builtin_amdgcn_fence(__ATOMIC_ACQUIRE, "agent");
            asm volatile("s_waitcnt vmcnt(0)" ::: "memory");
        }
    }
    __syncthreads();
}

struct Args { const float* in[27]; float* out; unsigned char* ws; int ph_lo, ph_hi; };
struct Frame {
    LAS unsigned char* lds; unsigned char* ws; unsigned* ctl;
    int tid, lane, wave, G, bid;
    const LAS unsigned long long* intab; float* out;
};
DI const float* inp(const LAS unsigned long long* tab, int k) { const unsigned long long v = tab[k]; const unsigned lo = __builtin_amdgcn_readfirstlane((unsigned)v), hi = __builtin_amdgcn_readfirstlane((unsigned)(v >> 32)); return (const float*)(((unsigned long long)hi << 32) | lo); }
#define INP(k) inp(F.intab, k)
#define WSP(T, off) ((T*)(F.ws + (off)))

DI void mod_item(const Frame& F, int item, const LAS float* s9, LAS float* red) {
    const int l = item / 96, c0 = (item % 96) * 64;
    const float* W = INP(4) + (size_t)l * 1024 * 6144 + c0;
    const int cg = F.lane & 15, ks = F.wave * 4 + (F.lane >> 4);
    f32x4 acc[9];
#pragma unroll
    for (int r = 0; r < 9; ++r) acc[r] = (f32x4){0.f, 0.f, 0.f, 0.f};
#pragma unroll 4
    for (int i = 0; i < 32; ++i) { const int k = ks + 32 * i; const f32x4 w = *(const f32x4*)(W + (size_t)k * 6144 + cg * 4);
#pragma unroll
        for (int r = 0; r < 9; ++r) acc[r] += w * s9[r * 1024 + k]; }
#pragma unroll
    for (int r = 0; r < 9; ++r)
#pragma unroll
        for (int j = 0; j < 4; ++j) { float v = acc[r][j]; v += __shfl_xor(v, 16); v += __shfl_xor(v, 32); acc[r][j] = v; }
    __syncthreads();
    if (F.lane < 16) {
#pragma unroll
        for (int r = 0; r < 9; ++r) *(LAS f32x4*)(red + (F.wave * 9 + r) * 64 + cg * 4) = acc[r]; }
    __syncthreads();
    for (int e = F.tid; e < 9 * 64; e += NTHR) { const int r = e / 64, c = e % 64; float s = 0.f;
#pragma unroll
        for (int w = 0; w < 8; ++w) s += red[(w * 9 + r) * 64 + c];
        WSP(float, WS_MOD)[((size_t)l * 9 + r) * 6144 + c0 + c] = s + INP(5)[l * 6144 + c0 + c]; }
}

DI void tr_item(const float* src, int ld, const float* ksc, bf16_t* dst, int Kd, int n0, int k0, LAS float* scr, int lane) {
    const int c = lane & 7;
    if (src == nullptr) {
#pragma unroll
        for (int j = 0; j < 4; ++j) { const int n = (lane >> 3) + 8 * j; *(u32x4*)(dst + (size_t)(n0 + n) * Kd + k0 + 8 * c) = (u32x4){0u, 0u, 0u, 0u}; }
        return; }
#pragma unroll 8
    for (int i = 0; i < 32; ++i) { const int kk = 2 * i + (lane >> 5); float v = src[(size_t)kk * ld + (lane & 31)]; if (ksc) v *= ksc[kk]; scr[kk * 33 + (lane & 31)] = v; }
    asm volatile("s_waitcnt lgkmcnt(0)" ::: "memory");
#pragma unroll
    for (int j = 0; j < 4; ++j) { const int n = (lane >> 3) + 8 * j; const LAS float* s = scr + (8 * c) * 33 + n;
        u32x4 o; o.x = cvt_pk(s[0 * 33], s[1 * 33]); o.y = cvt_pk(s[2 * 33], s[3 * 33]); o.z = cvt_pk(s[4 * 33], s[5 * 33]); o.w = cvt_pk(s[6 * 33], s[7 * 33]);
        *(u32x4*)(dst + (size_t)(n0 + n) * Kd + k0 + 8 * c) = o; }
    asm volatile("s_waitcnt lgkmcnt(0)" ::: "memory");
}
constexpr int CV_WIN = 768, CV_WUP = 288, CV_WOUT = 512, CV_W1 = 16384, CV_W2 = 8192, CV_LAYER = CV_WIN + CV_WUP + CV_WOUT + CV_W1 + CV_W2;
DI void conv_item(const Frame& F, int it, LAS float* scr) {
    const int l = it / CV_LAYER; int r = it % CV_LAYER; const int lane = F.lane;
    if (r < CV_WIN) {
        const int kb = r / 48, g = r % 48, x = ((g >> 3) * 4 + (g & 3)) * 64 + 32 * ((g >> 2) & 1);
        const int sc = x < 960 ? x : (x < 1472 ? x + 32 : (x < 1504 ? x - 512 : -1));
        const float* src = sc < 0 ? nullptr : INP(8) + (size_t)l * 1024 * 1504 + (size_t)(kb * 64) * 1504 + sc;
        tr_item(src, 1504, nullptr, WSP(bf16_t, WS_WIN) + (size_t)l * 1536 * 1024, 1024, g * 32, kb * 64, scr, lane); return; }
    r -= CV_WIN;
    if (r < CV_WUP) {
        const int kb = r / 48, g = r % 48, slot = (g >> 3) * 4 + (g & 3), half = (g >> 2) & 1;
        const float* src = nullptr; const float* ksc = nullptr; int ld = 0;
        if (slot < 9 && kb < 3) { const int col = slot < 6 ? slot * 96 + 32 * half : (2 * (slot - 6) + half) * 96 + 64;
            src = INP(13) + (size_t)l * 192 * 576 + (size_t)(kb * 64) * 576 + col; ld = 576; ksc = INP(11) + l * 192 + kb * 64; }
        else if (slot >= 12 && (kb == 3 || kb == 4)) { const int h = slot < 18 ? slot - 12 : slot - 18; const int col = h * 128 + (slot < 18 ? 0 : 64) + 32 * half;
            src = INP(14) + (size_t)l * 128 * 768 + (size_t)((kb - 3) * 64) * 768 + col; ld = 768; ksc = INP(12) + l * 128 + (kb - 3) * 64; }
        tr_item(src, ld, ksc, WSP(bf16_t, WS_WUP) + (size_t)l * 1536 * 384, 384, g * 32, kb * 64, scr, lane); return; }
    r -= CV_WUP;
    if (r < CV_WOUT) { const int kb = r / 32, g = r % 32;
        tr_item(INP(22) + (size_t)l * 1024 * 1024 + (size_t)(kb * 64) * 1024 + g * 32, 1024, nullptr, WSP(bf16_t, WS_WOUT) + (size_t)l * 1024 * 1024, 1024, g * 32, kb * 64, scr, lane); return; }
    r -= CV_WOUT;
    if (r < CV_W1) { const int e = r / 1024, q = r % 1024, kb = q / 64, g = q % 64, pn = g >> 3, bj = (g >> 2) & 1, wc = g & 3;
        const float* src = (bj ? INP(25) : INP(24)) + ((size_t)l * 16 + e) * 1024 * 1024 + (size_t)(kb * 64) * 1024 + 128 * pn + 32 * wc;
        tr_item(src, 1024, nullptr, WSP(bf16_t, WS_W1) + ((size_t)l * 16 + e) * 2048 * 1024, 1024, g * 32, kb * 64, scr, lane); return; }
    r -= CV_W1;
    { const int e = r / 512, q = r % 512, kb = q / 32, g = q % 32;
        tr_item(INP(26) + ((size_t)l * 16 + e) * 1024 * 1024 + (size_t)(kb * 64) * 1024 + g * 32, 1024, nullptr, WSP(bf16_t, WS_W2) + ((size_t)l * 16 + e) * 1024 * 1024, 1024, g * 32, kb * 64, scr, lane); }
}
DI void p0_phase(const Frame& F) {
    LAS float* s9 = (LAS float*)F.lds;
    LAS float* red = (LAS float*)(F.lds + 9 * 1024 * 4);
    if (F.bid == 0) {
        for (int i = F.tid; i < 64 * 16; i += NTHR) { const int pos = i / 16, f = i % 16; const float inv = exp2f(-(float)(2 * f) / 32.f * 13.287712379549449f); const float a = (float)pos * inv; WSP(f32x2, WS_TAB64)[i] = (f32x2){cosf(a), sinf(a)}; }
        for (int i = F.tid; i < 64 * 8; i += NTHR) { const int pos = i / 8, f = i % 8; const float inv = exp2f(-(float)(2 * f) / 16.f * 13.287712379549449f); const float a = (float)pos * inv; WSP(f32x2, WS_TAB32)[i] = (f32x2){cosf(a), sinf(a)}; }
    }
    bool have_s9 = false;
    for (int it = F.bid; it < 192; it += F.G) {
        if (!have_s9) { for (int e = F.tid; e < 9 * 1024; e += NTHR) { const int r = e / 1024, k = e % 1024; const float v = r < 8 ? INP(1)[r * 1024 + k] : INP(3)[k]; s9[e] = silu_f(v); } have_s9 = true; __syncthreads(); }
        mod_item(F, it, s9, red);
    }
    __syncthreads();
    LAS float* scr = (LAS float*)(F.lds + F.wave * 16384);
    const int gw = F.bid * NWAVES + F.wave, NGW = F.G * NWAVES;
    for (int it = gw; it < 2 * CV_LAYER; it += NGW) conv_item(F, it, scr);
}

DI void norm_mod_store(const f32x4 (&v)[4], const float* g, const float* sh, const float* sc, bf16_t* orow, int lane) {
    float s = 0.f;
#pragma unroll
    for (int j = 0; j < 4; ++j) s += (v[j].x * v[j].x + v[j].y * v[j].y) + (v[j].z * v[j].z + v[j].w * v[j].w);
    const float rstd = 1.0f / sqrtf(wave_sum(s) * (1.f / 1024.f) + EPS);
#pragma unroll
    for (int j = 0; j < 4; ++j) { const int c = 4 * (lane + 64 * j); const f32x4 gv = *(const f32x4*)(g + c), sv = *(const f32x4*)(sh + c), cv = *(const f32x4*)(sc + c);
        const f32x4 o = v[j] * rstd * gv * (cv + 1.0f) + sv; u32x2 w; w.x = cvt_pk(o.x, o.y); w.y = cvt_pk(o.z, o.w); *(u32x2*)(orow + c) = w; }
}
DI const float* mod_row(const Frame& F, int l, int row) { const int r = row < LAT ? row / 4096 : 8; return WSP(float, WS_MOD) + ((size_t)l * 9 + r) * 6144; }
DI void init_norm_phase(const Frame& F) {
    const int gw = F.bid * NWAVES + F.wave, NGW = F.G * NWAVES;
    for (int row = gw; row < R; row += NGW) {
        const float* xr = row < LAT ? INP(0) + (size_t)row * 1024 : INP(2) + (size_t)(row - LAT) * 1024;
        f32x4 v[4];
#pragma unroll
        for (int j = 0; j < 4; ++j) v[j] = *(const f32x4*)(xr + 4 * (F.lane + 64 * j));
        const float* m = mod_row(F, 0, row);
        norm_mod_store(v, INP(6), m, m + 1024, WSP(bf16_t, WS_HB) + (size_t)row * 1024, F.lane);
    }
}
namespace g8 {
constexpr int BM = 256, BK = 64, HALF = 128, HTB = HALF * BK * 2, STAGE_BYTES = 8 * HTB;
DI int lds_byte(int r, int c) { const int st = (r >> 4) * 2 + (c >> 5), rr = r & 15, cc = c & 31, ob = rr * 64 + cc * 2; return st * 1024 + (ob ^ (((ob >> 9) & 1) << 5)); }
DI void stage_rc(int b, int& Rr, int& Cc) { const int st = b / 1024, sb = b % 1024, swz = sb ^ (((sb >> 9) & 1) << 5); Rr = (st >> 1) * 16 + swz / 64; Cc = (st & 1) * 32 + (swz % 64) / 2; }
DI int perm32(int rho) { const int n = rho >> 4, i = rho & 15; return 8 * (i >> 2) + 4 * n + (i & 3); }

struct Unit { int pm, pn, aux; const char* Bp; };

template <class Epi, class Sched>
DI void gemm_phase(const int tid, LAS unsigned char* lds, const char* Abase, int K, const Sched& S, const Epi& E) {
    asm volatile("" : "+s"(K));
    const int wid = __builtin_amdgcn_readfirstlane(tid >> 6), lane = tid & 63, wr = wid >> 2, wc = wid & 3, fr = lane & 15, fq = lane >> 4;
    const int nt = K / BK;
    int Rr[2], Cc[2]; unsigned voffB[2];
#pragma unroll
    for (int i = 0; i < 2; ++i) { int r_, c_; stage_rc(tid * 16 + i * 8192, r_, c_); Rr[i] = r_; Cc[i] = c_; const int Rb = Epi::PERM ? ((r_ & ~31) + perm32(r_ & 31)) : r_; voffB[i] = (unsigned)(Rb * K + c_) * 2u; }
    const size_t hstepB = (size_t)HALF * K * 2;
    const unsigned ldsw = (unsigned)wid * 1024u;
    const int aoff = lds_byte(wr * 64 + fr, fq * 8), boff = lds_byte(wc * 32 + fr, fq * 8);
#define G8_SA(b, h) (((b) * 2 + (h)) * HTB)
#define G8_SB(b, h) ((4 + (b) * 2 + (h)) * HTB)
#define G8_STAGE_A(bufoff, ao2, kt) do { _Pragma("unroll") for (int _i = 0; _i < 2; ++_i) \
        __builtin_amdgcn_global_load_lds((const unsigned*)(Abase + (size_t)(ao2)[_i] + (size_t)(kt) * 128), (LAS unsigned*)(lds + (bufoff) + ldsw + _i * 8192), 16, 0, 0); } while (0)
#define G8_STAGE_B(bufoff, bp, h, kt) do { _Pragma("unroll") for (int _i = 0; _i < 2; ++_i) \
        __builtin_amdgcn_global_load_lds((const unsigned*)((bp) + (size_t)(h) * hstepB + voffB[_i] + (size_t)(kt) * 128), (LAS unsigned*)(lds + (bufoff) + ldsw + _i * 8192), 16, 0, 0); } while (0)
#define G8_LDA(dst, b, h) do { _Pragma("unroll") for (int m = 0; m < 4; ++m) _Pragma("unroll") for (int k = 0; k < 2; ++k) dst[m][k] = *(const LAS bf16x8*)(lds + G8_SA(b, h) + aoff + m * 2048 + k * 1024); } while (0)
#define G8_LDB(dst, b, h) do { _Pragma("unroll") for (int n = 0; n < 2; ++n) _Pragma("unroll") for (int k = 0; k < 2; ++k) dst[n][k] = *(const LAS bf16x8*)(lds + G8_SB(b, h) + boff + n * 2048 + k * 1024); } while (0)
#define G8_MMA(ai, bj, At, Bt) do { __builtin_amdgcn_s_setprio(1); _Pragma("unroll") for (int m = 0; m < 4; ++m) _Pragma("unroll") for (int n = 0; n < 2; ++n) _Pragma("unroll") for (int k = 0; k < 2; ++k) \
        acc[ai][bj][m][n] = __builtin_amdgcn_mfma_f32_16x16x32_bf16(Bt[n][k], At[m][k], acc[ai][bj][m][n], 0, 0, 0); __builtin_amdgcn_s_setprio(0); } while (0)
#define G8_WAIT_V(n) asm volatile("s_waitcnt vmcnt(" #n ")" ::: "memory")
#define G8_WAIT_L(n) asm volatile("s_waitcnt lgkmcnt(" #n ")" ::: "memory")
#define G8_BAR __builtin_amdgcn_s_barrier()
#define G8_SCHED __builtin_amdgcn_sched_barrier(0)
    Unit cur, nxt; int ui = 0;
    if (!S.next(0, cur)) return;
    unsigned aoc[2][2], aon[2][2];
    S.aoffs(cur, Rr, Cc, aoc);
    f32x4 acc[2][2][4][2];
#pragma unroll
    for (int a = 0; a < 2; ++a)
#pragma unroll
        for (int b = 0; b < 2; ++b)
#pragma unroll
            for (int m = 0; m < 4; ++m)
#pragma unroll
                for (int n = 0; n < 2; ++n) acc[a][b][m][n] = (f32x4){0.f, 0.f, 0.f, 0.f};
    bf16x8 At[4][2], B0[2][2], B1[2][2];
    const char* cB = cur.Bp;
    G8_STAGE_B(G8_SB(0, 0), cB, 0, 0); G8_STAGE_B(G8_SB(0, 1), cB, 1, 0); G8_STAGE_A(G8_SA(0, 0), aoc[0], 0); G8_STAGE_A(G8_SA(0, 1), aoc[1], 0);
    if (wr == 1) G8_BAR;
    G8_WAIT_V(2); G8_BAR;
    G8_STAGE_B(G8_SB(1, 0), cB, 0, 1); G8_STAGE_A(G8_SA(1, 0), aoc[0], 1); G8_STAGE_B(G8_SB(1, 1), cB, 1, 1);
    G8_WAIT_V(6); G8_BAR;
    for (;;) {
        const bool has_next = S.next(ui + 1, nxt);
        if (has_next) S.aoffs(nxt, Rr, Cc, aon);
        else {
#pragma unroll
            for (int h = 0; h < 2; ++h)
#pragma unroll
                for (int i = 0; i < 2; ++i) aon[h][i] = aoc[h][i]; }
        const char* nB = has_next ? nxt.Bp : cB;
        for (int t = 0; t < nt; t += 2) {
            const bool last = (t == nt - 2);
            unsigned a2[2][2];
#pragma unroll
            for (int h = 0; h < 2; ++h)
#pragma unroll
                for (int i = 0; i < 2; ++i) a2[h][i] = last ? aon[h][i] : aoc[h][i];
            const int kt2 = last ? 0 : t + 2; const char* b2 = last ? nB : cB;
            G8_LDB(B0, 0, 0); G8_LDB(B1, 0, 1); G8_SCHED; G8_LDA(At, 0, 0); G8_STAGE_A(G8_SA(1, 1), aoc[1], t + 1);
            G8_WAIT_V(8); G8_WAIT_L(0); G8_BAR; G8_MMA(0, 0, At, B0); G8_MMA(0, 1, At, B1); G8_BAR; G8_SCHED;
            G8_LDA(At, 0, 1); G8_STAGE_B(G8_SB(0, 0), b2, 0, kt2); G8_STAGE_B(G8_SB(0, 1), b2, 1, kt2); G8_STAGE_A(G8_SA(0, 0), a2[0], kt2);
            G8_WAIT_V(8); G8_WAIT_L(0); G8_BAR; G8_MMA(1, 0, At, B0); G8_MMA(1, 1, At, B1); G8_BAR; G8_SCHED;
            G8_LDB(B0, 1, 0); G8_LDB(B1, 1, 1); G8_SCHED; G8_LDA(At, 1, 0); G8_STAGE_A(G8_SA(0, 1), a2[1], kt2);
            G8_WAIT_V(8); G8_WAIT_L(0); G8_BAR; G8_MMA(0, 0, At, B0); G8_MMA(0, 1, At, B1); G8_BAR; G8_SCHED;
            G8_LDA(At, 1, 1); G8_STAGE_B(G8_SB(1, 0), b2, 0, kt2 + 1); G8_STAGE_B(G8_SB(1, 1), b2, 1, kt2 + 1); G8_STAGE_A(G8_SA(1, 0), a2[0], kt2 + 1);
            G8_WAIT_V(8); G8_WAIT_L(0); G8_BAR; G8_MMA(1, 0, At, B0); G8_MMA(1, 1, At, B1); G8_BAR; G8_SCHED;
        }
        if (wr == 0) G8_BAR;
        E(acc, cur, wr, wc, fr, fq);
        if (!has_next) break;
#pragma unroll
        for (int a = 0; a < 2; ++a)
#pragma unroll
            for (int b = 0; b < 2; ++b)
#pragma unroll
                for (int m = 0; m < 4; ++m)
#pragma unroll
                    for (int n = 0; n < 2; ++n) acc[a][b][m][n] = (f32x4){0.f, 0.f, 0.f, 0.f};
        cur = nxt; cB = nB;
#pragma unroll
        for (int h = 0; h < 2; ++h)
#pragma unroll
            for (int i = 0; i < 2; ++i) aoc[h][i] = aon[h][i];
        ++ui;
        if (wr == 1) G8_BAR;
    }
    G8_WAIT_V(0);
    G8_BAR;
#undef G8_SA
#undef G8_SB
#undef G8_STAGE_A
#undef G8_STAGE_B
#undef G8_LDA
#undef G8_LDB
#undef G8_MMA
#undef G8_WAIT_V
#undef G8_WAIT_L
#undef G8_BAR
#undef G8_SCHED
}

struct DenseSched {
    int nM, nN, nwg, G, c, K; const char* Bt;
    DI void init(int nM_, int nN_, int G_, int c_, int K_, const void* Bt_) { nM = nM_; nN = nN_; nwg = nM * nN; G = G_; c = c_; K = K_; Bt = (const char*)Bt_; }
    DI bool next(int i, Unit& u) const {
        const long L = (long)i * G + c; if (L >= nwg) return false;
        int wgid = (int)L; { const int q = nwg / 8, r = nwg % 8, xcd = wgid % 8, off = wgid / 8; wgid = (xcd < r ? xcd * (q + 1) : r * (q + 1) + (xcd - r) * q) + off; }
        const int WGM = 8, nig = WGM * nN, gid = wgid / nig, fm = gid * WGM, gsz = (nM - fm) < WGM ? (nM - fm) : WGM;
        u.pm = fm + ((wgid % nig) % gsz); u.pn = (wgid % nig) / gsz; u.aux = 0; u.Bp = Bt + (size_t)u.pn * 256 * K * 2; return true;
    }
    DI void aoffs(const Unit& u, const int (&Rr)[2], const int (&Cc)[2], unsigned (&ao)[2][2]) const {
#pragma unroll
        for (int h = 0; h < 2; ++h)
#pragma unroll
            for (int i = 0; i < 2; ++i) ao[h][i] = (unsigned)(((size_t)(u.pm * 256 + h * 128 + Rr[i]) * K + Cc[i]) * 2);
    }
};
template <bool GATHER>
struct MoeSched {
    int nN, tiles_per_e, nwg, G, c, K, NBt; const char* Bt; size_t estride; const int* gidx; bool with_ctx;
    DI void init(int nN_, bool with_ctx_, int G_, int c_, int K_, const void* Bt_, size_t estride_, const int* gidx_) {
        nN = nN_; with_ctx = with_ctx_; tiles_per_e = NB * 2 + (with_ctx_ ? 1 : 0); nwg = 16 * tiles_per_e * nN; G = G_; c = c_; K = K_; Bt = (const char*)Bt_; estride = estride_; gidx = gidx_; }
    DI bool next(int i, Unit& u) const {
        const long L = (long)i * G + c; if (L >= nwg) return false;
        const int mt = (int)L / nN; u.pn = (int)L % nN; const int e = mt / tiles_per_e, j = mt % tiles_per_e;
        const int rowbase = j < NB * 2 ? ((j >> 1) * 16 + e) * 512 + (j & 1) * 256 : MOE_LAT + e * 256;
        u.pm = rowbase / 256; u.aux = e; u.Bp = Bt + (size_t)e * estride + (size_t)u.pn * 256 * K * 2; return true;
    }
    DI void aoffs(const Unit& u, const int (&Rr)[2], const int (&Cc)[2], unsigned (&ao)[2][2]) const {
#pragma unroll
        for (int h = 0; h < 2; ++h)
#pragma unroll
            for (int i = 0; i < 2; ++i) { const int mrow = u.pm * 256 + h * 128 + Rr[i]; const int arow = GATHER ? gidx[mrow] : mrow; ao[h][i] = (unsigned)(((size_t)arow * K + Cc[i]) * 2); }
    }
};
}

typedef f32x4 Acc[2][2][4][2];
DI void st_bf16x4(bf16_t* p, const f32x4 v) { u32x2 w; w.x = cvt_pk(v.x, v.y); w.y = cvt_pk(v.z, v.w); *(u32x2*)p = w; }

struct EpiInProj {
    static constexpr bool PERM = false;
    unsigned char* ws; const LAS unsigned long long* in; int l; const LAS f32x2* tab64; const LAS f32x2* tab32;
    DI void operator()(const Acc& acc, const g8::Unit& u, int wr, int wc, int fr, int fq) const {
        asm volatile("" : "+v"(fr), "+v"(fq));
        const int slot = 4 * u.pn + wc; const int rowt = u.pm * 256 + wr * 64 + fr; const bool lat = (u.pm * 256) < LAT;
        int kind; bf16_t* dst; int ld, coff; const float* gain = nullptr; float qs = 1.f;
        if (slot < 6)       { kind = 0; dst = (bf16_t*)(ws + Z_QA); ld = 384; coff = slot * 64; gain = inp(in, 9) + l * 64; qs = QS64; }
        else if (slot < 8)  { kind = 0; dst = (bf16_t*)(ws + Z_KA); ld = 128; coff = (slot - 6) * 64; gain = inp(in, 10) + l * 64; }
        else if (slot < 10) { kind = 1; dst = (bf16_t*)(ws + Z_VA); ld = 128; coff = (slot - 8) * 64; }
        else if (slot < 15) { kind = 2; dst = (bf16_t*)(ws + Z_CRAW); ld = 384; coff = (slot - 10) * 64; }
        else if (slot < 19) { kind = 0; dst = (bf16_t*)(ws + Z_QC); ld = 256; coff = (slot - 15) * 64; gain = inp(in, 19) + l * 64; qs = QS64; }
        else if (slot < 21) { kind = 0; dst = (bf16_t*)(ws + Z_KC); ld = 128; coff = (slot - 19) * 64; gain = inp(in, 20) + l * 64; }
        else if (slot < 23) { kind = 1; dst = (bf16_t*)(ws + Z_VC); ld = 128; coff = (slot - 21) * 64; }
        else                { kind = 3; dst = (bf16_t*)(ws + Z_KB); ld = 576; coff = 64; gain = inp(in, 18) + l * 32; }
        if (kind == 0) {
            f32x4 g[2][2];
#pragma unroll
            for (int bj = 0; bj < 2; ++bj)
#pragma unroll
                for (int n = 0; n < 2; ++n) g[bj][n] = *(const f32x4*)(gain + 32 * bj + 16 * n + 4 * fq) * qs;
#pragma unroll
            for (int ai = 0; ai < 2; ++ai)
#pragma unroll
                for (int m = 0; m < 4; ++m) {
                    const int row = rowt + ai * 128 + m * 16; float s = 0.f;
#pragma unroll
                    for (int bj = 0; bj < 2; ++bj)
#pragma unroll
                        for (int n = 0; n < 2; ++n) { const f32x4 x = acc[ai][bj][m][n]; s += (x.x * x.x + x.y * x.y) + (x.z * x.z + x.w * x.w); }
                    s += __shfl_xor(s, 16); s += __shfl_xor(s, 32);
                    const float rstd = 1.0f / sqrtf(s * (1.f / 64.f) + EPS);
                    const int t = row & 4095, pr = t >> 6, pc = t & 63;
#pragma unroll
                    for (int bj = 0; bj < 2; ++bj) {
                        f32x4 x1 = acc[ai][bj][m][0] * rstd * g[bj][0], x2 = acc[ai][bj][m][1] * rstd * g[bj][1];
                        if (lat) { const LAS f32x2* tb = tab64 + (bj == 0 ? pr : pc) * 16 + 4 * fq; f32x4 o1, o2;
#pragma unroll
                            for (int i = 0; i < 4; ++i) { const f32x2 cs = tb[i]; o1[i] = x1[i] * cs.x - x2[i] * cs.y; o2[i] = x2[i] * cs.x + x1[i] * cs.y; }
                            x1 = o1; x2 = o2; }
                        bf16_t* p = dst + (size_t)row * ld + coff + 32 * bj + 4 * fq;
                        st_bf16x4(p, x1); st_bf16x4(p + 16, x2);
                    }
                    asm volatile("" ::: "memory");
                }
        } else if (kind == 1 || kind == 2) {
#pragma unroll
            for (int ai = 0; ai < 2; ++ai)
#pragma unroll
                for (int m = 0; m < 4; ++m) {
                    const int row = rowt + ai * 128 + m * 16; float s = 0.f;
#pragma unroll
                    for (int bj = 0; bj < 2; ++bj)
#pragma unroll
                        for (int n = 0; n < 2; ++n) { const f32x4 x = acc[ai][bj][m][n]; s += (x.x * x.x + x.y * x.y) + (x.z * x.z + x.w * x.w);
                            st_bf16x4(dst + (size_t)row * ld + coff + 32 * bj + 16 * n + 4 * fq, x); }
                    if (kind == 2) { s += __shfl_xor(s, 16); s += __shfl_xor(s, 32); if (fq == 0) ((float*)(ws + WS_SSQ))[(size_t)row * 8 + (slot - 10)] = s; }
                }
        } else {
            const f32x4 g0 = *(const f32x4*)(gain + 4 * fq), g1 = *(const f32x4*)(gain + 16 + 4 * fq);
            bf16_t* craw = (bf16_t*)(ws + Z_CRAW);
#pragma unroll
            for (int ai = 0; ai < 2; ++ai)
#pragma unroll
                for (int m = 0; m < 4; ++m) {
                    const int row = rowt + ai * 128 + m * 16;
                    const f32x4 a0 = acc[ai][0][m][0], a1 = acc[ai][0][m][1];
                    float s = (a0.x * a0.x + a0.y * a0.y) + (a0.z * a0.z + a0.w * a0.w) + (a1.x * a1.x + a1.y * a1.y) + (a1.z * a1.z + a1.w * a1.w);
                    s += __shfl_xor(s, 16); s += __shfl_xor(s, 32);
                    const float rstd = 1.0f / sqrtf(s * (1.f / 32.f) + EPS);
                    f32x4 v0 = a0 * rstd * g0, v1 = a1 * rstd * g1;
                    if (lat) { const int t = row & 4095, pr = t >> 6, pc = t & 63;
                        f32x4 p0, p1;
#pragma unroll
                        for (int i = 0; i < 4; ++i) { p0[i] = __shfl_xor(v0[i], 32); p1[i] = __shfl_xor(v1[i], 32); }
                        const LAS f32x2* t0 = tab32 + pr * 8 + 4 * (fq & 1); const LAS f32x2* t1 = tab32 + pc * 8 + 4 * (fq & 1);
#pragma unroll
                        for (int i = 0; i < 4; ++i) { const f32x2 c0 = t0[i], c1 = t1[i];
                            v0[i] = fq < 2 ? v0[i] * c0.x - p0[i] * c0.y : v0[i] * c0.x + p0[i] * c0.y;
                            v1[i] = fq < 2 ? v1[i] * c1.x - p1[i] * c1.y : v1[i] * c1.x + p1[i] * c1.y; } }
                    u32x2 w0, w1; w0.x = cvt_pk(v0.x, v0.y); w0.y = cvt_pk(v0.z, v0.w); w1.x = cvt_pk(v1.x, v1.y); w1.y = cvt_pk(v1.z, v1.w);
#pragma unroll
                    for (int h = 0; h < 6; ++h) { bf16_t* p = dst + (size_t)row * 576 + h * 96 + 64 + 4 * fq; *(u32x2*)p = w0; *(u32x2*)(p + 16) = w1; }
                    const u32x2 z = {0u, 0u};
#pragma unroll
                    for (int q = 0; q < 4; ++q) *(u32x2*)(craw + (size_t)row * 384 + 320 + 16 * q + 4 * fq) = z;
                    asm volatile("" ::: "memory");
                }
        }
    }
};

struct EpiUpProj {
    static constexpr bool PERM = false;
    unsigned char* ws; const LAS unsigned long long* in; int l; const LAS f32x2* tab32;
    DI void operator()(const Acc& acc, const g8::Unit& u, int wr, int wc, int fr, int fq) const {
        asm volatile("" : "+v"(fr), "+v"(fq));
        const int slot = 4 * u.pn + wc; if (slot >= 9 && slot < 12) return;
        const int rowt = u.pm * 256 + wr * 64 + fr; const bool lat = (u.pm * 256) < LAT;
        const float* ssq = (const float*)(ws + WS_SSQ);
        bf16_t* qB = (bf16_t*)(ws + Z_QB); bf16_t* kB = (bf16_t*)(ws + Z_KB); bf16_t* vB = (bf16_t*)(ws + Z_VB);
        const bool isq = slot < 9;
#pragma unroll
        for (int ai = 0; ai < 2; ++ai)
#pragma unroll
            for (int m = 0; m < 4; ++m) {
                const int row = rowt + ai * 128 + m * 16;
                const f32x4 sa = *(const f32x4*)(ssq + (size_t)row * 8); const float sb = ssq[(size_t)row * 8 + 4];
                const float r0 = isq ? 1.0f / sqrtf((sa.x + sa.y + sa.z) * (1.f / 192.f) + EPS) : 1.0f / sqrtf((sa.w + sb) * (1.f / 128.f) + EPS);
                if (slot < 6 || (slot >= 12 && slot < 18)) {
                    const float* gain = slot < 6 ? inp(in, 15) + l * 64 : inp(in, 16) + l * 64; const float qs = slot < 6 ? QS96 : 1.f;
                    const int h = slot < 6 ? slot : slot - 12; bf16_t* dst = (slot < 6 ? qB : kB) + (size_t)row * 576 + h * 96;
                    float s = 0.f; f32x4 x[2][2];
#pragma unroll
                    for (int bj = 0; bj < 2; ++bj)
#pragma unroll
                        for (int n = 0; n < 2; ++n) { x[bj][n] = acc[ai][bj][m][n] * r0; s += (x[bj][n].x * x[bj][n].x + x[bj][n].y * x[bj][n].y) + (x[bj][n].z * x[bj][n].z + x[bj][n].w * x[bj][n].w); }
                    s += __shfl_xor(s, 16); s += __shfl_xor(s, 32);
                    const float rstd = qs / sqrtf(s * (1.f / 64.f) + EPS);
#pragma unroll
                    for (int bj = 0; bj < 2; ++bj)
#pragma unroll
                        for (int n = 0; n < 2; ++n) { const int c = 32 * bj + 16 * n + 4 * fq; st_bf16x4(dst + c, x[bj][n] * rstd * *(const f32x4*)(gain + c)); }
                } else if (slot >= 18) {
                    bf16_t* dst = vB + (size_t)row * 384 + (slot - 18) * 64;
#pragma unroll
                    for (int bj = 0; bj < 2; ++bj)
#pragma unroll
                        for (int n = 0; n < 2; ++n) st_bf16x4(dst + 32 * bj + 16 * n + 4 * fq, acc[ai][bj][m][n] * r0);
                } else {
                    const float* gain = inp(in, 17) + l * 32;
#pragma unroll
                    for (int bj = 0; bj < 2; ++bj) {
                        const f32x4 a0 = acc[ai][bj][m][0] * r0, a1 = acc[ai][bj][m][1] * r0;
                        float s = (a0.x * a0.x + a0.y * a0.y) + (a0.z * a0.z + a0.w * a0.w) + (a1.x * a1.x + a1.y * a1.y) + (a1.z * a1.z + a1.w * a1.w);
                        s += __shfl_xor(s, 16); s += __shfl_xor(s, 32);
                        const float rstd = QS96 / sqrtf(s * (1.f / 32.f) + EPS);
                        f32x4 v0 = a0 * rstd * *(const f32x4*)(gain + 4 * fq), v1 = a1 * rstd * *(const f32x4*)(gain + 16 + 4 * fq);
                        if (lat) { const int t = row & 4095, pr = t >> 6, pc = t & 63; f32x4 p0, p1;
#pragma unroll
                            for (int i = 0; i < 4; ++i) { p0[i] = __shfl_xor(v0[i], 32); p1[i] = __shfl_xor(v1[i], 32); }
                            const LAS f32x2* t0 = tab32 + pr * 8 + 4 * (fq & 1); const LAS f32x2* t1 = tab32 + pc * 8 + 4 * (fq & 1);
#pragma unroll
                            for (int i = 0; i < 4; ++i) { const f32x2 c0 = t0[i], c1 = t1[i];
                                v0[i] = fq < 2 ? v0[i] * c0.x - p0[i] * c0.y : v0[i] * c0.x + p0[i] * c0.y;
                                v1[i] = fq < 2 ? v1[i] * c1.x - p1[i] * c1.y : v1[i] * c1.x + p1[i] * c1.y; } }
                        bf16_t* p = qB + (size_t)row * 576 + (2 * (slot - 6) + bj) * 96 + 64 + 4 * fq;
                        st_bf16x4(p, v0); st_bf16x4(p + 16, v1);
                    }
                }
                asm volatile("" ::: "memory");
            }
    }
};

struct EpiOutProj {
    static constexpr bool PERM = false;
    unsigned char* ws; const float* xin; const float* cin; float* out; int l;
    DI void operator()(const Acc& acc, const g8::Unit& u, int wr, int wc, int fr, int fq) const {
        asm volatile("" : "+v"(fr), "+v"(fq));
        const int rowt = u.pm * 256 + wr * 64 + fr; const bool lat = (u.pm * 256) < LAT;
        const float* mod = (const float*)(ws + WS_MOD) + ((size_t)l * 9 + (lat ? (u.pm * 256) / 4096 : 8)) * 6144 + 2048;
        const int col0 = u.pn * 256 + wc * 32 + 4 * fq;
        f32x4 gv[2][2];
#pragma unroll
        for (int bj = 0; bj < 2; ++bj)
#pragma unroll
            for (int n = 0; n < 2; ++n) gv[bj][n] = *(const f32x4*)(mod + col0 + 128 * bj + 16 * n);
#pragma unroll
        for (int ai = 0; ai < 2; ++ai)
#pragma unroll
            for (int m = 0; m < 4; ++m) {
                const int row = rowt + ai * 128 + m * 16;
                const float* src = lat ? xin + (size_t)row * 1024 : cin + (size_t)(row - LAT) * 1024;
                float* dst = lat ? out + (size_t)row * 1024 : (float*)(ws + WS_CTXF) + (size_t)(row - LAT) * 1024;
#pragma unroll
                for (int bj = 0; bj < 2; ++bj)
#pragma unroll
                    for (int n = 0; n < 2; ++n) { const int c = col0 + 128 * bj + 16 * n; *(f32x4*)(dst + c) = *(const f32x4*)(src + c) + gv[bj][n] * acc[ai][bj][m][n]; }
            }
    }
};

struct EpiMoe1 {
    static constexpr bool PERM = true;
    unsigned char* ws;
    DI void operator()(const Acc& acc, const g8::Unit& u, int wr, int wc, int fr, int fq) const {
        asm volatile("" : "+v"(fr), "+v"(fq));
        bf16_t* hid = (bf16_t*)(ws + Z_HID);
#pragma unroll
        for (int ai = 0; ai < 2; ++ai)
#pragma unroll
            for (int m = 0; m < 4; ++m) {
                const int row = u.pm * 256 + ai * 128 + wr * 64 + m * 16 + fr; u32x4 w;
                f32x4 h0, h1;
#pragma unroll
                for (int i = 0; i < 4; ++i) { h0[i] = silu_f(acc[ai][0][m][0][i]) * acc[ai][1][m][0][i]; h1[i] = silu_f(acc[ai][0][m][1][i]) * acc[ai][1][m][1][i]; }
                w.x = cvt_pk(h0.x, h0.y); w.y = cvt_pk(h0.z, h0.w); w.z = cvt_pk(h1.x, h1.y); w.w = cvt_pk(h1.z, h1.w);
                *(u32x4*)(hid + (size_t)row * 1024 + u.pn * 128 + wc * 32 + 8 * fq) = w;
            }
    }
};
struct EpiMoe2 {
    static constexpr bool PERM = true;
    unsigned char* ws;
    DI void operator()(const Acc& acc, const g8::Unit& u, int wr, int wc, int fr, int fq) const {
        asm volatile("" : "+v"(fr), "+v"(fq));
        bf16_t* ye = (bf16_t*)(ws + Z_YE); const float* gate = (const float*)(ws + WS_GATE);
#pragma unroll
        for (int ai = 0; ai < 2; ++ai)
#pragma unroll
            for (int m = 0; m < 4; ++m) {
                const int row = u.pm * 256 + ai * 128 + wr * 64 + m * 16 + fr; const float gv = gate[row];
#pragma unroll
                for (int bj = 0; bj < 2; ++bj) { const f32x4 a = acc[ai][bj][m][0] * gv, b = acc[ai][bj][m][1] * gv; u32x4 w;
                    w.x = cvt_pk(a.x, a.y); w.y = cvt_pk(a.z, a.w); w.z = cvt_pk(b.x, b.y); w.w = cvt_pk(b.z, b.w);
                    *(u32x4*)(ye + (size_t)row * 1024 + u.pn * 256 + bj * 128 + wc * 32 + 8 * fq) = w; }
            }
    }
};
DI int crow(int i, int hh) { return (i & 3) + 8 * (i >> 2) + 4 * hh; }
typedef short v4i16_t __attribute__((ext_vector_type(4)));
DI s16x4 vtr(const LAS unsigned char* p) { return __builtin_bit_cast(s16x4, __builtin_amdgcn_ds_read_tr16_b64_v4i16((LAS v4i16_t*)p)); }
#define MFMA32(a, b, c) __builtin_amdgcn_mfma_f32_32x32x16_bf16((a), (b), (c), 0, 0, 0)

struct AttnDesc { const bf16_t* Q; int ldq, qoff; const bf16_t* K; int ldk, koff; const bf16_t* V; int ldv, voff; bf16_t* O; int ooff; float sink2; };
template <int DQ, int MODE>
DI void attn_unit(const int tid, LAS unsigned char* lds, const AttnDesc& d, int b, int qb, bool has_sink) {
    constexpr int KSTR = DQ * 2 + 16, VSTR = 192, KBUF = 64 * KSTR, VBUF = 64 * VSTR, NS = DQ / 16, KCH = DQ / 8;
    const int lane = tid & 63, wid = __builtin_amdgcn_readfirstlane(tid >> 6), r = lane & 31, hh = lane >> 5;
    const int q0 = qb * 256;
    const int qrow = (MODE == 2 ? LAT + b * 256 : b * 4096) + q0 + wid * 32 + r;
    int lo = 0, ntl = 0;
    if (MODE == 0) { lo = 0; ntl = 64; }
    if (MODE == 1) { lo = q0 - 128 < 0 ? 0 : q0 - 128; const int hi = q0 + 384 > 4096 ? 4096 : q0 + 384; ntl = (hi - lo) / 64; }
    const int NT = 4 + ntl;
    auto tile_row = [&](int t) -> int { return t < 4 ? LAT + b * 256 + t * 64 : b * 4096 + lo + (t - 4) * 64; };
    bf16x8 qf[NS];
#pragma unroll
    for (int s = 0; s < NS; ++s) qf[s] = *(const bf16x8*)(d.Q + (size_t)qrow * d.ldq + d.qoff + 16 * s + 8 * hh);
    const int krow0 = tid / KCH, kch0 = tid % KCH, krow1 = (tid + 512) / KCH, kch1 = (tid + 512) % KCH; const bool k2 = (DQ == 96) && (tid < 256);
    const int vrow = tid >> 3, vch = tid & 7;
    u32x4 kr0, kr1 = (u32x4){0u, 0u, 0u, 0u}, vr;
    auto load_tile = [&](int t) { const int row0 = tile_row(t);
        kr0 = *(const u32x4*)(d.K + (size_t)(row0 + krow0) * d.ldk + d.koff + kch0 * 8);
        if (k2) kr1 = *(const u32x4*)(d.K + (size_t)(row0 + krow1) * d.ldk + d.koff + kch1 * 8);
        vr = *(const u32x4*)(d.V + (size_t)(row0 + vrow) * d.ldv + d.voff + vch * 8); };
    auto store_tile = [&](int buf) { LAS unsigned char* kb = lds + buf * KBUF; LAS unsigned char* vb = lds + 2 * KBUF + buf * VBUF;
        *(LAS u32x4*)(kb + krow0 * KSTR + kch0 * 16) = kr0;
        if (k2) *(LAS u32x4*)(kb + krow1 * KSTR + kch1 * 16) = kr1;
        *(LAS u32x4*)(vb + vrow * VSTR + vch * 16) = vr; };
    float m = -1e30f, l = 0.f;
    if (has_sink) { m = d.sink2; l = hh == 0 ? 1.f : 0.f; }
    f32x16 o0, o1;
#pragma unroll
    for (int i = 0; i < 16; ++i) { o0[i] = 0.f; o1[i] = 0.f; }
    const int koffl = r * KSTR + hh * 16;
    const int voffl = (4 * hh + ((lane & 15) >> 2)) * VSTR + (16 * ((lane >> 4) & 1) + 4 * (lane & 3)) * 2;
    __syncthreads();
    load_tile(0); store_tile(0);
    __syncthreads();
    for (int t = 0; t < NT; ++t) {
        const int buf = t & 1;
        if (t + 1 < NT) load_tile(t + 1);
        const LAS unsigned char* kb = lds + buf * KBUF + koffl; const LAS unsigned char* vb = lds + 2 * KBUF + buf * VBUF + voffl;
        f32x16 s0, s1;
#pragma unroll
        for (int i = 0; i < 16; ++i) { s0[i] = 0.f; s1[i] = 0.f; }
#pragma unroll
        for (int s = 0; s < NS; ++s) { const bf16x8 a0 = *(const LAS bf16x8*)(kb + s * 32), a1 = *(const LAS bf16x8*)(kb + 32 * KSTR + s * 32);
            s0 = MFMA32(a0, qf[s], s0); s1 = MFMA32(a1, qf[s], s1); }
        if (MODE == 1 && t >= 4) { const int kp0 = lo + (t - 4) * 64, qp = q0 + wid * 32 + r;
#pragma unroll
            for (int i = 0; i < 16; ++i) { const int dk0 = kp0 + crow(i, hh) - qp, dk1 = dk0 + 32;
                if (dk0 > 128 || dk0 < -128) s0[i] = -1e30f; if (dk1 > 128 || dk1 < -128) s1[i] = -1e30f; } }
        float mx = fmaxf(s0[0], s1[0]);
#pragma unroll
        for (int i = 1; i < 16; ++i) mx = fmaxf(mx, fmaxf(s0[i], s1[i]));
        mx = fmaxf(mx, __shfl_xor(mx, 32));
        const float mn = fmaxf(m, mx), alpha = exp2f(m - mn); m = mn;
        float ps = 0.f;
#pragma unroll
        for (int i = 0; i < 16; ++i) { s0[i] = exp2f(s0[i] - mn); s1[i] = exp2f(s1[i] - mn); ps += s0[i] + s1[i]; }
        l = l * alpha + ps;
#pragma unroll
        for (int i = 0; i < 16; ++i) { o0[i] *= alpha; o1[i] *= alpha; }
        bf16x8 pb[4];
#pragma unroll
        for (int s = 0; s < 2; ++s) {
            u32x4 w0, w1;
            w0.x = cvt_pk(s0[8 * s + 0], s0[8 * s + 1]); w0.y = cvt_pk(s0[8 * s + 2], s0[8 * s + 3]); w0.z = cvt_pk(s0[8 * s + 4], s0[8 * s + 5]); w0.w = cvt_pk(s0[8 * s + 6], s0[8 * s + 7]);
            w1.x = cvt_pk(s1[8 * s + 0], s1[8 * s + 1]); w1.y = cvt_pk(s1[8 * s + 2], s1[8 * s + 3]); w1.z = cvt_pk(s1[8 * s + 4], s1[8 * s + 5]); w1.w = cvt_pk(s1[8 * s + 6], s1[8 * s + 7]);
            pb[s] = __builtin_bit_cast(bf16x8, w0); pb[2 + s] = __builtin_bit_cast(bf16x8, w1); }
#pragma unroll
        for (int ks = 0; ks < 4; ++ks) {
            const s16x4 a_lo = vtr(vb + (16 * ks) * VSTR), a_hi = vtr(vb + (16 * ks + 8) * VSTR);
            const s16x4 b_lo = vtr(vb + (16 * ks) * VSTR + 64), b_hi = vtr(vb + (16 * ks + 8) * VSTR + 64);
            const bf16x8 va = __builtin_shufflevector(a_lo, a_hi, 0, 1, 2, 3, 4, 5, 6, 7), vb2 = __builtin_shufflevector(b_lo, b_hi, 0, 1, 2, 3, 4, 5, 6, 7);
            o0 = MFMA32(va, pb[ks], o0); o1 = MFMA32(vb2, pb[ks], o1);
        }
        if (t + 1 < NT) store_tile(buf ^ 1);
        __syncthreads();
    }
    l += __shfl_xor(l, 32);
    const float inv = 1.0f / l;
    bf16_t* op = d.O + (size_t)qrow * 1024 + d.ooff + 4 * hh;
#pragma unroll
    for (int g4 = 0; g4 < 4; ++g4) {
        u32x2 w; w.x = cvt_pk(o0[4 * g4] * inv, o0[4 * g4 + 1] * inv); w.y = cvt_pk(o0[4 * g4 + 2] * inv, o0[4 * g4 + 3] * inv); *(u32x2*)(op + 8 * g4) = w;
        u32x2 x; x.x = cvt_pk(o1[4 * g4] * inv, o1[4 * g4 + 1] * inv); x.y = cvt_pk(o1[4 * g4 + 2] * inv, o1[4 * g4 + 3] * inv); *(u32x2*)(op + 32 + 8 * g4) = x;
    }
}

DI void attn_phase(const Frame& F, int l, bool with_ctx) {
    constexpr int NU_B = NB * 96, NU_A = NB * 96, NU_C = NB * 64, NU_X = NB * 16;
    const int NU = NU_B + NU_A + NU_C + (with_ctx ? NU_X : 0);
    unsigned* head = F.ctl + CW_QUEUE + 64 * l;
    volatile LAS int* slot = (volatile LAS int*)(F.lds + LDS_MISC + 16);
    unsigned char* ws = F.ws;
    const float* sinkp = INP(21) + l * 4;
    for (;;) {
        __syncthreads();
        if (F.tid == 0) *slot = (int)__hip_atomic_fetch_add(head, 1u, __ATOMIC_RELAXED, __HIP_MEMORY_SCOPE_AGENT);
        __syncthreads();
        int u = *slot; if (u >= NU) break;
        AttnDesc d;
        if (u < NU_B) { const int b = u / 96, h = (u % 96) / 16, qb = u % 16;
            d = AttnDesc{(const bf16_t*)(ws + Z_QB), 576, h * 96, (const bf16_t*)(ws + Z_KB), 576, h * 96, (const bf16_t*)(ws + Z_VB), 384, h * 64, (bf16_t*)(ws + Z_OB), 384 + h * 64, 0.f};
            attn_unit<96, 0>(F.tid, F.lds, d, b, qb, false); continue; }
        u -= NU_B;
        if (u < NU_A) { const int b = u / 96, h = (u % 96) / 16, qb = u % 16;
            d = AttnDesc{(const bf16_t*)(ws + Z_QA), 384, h * 64, (const bf16_t*)(ws + Z_KA), 128, (h / 3) * 64, (const bf16_t*)(ws + Z_VA), 128, (h / 3) * 64, (bf16_t*)(ws + Z_OB), h * 64, 0.f};
            attn_unit<64, 0>(F.tid, F.lds, d, b, qb, false); continue; }
        u -= NU_A;
        if (u < NU_C) { const int b = u / 64, h = (u % 64) / 16, qb = u % 16;
            d = AttnDesc{(const bf16_t*)(ws + Z_QC), 256, h * 64, (const bf16_t*)(ws + Z_KC), 128, (h / 2) * 64, (const bf16_t*)(ws + Z_VC), 128, (h / 2) * 64, (bf16_t*)(ws + Z_OB), 768 + h * 64, sinkp[h] * LOG2E};
            attn_unit<64, 1>(F.tid, F.lds, d, b, qb, true); continue; }
        u -= NU_C;
        { const int b = u / 16, hx = u % 16;
            if (hx < 6) { const int h = hx;
                d = AttnDesc{(const bf16_t*)(ws + Z_QA), 384, h * 64, (const bf16_t*)(ws + Z_KA), 128, (h / 3) * 64, (const bf16_t*)(ws + Z_VA), 128, (h / 3) * 64, (bf16_t*)(ws + Z_OB), h * 64, 0.f};
                attn_unit<64, 2>(F.tid, F.lds, d, b, 0, false); }
            else if (hx < 12) { const int h = hx - 6;
                d = AttnDesc{(const bf16_t*)(ws + Z_QB), 576, h * 96, (const bf16_t*)(ws + Z_KB), 576, h * 96, (const bf16_t*)(ws + Z_VB), 384, h * 64, (bf16_t*)(ws + Z_OB), 384 + h * 64, 0.f};
                attn_unit<96, 2>(F.tid, F.lds, d, b, 0, false); }
            else { const int h = hx - 12;
                d = AttnDesc{(const bf16_t*)(ws + Z_QC), 256, h * 64, (const bf16_t*)(ws + Z_KC), 128, (h / 2) * 64, (const bf16_t*)(ws + Z_VC), 128, (h / 2) * 64, (bf16_t*)(ws + Z_OB), 768 + h * 64, sinkp[h] * LOG2E};
                attn_unit<64, 2>(F.tid, F.lds, d, b, 0, true); }
        }
    }
}

DI void router_phase(const Frame& F, int l, bool with_ctx) {
    LAS float* wT = (LAS float*)F.lds;
    const float* wr = INP(23) + (size_t)l * 1024 * 16;
    for (int e = F.tid; e < 16 * 1024; e += NTHR) { const int k = e / 16, x = e % 16; wT[x * 1024 + k] = wr[e]; }
    __syncthreads();
    const int gw = F.bid * NWAVES + F.wave, NGW = F.G * NWAVES, NR = with_ctx ? R : LAT, lane = F.lane;
    const float* g = INP(7) + l * 1024;
    for (int row = gw; row < NR; row += NGW) {
        const float* xr = row < LAT ? F.out + (size_t)row * 1024 : WSP(float, WS_CTXF) + (size_t)(row - LAT) * 1024;
        const float* m = mod_row(F, l, row);
        f32x4 v[4]; float s = 0.f;
#pragma unroll
        for (int j = 0; j < 4; ++j) { v[j] = *(const f32x4*)(xr + 4 * (lane + 64 * j)); s += (v[j].x * v[j].x + v[j].y * v[j].y) + (v[j].z * v[j].z + v[j].w * v[j].w); }
        const float rstd = 1.0f / sqrtf(wave_sum(s) * (1.f / 1024.f) + EPS);
        float lg[16];
#pragma unroll
        for (int e = 0; e < 16; ++e) lg[e] = 0.f;
        bf16_t* orow = WSP(bf16_t, WS_HB) + (size_t)row * 1024;
#pragma unroll
        for (int j = 0; j < 4; ++j) { const int c = 4 * (lane + 64 * j); const f32x4 gv = *(const f32x4*)(g + c), sv = *(const f32x4*)(m + 3072 + c), cv = *(const f32x4*)(m + 4096 + c);
            v[j] = v[j] * rstd * gv * (cv + 1.0f) + sv; u32x2 w; w.x = cvt_pk(v[j].x, v[j].y); w.y = cvt_pk(v[j].z, v[j].w); *(u32x2*)(orow + c) = w; }
        asm volatile("" ::: "memory");
#pragma unroll
        for (int e = 0; e < 16; ++e) {
#pragma unroll
            for (int j = 0; j < 4; ++j) { const f32x4 wv = *(const LAS f32x4*)(wT + e * 1024 + 4 * (lane + 64 * j)); lg[e] += (v[j].x * wv.x + v[j].y * wv.y) + (v[j].z * wv.z + v[j].w * wv.w); }
            if (e & 1) asm volatile("" ::: "memory"); }
#pragma unroll
        for (int e = 0; e < 16; ++e) lg[e] = wave_sum(lg[e]);
        float mx = lg[0];
#pragma unroll
        for (int e = 1; e < 16; ++e) mx = fmaxf(mx, lg[e]);
        float sum = 0.f;
#pragma unroll
        for (int e = 0; e < 16; ++e) { lg[e] = expf(lg[e] - mx); sum += lg[e]; }
        const float isum = 1.0f / sum;
        float mine = 0.f;
#pragma unroll
        for (int e = 0; e < 16; ++e) mine = (lane == e) ? lg[e] * isum : mine;
        if (lane < 16) {
            if (row < LAT) WSP(float, WS_AFFL)[((size_t)(row / 4096) * 16 + lane) * 4096 + (row & 4095)] = mine;
            else { const int rc = row - LAT; WSP(float, WS_AFFC)[((size_t)(rc / 256) * 16 + lane) * 256 + (rc & 255)] = mine; }
        }
    }
}

DI void topk_phase(const Frame& F, bool with_ctx) {
    LAS unsigned* hist = (LAS unsigned*)F.lds;
    LAS unsigned* sh = hist + 256;
    LAS unsigned* scan = hist + 512;
    const int NL = NB * 16 * (with_ctx ? 2 : 1), tid = F.tid;
    for (int li = F.bid; li < NL; li += F.G) {
        const bool isctx = li >= NB * 16; const int be = isctx ? li - NB * 16 : li, b = be / 16, e = be % 16;
        const int n = isctx ? 256 : 4096, cap = n / 8, per = isctx ? 1 : 8;
        const float* a = isctx ? WSP(float, WS_AFFC) + (size_t)be * 256 : WSP(float, WS_AFFL) + (size_t)be * 4096;
        unsigned key[8]; const bool act = tid * per < n;
#pragma unroll
        for (int j = 0; j < 8; ++j) key[j] = (act && j < per) ? __float_as_uint(a[tid * per + j]) : 0u;
        unsigned prefix = 0u, rem = (unsigned)cap;
        for (int pass = 0; pass < 4; ++pass) {
            const int shift = 24 - 8 * pass;
            __syncthreads();
            if (tid < 256) hist[tid] = 0u;
            __syncthreads();
#pragma unroll
            for (int j = 0; j < 8; ++j) if (act && j < per) { const unsigned k = key[j]; const bool match = pass == 0 ? true : ((k >> (shift + 8)) == (prefix >> (shift + 8))); if (match) __hip_atomic_fetch_add(&hist[(k >> shift) & 255u], 1u, __ATOMIC_RELAXED, __HIP_MEMORY_SCOPE_WORKGROUP); }
            __syncthreads();
            if (tid == 0) { unsigned cum = 0u; int bin = 255; for (; bin > 0; --bin) { const unsigned c = hist[bin]; if (cum + c >= rem) break; cum += c; } sh[0] = prefix | ((unsigned)bin << shift); sh[1] = rem - cum; }
            __syncthreads();
            prefix = sh[0]; rem = sh[1];
        }
        unsigned cg = 0u, ce = 0u;
#pragma unroll
        for (int j = 0; j < 8; ++j) if (act && j < per) { cg += key[j] > prefix ? 1u : 0u; ce += key[j] == prefix ? 1u : 0u; }
        __syncthreads();
        scan[tid] = cg; scan[512 + tid] = ce;
        __syncthreads();
        if (tid < 2) { unsigned run = 0u; LAS unsigned* p = scan + 512 * tid; for (int i = 0; i < 512; ++i) { const unsigned c = p[i]; p[i] = run; run += c; } }
        __syncthreads();
        unsigned gb = scan[tid], eb = scan[512 + tid];
        const int rowb = isctx ? LAT + b * 256 : b * 4096;
        const int mbase = isctx ? MOE_LAT + e * 256 + b * 32 : (b * 16 + e) * 512;
        int* gidx = WSP(int, WS_GIDX); float* gate = WSP(float, WS_GATE); int* inv = WSP(int, WS_INV);
#pragma unroll
        for (int j = 0; j < 8; ++j) if (act && j < per) {
            const unsigned k = key[j]; const int t = tid * per + j; int slot = -1;
            if (k > prefix) { slot = (int)(gb + (eb < rem ? eb : rem)); ++gb; }
            else if (k == prefix) { if (eb < rem) slot = (int)(gb + eb); ++eb; }
            if (slot >= 0) { gidx[mbase + slot] = rowb + t; gate[mbase + slot] = __uint_as_float(k); }
            inv[(size_t)(rowb + t) * 16 + e] = slot >= 0 ? mbase + slot : -1;
        }
        if (isctx && NB < 8 && b == 0) { for (int i = NB * 32 + tid; i < 256; i += NTHR) { gidx[MOE_LAT + e * 256 + i] = LAT; gate[MOE_LAT + e * 256 + i] = 0.f; } }
    }
}

DI void combine_phase(const Frame& F, int l, bool with_ctx) {
    const int gw = F.bid * NWAVES + F.wave, NGW = F.G * NWAVES, NR = with_ctx ? R : LAT, lane = F.lane;
    const bool last = (l == DEPTH - 1);
    const bf16_t* ye = WSP(bf16_t, Z_YE); const int* inv = WSP(int, WS_INV);
    for (int row = gw; row < NR; row += NGW) {
        float* xr = row < LAT ? F.out + (size_t)row * 1024 : WSP(float, WS_CTXF) + (size_t)(row - LAT) * 1024;
        const float* m = mod_row(F, l, row);
        f32x4 acc[4];
#pragma unroll
        for (int j = 0; j < 4; ++j) acc[j] = (f32x4){0.f, 0.f, 0.f, 0.f};
        const int myslot = lane < 16 ? inv[(size_t)row * 16 + lane] : -1;
#pragma unroll
        for (int e = 0; e < 16; ++e) { const int s = __shfl(myslot, e); if (s >= 0) { const bf16_t* yr = ye + (size_t)s * 1024;
#pragma unroll
                for (int j = 0; j < 4; ++j) { const u32x2 w = *(const u32x2*)(yr + 4 * (lane + 64 * j)); acc[j].x += bf_lo(w.x); acc[j].y += bf_hi(w.x); acc[j].z += bf_lo(w.y); acc[j].w += bf_hi(w.y); } } }
        f32x4 v[4];
#pragma unroll
        for (int j = 0; j < 4; ++j) { const int c = 4 * (lane + 64 * j); v[j] = *(const f32x4*)(xr + c) + *(const f32x4*)(m + 5120 + c) * acc[j]; *(f32x4*)(xr + c) = v[j]; }
        if (!last) { const float* m2 = mod_row(F, l + 1, row); norm_mod_store(v, INP(6) + (l + 1) * 1024, m2, m2 + 1024, WSP(bf16_t, WS_HB) + (size_t)row * 1024, lane); }
    }
}
constexpr int NPHASE = 2 + 9 * DEPTH;
DI void load_tabs(const Frame& F) {
    const f32x2* t64 = WSP(f32x2, WS_TAB64); const f32x2* t32 = WSP(f32x2, WS_TAB32);
    LAS f32x2* l64 = (LAS f32x2*)(F.lds + LDS_TAB64); LAS f32x2* l32 = (LAS f32x2*)(F.lds + LDS_TAB32);
    for (int i = F.tid; i < 64 * 16; i += NTHR) l64[i] = t64[i];
    for (int i = F.tid; i < 64 * 8; i += NTHR) l32[i] = t32[i];
    __syncthreads();
}
#ifndef PH_EN
#define PH_EN(k) 1
#endif
DI void run_phase(const Frame& F, int ph) {
    unsigned char* ws = F.ws;
    if (ph == 0) { if (PH_EN(100)) p0_phase(F); return; }
    if (ph == 1) { if (PH_EN(101)) init_norm_phase(F); return; }
    const int l = (ph - 2) / 9, s = (ph - 2) % 9; const bool last = (l == DEPTH - 1);
    switch (s) {
    case 0: if (PH_EN(0)) { load_tabs(F);
        g8::DenseSched S; S.init(MT, 6, F.G, F.bid, 1024, ws + WS_WIN + (size_t)l * 1536 * 1024 * 2);
        EpiInProj E{ws, F.intab, l, (const LAS f32x2*)(F.lds + LDS_TAB64), (const LAS f32x2*)(F.lds + LDS_TAB32)};
        g8::gemm_phase(F.tid, F.lds, (const char*)(ws + WS_HB), 1024, S, E); } break;
    case 1: if (PH_EN(1)) { load_tabs(F);
        g8::DenseSched S; S.init(MT, 6, F.G, F.bid, 384, ws + WS_WUP + (size_t)l * 1536 * 384 * 2);
        EpiUpProj E{ws, F.intab, l, (const LAS f32x2*)(F.lds + LDS_TAB32)};
        g8::gemm_phase(F.tid, F.lds, (const char*)(ws + Z_CRAW), 384, S, E); } break;
    case 2: if (PH_EN(2)) attn_phase(F, l, !last); break;
    case 3: if (PH_EN(3)) { g8::DenseSched S; S.init(last ? LAT / 256 : MT, 4, F.G, F.bid, 1024, ws + WS_WOUT + (size_t)l * 1024 * 1024 * 2);
        EpiOutProj E{ws, l == 0 ? INP(0) : F.out, INP(2), F.out, l};
        g8::gemm_phase(F.tid, F.lds, (const char*)(ws + Z_OB), 1024, S, E); } break;
    case 4: if (PH_EN(4)) router_phase(F, l, !last); break;
    case 5: if (PH_EN(5)) topk_phase(F, !last); break;
    case 6: if (PH_EN(6)) { g8::MoeSched<true> S; S.init(8, !last, F.G, F.bid, 1024, ws + WS_W1 + (size_t)l * 16 * 2048 * 1024 * 2, (size_t)2048 * 1024 * 2, (const int*)(ws + WS_GIDX));
        EpiMoe1 E{ws}; g8::gemm_phase(F.tid, F.lds, (const char*)(ws + WS_HB), 1024, S, E); } break;
    case 7: if (PH_EN(7)) { g8::MoeSched<false> S; S.init(4, !last, F.G, F.bid, 1024, ws + WS_W2 + (size_t)l * 16 * 1024 * 1024 * 2, (size_t)1024 * 1024 * 2, nullptr);
        EpiMoe2 E{ws}; g8::gemm_phase(F.tid, F.lds, (const char*)(ws + Z_HID), 1024, S, E); } break;
    case 8: if (PH_EN(8)) combine_phase(F, l, !last); break;
    }
}
__global__ void __launch_bounds__(NTHR, 2) mega_kernel(Args a) {
    extern __shared__ __attribute__((aligned(16))) unsigned char lds_raw[];
    Frame F; F.lds = (LAS unsigned char*)lds_raw; F.ws = a.ws; F.ctl = (unsigned*)(a.ws + WS_CTL);
    F.tid = threadIdx.x; F.lane = F.tid & 63; F.wave = __builtin_amdgcn_readfirstlane(F.tid >> 6); F.G = gridDim.x; F.bid = blockIdx.x; F.out = a.out;
    { LAS unsigned long long* tab = (LAS unsigned long long*)(F.lds + LDS_INTAB); if (F.tid < 27) tab[F.tid] = (unsigned long long)a.in[F.tid]; F.intab = tab; }
    volatile LAS unsigned* MISC = (volatile LAS unsigned*)(F.lds + LDS_MISC);
    if (F.tid < 64) MISC[F.tid] = 0u;
    __syncthreads();
    const bool multi = a.ph_hi - a.ph_lo > 1;
    XcdBarrier bar; bar.bar = F.ctl + CW_BAR; bar.x = 0; bar.st = MISC;
    if (multi) bar = xcd_barrier_post(F.ctl + CW_BAR, MISC);
    for (int ph = a.ph_lo; ph < a.ph_hi; ++ph) {
        {
            unsigned long long w_ = (unsigned long long)F.ws, o_ = (unsigned long long)F.out; unsigned l_ = (unsigned)(unsigned long long)F.lds, t_ = (unsigned)(unsigned long long)F.intab; int tid_ = threadIdx.x, g_ = gridDim.x, b_ = blockIdx.x;
            asm volatile("" : "+s"(w_), "+s"(o_), "+s"(l_), "+s"(t_), "+v"(tid_), "+s"(g_), "+s"(b_));
            F.ws = (unsigned char*)w_; F.out = (float*)o_; F.lds = (LAS unsigned char*)(unsigned long long)l_; F.intab = (const LAS unsigned long long*)(unsigned long long)t_; F.ctl = (unsigned*)(F.ws + WS_CTL);
            F.tid = tid_; F.lane = tid_ & 63; F.wave = __builtin_amdgcn_readfirstlane(tid_ >> 6); F.G = g_; F.bid = b_; }
        run_phase(F, ph);
        if (ph + 1 < a.ph_hi) xcd_barrier(bar);
    }
}
}

extern "C" void kernel_launch(void* const* d_in, const int* in_sizes, int n_in, void* d_out, int out_size, void* d_ws, size_t ws_size, hipStream_t stream) {
    static int grid = 0;
    if (grid == 0) {
        if (n_in != 27 || out_size != 8 * 4096 * 1024 || ws_size < fp::WS_END) { fprintf(stderr, "kernel_launch: unexpected problem (n_in %d, out %d, ws %zu < %zu)\n", n_in, out_size, ws_size, (size_t)fp::WS_END); grid = -1; return; }
        int dev = 0, cus = 0, per_cu = 0;
        if (hipGetDevice(&dev) != hipSuccess || hipDeviceGetAttribute(&cus, hipDeviceAttributeMultiprocessorCount, dev) != hipSuccess) { fprintf(stderr, "kernel_launch: device query failed\n"); grid = -1; return; }
        if (hipFuncSetAttribute((const void*)fp::mega_kernel, hipFuncAttributeMaxDynamicSharedMemorySize, fp::LDS_BYTES) != hipSuccess) { fprintf(stderr, "kernel_launch: hipFuncSetAttribute failed\n"); grid = -1; return; }
        if (hipOccupancyMaxActiveBlocksPerMultiprocessor(&per_cu, (const void*)fp::mega_kernel, fp::NTHR, fp::LDS_BYTES) != hipSuccess || per_cu < 1) fprintf(stderr, "kernel_launch: note: occupancy query reports %d workgroups per CU\n", per_cu);
        (void)hipGetLastError();
        grid = cus;
    }
    if (grid < 0) return;
    if (hipMemsetAsync((char*)d_ws + fp::WS_CTL, 0, fp::CTL_BYTES, stream) != hipSuccess) { fprintf(stderr, "kernel_launch: memset failed\n"); return; }
    fp::Args a{};
    for (int i = 0; i < 27; ++i) a.in[i] = (const float*)d_in[i];
    a.out = (float*)d_out; a.ws = (unsigned char*)d_ws; a.ph_lo = 0; a.ph_hi = fp::NPHASE;
    hipLaunchKernelGGL(fp::mega_kernel, dim3(grid), dim3(fp::NTHR), fp::LDS_BYTES, stream, a);
}
```

```cpp
#include <hip/hip_runtime.h>
#include <stdint.h>
#include <stdio.h>
#include <math.h>
#include <type_traits>
constexpr int DEPTH = 2;
#define FAST_NB 8
namespace fp {
#define LAS __attribute__((address_space(3)))
#define GAS __attribute__((address_space(1)))
typedef unsigned short bf16_t;
typedef short bf16x8 __attribute__((ext_vector_type(8)));
typedef short s16x4 __attribute__((ext_vector_type(4)));
typedef float f32x4 __attribute__((ext_vector_type(4)));
typedef float f32x16 __attribute__((ext_vector_type(16)));
typedef unsigned u32x4 __attribute__((ext_vector_type(4)));
typedef unsigned u32x2 __attribute__((ext_vector_type(2)));
typedef float f32x2 __attribute__((ext_vector_type(2)));
#define DI __device__ __forceinline__

DI unsigned cvt_pk(float lo, float hi) { typedef float f2 __attribute__((ext_vector_type(2))); typedef __bf16 b2 __attribute__((ext_vector_type(2))); f2 v = {lo, hi}; b2 b = __builtin_convertvector(v, b2); return __builtin_bit_cast(unsigned, b); }
DI float bf_lo(unsigned w) { return __uint_as_float(w << 16); }
DI float bf_hi(unsigned w) { return __uint_as_float(w & 0xffff0000u); }
DI float silu_f(float v) { return v / (1.f + __expf(-v)); }
template <int M> DI float swz_xor(float v) { return __int_as_float(__builtin_amdgcn_ds_swizzle(__float_as_int(v), (M << 10) | 0x1F)); }
DI float add_xor16(float v) { return v + swz_xor<16>(v); }
DI float add_xor32(float v) { auto r = __builtin_amdgcn_permlane32_swap(__float_as_uint(v), __float_as_uint(v), false, false); return __uint_as_float(r[0]) + __uint_as_float(r[1]); }
DI float other32(float v, bool upper_half) { auto r = __builtin_amdgcn_permlane32_swap(__float_as_uint(v), __float_as_uint(v), false, false); return __uint_as_float(upper_half ? r[0] : r[1]); }
DI float wave_sum(float v) { v += swz_xor<1>(v); v += swz_xor<2>(v); v += swz_xor<4>(v); v += swz_xor<8>(v); v += swz_xor<16>(v); return add_xor32(v); }
DI unsigned shfl_up_u(unsigned v, int o, int lane) { return (unsigned)__builtin_amdgcn_ds_bpermute((lane - o) << 2, (int)v); }

constexpr int NB = FAST_NB;
constexpr int LAT = NB * 4096, CTXR = NB * 256, R = LAT + CTXR, MT = R / 256;
constexpr int MOE_LAT = NB * 16 * 512, MOE_ROWS = MOE_LAT + 16 * 256;
constexpr float EPS = 1e-6f, LOG2E = 1.4426950408889634f;
constexpr float QS64 = 0.125f * LOG2E, QS96 = 0.10206207261596575f * LOG2E;
constexpr float QF64 = QS64 * 8.f, QF96 = QS96 * 8.f;
constexpr int NWAVES = 8, NTHR = 512;

constexpr size_t al256(size_t x) { return (x + 255) & ~(size_t)255; }
constexpr size_t WS_CTL = 0, CTL_BYTES = 65536;
constexpr size_t WS_MOD = WS_CTL + CTL_BYTES;
constexpr size_t WS_TAB64 = WS_MOD + al256((size_t)2 * 9 * 6144 * 4);
constexpr size_t WS_TAB32 = WS_TAB64 + 8192;
constexpr size_t WS_WIN = WS_TAB32 + 4096;
constexpr size_t WS_WUP = WS_WIN + (size_t)2 * 1536 * 1024 * 2;
constexpr size_t WS_WOUT = WS_WUP + (size_t)2 * 1536 * 384 * 2;
constexpr size_t WS_W1 = WS_WOUT + (size_t)2 * 1024 * 1024 * 2;
constexpr size_t WS_W2 = WS_W1 + (size_t)2 * 16 * 2048 * 1024 * 2;
constexpr size_t WS_HB = WS_W2 + (size_t)2 * 16 * 1024 * 1024 * 2;
constexpr size_t WS_CTXF = WS_HB + (size_t)R * 1024 * 2;
constexpr size_t WS_SSQ = WS_CTXF + (size_t)CTXR * 1024 * 4;
constexpr size_t WS_AFFL = WS_SSQ + (size_t)R * 8 * 4;
constexpr size_t WS_AFFC = WS_AFFL + (size_t)NB * 16 * 4096 * 4;
constexpr size_t WS_GIDX = WS_AFFC + (size_t)NB * 16 * 256 * 4;
constexpr size_t WS_GATE = WS_GIDX + (size_t)MOE_ROWS * 4;
constexpr size_t WS_INV = WS_GATE + (size_t)MOE_ROWS * 4;
constexpr size_t WS_Z = al256(WS_INV + (size_t)R * 16 * 4);
constexpr size_t Z_QA = WS_Z, Z_KA = Z_QA + (size_t)R * 384 * 2, Z_VA = Z_KA + (size_t)R * 128 * 2, Z_QC = Z_VA + (size_t)R * 128 * 2, Z_KC = Z_QC + (size_t)R * 256 * 2,
                 Z_VC = Z_KC + (size_t)R * 128 * 2, Z_CRAW = Z_VC + (size_t)R * 128 * 2, Z_QB = Z_CRAW + (size_t)R * 384 * 2, Z_KB = Z_QB + (size_t)R * 576 * 2,
                 Z_VB = Z_KB + (size_t)R * 576 * 2, Z_OB = Z_VB + (size_t)R * 384 * 2, Z_END1 = Z_OB + (size_t)R * 1024 * 2;
constexpr size_t Z_HID = WS_Z, Z_YE = Z_HID + (size_t)MOE_ROWS * 1024 * 2, Z_END2 = Z_YE + (size_t)MOE_ROWS * 1024 * 2;
constexpr size_t WS_END = al256(Z_END1 > Z_END2 ? Z_END1 : Z_END2);
constexpr int CW_BAR = 1024;
constexpr int CW_QUEUE = 8192;

constexpr int RING_BYTES = 131072;
constexpr int LDS_TAB64 = RING_BYTES, LDS_TAB32 = LDS_TAB64 + 8192, LDS_MISC = LDS_TAB32 + 4096;
constexpr int LDS_INTAB = LDS_MISC + 256;
constexpr int LDS_BYTES = 147456;

#define XB_TMO      128
#define XB_XCNT(j)  (256  + 64 * (j))
#define XB_XSUB(j)  (1280 + 64 * (j))
#define XB_XGEN(j)  (2304 + 64 * (j))
#define XB_TOP      3328
#define XB_TOPGEN   3392
#define XCD_BAR_WORDS 3456
#define XB_SPIN_CAP (1u << 20)
DI unsigned xb_ld(unsigned* p)              { return __hip_atomic_load(p, __ATOMIC_RELAXED, __HIP_MEMORY_SCOPE_AGENT); }
DI unsigned xb_add(unsigned* p, unsigned v) { return __hip_atomic_fetch_add(p, v, __ATOMIC_RELAXED, __HIP_MEMORY_SCOPE_AGENT); }
DI unsigned xb_xcc_id() { return (unsigned)__builtin_amdgcn_s_getreg((3 << 11) | 20) & 0xFu; }
#define XB_SPIN(cond, bar) do { unsigned _sp = 0; while (cond) { __builtin_amdgcn_s_sleep(1); \
    if ((++_sp & 255u) == 0u) { if (xb_ld(&(bar)[XB_TMO])) break; if (_sp > XB_SPIN_CAP) { atomicAdd(&(bar)[XB_TMO], 1u); break; } } } } while (0)
struct XcdBarrier { unsigned* bar; unsigned x; volatile LAS unsigned* st; };
DI XcdBarrier xcd_barrier_post(unsigned* bar, volatile LAS unsigned* st) {
    XcdBarrier b; b.bar = bar; b.x = xb_xcc_id(); b.st = st;
    if (threadIdx.x == 0) (void)xb_add(&bar[XB_XCNT(b.x)], 1u);
    return b;
}
DI void xcd_barrier_complete(unsigned* bar, unsigned x, unsigned& nloc, unsigned& nx) {
    asm volatile("" : "+s"(x));
    const unsigned G = gridDim.x * gridDim.y * gridDim.z;
    unsigned sum, cnt, mine, sp = 0u;
    for (;;) {
        sum = 0u; cnt = 0u; mine = 0u;
#pragma unroll
        for (unsigned j = 0; j < 16; ++j) { const unsigned c = xb_ld(&bar[XB_XCNT(j)]); sum += c; cnt += (c > 0u) ? 1u : 0u; mine = (j == x) ? c : mine; }
        if (sum == G) break;
        __builtin_amdgcn_s_sleep(1);
        if ((++sp & 255u) == 0u) { if (xb_ld(&bar[XB_TMO])) break; if (sp > XB_SPIN_CAP) { atomicAdd(&bar[XB_TMO], 1u); break; } }
    }
    nloc = mine > 0u ? mine : 1u; nx = cnt > 0u ? cnt : 1u;
}
DI void xcd_barrier(const XcdBarrier& b) {
    asm volatile("s_waitcnt vmcnt(0)" ::: "memory");
    __syncthreads();
    if (threadIdx.x == 0) {
        unsigned* bar = b.bar; asm volatile("" : "+s"(bar));
        __builtin_amdgcn_s_waitcnt(0);
        unsigned nloc = b.st[0], nx = b.st[1];
        if (nloc == 0u) { xcd_barrier_complete(bar, b.x, nloc, nx); b.st[0] = nloc; b.st[1] = nx; }
        const unsigned old = xb_add(&bar[XB_XSUB(b.x)], 1u);
        const unsigned gen = old / nloc;
        if (old + 1u == (gen + 1u) * nloc) {
            __builtin_amdgcn_fence(__ATOMIC_RELEASE, "agent");
            asm volatile("s_waitcnt vmcnt(0)" ::: "memory");
            const unsigned og = xb_add(&bar[XB_TOP], 1u);
            const unsigned tg = og / nx;
            if (og + 1u == (tg + 1u) * nx) xb_add(&bar[XB_TOPGEN], 1u);
            else XB_SPIN(xb_ld(&bar[XB_TOPGEN]) == tg, bar);
            __builtin_amdgcn_fence(__ATOMIC_ACQUIRE, "agent");
            xb_add(&bar[XB_XGEN(b.x)], 1u);
            asm volatile("s_waitcnt vmcnt(0)" ::: "memory");
        } else {
            XB_SPIN(xb_ld(&bar[XB_XGEN(b.x)]) == gen, bar);
            __builtin_amdgcn_fence(__ATOMIC_ACQUIRE, "agent");
            asm volatile("s_waitcnt vmcnt(0)" ::: "memory");
        }
    }
    __syncthreads();
}

struct Args { const float* in[27]; float* out; unsigned char* ws; int ph_lo, ph_hi, li, pad; };
struct Frame {
    LAS unsigned char* lds; unsigned char* ws; unsigned* ctl;
    int tid, lane, wave, G, bid;
    const LAS unsigned long long* intab; float* out;
};
DI const float* inp(const LAS unsigned long long* tab, int k) { const unsigned long long v = tab[k]; const unsigned lo = __builtin_amdgcn_readfirstlane((unsigned)v), hi = __builtin_amdgcn_readfirstlane((unsigned)(v >> 32)); return (const float*)(const GAS float*)(((unsigned long long)hi << 32) | lo); }
#define INP(k) inp(F.intab, k)
#define WSP(T, off) ((T*)(F.ws + (off)))

DI void mod_item(const Frame& F, int item, const LAS float* s9, LAS float* red) {
    const int l = item / 96, c0 = (item % 96) * 64;
    const float* W = INP(4) + (size_t)l * 1024 * 6144 + c0;
    const int cg = F.lane & 15, ks = F.wave * 4 + (F.lane >> 4);
    f32x4 acc[9];
#pragma unroll
    for (int r = 0; r < 9; ++r) acc[r] = (f32x4){0.f, 0.f, 0.f, 0.f};
#pragma unroll 4
    for (int i = 0; i < 32; ++i) { const int k = ks + 32 * i; const f32x4 w = *(const f32x4*)(W + (size_t)k * 6144 + cg * 4);
#pragma unroll
        for (int r = 0; r < 9; ++r) acc[r] += w * s9[r * 1024 + k]; }
#pragma unroll
    for (int r = 0; r < 9; ++r)
#pragma unroll
        for (int j = 0; j < 4; ++j) { acc[r][j] = add_xor32(add_xor16(acc[r][j])); }
    __syncthreads();
    if (F.lane < 16) {
#pragma unroll
        for (int r = 0; r < 9; ++r) *(LAS f32x4*)(red + (F.wave * 9 + r) * 64 + cg * 4) = acc[r]; }
    __syncthreads();
    for (int e = F.tid; e < 9 * 64; e += NTHR) { const int r = e / 64, c = e % 64; float s = 0.f;
#pragma unroll
        for (int w = 0; w < 8; ++w) s += red[(w * 9 + r) * 64 + c];
        WSP(float, WS_MOD)[((size_t)l * 9 + r) * 6144 + c0 + c] = s + INP(5)[l * 6144 + c0 + c]; }
}

DI void cv_block(const float* src  , int ld, const float* ksc, bf16_t* drow  ) {
#pragma unroll
    for (int kc = 0; kc < 8; ++kc) {
        float v[8];
#pragma unroll
        for (int j = 0; j < 8; ++j) v[j] = src ? src[(size_t)(kc * 8 + j) * ld] : 0.f;
        if (ksc) {
#pragma unroll
            for (int j = 0; j < 8; ++j) v[j] *= ksc[kc * 8 + j]; }
        u32x4 o; o.x = cvt_pk(v[0], v[1]); o.y = cvt_pk(v[2], v[3]); o.z = cvt_pk(v[4], v[5]); o.w = cvt_pk(v[6], v[7]);
        *(u32x4*)(drow + kc * 8) = o;
    }
}
DI void cv_block_fp8(const float* src, int ld, unsigned char* drow) {
#pragma unroll
    for (int kc = 0; kc < 4; ++kc) {
        float v[16];
#pragma unroll
        for (int j = 0; j < 16; ++j) v[j] = src[(size_t)(kc * 16 + j) * ld] * 64.0f;
        u32x4 o;
        { int w = __builtin_amdgcn_cvt_pk_fp8_f32(v[0], v[1], 0, false); w = __builtin_amdgcn_cvt_pk_fp8_f32(v[2], v[3], w, true); o.x = (unsigned)w; }
        { int w = __builtin_amdgcn_cvt_pk_fp8_f32(v[4], v[5], 0, false); w = __builtin_amdgcn_cvt_pk_fp8_f32(v[6], v[7], w, true); o.y = (unsigned)w; }
        { int w = __builtin_amdgcn_cvt_pk_fp8_f32(v[8], v[9], 0, false); w = __builtin_amdgcn_cvt_pk_fp8_f32(v[10], v[11], w, true); o.z = (unsigned)w; }
        { int w = __builtin_amdgcn_cvt_pk_fp8_f32(v[12], v[13], 0, false); w = __builtin_amdgcn_cvt_pk_fp8_f32(v[14], v[15], w, true); o.w = (unsigned)w; }
        *(u32x4*)(drow + kc * 16) = o;
    }
}
constexpr int CV_WIN = 384, CV_WUP = 144, CV_WOUT = 256, CV_W1 = 8192, CV_W2 = 4096, CV_LAYER = CV_WIN + CV_WUP + CV_WOUT + CV_W1 + CV_W2;
DI void conv_item(const Frame& F, int it) {
    const int l = it / CV_LAYER; int r = it % CV_LAYER; const int lane = F.lane, hl = lane >> 5, ll = lane & 31;
    if (r < CV_WIN) {
        const int kb = r / 24, g = (r % 24) * 2 + hl, x = ((g >> 3) * 4 + (g & 3)) * 64 + 32 * ((g >> 2) & 1) + ll;
        const int sc = x < 960 ? x : (x < 1472 ? x + 32 : (x < 1504 ? x - 512 : -1));
        const float* src = sc < 0 ? nullptr : INP(8) + (size_t)l * 1024 * 1504 + (size_t)(kb * 64) * 1504 + sc;
        cv_block(src, 1504, nullptr, WSP(bf16_t, WS_WIN) + (size_t)l * 1536 * 1024 + (size_t)((r % 24) * 64 + lane) * 1024 + kb * 64); return; }
    r -= CV_WIN;
    if (r < CV_WUP) {
        const int kb = r / 24, g = (r % 24) * 2 + hl, slot = (g >> 3) * 4 + (g & 3), half = (g >> 2) & 1;
        const float* src = nullptr; const float* ksc = nullptr; int ld = 0;
        if (slot < 9 && kb < 3) { const int col = slot < 6 ? slot * 96 + 32 * half : (2 * (slot - 6) + half) * 96 + 64;
            src = INP(13) + (size_t)l * 192 * 576 + (size_t)(kb * 64) * 576 + col + ll; ld = 576; ksc = INP(11) + l * 192 + kb * 64; }
        else if (slot >= 12 && (kb == 3 || kb == 4)) { const int h = slot < 18 ? slot - 12 : slot - 18; const int col = h * 128 + (slot < 18 ? 0 : 64) + 32 * half;
            src = INP(14) + (size_t)l * 128 * 768 + (size_t)((kb - 3) * 64) * 768 + col + ll; ld = 768; ksc = INP(12) + l * 128 + (kb - 3) * 64; }
        cv_block(src, ld, ksc, WSP(bf16_t, WS_WUP) + (size_t)l * 1536 * 384 + (size_t)((r % 24) * 64 + lane) * 384 + kb * 64); return; }
    r -= CV_WUP;
    if (r < CV_WOUT) { const int kb = r / 16, g = r % 16;
        cv_block(INP(22) + (size_t)l * 1024 * 1024 + (size_t)(kb * 64) * 1024 + g * 64 + lane, 1024, nullptr, WSP(bf16_t, WS_WOUT) + (size_t)l * 1024 * 1024 + (size_t)(g * 64 + lane) * 1024 + kb * 64); return; }
    r -= CV_WOUT;
    if (r < CV_W1) { const int e = r / 512, q = r % 512, kb = q / 32, g = (q % 32) * 2 + hl, pn = g >> 3, bj = (g >> 2) & 1, wc = g & 3;
        const float* src = (bj ? INP(25) : INP(24)) + ((size_t)l * 16 + e) * 1024 * 1024 + (size_t)(kb * 64) * 1024 + 128 * pn + 32 * wc + ll;
        cv_block_fp8(src, 1024, WSP(unsigned char, WS_W1) + ((size_t)l * 16 + e) * 2048 * 1024 + (size_t)((q % 32) * 64 + lane) * 1024 + kb * 64); return; }
    r -= CV_W1;
    { const int e = r / 256, q = r % 256, kb = q / 16, g = q % 16;
        cv_block_fp8(INP(26) + ((size_t)l * 16 + e) * 1024 * 1024 + (size_t)(kb * 64) * 1024 + g * 64 + lane, 1024, WSP(unsigned char, WS_W2) + ((size_t)l * 16 + e) * 1024 * 1024 + (size_t)(g * 64 + lane) * 1024 + kb * 64); }
}
DI void p0_phase(const Frame& F) {
    LAS float* s9 = (LAS float*)F.lds;
    LAS float* red = (LAS float*)(F.lds + 9 * 1024 * 4);
    if (F.bid == 0) {
        for (int i = F.tid; i < 64 * 16; i += NTHR) { const int pos = i / 16, f = i % 16; const float inv = exp2f(-(float)(2 * f) / 32.f * 13.287712379549449f); const float a = (float)pos * inv; WSP(f32x2, WS_TAB64)[i] = (f32x2){cosf(a), sinf(a)}; }
        for (int i = F.tid; i < 64 * 8; i += NTHR) { const int pos = i / 8, f = i % 8; const float inv = exp2f(-(float)(2 * f) / 16.f * 13.287712379549449f); const float a = (float)pos * inv; WSP(f32x2, WS_TAB32)[i] = (f32x2){cosf(a), sinf(a)}; }
    }
    bool have_s9 = false;
    for (int it = F.bid; it < 192; it += F.G) {
        if (!have_s9) { for (int e = F.tid; e < 9 * 1024; e += NTHR) { const int r = e / 1024, k = e % 1024; const float v = r < 8 ? INP(1)[r * 1024 + k] : INP(3)[k]; s9[e] = silu_f(v); } have_s9 = true; __syncthreads(); }
        mod_item(F, it, s9, red);
    }
    __syncthreads();
    const int gw = F.bid * NWAVES + F.wave, NGW = F.G * NWAVES;
    for (int it = gw; it < 2 * CV_LAYER; it += NGW) conv_item(F, it);
}

DI void norm_mod_store(const f32x4 (&v)[4], const float* g, const float* sh, const float* sc, bf16_t* orow, int lane) {
    float s = 0.f;
#pragma unroll
    for (int j = 0; j < 4; ++j) s += (v[j].x * v[j].x + v[j].y * v[j].y) + (v[j].z * v[j].z + v[j].w * v[j].w);
    const float rstd = 1.0f / sqrtf(wave_sum(s) * (1.f / 1024.f) + EPS);
#pragma unroll
    for (int j = 0; j < 4; ++j) { const int c = 4 * (lane + 64 * j); const f32x4 gv = *(const f32x4*)(g + c), sv = *(const f32x4*)(sh + c), cv = *(const f32x4*)(sc + c);
        const f32x4 o = v[j] * rstd * gv * (cv + 1.0f) + sv; u32x2 w; w.x = cvt_pk(o.x, o.y); w.y = cvt_pk(o.z, o.w); *(u32x2*)(orow + c) = w; }
}
DI const float* mod_row(const Frame& F, int l, int row) { const int r = row < LAT ? row / 4096 : 8; return WSP(float, WS_MOD) + ((size_t)l * 9 + r) * 6144; }
DI void init_norm_phase(const Frame& F) {
    const int gw = F.bid * NWAVES + F.wave, NGW = F.G * NWAVES;
    for (int row = gw; row < R; row += NGW) {
        const float* xr = row < LAT ? INP(0) + (size_t)row * 1024 : INP(2) + (size_t)(row - LAT) * 1024;
        f32x4 v[4];
#pragma unroll
        for (int j = 0; j < 4; ++j) v[j] = *(const f32x4*)(xr + 4 * (F.lane + 64 * j));
        const float* m = mod_row(F, 0, row);
        norm_mod_store(v, INP(6), m, m + 1024, WSP(bf16_t, WS_HB) + (size_t)row * 1024, F.lane);
    }
}
namespace g8 {
constexpr int BM = 256, BK = 64, HALF = 128, HTB = HALF * BK * 2, STAGE_BYTES = 8 * HTB;
DI int lds_byte(int r, int c) { const int st = (r >> 4) * 2 + (c >> 5), rr = r & 15, cc = c & 31, ob = rr * 64 + cc * 2; return st * 1024 + (ob ^ (((ob >> 9) & 1) << 5)); }
DI void stage_rc(int b, int& Rr, int& Cc) { const int st = b / 1024, sb = b % 1024, swz = sb ^ (((sb >> 9) & 1) << 5); Rr = (st >> 1) * 16 + swz / 64; Cc = (st & 1) * 32 + (swz % 64) / 2; }
DI int perm32(int rho) { const int n = rho >> 4, i = rho & 15; return 8 * (i >> 2) + 4 * n + (i & 3); }

typedef int i32x4 __attribute__((ext_vector_type(4)));
typedef int i32x8 __attribute__((ext_vector_type(8)));
struct Unit { int pm, pn, aux; const char* Bp; };

template <class Epi, class Sched>
DI void gemm_phase(const int tid, LAS unsigned char* lds, const char* Abase, int K, const Sched& S, const Epi& E) {
    asm volatile("" : "+s"(K));
    const int wid = __builtin_amdgcn_readfirstlane(tid >> 6), lane = tid & 63, wr = wid >> 2, wc = wid & 3, fr = lane & 15, fq = lane >> 4;
    const int nt = K / BK;
    int Rr[2], Cc[2]; unsigned voffB[2];
#pragma unroll
    for (int i = 0; i < 2; ++i) { int r_, c_; stage_rc(tid * 16 + i * 8192, r_, c_); Rr[i] = r_; Cc[i] = c_; const int Rb = Epi::PERM ? ((r_ & ~31) + perm32(r_ & 31)) : r_; voffB[i] = (unsigned)(Rb * K + c_) * 2u; }
    const size_t hstepB = (size_t)HALF * K * 2;
    const unsigned ldsw = (unsigned)wid * 1024u;
    const int aoff = lds_byte(wr * 64 + fr, fq * 8), boff = lds_byte(wc * 32 + fr, fq * 8);
#define G8_SA(b, h) (((b) * 2 + (h)) * HTB)
#define G8_SB(b, h) ((4 + (b) * 2 + (h)) * HTB)
#define G8_STAGE_A(bufoff, ao2, kt) do { _Pragma("unroll") for (int _i = 0; _i < 2; ++_i) \
        __builtin_amdgcn_global_load_lds((const unsigned*)(Abase + (size_t)(ao2)[_i] + (size_t)(kt) * 128), (LAS unsigned*)(lds + (bufoff) + ldsw + _i * 8192), 16, 0, 0); } while (0)
#define G8_STAGE_B(bufoff, bp, h, kt) do { _Pragma("unroll") for (int _i = 0; _i < 2; ++_i) \
        __builtin_amdgcn_global_load_lds((const unsigned*)((bp) + (size_t)(h) * hstepB + voffB[_i] + (size_t)(kt) * 128), (LAS unsigned*)(lds + (bufoff) + ldsw + _i * 8192), 16, 0, 0); } while (0)
#define G8_LD16(off) (*(const LAS i32x4*)(lds + (off)))
#define G8_LDA(dst, b, h) do { _Pragma("unroll") for (int m = 0; m < 4; ++m) { const i32x4 lo_ = G8_LD16(G8_SA(b, h) + aoff + m * 2048), hi_ = G8_LD16(G8_SA(b, h) + aoff + m * 2048 + 1024); dst[m] = __builtin_shufflevector(lo_, hi_, 0, 1, 2, 3, 4, 5, 6, 7); } } while (0)
#define G8_LDB(dst, b, h) do { _Pragma("unroll") for (int n = 0; n < 2; ++n) { const i32x4 lo_ = G8_LD16(G8_SB(b, h) + boff + n * 2048), hi_ = G8_LD16(G8_SB(b, h) + boff + n * 2048 + 1024); dst[n] = __builtin_shufflevector(lo_, hi_, 0, 1, 2, 3, 4, 5, 6, 7); } } while (0)
#define G8_HALF(v, k) __builtin_bit_cast(bf16x8, __builtin_shufflevector((v), (v), 4 * (k), 4 * (k) + 1, 4 * (k) + 2, 4 * (k) + 3))
#define G8_MMA(ai, bj, At, Bt) do { __builtin_amdgcn_s_setprio(1); _Pragma("unroll") for (int m = 0; m < 4; ++m) _Pragma("unroll") for (int n = 0; n < 2; ++n) { \
        if constexpr (Epi::FP8) asm volatile("v_mfma_scale_f32_16x16x128_f8f6f4 %0, %1, %2, %0, %3, %3 op_sel_hi:[0,0,0]" : "+v"(acc[ai][bj][m][n]) : "v"(Bt[n]), "v"(At[m]), "v"(fp8_scale)); \
        else { acc[ai][bj][m][n] = __builtin_amdgcn_mfma_f32_16x16x32_bf16(G8_HALF(Bt[n], 0), G8_HALF(At[m], 0), acc[ai][bj][m][n], 0, 0, 0); \
               acc[ai][bj][m][n] = __builtin_amdgcn_mfma_f32_16x16x32_bf16(G8_HALF(Bt[n], 1), G8_HALF(At[m], 1), acc[ai][bj][m][n], 0, 0, 0); } } __builtin_amdgcn_s_setprio(0); } while (0)
#define G8_WAIT_V(n) asm volatile("s_waitcnt vmcnt(" #n ")" ::: "memory")
#define G8_WAIT_L(n) asm volatile("s_waitcnt lgkmcnt(" #n ")" ::: "memory")
#define G8_BAR __builtin_amdgcn_s_barrier()
#define G8_SCHED __builtin_amdgcn_sched_barrier(0)
    const int fp8_scale = 0x7F7F7F7F;
    Unit cur, nxt; int ui = 0;
    if (!S.next(0, cur)) return;
    unsigned aoc[2][2], aon[2][2];
    S.aoffs(cur, Rr, Cc, aoc);
    f32x4 acc[2][2][4][2];
#pragma unroll
    for (int a = 0; a < 2; ++a)
#pragma unroll
        for (int b = 0; b < 2; ++b)
#pragma unroll
            for (int m = 0; m < 4; ++m)
#pragma unroll
                for (int n = 0; n < 2; ++n) acc[a][b][m][n] = (f32x4){0.f, 0.f, 0.f, 0.f};
    i32x8 At[4], B0[2], B1[2];
    const char* cB = cur.Bp;
    G8_STAGE_B(G8_SB(0, 0), cB, 0, 0); G8_STAGE_B(G8_SB(0, 1), cB, 1, 0); G8_STAGE_A(G8_SA(0, 0), aoc[0], 0); G8_STAGE_A(G8_SA(0, 1), aoc[1], 0);
    if (wr == 1) G8_BAR;
    G8_WAIT_V(2); G8_BAR;
    G8_STAGE_B(G8_SB(1, 0), cB, 0, 1); G8_STAGE_A(G8_SA(1, 0), aoc[0], 1); G8_STAGE_B(G8_SB(1, 1), cB, 1, 1);
    G8_WAIT_V(6); G8_BAR;
    for (;;) {
        const bool has_next = S.next(ui + 1, nxt);
        if (has_next) S.aoffs(nxt, Rr, Cc, aon);
        else {
#pragma unroll
            for (int h = 0; h < 2; ++h)
#pragma unroll
                for (int i = 0; i < 2; ++i) aon[h][i] = aoc[h][i]; }
        const char* nB = has_next ? nxt.Bp : cB;
        for (int t = 0; t < nt; t += 2) {
            const bool last = (t == nt - 2);
            unsigned a2[2][2];
#pragma unroll
            for (int h = 0; h < 2; ++h)
#pragma unroll
                for (int i = 0; i < 2; ++i) a2[h][i] = last ? aon[h][i] : aoc[h][i];
            const int kt2 = last ? 0 : t + 2; const char* b2 = last ? nB : cB;
            G8_LDB(B0, 0, 0); G8_LDB(B1, 0, 1); G8_SCHED; G8_LDA(At, 0, 0); G8_STAGE_A(G8_SA(1, 1), aoc[1], t + 1);
            G8_WAIT_V(8); G8_WAIT_L(0); G8_BAR; G8_MMA(0, 0, At, B0); G8_MMA(0, 1, At, B1); G8_BAR; G8_SCHED;
            G8_LDA(At, 0, 1); G8_STAGE_B(G8_SB(0, 0), b2, 0, kt2); G8_STAGE_B(G8_SB(0, 1), b2, 1, kt2); G8_STAGE_A(G8_SA(0, 0), a2[0], kt2);
            G8_WAIT_V(8); G8_WAIT_L(0); G8_BAR; G8_MMA(1, 0, At, B0); G8_MMA(1, 1, At, B1); G8_BAR; G8_SCHED;
            G8_LDB(B0, 1, 0); G8_LDB(B1, 1, 1); G8_SCHED; G8_LDA(At, 1, 0); G8_STAGE_A(G8_SA(0, 1), a2[1], kt2);
            G8_WAIT_V(8); G8_WAIT_L(0); G8_BAR; G8_MMA(0, 0, At, B0); G8_MMA(0, 1, At, B1); G8_BAR; G8_SCHED;
            G8_LDA(At, 1, 1); G8_STAGE_B(G8_SB(1, 0), b2, 0, kt2 + 1); G8_STAGE_B(G8_SB(1, 1), b2, 1, kt2 + 1); G8_STAGE_A(G8_SA(1, 0), a2[0], kt2 + 1);
            G8_WAIT_V(8); G8_WAIT_L(0); G8_BAR; G8_MMA(1, 0, At, B0); G8_MMA(1, 1, At, B1); G8_BAR; G8_SCHED;
        }
        if (wr == 0) G8_BAR;
        if constexpr (Epi::FP8) asm volatile("s_nop 15\n\ts_nop 15" ::: "memory");
        E(acc, cur, wr, wc, fr, fq);
        if (!has_next) break;
#pragma unroll
        for (int a = 0; a < 2; ++a)
#pragma unroll
            for (int b = 0; b < 2; ++b)
#pragma unroll
                for (int m = 0; m < 4; ++m)
#pragma unroll
                    for (int n = 0; n < 2; ++n) acc[a][b][m][n] = (f32x4){0.f, 0.f, 0.f, 0.f};
        cur = nxt; cB = nB;
#pragma unroll
        for (int h = 0; h < 2; ++h)
#pragma unroll
            for (int i = 0; i < 2; ++i) aoc[h][i] = aon[h][i];
        ++ui;
        if (wr == 1) G8_BAR;
    }
    G8_WAIT_V(0);
    G8_BAR;
#undef G8_SA
#undef G8_SB
#undef G8_STAGE_A
#undef G8_STAGE_B
#undef G8_LDA
#undef G8_LDB
#undef G8_MMA
#undef G8_HALF
#undef G8_LD16
#undef G8_WAIT_V
#undef G8_WAIT_L
#undef G8_BAR
#undef G8_SCHED
}

struct DenseSched {
    int nM, nN, nwg, G, c, K; const char* Bt;
    DI void init(int nM_, int nN_, int G_, int c_, int K_, const void* Bt_) { nM = nM_; nN = nN_; nwg = nM * nN; G = G_; c = c_; K = K_; Bt = (const char*)Bt_; }
    DI bool next(int i, Unit& u) const {
        const long L = (long)i * G + c; if (L >= nwg) return false;
        int wgid = (int)L; { const int q = nwg / 8, r = nwg % 8, xcd = wgid % 8, off = wgid / 8; wgid = (xcd < r ? xcd * (q + 1) : r * (q + 1) + (xcd - r) * q) + off; }
        const int WGM = 8, nig = WGM * nN, gid = wgid / nig, fm = gid * WGM, gsz = (nM - fm) < WGM ? (nM - fm) : WGM;
        u.pm = fm + ((wgid % nig) % gsz); u.pn = (wgid % nig) / gsz; u.aux = 0; u.Bp = Bt + (size_t)u.pn * 256 * K * 2; return true;
    }
    DI void aoffs(const Unit& u, const int (&Rr)[2], const int (&Cc)[2], unsigned (&ao)[2][2]) const {
#pragma unroll
        for (int h = 0; h < 2; ++h)
#pragma unroll
            for (int i = 0; i < 2; ++i) ao[h][i] = (unsigned)(((size_t)(u.pm * 256 + h * 128 + Rr[i]) * K + Cc[i]) * 2);
    }
};
template <bool GATHER>
struct MoeSched {
    int nN, tiles_per_e, nwg, G, c, K, NBt; const char* Bt; size_t estride; const int* gidx; bool with_ctx;
    DI void init(int nN_, bool with_ctx_, int G_, int c_, int K_, const void* Bt_, size_t estride_, const int* gidx_) {
        nN = nN_; with_ctx = with_ctx_; tiles_per_e = NB * 2 + (with_ctx_ ? 1 : 0); nwg = 16 * tiles_per_e * nN; G = G_; c = c_; K = K_; Bt = (const char*)Bt_; estride = estride_; gidx = gidx_; }
    DI bool next(int i, Unit& u) const {
        int mt;
        if (G % (8 * nN) == 0) {
            const int per = (G / 8) / nN, xcd = c & 7, j8 = c >> 3; mt = (i * 8 + xcd) * per + j8 / nN; u.pn = j8 % nN; if (mt >= 16 * tiles_per_e) return false;
        } else { const long L = (long)i * G + c; if (L >= nwg) return false; mt = (int)L / nN; u.pn = (int)L % nN; }
        const int e = mt / tiles_per_e, j = mt % tiles_per_e;
        const int rowbase = j < NB * 2 ? ((j >> 1) * 16 + e) * 512 + (j & 1) * 256 : MOE_LAT + e * 256;
        u.pm = rowbase / 256; u.aux = e; u.Bp = Bt + (size_t)e * estride + (size_t)u.pn * 256 * K * 2; return true;
    }
    DI void aoffs(const Unit& u, const int (&Rr)[2], const int (&Cc)[2], unsigned (&ao)[2][2]) const {
#pragma unroll
        for (int h = 0; h < 2; ++h)
#pragma unroll
            for (int i = 0; i < 2; ++i) { const int mrow = u.pm * 256 + h * 128 + Rr[i]; const int arow = GATHER ? gidx[mrow] : mrow; ao[h][i] = (unsigned)(((size_t)arow * K + Cc[i]) * 2); }
    }
};
}

typedef f32x4 Acc[2][2][4][2];
DI unsigned pk_fp8x4(float a, float b, float c, float d) { int w = __builtin_amdgcn_cvt_pk_fp8_f32(a, b, 0, false); w = __builtin_amdgcn_cvt_pk_fp8_f32(c, d, w, true); return (unsigned)w; }
DI unsigned pk_fp8v(const f32x4 v) { return pk_fp8x4(v.x, v.y, v.z, v.w); }
DI void st_bf16x4(bf16_t* p, const f32x4 v) { u32x2 w; w.x = cvt_pk(v.x, v.y); w.y = cvt_pk(v.z, v.w); *(u32x2*)p = w; }

struct EpiInProj {
    static constexpr bool PERM = false, FP8 = false;
    unsigned char* ws; const LAS unsigned long long* in; int l; const LAS f32x2* tab64; const LAS f32x2* tab32;
    DI void operator()(const Acc& acc, const g8::Unit& u, int wr, int wc, int fr, int fq) const {
        asm volatile("" : "+v"(fr), "+v"(fq));
        const int slot = 4 * u.pn + wc; const int rowt = u.pm * 256 + wr * 64 + fr; const bool lat = (u.pm * 256) < LAT;
        int kind; bf16_t* dst; int ld, coff; const float* gain = nullptr; float qs = 1.f;
        if (slot < 6)       { kind = 0; dst = (bf16_t*)(ws + Z_QA); ld = 384; coff = slot * 64; gain = inp(in, 9) + l * 64; qs = QF64; }
        else if (slot < 8)  { kind = 0; dst = (bf16_t*)(ws + Z_KA); ld = 128; coff = (slot - 6) * 64; gain = inp(in, 10) + l * 64; }
        else if (slot < 10) { kind = 1; dst = (bf16_t*)(ws + Z_VA); ld = 128; coff = (slot - 8) * 64; }
        else if (slot < 15) { kind = 2; dst = (bf16_t*)(ws + Z_CRAW); ld = 384; coff = (slot - 10) * 64; }
        else if (slot < 19) { kind = 0; dst = (bf16_t*)(ws + Z_QC); ld = 256; coff = (slot - 15) * 64; gain = inp(in, 19) + l * 64; qs = QF64; }
        else if (slot < 21) { kind = 0; dst = (bf16_t*)(ws + Z_KC); ld = 128; coff = (slot - 19) * 64; gain = inp(in, 20) + l * 64; }
        else if (slot < 23) { kind = 1; dst = (bf16_t*)(ws + Z_VC); ld = 128; coff = (slot - 21) * 64; }
        else                { kind = 3; dst = (bf16_t*)(ws + Z_KB); ld = 576; coff = 64; gain = inp(in, 18) + l * 32; }
        if (kind == 0) {
            f32x4 g[2][2];
#pragma unroll
            for (int bj = 0; bj < 2; ++bj)
#pragma unroll
                for (int n = 0; n < 2; ++n) g[bj][n] = *(const f32x4*)(gain + 32 * bj + 16 * n + 4 * fq) * qs;
#pragma unroll
            for (int ai = 0; ai < 2; ++ai)
#pragma unroll
                for (int m = 0; m < 4; ++m) {
                    const int row = rowt + ai * 128 + m * 16; float s = 0.f;
#pragma unroll
                    for (int bj = 0; bj < 2; ++bj)
#pragma unroll
                        for (int n = 0; n < 2; ++n) { const f32x4 x = acc[ai][bj][m][n]; s += (x.x * x.x + x.y * x.y) + (x.z * x.z + x.w * x.w); }
                    s = add_xor32(add_xor16(s));
                    const float rstd = 1.0f / sqrtf(s * (1.f / 64.f) + EPS);
                    const int t = row & 4095, pr = t >> 6, pc = t & 63;
#pragma unroll
                    for (int bj = 0; bj < 2; ++bj) {
                        f32x4 x1 = acc[ai][bj][m][0] * rstd * g[bj][0], x2 = acc[ai][bj][m][1] * rstd * g[bj][1];
                        if (lat) { const LAS f32x2* tb = tab64 + (bj == 0 ? pr : pc) * 16 + 4 * fq; f32x4 o1, o2;
#pragma unroll
                            for (int i = 0; i < 4; ++i) { const f32x2 cs = tb[i]; o1[i] = x1[i] * cs.x - x2[i] * cs.y; o2[i] = x2[i] * cs.x + x1[i] * cs.y; }
                            x1 = o1; x2 = o2; }
                        unsigned char* p = (unsigned char*)dst + (size_t)row * ld + coff + 32 * bj + 4 * fq;
                        *(unsigned*)p = pk_fp8v(x1); *(unsigned*)(p + 16) = pk_fp8v(x2);
                    }
                    asm volatile("" ::: "memory");
                }
        } else if (kind == 1 || kind == 2) {
#pragma unroll
            for (int ai = 0; ai < 2; ++ai)
#pragma unroll
                for (int m = 0; m < 4; ++m) {
                    const int row = rowt + ai * 128 + m * 16; float s = 0.f;
#pragma unroll
                    for (int bj = 0; bj < 2; ++bj)
#pragma unroll
                        for (int n = 0; n < 2; ++n) { const f32x4 x = acc[ai][bj][m][n]; s += (x.x * x.x + x.y * x.y) + (x.z * x.z + x.w * x.w);
                            st_bf16x4(dst + (size_t)row * ld + coff + 32 * bj + 16 * n + 4 * fq, x); }
                    if (kind == 2) { s = add_xor32(add_xor16(s)); if (fq == 0) ((float*)(ws + WS_SSQ))[(size_t)row * 8 + (slot - 10)] = s; }
                }
        } else {
            const f32x4 g0 = *(const f32x4*)(gain + 4 * fq), g1 = *(const f32x4*)(gain + 16 + 4 * fq);
            bf16_t* craw = (bf16_t*)(ws + Z_CRAW);
#pragma unroll
            for (int ai = 0; ai < 2; ++ai)
#pragma unroll
                for (int m = 0; m < 4; ++m) {
                    const int row = rowt + ai * 128 + m * 16;
                    const f32x4 a0 = acc[ai][0][m][0], a1 = acc[ai][0][m][1];
                    float s = (a0.x * a0.x + a0.y * a0.y) + (a0.z * a0.z + a0.w * a0.w) + (a1.x * a1.x + a1.y * a1.y) + (a1.z * a1.z + a1.w * a1.w);
                    s = add_xor32(add_xor16(s));
                    const float rstd = 1.0f / sqrtf(s * (1.f / 32.f) + EPS);
                    f32x4 v0 = a0 * rstd * g0, v1 = a1 * rstd * g1;
                    if (lat) { const int t = row & 4095, pr = t >> 6, pc = t & 63;
                        f32x4 p0, p1;
#pragma unroll
                        for (int i = 0; i < 4; ++i) { p0[i] = other32(v0[i], fq >= 2); p1[i] = other32(v1[i], fq >= 2); }
                        const LAS f32x2* t0 = tab32 + pr * 8 + 4 * (fq & 1); const LAS f32x2* t1 = tab32 + pc * 8 + 4 * (fq & 1);
#pragma unroll
                        for (int i = 0; i < 4; ++i) { const f32x2 c0 = t0[i], c1 = t1[i];
                            v0[i] = fq < 2 ? v0[i] * c0.x - p0[i] * c0.y : v0[i] * c0.x + p0[i] * c0.y;
                            v1[i] = fq < 2 ? v1[i] * c1.x - p1[i] * c1.y : v1[i] * c1.x + p1[i] * c1.y; } }
                    const unsigned w0 = pk_fp8v(v0), w1 = pk_fp8v(v1);
#pragma unroll
                    for (int h = 0; h < 6; ++h) { unsigned char* p = (unsigned char*)dst + (size_t)row * 768 + h * 128 + 64 + 4 * fq; *(unsigned*)p = w0; *(unsigned*)(p + 16) = w1; *(unsigned*)(p + 32) = 0u; *(unsigned*)(p + 48) = 0u; }
                    const u32x2 z = {0u, 0u};
#pragma unroll
                    for (int q = 0; q < 4; ++q) *(u32x2*)(craw + (size_t)row * 384 + 320 + 16 * q + 4 * fq) = z;
                    asm volatile("" ::: "memory");
                }
        }
    }
};

struct EpiUpProj {
    static constexpr bool PERM = false, FP8 = false;
    unsigned char* ws; const LAS unsigned long long* in; int l; const LAS f32x2* tab32;
    DI void operator()(const Acc& acc, const g8::Unit& u, int wr, int wc, int fr, int fq) const {
        asm volatile("" : "+v"(fr), "+v"(fq));
        const int slot = 4 * u.pn + wc; if (slot >= 9 && slot < 12) return;
        const int rowt = u.pm * 256 + wr * 64 + fr; const bool lat = (u.pm * 256) < LAT;
        const float* ssq = (const float*)(ws + WS_SSQ);
        bf16_t* qB = (bf16_t*)(ws + Z_QB); bf16_t* kB = (bf16_t*)(ws + Z_KB); bf16_t* vB = (bf16_t*)(ws + Z_VB);
        const bool isq = slot < 9;
#pragma unroll
        for (int ai = 0; ai < 2; ++ai)
#pragma unroll
            for (int m = 0; m < 4; ++m) {
                const int row = rowt + ai * 128 + m * 16;
                const f32x4 sa = *(const f32x4*)(ssq + (size_t)row * 8); const float sb = ssq[(size_t)row * 8 + 4];
                const float r0 = isq ? 1.0f / sqrtf((sa.x + sa.y + sa.z) * (1.f / 192.f) + EPS) : 1.0f / sqrtf((sa.w + sb) * (1.f / 128.f) + EPS);
                if (slot < 6 || (slot >= 12 && slot < 18)) {
                    const float* gain = slot < 6 ? inp(in, 15) + l * 64 : inp(in, 16) + l * 64; const float qs = slot < 6 ? QF96 : 1.f;
                    const int h = slot < 6 ? slot : slot - 12; unsigned char* dst = (unsigned char*)(slot < 6 ? qB : kB) + (size_t)row * 768 + h * 128;
                    float s = 0.f; f32x4 x[2][2];
#pragma unroll
                    for (int bj = 0; bj < 2; ++bj)
#pragma unroll
                        for (int n = 0; n < 2; ++n) { x[bj][n] = acc[ai][bj][m][n] * r0; s += (x[bj][n].x * x[bj][n].x + x[bj][n].y * x[bj][n].y) + (x[bj][n].z * x[bj][n].z + x[bj][n].w * x[bj][n].w); }
                    s = add_xor32(add_xor16(s));
                    const float rstd = qs / sqrtf(s * (1.f / 64.f) + EPS);
#pragma unroll
                    for (int bj = 0; bj < 2; ++bj)
#pragma unroll
                        for (int n = 0; n < 2; ++n) { const int c = 32 * bj + 16 * n + 4 * fq; *(unsigned*)(dst + c) = pk_fp8v(x[bj][n] * rstd * *(const f32x4*)(gain + c)); }
                } else if (slot >= 18) {
                    bf16_t* dst = vB + (size_t)row * 384 + (slot - 18) * 64;
#pragma unroll
                    for (int bj = 0; bj < 2; ++bj)
#pragma unroll
                        for (int n = 0; n < 2; ++n) st_bf16x4(dst + 32 * bj + 16 * n + 4 * fq, acc[ai][bj][m][n] * r0);
                } else {
                    const float* gain = inp(in, 17) + l * 32;
#pragma unroll
                    for (int bj = 0; bj < 2; ++bj) {
                        const f32x4 a0 = acc[ai][bj][m][0] * r0, a1 = acc[ai][bj][m][1] * r0;
                        float s = (a0.x * a0.x + a0.y * a0.y) + (a0.z * a0.z + a0.w * a0.w) + (a1.x * a1.x + a1.y * a1.y) + (a1.z * a1.z + a1.w * a1.w);
                        s = add_xor32(add_xor16(s));
                        const float rstd = QF96 / sqrtf(s * (1.f / 32.f) + EPS);
                        f32x4 v0 = a0 * rstd * *(const f32x4*)(gain + 4 * fq), v1 = a1 * rstd * *(const f32x4*)(gain + 16 + 4 * fq);
                        if (lat) { const int t = row & 4095, pr = t >> 6, pc = t & 63; f32x4 p0, p1;
#pragma unroll
                            for (int i = 0; i < 4; ++i) { p0[i] = other32(v0[i], fq >= 2); p1[i] = other32(v1[i], fq >= 2); }
                            const LAS f32x2* t0 = tab32 + pr * 8 + 4 * (fq & 1); const LAS f32x2* t1 = tab32 + pc * 8 + 4 * (fq & 1);
#pragma unroll
                            for (int i = 0; i < 4; ++i) { const f32x2 c0 = t0[i], c1 = t1[i];
                                v0[i] = fq < 2 ? v0[i] * c0.x - p0[i] * c0.y : v0[i] * c0.x + p0[i] * c0.y;
                                v1[i] = fq < 2 ? v1[i] * c1.x - p1[i] * c1.y : v1[i] * c1.x + p1[i] * c1.y; } }
                        unsigned char* p = (unsigned char*)qB + (size_t)row * 768 + (2 * (slot - 6) + bj) * 128 + 64 + 4 * fq;
                        *(unsigned*)p = pk_fp8v(v0); *(unsigned*)(p + 16) = pk_fp8v(v1); *(unsigned*)(p + 32) = 0u; *(unsigned*)(p + 48) = 0u;
                    }
                }
                asm volatile("" ::: "memory");
            }
    }
};

struct EpiOutProj {
    static constexpr bool PERM = false, FP8 = false;
    unsigned char* ws; const float* xin; const float* cin; float* out; int l;
    DI void operator()(const Acc& acc, const g8::Unit& u, int wr, int wc, int fr, int fq) const {
        asm volatile("" : "+v"(fr), "+v"(fq));
        const int rowt = u.pm * 256 + wr * 64 + fr; const bool lat = (u.pm * 256) < LAT;
        const float* mod = (const float*)(ws + WS_MOD) + ((size_t)l * 9 + (lat ? (u.pm * 256) / 4096 : 8)) * 6144 + 2048;
        const int col0 = u.pn * 256 + wc * 32 + 4 * fq;
        f32x4 gv[2][2];
#pragma unroll
        for (int bj = 0; bj < 2; ++bj)
#pragma unroll
            for (int n = 0; n < 2; ++n) gv[bj][n] = *(const f32x4*)(mod + col0 + 128 * bj + 16 * n);
#pragma unroll
        for (int ai = 0; ai < 2; ++ai)
#pragma unroll
            for (int m = 0; m < 4; ++m) {
                const int row = rowt + ai * 128 + m * 16;
                const float* src = lat ? xin + (size_t)row * 1024 : cin + (size_t)(row - LAT) * 1024;
                float* dst = lat ? out + (size_t)row * 1024 : (float*)(ws + WS_CTXF) + (size_t)(row - LAT) * 1024;
#pragma unroll
                for (int bj = 0; bj < 2; ++bj)
#pragma unroll
                    for (int n = 0; n < 2; ++n) { const int c = col0 + 128 * bj + 16 * n; *(f32x4*)(dst + c) = *(const f32x4*)(src + c) + gv[bj][n] * acc[ai][bj][m][n]; }
            }
    }
};

constexpr int WSH = 6, HSH = 3;
struct EpiMoe1 {
    static constexpr bool PERM = true, FP8 = true;
    unsigned char* ws;
    DI void operator()(const Acc& acc, const g8::Unit& u, int wr, int wc, int fr, int fq) const {
        asm volatile("" : "+v"(fr), "+v"(fq));
        unsigned char* hid = ws + Z_HID; constexpr float SC = 1.0f / (float)(1 << WSH), HS = (float)(1 << HSH);
#pragma unroll
        for (int ai = 0; ai < 2; ++ai)
#pragma unroll
            for (int m = 0; m < 4; ++m) {
                const int row = u.pm * 256 + ai * 128 + wr * 64 + m * 16 + fr;
                f32x4 h0, h1;
#pragma unroll
                for (int i = 0; i < 4; ++i) { h0[i] = silu_f(acc[ai][0][m][0][i] * SC) * (acc[ai][1][m][0][i] * (SC * HS)); h1[i] = silu_f(acc[ai][0][m][1][i] * SC) * (acc[ai][1][m][1][i] * (SC * HS)); }
                u32x2 w; w.x = pk_fp8x4(h0.x, h0.y, h0.z, h0.w); w.y = pk_fp8x4(h1.x, h1.y, h1.z, h1.w);
                *(u32x2*)(hid + (size_t)row * 1024 + u.pn * 128 + wc * 32 + 8 * fq) = w;
            }
    }
};
struct EpiMoe2 {
    static constexpr bool PERM = true, FP8 = true;
    unsigned char* ws;
    DI void operator()(const Acc& acc, const g8::Unit& u, int wr, int wc, int fr, int fq) const {
        asm volatile("" : "+v"(fr), "+v"(fq));
        bf16_t* ye = (bf16_t*)(ws + Z_YE); const float* gate = (const float*)(ws + WS_GATE); constexpr float SC = 1.0f / (float)(1 << (WSH + HSH));
#pragma unroll
        for (int ai = 0; ai < 2; ++ai)
#pragma unroll
            for (int m = 0; m < 4; ++m) {
                const int row = u.pm * 256 + ai * 128 + wr * 64 + m * 16 + fr; const float gv = gate[row] * SC;
#pragma unroll
                for (int bj = 0; bj < 2; ++bj) { const f32x4 a = acc[ai][bj][m][0] * gv, b = acc[ai][bj][m][1] * gv; u32x4 w;
                    w.x = cvt_pk(a.x, a.y); w.y = cvt_pk(a.z, a.w); w.z = cvt_pk(b.x, b.y); w.w = cvt_pk(b.z, b.w);
                    *(u32x4*)(ye + (size_t)row * 1024 + u.pn * 256 + bj * 128 + wc * 32 + 8 * fq) = w; }
            }
    }
};
DI int crow(int i, int hh) { return (i & 3) + 8 * (i >> 2) + 4 * hh; }
typedef short v4i16_t __attribute__((ext_vector_type(4)));
DI s16x4 vtr(const LAS unsigned char* p) { return __builtin_bit_cast(s16x4, __builtin_amdgcn_ds_read_tr16_b64_v4i16((LAS v4i16_t*)p)); }
#define MFMA32(a, b, c) __builtin_amdgcn_mfma_f32_32x32x16_bf16((a), (b), (c), 0, 0, 0)

struct AttnDesc { const unsigned char* Q; int ldq, qoff; const unsigned char* K; int ldk, koff; const bf16_t* V; int ldv, voff; bf16_t* O; int ooff; float sink2; };
DI float fmax3(float a, float b, float c) { return __builtin_fmaxf(__builtin_fmaxf(a, b), c); }
typedef int i32x4 __attribute__((ext_vector_type(4)));
typedef int i32x8 __attribute__((ext_vector_type(8)));
#define MFMA8Z(acc, a, b, sa, sb) asm volatile("v_mfma_scale_f32_32x32x64_f8f6f4 %0, %1, %2, 0, %3, %4 op_sel_hi:[0,0,0]" : "=&v"(acc) : "v"(a), "v"(b), "v"(sa), "v"(sb))
#define MFMA8(acc, a, b, sa, sb) asm volatile("v_mfma_scale_f32_32x32x64_f8f6f4 %0, %1, %2, %0, %3, %4 op_sel_hi:[0,0,0]" : "+v"(acc) : "v"(a), "v"(b), "v"(sa), "v"(sb))
template <int DQB  , int MODE, bool TRACK, int ABL = 0>
DI void attn_unit(const int tid, LAS unsigned char* lds, const AttnDesc& d, int b, int qb, bool has_sink) {
    constexpr int KSTR = DQB + 16, VSTR = 192, KBUF = 64 * KSTR, VBUF = 64 * VSTR, NS = DQB / 64, KCH = DQB / 16;
    const int lane = tid & 63, wid = __builtin_amdgcn_readfirstlane(tid >> 6), r = lane & 31, hh = lane >> 5;
    const int q0 = qb * 256;
    const int qrow = (MODE == 2 ? LAT + b * 256 : b * 4096) + q0 + wid * 32 + r;
    int lo = 0, ntl = 0;
    if (MODE == 0) { lo = 0; ntl = 64; }
    if (MODE == 1) { lo = q0 - 128 < 0 ? 0 : q0 - 128; const int hi = q0 + 384 > 4096 ? 4096 : q0 + 384; ntl = (hi - lo) / 64; }
    const int NT = 4 + ntl;
    auto tile_row = [&](int t) -> int { return t < 4 ? LAT + b * 256 + t * 64 : b * 4096 + lo + (t - 4) * 64; };
    i32x8 qf[NS];
#pragma unroll
    for (int s = 0; s < NS; ++s) { const unsigned char* qp = d.Q + (size_t)qrow * d.ldq + d.qoff + 64 * s + 32 * hh; const i32x4 lo4 = *(const i32x4*)qp, hi4 = *(const i32x4*)(qp + 16); qf[s] = __builtin_shufflevector(lo4, hi4, 0, 1, 2, 3, 4, 5, 6, 7); }
    const int sclK = 0x7F7F7F7F, sclQ = 0x7C7C7C7C;
    constexpr int KC1 = KCH + 1, VC1 = 12;
    const int kc0 = tid, kc1 = tid + 512, vc0 = tid, vc1 = tid + 512;
    const int kr_0 = kc0 / KC1, kh_0 = kc0 % KC1, kr_1 = kc1 / KC1, kh_1 = kc1 % KC1, vr_0 = vc0 / VC1, vh_0 = vc0 % VC1, vr_1 = vc1 / VC1, vh_1 = vc1 % VC1;
    const unsigned kg0 = (unsigned)(kr_0 * d.ldk + d.koff + (kh_0 < KCH ? kh_0 : 0) * 16), kg1 = (unsigned)(kr_1 * d.ldk + d.koff + (kh_1 < KCH ? kh_1 : 0) * 16);
    const unsigned vg0 = (unsigned)((vr_0 * d.ldv + d.voff) * 2 + (vh_0 < 8 ? vh_0 : 0) * 16), vg1 = (unsigned)((vr_1 * d.ldv + d.voff) * 2 + (vh_1 < 8 ? vh_1 : 0) * 16);
    auto dma_k = [&](int t, int buf) { const unsigned char* kb_ = d.K + (size_t)tile_row(t) * d.ldk;
        if (wid * 64 < 64 * KC1) __builtin_amdgcn_global_load_lds((const unsigned*)(kb_ + kg0), (LAS unsigned*)(lds + buf * KBUF + wid * 1024), 16, 0, 0);
        if (512 + wid * 64 < 64 * KC1) __builtin_amdgcn_global_load_lds((const unsigned*)(kb_ + kg1), (LAS unsigned*)(lds + buf * KBUF + 8192 + wid * 1024), 16, 0, 0); };
    auto dma_v = [&](int t, int buf) { const unsigned char* vb_ = (const unsigned char*)d.V + (size_t)tile_row(t) * d.ldv * 2;
        __builtin_amdgcn_global_load_lds((const unsigned*)(vb_ + vg0), (LAS unsigned*)(lds + 2 * KBUF + buf * VBUF + wid * 1024), 16, 0, 0);
        if (wid < 4) __builtin_amdgcn_global_load_lds((const unsigned*)(vb_ + vg1), (LAS unsigned*)(lds + 2 * KBUF + buf * VBUF + 8192 + wid * 1024), 16, 0, 0); };
#define DMA_WAIT() asm volatile("s_waitcnt vmcnt(0)" ::: "memory")
    constexpr float THR = 8.f;
    float m = -1e30f, l = 0.f;
    if (has_sink) { if (TRACK) { m = d.sink2; l = hh == 0 ? 1.f : 0.f; } else { l = hh == 0 ? __builtin_amdgcn_exp2f(d.sink2) : 0.f; } }
    if (!TRACK) m = 0.f;
    f32x16 o0, o1, s0, s1, n0, n1;
#pragma unroll
    for (int i = 0; i < 16; ++i) { o0[i] = 0.f; o1[i] = 0.f; }
    const int koffl = r * KSTR + hh * 32;
    const int voffl = (4 * hh + ((lane & 15) >> 2)) * VSTR + (16 * ((lane >> 4) & 1) + 4 * (lane & 3)) * 2;
    bf16x8 pb[4];
    auto kfrag = [&](const LAS unsigned char* p) -> i32x8 { const i32x4 lo4 = *(const LAS i32x4*)p, hi4 = *(const LAS i32x4*)(p + 16); return __builtin_shufflevector(lo4, hi4, 0, 1, 2, 3, 4, 5, 6, 7); };
    auto qk = [&](int buf, f32x16& a0, f32x16& a1, float init) { const LAS unsigned char* kb = lds + buf * KBUF + koffl;
#pragma unroll
        for (int i = 0; i < 16; ++i) { a0[i] = init; a1[i] = init; }
        asm volatile("s_nop 1" : "+v"(a0), "+v"(a1));
#pragma unroll
        for (int s = 0; s < NS; ++s) { const i32x8 x0 = kfrag(kb + s * 64), x1 = kfrag(kb + 32 * KSTR + s * 64); MFMA8(a0, x0, qf[s], sclK, sclQ); MFMA8(a1, x1, qf[s], sclK, sclQ); }
        asm volatile("s_nop 15\n\ts_nop 15\n\ts_nop 7" : "+v"(a0), "+v"(a1)); };
    auto pv = [&](int buf) { const LAS unsigned char* vb = lds + 2 * KBUF + buf * VBUF + voffl;
#pragma unroll
        for (int ks = 0; ks < 4; ++ks) {
            const s16x4 a_lo = vtr(vb + (16 * ks) * VSTR), a_hi = vtr(vb + (16 * ks + 8) * VSTR);
            const s16x4 b_lo = vtr(vb + (16 * ks) * VSTR + 64), b_hi = vtr(vb + (16 * ks + 8) * VSTR + 64);
            const bf16x8 va = __builtin_shufflevector(a_lo, a_hi, 0, 1, 2, 3, 4, 5, 6, 7), vb2 = __builtin_shufflevector(b_lo, b_hi, 0, 1, 2, 3, 4, 5, 6, 7);
            o0 = MFMA32(va, pb[ks], o0); o1 = MFMA32(vb2, pb[ks], o1); } };
    auto mask = [&](int t) {
        if (MODE == 1) { if (t >= 4) { const int kp0 = lo + (t - 4) * 64, qp = q0 + wid * 32 + r;
#pragma unroll
            for (int i = 0; i < 16; ++i) { const int dk0 = kp0 + crow(i, hh) - qp, dk1 = dk0 + 32;
                if (dk0 > 128 || dk0 < -128) s0[i] = -1e30f; if (dk1 > 128 || dk1 < -128) s1[i] = -1e30f; } } } };
    auto rowmax = [&]() -> float {
        float ma = fmax3(s0[0], s0[1], s1[0]), mb = fmax3(s0[2], s0[3], s1[1]); ma = fmax3(ma, s1[2], s1[3]);
#pragma unroll
        for (int i = 4; i < 16; i += 4) { ma = fmax3(ma, s0[i], s0[i + 1]); mb = fmax3(mb, s0[i + 2], s0[i + 3]); ma = fmax3(ma, s1[i], s1[i + 1]); mb = fmax3(mb, s1[i + 2], s1[i + 3]); }
        float mx = __builtin_fmaxf(ma, mb);
        auto rr = __builtin_amdgcn_permlane32_swap(__float_as_uint(mx), __float_as_uint(mx), false, false); return __builtin_fmaxf(__uint_as_float(rr[0]), __uint_as_float(rr[1])); };
    auto pack = [&]() {
#pragma unroll
        for (int s2 = 0; s2 < 2; ++s2) {
            u32x4 w0, w1;
            w0.x = cvt_pk(s0[8 * s2 + 0], s0[8 * s2 + 1]); w0.y = cvt_pk(s0[8 * s2 + 2], s0[8 * s2 + 3]); w0.z = cvt_pk(s0[8 * s2 + 4], s0[8 * s2 + 5]); w0.w = cvt_pk(s0[8 * s2 + 6], s0[8 * s2 + 7]);
            w1.x = cvt_pk(s1[8 * s2 + 0], s1[8 * s2 + 1]); w1.y = cvt_pk(s1[8 * s2 + 2], s1[8 * s2 + 3]); w1.z = cvt_pk(s1[8 * s2 + 4], s1[8 * s2 + 5]); w1.w = cvt_pk(s1[8 * s2 + 6], s1[8 * s2 + 7]);
            pb[s2] = __builtin_bit_cast(bf16x8, w0); pb[2 + s2] = __builtin_bit_cast(bf16x8, w1); } };
    auto exp_pack = [&]() {
        float ps0 = 0.f, ps1 = 0.f;
#pragma unroll
        for (int i = 0; i < 16; ++i) { s0[i] = __builtin_amdgcn_exp2f(s0[i]); s1[i] = __builtin_amdgcn_exp2f(s1[i]); ps0 += s0[i]; ps1 += s1[i]; }
        l += ps0 + ps1; pack(); };
#define SEG_BAR() do { asm volatile("s_waitcnt lgkmcnt(0)" ::: "memory"); __builtin_amdgcn_s_barrier(); asm volatile("" ::: "memory"); } while (0)
    const bool g1 = false;
    auto opA = [&](int t, bool n_valid) {
        mask(t);
        if (TRACK) { const float mx = rowmax();
            if (__builtin_expect(__any(mx > THR), 0)) {
                const float dl = __builtin_fmaxf(mx, 0.f), alpha = __builtin_amdgcn_exp2f(-dl);
                m += dl; l *= alpha;
#pragma unroll
                for (int i = 0; i < 16; ++i) { o0[i] *= alpha; o1[i] *= alpha; s0[i] -= dl; s1[i] -= dl; }
                if (g1) {
#pragma unroll
                    for (int j = 0; j < 4; ++j) { u32x4 w = __builtin_bit_cast(u32x4, pb[j]);
                        w.x = cvt_pk(bf_lo(w.x) * alpha, bf_hi(w.x) * alpha); w.y = cvt_pk(bf_lo(w.y) * alpha, bf_hi(w.y) * alpha); w.z = cvt_pk(bf_lo(w.z) * alpha, bf_hi(w.z) * alpha); w.w = cvt_pk(bf_lo(w.w) * alpha, bf_hi(w.w) * alpha);
                        pb[j] = __builtin_bit_cast(bf16x8, w); }
                } else if (n_valid) {
#pragma unroll
                    for (int i = 0; i < 16; ++i) { n0[i] -= dl; n1[i] -= dl; } }
            } }
        float ps0 = 0.f, ps1 = 0.f, ps2 = 0.f, ps3 = 0.f;
#pragma unroll
        for (int i = 0; i < 16; i += 4) {
            if (ABL != 2 && ABL != 5) { s0[i] = __builtin_amdgcn_exp2f(s0[i]); s0[i + 1] = __builtin_amdgcn_exp2f(s0[i + 1]); s0[i + 2] = __builtin_amdgcn_exp2f(s0[i + 2]); s0[i + 3] = __builtin_amdgcn_exp2f(s0[i + 3]);
                                        s1[i] = __builtin_amdgcn_exp2f(s1[i]); s1[i + 1] = __builtin_amdgcn_exp2f(s1[i + 1]); s1[i + 2] = __builtin_amdgcn_exp2f(s1[i + 2]); s1[i + 3] = __builtin_amdgcn_exp2f(s1[i + 3]); }
            ps0 += s0[i] + s1[i]; ps1 += s0[i + 1] + s1[i + 1]; ps2 += s0[i + 2] + s1[i + 2]; ps3 += s0[i + 3] + s1[i + 3]; }
        l += (ps0 + ps1) + (ps2 + ps3); };
    auto opB = [&](auto has_next_c, int nbuf, int pvbuf) {
        constexpr bool HAS_NEXT = decltype(has_next_c)::value;
        if constexpr (HAS_NEXT) {
            const LAS unsigned char* kb = lds + nbuf * KBUF + koffl;
            if constexpr (TRACK) { const float negm = -m;
#pragma unroll
                for (int i = 0; i < 16; ++i) { n0[i] = negm; n1[i] = negm; }
                asm volatile("s_nop 1" : "+v"(n0), "+v"(n1)); }
            i32x8 x0 = kfrag(kb), x1 = kfrag(kb + 32 * KSTR);
            if constexpr (TRACK) { MFMA8(n0, x0, qf[0], sclK, sclQ); MFMA8(n1, x1, qf[0], sclK, sclQ); } else { MFMA8Z(n0, x0, qf[0], sclK, sclQ); MFMA8Z(n1, x1, qf[0], sclK, sclQ); }
            if constexpr (NS == 2) { const i32x8 y0 = kfrag(kb + 64), y1 = kfrag(kb + 32 * KSTR + 64); MFMA8(n0, y0, qf[1], sclK, sclQ); MFMA8(n1, y1, qf[1], sclK, sclQ); }
        }
        {
            const LAS unsigned char* vb = lds + 2 * KBUF + pvbuf * VBUF + voffl;
            s16x4 a_lo = vtr(vb), a_hi = vtr(vb + 8 * VSTR), b_lo = vtr(vb + 64), b_hi = vtr(vb + 8 * VSTR + 64), c_lo = a_lo, c_hi = a_hi, d_lo = b_lo, d_hi = b_hi;
            __builtin_amdgcn_sched_barrier(0);
#pragma unroll
            for (int ks = 0; ks < 4; ++ks) {
                if (ks + 1 < 4) { c_lo = vtr(vb + (16 * (ks + 1)) * VSTR); c_hi = vtr(vb + (16 * (ks + 1) + 8) * VSTR); d_lo = vtr(vb + (16 * (ks + 1)) * VSTR + 64); d_hi = vtr(vb + (16 * (ks + 1) + 8) * VSTR + 64); }
                const bf16x8 va = __builtin_shufflevector(a_lo, a_hi, 0, 1, 2, 3, 4, 5, 6, 7), vb2 = __builtin_shufflevector(b_lo, b_hi, 0, 1, 2, 3, 4, 5, 6, 7);
                o0 = MFMA32(va, pb[ks], o0); o1 = MFMA32(vb2, pb[ks], o1);
                a_lo = c_lo; a_hi = c_hi; b_lo = d_lo; b_hi = d_hi;
                __builtin_amdgcn_sched_barrier(0);
            }
        } };
    __syncthreads();
    dma_k(0, 0); dma_k(1, 1); DMA_WAIT();
    __syncthreads();
    qk(0, s0, s1, 0.f);
    __syncthreads();
    dma_k(2, 0); dma_v(0, 0);
    mask(0);
    if (TRACK) { const float mx0 = rowmax(); const float mn = __builtin_fmaxf(m, mx0); const float alpha = __builtin_amdgcn_exp2f(m - mn); l *= alpha; m = mn;
#pragma unroll
      for (int i = 0; i < 16; ++i) { s0[i] -= mn; s1[i] -= mn; } }
    qk(1, n0, n1, -m);
    exp_pack();
    s0 = n0; s1 = n1;
    DMA_WAIT();
    __syncthreads();
    for (int t = 1; t < (ABL == 6 ? 2 : NT - 1); ++t) {
        if (ABL != 1 && ABL != 5) { dma_k(t + 2 < NT ? t + 2 : NT - 1, t & 1); dma_v(t, t & 1); }
        opB(std::true_type{}, (t + 1) & 1, (t - 1) & 1);
        opA(t, true);
        pack();
        DMA_WAIT(); SEG_BAR();
        s0 = n0; s1 = n1;
    }
    dma_v(NT - 1, (NT - 1) & 1);
    opB(std::false_type{}, 0, (NT - 2) & 1);
    opA(NT - 1, false); pack();
    DMA_WAIT(); SEG_BAR();
    pv((NT - 1) & 1);
    { auto rr = __builtin_amdgcn_permlane32_swap(__float_as_uint(l), __float_as_uint(l), false, false); l = __uint_as_float(rr[0]) + __uint_as_float(rr[1]); }
    const float inv = 1.0f / l;
    bf16_t* op = d.O + (size_t)qrow * 1024 + d.ooff + 4 * hh;
#pragma unroll
    for (int g4 = 0; g4 < 4; ++g4) {
        u32x2 w; w.x = cvt_pk(o0[4 * g4] * inv, o0[4 * g4 + 1] * inv); w.y = cvt_pk(o0[4 * g4 + 2] * inv, o0[4 * g4 + 3] * inv); *(u32x2*)(op + 8 * g4) = w;
        u32x2 x; x.x = cvt_pk(o1[4 * g4] * inv, o1[4 * g4 + 1] * inv); x.y = cvt_pk(o1[4 * g4 + 2] * inv, o1[4 * g4 + 3] * inv); *(u32x2*)(op + 32 + 8 * g4) = x;
    }
}

#ifndef TRACK_EN
#define TRACK_EN 1
#endif
DI void attn_phase(const Frame& F, int l, bool with_ctx, int rep = 0) {
    constexpr int NU_B = NB * 96, NU_A = NB * 96, NU_C = NB * 64, NU_X = NB * 16;
    const int NU = NU_B + NU_A + NU_C + (with_ctx ? NU_X : 0);
    unsigned* head = F.ctl + CW_QUEUE + 64 * (l + 2 * rep);
    volatile LAS int* slot = (volatile LAS int*)(F.lds + LDS_MISC + 16);
    const float* sinkp = INP(21) + l * 4;
    bool track;
    { auto amax = [&](const float* g, int n) { float v = 0.f; for (int i = 0; i < n; ++i) v = fmaxf(v, fabsf(g[i])); return v; };
      const float ga = 8.f * amax(INP(9) + l * 64, 64) * amax(INP(10) + l * 64, 64), gc = 8.f * amax(INP(19) + l * 64, 64) * amax(INP(20) + l * 64, 64);
      const float qn = amax(INP(15) + l * 64, 64), qr = amax(INP(17) + l * 32, 32), kn = amax(INP(16) + l * 64, 64), kr = amax(INP(18) + l * 32, 32);
      const float gb = sqrtf((64.f * qn * qn + 32.f * qr * qr) * (64.f * kn * kn + 32.f * kr * kr) / 96.f);
      const float sk = fmaxf(fmaxf(fabsf(sinkp[0]), fabsf(sinkp[1])), fmaxf(fabsf(sinkp[2]), fabsf(sinkp[3])));
      const float bound = fmaxf(fmaxf(ga, gc), fmaxf(gb, sk)) * LOG2E;
      track = !(bound < 100.f); }
    for (;;) {
        __syncthreads();
        if (F.tid == 0) *slot = (int)__hip_atomic_fetch_add(head, 1u, __ATOMIC_RELAXED, __HIP_MEMORY_SCOPE_AGENT);
        __syncthreads();
        int u = *slot; if (u >= NU) break;
        GAS unsigned char* wsg = (GAS unsigned char*)F.ws; asm volatile("" : "+s"(wsg)); unsigned char* ws = (unsigned char*)wsg;
        int tidu = F.tid; asm volatile("" : "+v"(tidu));
        AttnDesc d;
        if (u < NU_B) { const int b = u / 96, h = (u % 96) / 16, qb = u % 16;
            d = AttnDesc{(const unsigned char*)(ws + Z_QB), 768, h * 128, (const unsigned char*)(ws + Z_KB), 768, h * 128, (const bf16_t*)(ws + Z_VB), 384, h * 64, (bf16_t*)(ws + Z_OB), 384 + h * 64, 0.f};
#ifdef ATT_ABL
            if (rep) { attn_unit<128, 0, false, ATT_ABL>(tidu, F.lds, d, b, qb, false); continue; }
#endif
            if (TRACK_EN && track) attn_unit<128, 0, true>(tidu, F.lds, d, b, qb, false); else attn_unit<128, 0, false>(tidu, F.lds, d, b, qb, false); continue; }
        u -= NU_B;
        if (u < NU_A) { const int b = u / 96, h = (u % 96) / 16, qb = u % 16;
            d = AttnDesc{(const unsigned char*)(ws + Z_QA), 384, h * 64, (const unsigned char*)(ws + Z_KA), 128, (h / 3) * 64, (const bf16_t*)(ws + Z_VA), 128, (h / 3) * 64, (bf16_t*)(ws + Z_OB), h * 64, 0.f};
#ifdef ATT_ABL
            if (rep) { attn_unit<64, 0, false, ATT_ABL>(tidu, F.lds, d, b, qb, false); continue; }
#endif
            if (TRACK_EN && track) attn_unit<64, 0, true>(tidu, F.lds, d, b, qb, false); else attn_unit<64, 0, false>(tidu, F.lds, d, b, qb, false); continue; }
        u -= NU_A;
        if (u < NU_C) { const int b = u / 64, h = (u % 64) / 16, qb = u % 16;
            d = AttnDesc{(const unsigned char*)(ws + Z_QC), 256, h * 64, (const unsigned char*)(ws + Z_KC), 128, (h / 2) * 64, (const bf16_t*)(ws + Z_VC), 128, (h / 2) * 64, (bf16_t*)(ws + Z_OB), 768 + h * 64, sinkp[h] * LOG2E};
            if (TRACK_EN && track) attn_unit<64, 1, true>(tidu, F.lds, d, b, qb, true); else attn_unit<64, 1, false>(tidu, F.lds, d, b, qb, true); continue; }
        u -= NU_C;
        { const int b = u / 16, hx = u % 16;
            if (hx < 6) { const int h = hx;
                d = AttnDesc{(const unsigned char*)(ws + Z_QA), 384, h * 64, (const unsigned char*)(ws + Z_KA), 128, (h / 3) * 64, (const bf16_t*)(ws + Z_VA), 128, (h / 3) * 64, (bf16_t*)(ws + Z_OB), h * 64, 0.f};
                if (TRACK_EN && track) attn_unit<64, 2, true>(tidu, F.lds, d, b, 0, false); else attn_unit<64, 2, false>(tidu, F.lds, d, b, 0, false); }
            else if (hx < 12) { const int h = hx - 6;
                d = AttnDesc{(const unsigned char*)(ws + Z_QB), 768, h * 128, (const unsigned char*)(ws + Z_KB), 768, h * 128, (const bf16_t*)(ws + Z_VB), 384, h * 64, (bf16_t*)(ws + Z_OB), 384 + h * 64, 0.f};
                if (TRACK_EN && track) attn_unit<128, 2, true>(tidu, F.lds, d, b, 0, false); else attn_unit<128, 2, false>(tidu, F.lds, d, b, 0, false); }
            else { const int h = hx - 12;
                d = AttnDesc{(const unsigned char*)(ws + Z_QC), 256, h * 64, (const unsigned char*)(ws + Z_KC), 128, (h / 2) * 64, (const bf16_t*)(ws + Z_VC), 128, (h / 2) * 64, (bf16_t*)(ws + Z_OB), 768 + h * 64, sinkp[h] * LOG2E};
                if (TRACK_EN && track) attn_unit<64, 2, true>(tidu, F.lds, d, b, 0, true); else attn_unit<64, 2, false>(tidu, F.lds, d, b, 0, true); }
        }
    }
}

DI void router_phase(const Frame& F, int l, bool with_ctx) {
    LAS float* wT = (LAS float*)F.lds;
    const float* wr = INP(23) + (size_t)l * 1024 * 16;
    for (int e = F.tid; e < 16 * 1024; e += NTHR) { const int k = e / 16, x = e % 16; wT[x * 1024 + k] = wr[e]; }
    __syncthreads();
    const int gw = F.bid * NWAVES + F.wave, NGW = F.G * NWAVES, NR = with_ctx ? R : LAT, lane = F.lane;
    const float* g = INP(7) + l * 1024;
    for (int row = gw; row < NR; row += NGW) {
        const float* xr = row < LAT ? F.out + (size_t)row * 1024 : WSP(float, WS_CTXF) + (size_t)(row - LAT) * 1024;
        const float* m = mod_row(F, l, row);
        f32x4 v[4]; float s = 0.f;
#pragma unroll
        for (int j = 0; j < 4; ++j) { v[j] = *(const f32x4*)(xr + 4 * (lane + 64 * j)); s += (v[j].x * v[j].x + v[j].y * v[j].y) + (v[j].z * v[j].z + v[j].w * v[j].w); }
        const float rstd = 1.0f / sqrtf(wave_sum(s) * (1.f / 1024.f) + EPS);
        float lg[16];
#pragma unroll
        for (int e = 0; e < 16; ++e) lg[e] = 0.f;
        unsigned char* orow = WSP(unsigned char, WS_HB) + (size_t)row * 1024;
#pragma unroll
        for (int j = 0; j < 4; ++j) { const int c = 4 * (lane + 64 * j); const f32x4 gv = *(const f32x4*)(g + c), sv = *(const f32x4*)(m + 3072 + c), cv = *(const f32x4*)(m + 4096 + c);
            v[j] = v[j] * rstd * gv * (cv + 1.0f) + sv; *(unsigned*)(orow + c) = pk_fp8x4(v[j].x, v[j].y, v[j].z, v[j].w); }
        asm volatile("" ::: "memory");
#pragma unroll
        for (int e = 0; e < 16; ++e) {
#pragma unroll
            for (int j = 0; j < 4; ++j) { const f32x4 wv = *(const LAS f32x4*)(wT + e * 1024 + 4 * (lane + 64 * j)); lg[e] += (v[j].x * wv.x + v[j].y * wv.y) + (v[j].z * wv.z + v[j].w * wv.w); }
            if (e & 1) asm volatile("" ::: "memory"); }
#pragma unroll
        for (int e = 0; e < 16; ++e) lg[e] = wave_sum(lg[e]);
        float mx = lg[0];
#pragma unroll
        for (int e = 1; e < 16; ++e) mx = fmaxf(mx, lg[e]);
        float sum = 0.f;
#pragma unroll
        for (int e = 0; e < 16; ++e) { lg[e] = expf(lg[e] - mx); sum += lg[e]; }
        const float isum = 1.0f / sum;
        float mine = 0.f;
#pragma unroll
        for (int e = 0; e < 16; ++e) mine = (lane == e) ? lg[e] * isum : mine;
        if (lane < 16) {
            if (row < LAT) WSP(float, WS_AFFL)[((size_t)(row / 4096) * 16 + lane) * 4096 + (row & 4095)] = mine;
            else { const int rc = row - LAT; WSP(float, WS_AFFC)[((size_t)(rc / 256) * 16 + lane) * 256 + (rc & 255)] = mine; }
        }
    }
}

DI void topk_phase(const Frame& F, bool with_ctx) {
    LAS unsigned* hist = (LAS unsigned*)F.lds;
    LAS unsigned* sh = hist + 256;
    LAS unsigned* scan = hist + 512;
    const int NL = NB * 16 * (with_ctx ? 2 : 1), tid = F.tid;
    for (int li = F.bid; li < NL; li += F.G) {
        const bool isctx = li >= NB * 16; const int be = isctx ? li - NB * 16 : li, b = be / 16, e = be % 16;
        const int n = isctx ? 256 : 4096, cap = n / 8, per = isctx ? 1 : 8;
        const float* a = isctx ? WSP(float, WS_AFFC) + (size_t)be * 256 : WSP(float, WS_AFFL) + (size_t)be * 4096;
        unsigned key[8]; const bool act = tid * per < n;
#pragma unroll
        for (int j = 0; j < 8; ++j) key[j] = (act && j < per) ? __float_as_uint(a[tid * per + j]) : 0u;
        unsigned prefix = 0u, rem = (unsigned)cap;
        for (int pass = 0; pass < 4; ++pass) {
            const int shift = 24 - 8 * pass;
            __syncthreads();
            if (tid < 256) hist[tid] = 0u;
            __syncthreads();
#pragma unroll
            for (int j = 0; j < 8; ++j) if (act && j < per) { const unsigned k = key[j]; const bool match = pass == 0 ? true : ((k >> (shift + 8)) == (prefix >> (shift + 8))); if (match) __hip_atomic_fetch_add(&hist[(k >> shift) & 255u], 1u, __ATOMIC_RELAXED, __HIP_MEMORY_SCOPE_WORKGROUP); }
            __syncthreads();
            if (tid < 64) {
                const int b0 = 255 - 4 * tid; const unsigned c0 = hist[b0], c1 = hist[b0 - 1], c2 = hist[b0 - 2], c3 = hist[b0 - 3];
                unsigned incl = c0 + c1 + c2 + c3;
#pragma unroll
                for (int o = 1; o < 64; o <<= 1) { const unsigned v = shfl_up_u(incl, o, tid); if (tid >= o) incl += v; }
                unsigned cum = incl - (c0 + c1 + c2 + c3);
                if (cum < rem && incl >= rem) { int bin = b0; unsigned c = c0;
                    if (cum + c < rem) { cum += c; bin = b0 - 1; c = c1; if (cum + c < rem) { cum += c; bin = b0 - 2; c = c2; if (cum + c < rem) { cum += c; bin = b0 - 3; } } }
                    sh[0] = prefix | ((unsigned)bin << shift); sh[1] = rem - cum; }
            }
            __syncthreads();
            prefix = sh[0]; rem = sh[1];
        }
        unsigned cg = 0u, ce = 0u;
#pragma unroll
        for (int j = 0; j < 8; ++j) if (act && j < per) { cg += key[j] > prefix ? 1u : 0u; ce += key[j] == prefix ? 1u : 0u; }
        __syncthreads();
        scan[tid] = cg; scan[512 + tid] = ce;
        __syncthreads();
        unsigned gb, eb;
        {
            unsigned ig = cg, ie = ce; const int ln = tid & 63, wv = tid >> 6;
#pragma unroll
            for (int o = 1; o < 64; o <<= 1) { const unsigned vg = shfl_up_u(ig, o, ln), ve = shfl_up_u(ie, o, ln); if (ln >= o) { ig += vg; ie += ve; } }
            if (ln == 63) { scan[1024 + wv] = ig; scan[1040 + wv] = ie; }
            __syncthreads();
            unsigned og = 0u, oe = 0u;
#pragma unroll
            for (int w = 0; w < 8; ++w) { if (w < wv) { og += scan[1024 + w]; oe += scan[1040 + w]; } }
            gb = og + ig - cg; eb = oe + ie - ce;
        }
        const int rowb = isctx ? LAT + b * 256 : b * 4096;
        const int mbase = isctx ? MOE_LAT + e * 256 + b * 32 : (b * 16 + e) * 512;
        int* gidx = WSP(int, WS_GIDX); float* gate = WSP(float, WS_GATE); int* inv = WSP(int, WS_INV);
#pragma unroll
        for (int j = 0; j < 8; ++j) if (act && j < per) {
            const unsigned k = key[j]; const int t = tid * per + j; int slot = -1;
            if (k > prefix) { slot = (int)(gb + (eb < rem ? eb : rem)); ++gb; }
            else if (k == prefix) { if (eb < rem) slot = (int)(gb + eb); ++eb; }
            if (slot >= 0) { gidx[mbase + slot] = rowb + t; gate[mbase + slot] = __uint_as_float(k); }
            inv[(size_t)(rowb + t) * 16 + e] = slot >= 0 ? mbase + slot : -1;
        }
        if (isctx && NB < 8 && b == 0) { for (int i = NB * 32 + tid; i < 256; i += NTHR) { gidx[MOE_LAT + e * 256 + i] = LAT; gate[MOE_LAT + e * 256 + i] = 0.f; } }
    }
}

DI void combine_phase(const Frame& F, int l, bool with_ctx) {
    const int gw = F.bid * NWAVES + F.wave, NGW = F.G * NWAVES, NR = with_ctx ? R : LAT, lane = F.lane;
    const bool last = (l == DEPTH - 1);
    const bf16_t* ye = WSP(bf16_t, Z_YE); const int* inv = WSP(int, WS_INV);
    for (int row = gw; row < NR; row += NGW) {
        float* xr = row < LAT ? F.out + (size_t)row * 1024 : WSP(float, WS_CTXF) + (size_t)(row - LAT) * 1024;
        const float* m = mod_row(F, l, row);
        f32x4 acc[4];
#pragma unroll
        for (int j = 0; j < 4; ++j) acc[j] = (f32x4){0.f, 0.f, 0.f, 0.f};
        const int myslot = lane < 16 ? inv[(size_t)row * 16 + lane] : -1;
#pragma unroll
        for (int e = 0; e < 16; ++e) { const int s = __builtin_amdgcn_readlane(myslot, e); if (s >= 0) { const bf16_t* yr = ye + (size_t)s * 1024;
#pragma unroll
                for (int j = 0; j < 4; ++j) { const u32x2 w = *(const u32x2*)(yr + 4 * (lane + 64 * j)); acc[j].x += bf_lo(w.x); acc[j].y += bf_hi(w.x); acc[j].z += bf_lo(w.y); acc[j].w += bf_hi(w.y); } } }
        f32x4 v[4];
#pragma unroll
        for (int j = 0; j < 4; ++j) { const int c = 4 * (lane + 64 * j); v[j] = *(const f32x4*)(xr + c) + *(const f32x4*)(m + 5120 + c) * acc[j]; *(f32x4*)(xr + c) = v[j]; }
        if (!last) { const float* m2 = mod_row(F, l + 1, row); norm_mod_store(v, INP(6) + (l + 1) * 1024, m2, m2 + 1024, WSP(bf16_t, WS_HB) + (size_t)row * 1024, lane); }
    }
}
constexpr int NPHASE = 2 + 9 * DEPTH;
DI void load_tabs(const Frame& F) {
    const f32x2* t64 = WSP(f32x2, WS_TAB64); const f32x2* t32 = WSP(f32x2, WS_TAB32);
    LAS f32x2* l64 = (LAS f32x2*)(F.lds + LDS_TAB64); LAS f32x2* l32 = (LAS f32x2*)(F.lds + LDS_TAB32);
    for (int i = F.tid; i < 64 * 16; i += NTHR) l64[i] = t64[i];
    for (int i = F.tid; i < 64 * 8; i += NTHR) l32[i] = t32[i];
    __syncthreads();
}
#ifndef PH_EN
#define PH_EN(k) 1
#endif
DI void run_phase(const Frame& F, int ph, int rep = 0) {
    unsigned char* ws = F.ws;
    if (ph == 0) { if (PH_EN(100)) p0_phase(F); return; }
    if (ph == 1) { if (PH_EN(101)) init_norm_phase(F); return; }
    const int l = (ph - 2) / 9, s = (ph - 2) % 9; const bool last = (l == DEPTH - 1);
    switch (s) {
    case 0: if (PH_EN(0)) { load_tabs(F);
        g8::DenseSched S; S.init(MT, 6, F.G, F.bid, 1024, ws + WS_WIN + (size_t)l * 1536 * 1024 * 2);
        EpiInProj E{ws, F.intab, l, (const LAS f32x2*)(F.lds + LDS_TAB64), (const LAS f32x2*)(F.lds + LDS_TAB32)};
        g8::gemm_phase(F.tid, F.lds, (const char*)(ws + WS_HB), 1024, S, E); } break;
    case 1: if (PH_EN(1)) { load_tabs(F);
        g8::DenseSched S; S.init(MT, 6, F.G, F.bid, 384, ws + WS_WUP + (size_t)l * 1536 * 384 * 2);
        EpiUpProj E{ws, F.intab, l, (const LAS f32x2*)(F.lds + LDS_TAB32)};
        g8::gemm_phase(F.tid, F.lds, (const char*)(ws + Z_CRAW), 384, S, E); } break;
    case 2: if (PH_EN(2)) attn_phase(F, l, !last, rep); break;
    case 3: if (PH_EN(3)) { g8::DenseSched S; S.init(last ? LAT / 256 : MT, 4, F.G, F.bid, 1024, ws + WS_WOUT + (size_t)l * 1024 * 1024 * 2);
        EpiOutProj E{ws, l == 0 ? INP(0) : F.out, INP(2), F.out, l};
        g8::gemm_phase(F.tid, F.lds, (const char*)(ws + Z_OB), 1024, S, E); } break;
    case 4: if (PH_EN(4)) router_phase(F, l, !last); break;
    case 5: if (PH_EN(5)) topk_phase(F, !last); break;
    case 6: if (PH_EN(6)) { g8::MoeSched<true> S; S.init(8, !last, F.G, F.bid, 512, ws + WS_W1 + (size_t)l * 16 * 2048 * 1024, (size_t)2048 * 1024, (const int*)(ws + WS_GIDX));
        EpiMoe1 E{ws}; g8::gemm_phase(F.tid, F.lds, (const char*)(ws + WS_HB), 512, S, E); } break;
    case 7: if (PH_EN(7)) { g8::MoeSched<false> S; S.init(4, !last, F.G, F.bid, 512, ws + WS_W2 + (size_t)l * 16 * 1024 * 1024, (size_t)1024 * 1024, nullptr);
        EpiMoe2 E{ws}; g8::gemm_phase(F.tid, F.lds, (const char*)(ws + Z_HID), 512, S, E); } break;
    case 8: if (PH_EN(8)) combine_phase(F, l, !last); break;
    }
}
__global__ void __launch_bounds__(NTHR, 2) mega_kernel(Args a) {
    extern __shared__ __attribute__((aligned(16))) unsigned char lds_raw[];
    Frame F; F.lds = (LAS unsigned char*)lds_raw; F.ws = a.ws; F.ctl = (unsigned*)(a.ws + WS_CTL);
    F.tid = threadIdx.x; F.lane = F.tid & 63; F.wave = __builtin_amdgcn_readfirstlane(F.tid >> 6); F.G = gridDim.x; F.bid = blockIdx.x; F.out = a.out;
    { LAS unsigned long long* tab = (LAS unsigned long long*)(F.lds + LDS_INTAB); if (F.tid < 27) tab[F.tid] = (unsigned long long)a.in[F.tid]; F.intab = tab; }
    volatile LAS unsigned* MISC = (volatile LAS unsigned*)(F.lds + LDS_MISC);
    if (F.tid < 64) MISC[F.tid] = 0u;
    __syncthreads();
    const bool multi = a.ph_hi - a.ph_lo > 1;
    XcdBarrier bar; bar.bar = F.ctl + CW_BAR + a.li * XCD_BAR_WORDS; bar.x = 0; bar.st = MISC;
    if (multi) bar = xcd_barrier_post(F.ctl + CW_BAR + a.li * XCD_BAR_WORDS, MISC);
    for (int ph = a.ph_lo; ph < a.ph_hi; ++ph) {
        {
            GAS unsigned char* w_ = (GAS unsigned char*)a.ws; GAS float* o_ = (GAS float*)a.out; unsigned l_ = (unsigned)(unsigned long long)F.lds, t_ = (unsigned)(unsigned long long)F.intab; int tid_ = threadIdx.x, g_ = gridDim.x, b_ = blockIdx.x;
            asm volatile("" : "+s"(w_), "+s"(o_), "+s"(l_), "+s"(t_), "+v"(tid_), "+s"(g_), "+s"(b_));
            F.ws = (unsigned char*)w_; F.out = (float*)o_; F.lds = (LAS unsigned char*)(unsigned long long)l_; F.intab = (const LAS unsigned long long*)(unsigned long long)t_; F.ctl = (unsigned*)(F.ws + WS_CTL);
            F.tid = tid_; F.lane = tid_ & 63; F.wave = __builtin_amdgcn_readfirstlane(tid_ >> 6); F.G = g_; F.bid = b_; }
        run_phase(F, ph, a.li);
#ifdef PROBE_I
        xcd_barrier(bar);
        if (F.bid == 0 && F.tid == 0) ((unsigned long long*)(F.ws + 49152))[ph + 1] = __builtin_amdgcn_s_memrealtime();
#else
        if (ph + 1 < a.ph_hi) xcd_barrier(bar);
#endif
    }
#ifdef PROBE_I
    {
        xcd_barrier(bar);
        const unsigned long long* ts = (const unsigned long long*)(F.ws + 49152);
        float ti = (float)(__hip_atomic_load(ts + PROBE_I + 1, __ATOMIC_RELAXED, __HIP_MEMORY_SCOPE_AGENT) - __hip_atomic_load(ts + PROBE_I, __ATOMIC_RELAXED, __HIP_MEMORY_SCOPE_AGENT)) * 0.01f;
        float tj = (float)(__hip_atomic_load(ts + PROBE_J + 1, __ATOMIC_RELAXED, __HIP_MEMORY_SCOPE_AGENT) - __hip_atomic_load(ts + PROBE_J, __ATOMIC_RELAXED, __HIP_MEMORY_SCOPE_AGENT)) * 0.01f;
        ti = exp2f(rintf(log2f(fmaxf(ti, 1.f)) * 14.2067f) / 14.2067f); tj = exp2f(rintf(log2f(fmaxf(tj, 1.f)) * 14.2067f) / 14.2067f);
        const float* xin = inp(F.intab, 0); const size_t n = (size_t)8 * 4096 * 1024;
        for (size_t i = (size_t)F.bid * NTHR + F.tid; i < n; i += (size_t)F.G * NTHR) F.out[i] = xin[i] + ti + (i == 0 ? 100.f * tj : 0.f);
    }
#endif
}
}

extern "C" void kernel_launch(void* const* d_in, const int* in_sizes, int n_in, void* d_out, int out_size, void* d_ws, size_t ws_size, hipStream_t stream) {
    static int grid = 0;
    if (grid == 0) {
        if (n_in != 27 || out_size != 8 * 4096 * 1024 || ws_size < fp::WS_END) { fprintf(stderr, "kernel_launch: unexpected problem (n_in %d, out %d, ws %zu < %zu)\n", n_in, out_size, ws_size, (size_t)fp::WS_END); grid = -1; return; }
        int dev = 0, cus = 0, per_cu = 0;
        if (hipGetDevice(&dev) != hipSuccess || hipDeviceGetAttribute(&cus, hipDeviceAttributeMultiprocessorCount, dev) != hipSuccess) { fprintf(stderr, "kernel_launch: device query failed\n"); grid = -1; return; }
        if (hipFuncSetAttribute((const void*)fp::mega_kernel, hipFuncAttributeMaxDynamicSharedMemorySize, fp::LDS_BYTES) != hipSuccess) { fprintf(stderr, "kernel_launch: hipFuncSetAttribute failed\n"); grid = -1; return; }
        if (hipOccupancyMaxActiveBlocksPerMultiprocessor(&per_cu, (const void*)fp::mega_kernel, fp::NTHR, fp::LDS_BYTES) != hipSuccess || per_cu < 1) fprintf(stderr, "kernel_launch: note: occupancy query reports %d workgroups per CU\n", per_cu);
        (void)hipGetLastError();
        grid = cus;
    }
    if (grid < 0) return;
    if (hipMemsetAsync((char*)d_ws + fp::WS_CTL, 0, fp::CTL_BYTES, stream) != hipSuccess) { fprintf(stderr, "kernel_launch: memset failed\n"); return; }
    fp::Args a{};
    for (int i = 0; i < 27; ++i) a.in[i] = (const float*)d_in[i];
    a.out = (float*)d_out; a.ws = (unsigned char*)d_ws; a.ph_lo = 0; a.ph_hi = fp::NPHASE;
#ifdef PROBE_SPLIT_LO
    a.ph_hi = PROBE_SPLIT_HI; a.li = 1; hipLaunchKernelGGL(fp::mega_kernel, dim3(grid), dim3(fp::NTHR), fp::LDS_BYTES, stream, a);
    a.ph_lo = PROBE_SPLIT_LO; a.ph_hi = fp::NPHASE; a.li = 0;
#endif
    hipLaunchKernelGGL(fp::mega_kernel, dim3(grid), dim3(fp::NTHR), fp::LDS_BYTES, stream, a);
}
```

```cpp
#include <hip/hip_runtime.h>
#include <stdint.h>
#include <stdio.h>
#include <math.h>
#include <type_traits>
constexpr int DEPTH = 2;
#define FAST_NB 8
namespace fp {
#define LAS __attribute__((address_space(3)))
#define GAS __attribute__((address_space(1)))
typedef unsigned short bf16_t;
typedef short bf16x8 __attribute__((ext_vector_type(8)));
typedef short s16x4 __attribute__((ext_vector_type(4)));
typedef float f32x4 __attribute__((ext_vector_type(4)));
typedef float f32x16 __attribute__((ext_vector_type(16)));
typedef unsigned u32x4 __attribute__((ext_vector_type(4)));
typedef unsigned u32x2 __attribute__((ext_vector_type(2)));
typedef float f32x2 __attribute__((ext_vector_type(2)));
#define DI __device__ __forceinline__

DI unsigned cvt_pk(float lo, float hi) { typedef float f2 __attribute__((ext_vector_type(2))); typedef __bf16 b2 __attribute__((ext_vector_type(2))); f2 v = {lo, hi}; b2 b = __builtin_convertvector(v, b2); return __builtin_bit_cast(unsigned, b); }
DI float bf_lo(unsigned w) { return __uint_as_float(w << 16); }
DI float bf_hi(unsigned w) { return __uint_as_float(w & 0xffff0000u); }
DI float silu_f(float v) { return v / (1.f + __expf(-v)); }
template <int M> DI float swz_xor(float v) { return __int_as_float(__builtin_amdgcn_ds_swizzle(__float_as_int(v), (M << 10) | 0x1F)); }
DI float add_xor16(float v) { return v + swz_xor<16>(v); }
DI float add_xor32(float v) { auto r = __builtin_amdgcn_permlane32_swap(__float_as_uint(v), __float_as_uint(v), false, false); return __uint_as_float(r[0]) + __uint_as_float(r[1]); }
DI float other32(float v, bool upper_half) { auto r = __builtin_amdgcn_permlane32_swap(__float_as_uint(v), __float_as_uint(v), false, false); return __uint_as_float(upper_half ? r[0] : r[1]); }
DI float wave_sum(float v) { v += swz_xor<1>(v); v += swz_xor<2>(v); v += swz_xor<4>(v); v += swz_xor<8>(v); v += swz_xor<16>(v); return add_xor32(v); }
DI unsigned shfl_up_u(unsigned v, int o, int lane) { return (unsigned)__builtin_amdgcn_ds_bpermute((lane - o) << 2, (int)v); }

constexpr int NB = FAST_NB;
constexpr int LAT = NB * 4096, CTXR = NB * 256, R = LAT + CTXR, MT = R / 256;
constexpr int MOE_LAT = NB * 16 * 512, MOE_ROWS = MOE_LAT + 16 * 256;
constexpr float EPS = 1e-6f, LOG2E = 1.4426950408889634f;
constexpr float QS64 = 0.125f * LOG2E, QS96 = 0.10206207261596575f * LOG2E;
constexpr float QF64 = QS64 * 8.f, QF96 = QS96 * 8.f;
constexpr int NWAVES = 8, NTHR = 512;

constexpr size_t al256(size_t x) { return (x + 255) & ~(size_t)255; }
constexpr size_t WS_CTL = 0, CTL_BYTES = 65536;
constexpr size_t WS_MOD = WS_CTL + CTL_BYTES;
constexpr size_t WS_TAB64 = WS_MOD + al256((size_t)2 * 9 * 6144 * 4);
constexpr size_t WS_TAB32 = WS_TAB64 + 8192;
constexpr size_t WS_WIN = WS_TAB32 + 4096;
constexpr size_t WS_WUP = WS_WIN + (size_t)2 * 1536 * 1024 * 2;
constexpr size_t WS_WOUT = WS_WUP + (size_t)2 * 1536 * 384 * 2;
constexpr size_t WS_W1 = WS_WOUT + (size_t)2 * 1024 * 1024 * 2;
constexpr size_t WS_W2 = WS_W1 + (size_t)2 * 16 * 2048 * 1024 * 2;
constexpr size_t WS_HB = WS_W2 + (size_t)2 * 16 * 1024 * 1024 * 2;
constexpr size_t WS_CTXF = WS_HB + (size_t)R * 1024 * 2;
constexpr size_t WS_SSQ = WS_CTXF + (size_t)CTXR * 1024 * 4;
constexpr size_t WS_AFFL = WS_SSQ + (size_t)R * 8 * 4;
constexpr size_t WS_AFFC = WS_AFFL + (size_t)NB * 16 * 4096 * 4;
constexpr size_t WS_GIDX = WS_AFFC + (size_t)NB * 16 * 256 * 4;
constexpr size_t WS_GATE = WS_GIDX + (size_t)MOE_ROWS * 4;
constexpr size_t WS_INV = WS_GATE + (size_t)MOE_ROWS * 4;
constexpr size_t WS_Z = al256(WS_INV + (size_t)R * 16 * 4);
constexpr size_t Z_QA = WS_Z, Z_KA = Z_QA + (size_t)R * 384 * 2, Z_VA = Z_KA + (size_t)R * 128 * 2, Z_QC = Z_VA + (size_t)R * 128 * 2, Z_KC = Z_QC + (size_t)R * 256 * 2,
                 Z_VC = Z_KC + (size_t)R * 128 * 2, Z_CRAW = Z_VC + (size_t)R * 128 * 2, Z_QB = Z_CRAW + (size_t)R * 384 * 2, Z_KB = Z_QB + (size_t)R * 576 * 2,
                 Z_VB = Z_KB + (size_t)R * 576 * 2, Z_OB = Z_VB + (size_t)R * 384 * 2, Z_END1 = Z_OB + (size_t)R * 1024 * 2;
constexpr size_t VT_TILE = 4096, VT_HEAD = 68 * VT_TILE;
constexpr size_t Z_HID = WS_Z, Z_YE = Z_HID + (size_t)MOE_ROWS * 1024 * 2, Z_END2 = Z_YE + (size_t)MOE_ROWS * 1024 * 2;
constexpr size_t WS_END = al256(Z_END1 > Z_END2 ? Z_END1 : Z_END2);
constexpr int CW_BAR = 1024;
constexpr int CW_QUEUE = 8192;

DI int vt_pos(int k) { return ((k & 4) << 3) | ((k & 32) >> 1) | ((k & 24) >> 1) | (k & 3); }
constexpr int RING_BYTES = 131072;
constexpr int LDS_TAB64 = RING_BYTES, LDS_TAB32 = LDS_TAB64 + 8192, LDS_MISC = LDS_TAB32 + 4096;
constexpr int LDS_INTAB = LDS_MISC + 256;
constexpr int LDS_BYTES = 147456;

#define XB_TMO      128
#define XB_XCNT(j)  (256  + 64 * (j))
#define XB_XSUB(j)  (1280 + 64 * (j))
#define XB_XGEN(j)  (2304 + 64 * (j))
#define XB_TOP      3328
#define XB_TOPGEN   3392
#define XCD_BAR_WORDS 3456
#define XB_SPIN_CAP (1u << 20)
DI unsigned xb_ld(unsigned* p)              { return __hip_atomic_load(p, __ATOMIC_RELAXED, __HIP_MEMORY_SCOPE_AGENT); }
DI unsigned xb_add(unsigned* p, unsigned v) { return __hip_atomic_fetch_add(p, v, __ATOMIC_RELAXED, __HIP_MEMORY_SCOPE_AGENT); }
DI unsigned xb_xcc_id() { return (unsigned)__builtin_amdgcn_s_getreg((3 << 11) | 20) & 0xFu; }
#define XB_SPIN(cond, bar) do { unsigned _sp = 0; while (cond) { __builtin_amdgcn_s_sleep(1); \
    if ((++_sp & 255u) == 0u) { if (xb_ld(&(bar)[XB_TMO])) break; if (_sp > XB_SPIN_CAP) { atomicAdd(&(bar)[XB_TMO], 1u); break; } } } } while (0)
struct XcdBarrier { unsigned* bar; unsigned x; volatile LAS unsigned* st; };
DI XcdBarrier xcd_barrier_post(unsigned* bar, volatile LAS unsigned* st) {
    XcdBarrier b; b.bar = bar; b.x = xb_xcc_id(); b.st = st;
    if (threadIdx.x == 0) (void)xb_add(&bar[XB_XCNT(b.x)], 1u);
    return b;
}
DI void xcd_barrier_complete(unsigned* bar, unsigned x, unsigned& nloc, unsigned& nx) {
    asm volatile("" : "+s"(x));
    const unsigned G = gridDim.x * gridDim.y * gridDim.z;
    unsigned sum, cnt, mine, sp = 0u;
    for (;;) {
        sum = 0u; cnt = 0u; mine = 0u;
#pragma unroll
        for (unsigned j = 0; j < 16; ++j) { const unsigned c = xb_ld(&bar[XB_XCNT(j)]); sum += c; cnt += (c > 0u) ? 1u : 0u; mine = (j == x) ? c : mine; }
        if (sum == G) break;
        __builtin_amdgcn_s_sleep(1);
        if ((++sp & 255u) == 0u) { if (xb_ld(&bar[XB_TMO])) break; if (sp > XB_SPIN_CAP) { atomicAdd(&bar[XB_TMO], 1u); break; } }
    }
    nloc = mine > 0u ? mine : 1u; nx = cnt > 0u ? cnt : 1u;
}
DI void xcd_barrier(const XcdBarrier& b) {
    asm volatile("s_waitcnt vmcnt(0)" ::: "memory");
    __syncthreads();
    if (threadIdx.x == 0) {
        unsigned* bar = b.bar; asm volatile("" : "+s"(bar));
        __builtin_amdgcn_s_waitcnt(0);
        unsigned nloc = b.st[0], nx = b.st[1];
        if (nloc == 0u) { xcd_barrier_complete(bar, b.x, nloc, nx); b.st[0] = nloc; b.st[1] = nx; }
        const unsigned old = xb_add(&bar[XB_XSUB(b.x)], 1u);
        const unsigned gen = old / nloc;
        if (old + 1u == (gen + 1u) * nloc) {
            __builtin_amdgcn_fence(__ATOMIC_RELEASE, "agent");
            asm volatile("s_waitcnt vmcnt(0)" ::: "memory");
            const unsigned og = xb_add(&bar[XB_TOP], 1u);
            const unsigned tg = og / nx;
            if (og + 1u == (tg + 1u) * nx) xb_add(&bar[XB_TOPGEN], 1u);
            else XB_SPIN(xb_ld(&bar[XB_TOPGEN]) == tg, bar);
            __builtin_amdgcn_fence(__ATOMIC_ACQUIRE, "agent");
            xb_add(&bar[XB_XGEN(b.x)], 1u);
            asm volatile("s_waitcnt vmcnt(0)" ::: "memory");
        } else {
            XB_SPIN(xb_ld(&bar[XB_XGEN(b.x)]) == gen, bar);
            __builtin_amdgcn_fence(__ATOMIC_ACQUIRE, "agent");
            asm volatile("s_waitcnt vmcnt(0)" ::: "memory");
        }
    }
    __syncthreads();
}

struct Args { const float* in[27]; float* out; unsigned char* ws; int ph_lo, ph_hi, li, pad; };
struct Frame {
    LAS unsigned char* lds; unsigned char* ws; unsigned* ctl;
    int tid, lane, wave, G, bid;
    const LAS unsigned long long* intab; float* out;
};
DI const float* inp(const LAS unsigned long long* tab, int k) { const unsigned long long v = tab[k]; const unsigned lo = __builtin_amdgcn_readfirstlane((unsigned)v), hi = __builtin_amdgcn_readfirstlane((unsigned)(v >> 32)); return (const float*)(const GAS float*)(((unsigned long long)hi << 32) | lo); }
#define INP(k) inp(F.intab, k)
#define WSP(T, off) ((T*)(F.ws + (off)))

DI void mod_item(const Frame& F, int item, const LAS float* s9, LAS float* red) {
    const int l = item / 96, c0 = (item % 96) * 64;
    const float* W = INP(4) + (size_t)l * 1024 * 6144 + c0;
    const int cg = F.lane & 15, ks = F.wave * 4 + (F.lane >> 4);
    f32x4 acc[9];
#pragma unroll
    for (int r = 0; r < 9; ++r) acc[r] = (f32x4){0.f, 0.f, 0.f, 0.f};
#pragma unroll 4
    for (int i = 0; i < 32; ++i) { const int k = ks + 32 * i; const f32x4 w = *(const f32x4*)(W + (size_t)k * 6144 + cg * 4);
#pragma unroll
        for (int r = 0; r < 9; ++r) acc[r] += w * s9[r * 1024 + k]; }
#pragma unroll
    for (int r = 0; r < 9; ++r)
#pragma unroll
        for (int j = 0; j < 4; ++j) { acc[r][j] = add_xor32(add_xor16(acc[r][j])); }
    __syncthreads();
    if (F.lane < 16) {
#pragma unroll
        for (int r = 0; r < 9; ++r) *(LAS f32x4*)(red + (F.wave * 9 + r) * 64 + cg * 4) = acc[r]; }
    __syncthreads();
    for (int e = F.tid; e < 9 * 64; e += NTHR) { const int r = e / 64, c = e % 64; float s = 0.f;
#pragma unroll
        for (int w = 0; w < 8; ++w) s += red[(w * 9 + r) * 64 + c];
        WSP(float, WS_MOD)[((size_t)l * 9 + r) * 6144 + c0 + c] = s + INP(5)[l * 6144 + c0 + c]; }
}

DI void cv_block(const float* src  , int ld, const float* ksc, bf16_t* drow  ) {
#pragma unroll
    for (int kc = 0; kc < 8; ++kc) {
        float v[8];
#pragma unroll
        for (int j = 0; j < 8; ++j) v[j] = src ? src[(size_t)(kc * 8 + j) * ld] : 0.f;
        if (ksc) {
#pragma unroll
            for (int j = 0; j < 8; ++j) v[j] *= ksc[kc * 8 + j]; }
        u32x4 o; o.x = cvt_pk(v[0], v[1]); o.y = cvt_pk(v[2], v[3]); o.z = cvt_pk(v[4], v[5]); o.w = cvt_pk(v[6], v[7]);
        *(u32x4*)(drow + kc * 8) = o;
    }
}
DI void cv_block_fp8(const float* src, int ld, unsigned char* drow) {
#pragma unroll
    for (int kc = 0; kc < 4; ++kc) {
        float v[16];
#pragma unroll
        for (int j = 0; j < 16; ++j) v[j] = src[(size_t)(kc * 16 + j) * ld] * 64.0f;
        u32x4 o;
        { int w = __builtin_amdgcn_cvt_pk_fp8_f32(v[0], v[1], 0, false); w = __builtin_amdgcn_cvt_pk_fp8_f32(v[2], v[3], w, true); o.x = (unsigned)w; }
        { int w = __builtin_amdgcn_cvt_pk_fp8_f32(v[4], v[5], 0, false); w = __builtin_amdgcn_cvt_pk_fp8_f32(v[6], v[7], w, true); o.y = (unsigned)w; }
        { int w = __builtin_amdgcn_cvt_pk_fp8_f32(v[8], v[9], 0, false); w = __builtin_amdgcn_cvt_pk_fp8_f32(v[10], v[11], w, true); o.z = (unsigned)w; }
        { int w = __builtin_amdgcn_cvt_pk_fp8_f32(v[12], v[13], 0, false); w = __builtin_amdgcn_cvt_pk_fp8_f32(v[14], v[15], w, true); o.w = (unsigned)w; }
        *(u32x4*)(drow + kc * 16) = o;
    }
}
constexpr int CV_WIN = 384, CV_WUP = 144, CV_WOUT = 256, CV_W1 = 8192, CV_W2 = 4096, CV_LAYER = CV_WIN + CV_WUP + CV_WOUT + CV_W1 + CV_W2;
DI void conv_item(const Frame& F, int it) {
    const int l = it / CV_LAYER; int r = it % CV_LAYER; const int lane = F.lane, hl = lane >> 5, ll = lane & 31;
    if (r < CV_WIN) {
        const int kb = r / 24, g = (r % 24) * 2 + hl, x = ((g >> 3) * 4 + (g & 3)) * 64 + 32 * ((g >> 2) & 1) + ll;
        const int sc = x < 960 ? x : (x < 1472 ? x + 32 : (x < 1504 ? x - 512 : -1));
        const float* src = sc < 0 ? nullptr : INP(8) + (size_t)l * 1024 * 1504 + (size_t)(kb * 64) * 1504 + sc;
        cv_block(src, 1504, nullptr, WSP(bf16_t, WS_WIN) + (size_t)l * 1536 * 1024 + (size_t)((r % 24) * 64 + lane) * 1024 + kb * 64); return; }
    r -= CV_WIN;
    if (r < CV_WUP) {
        const int kb = r / 24, g = (r % 24) * 2 + hl, slot = (g >> 3) * 4 + (g & 3), half = (g >> 2) & 1;
        const float* src = nullptr; const float* ksc = nullptr; int ld = 0;
        if (slot < 9 && kb < 3) { const int col = slot < 6 ? slot * 96 + 32 * half : (2 * (slot - 6) + half) * 96 + 64;
            src = INP(13) + (size_t)l * 192 * 576 + (size_t)(kb * 64) * 576 + col + ll; ld = 576; ksc = INP(11) + l * 192 + kb * 64; }
        else if (slot >= 12 && (kb == 3 || kb == 4)) { const int h = slot < 18 ? slot - 12 : slot - 18; const int col = h * 128 + (slot < 18 ? 0 : 64) + 32 * half;
            src = INP(14) + (size_t)l * 128 * 768 + (size_t)((kb - 3) * 64) * 768 + col + ll; ld = 768; ksc = INP(12) + l * 128 + (kb - 3) * 64; }
        cv_block(src, ld, ksc, WSP(bf16_t, WS_WUP) + (size_t)l * 1536 * 384 + (size_t)((r % 24) * 64 + lane) * 384 + kb * 64); return; }
    r -= CV_WUP;
    if (r < CV_WOUT) { const int kb = r / 16, g = r % 16;
        cv_block(INP(22) + (size_t)l * 1024 * 1024 + (size_t)(kb * 64) * 1024 + g * 64 + lane, 1024, nullptr, WSP(bf16_t, WS_WOUT) + (size_t)l * 1024 * 1024 + (size_t)(g * 64 + lane) * 1024 + kb * 64); return; }
    r -= CV_WOUT;
    if (r < CV_W1) { const int e = r / 512, q = r % 512, kb = q / 32, g = (q % 32) * 2 + hl, pn = g >> 3, bj = (g >> 2) & 1, wc = g & 3;
        const float* src = (bj ? INP(25) : INP(24)) + ((size_t)l * 16 + e) * 1024 * 1024 + (size_t)(kb * 64) * 1024 + 128 * pn + 32 * wc + ll;
        cv_block_fp8(src, 1024, WSP(unsigned char, WS_W1) + ((size_t)l * 16 + e) * 2048 * 1024 + (size_t)((q % 32) * 64 + lane) * 1024 + kb * 64); return; }
    r -= CV_W1;
    { const int e = r / 256, q = r % 256, kb = q / 16, g = q % 16;
        cv_block_fp8(INP(26) + ((size_t)l * 16 + e) * 1024 * 1024 + (size_t)(kb * 64) * 1024 + g * 64 + lane, 1024, WSP(unsigned char, WS_W2) + ((size_t)l * 16 + e) * 1024 * 1024 + (size_t)(g * 64 + lane) * 1024 + kb * 64); }
}
DI void p0_phase(const Frame& F) {
    LAS float* s9 = (LAS float*)F.lds;
    LAS float* red = (LAS float*)(F.lds + 9 * 1024 * 4);
    if (F.bid == 0) {
        for (int i = F.tid; i < 64 * 16; i += NTHR) { const int pos = i / 16, f = i % 16; const float inv = exp2f(-(float)(2 * f) / 32.f * 13.287712379549449f); const float a = (float)pos * inv; WSP(f32x2, WS_TAB64)[i] = (f32x2){cosf(a), sinf(a)}; }
        for (int i = F.tid; i < 64 * 8; i += NTHR) { const int pos = i / 8, f = i % 8; const float inv = exp2f(-(float)(2 * f) / 16.f * 13.287712379549449f); const float a = (float)pos * inv; WSP(f32x2, WS_TAB32)[i] = (f32x2){cosf(a), sinf(a)}; }
    }
    bool have_s9 = false;
    for (int it = F.bid; it < 192; it += F.G) {
        if (!have_s9) { for (int e = F.tid; e < 9 * 1024; e += NTHR) { const int r = e / 1024, k = e % 1024; const float v = r < 8 ? INP(1)[r * 1024 + k] : INP(3)[k]; s9[e] = silu_f(v); } have_s9 = true; __syncthreads(); }
        mod_item(F, it, s9, red);
    }
    __syncthreads();
    const int gw = F.bid * NWAVES + F.wave, NGW = F.G * NWAVES;
    for (int it = gw; it < 2 * CV_LAYER; it += NGW) conv_item(F, it);
}

DI void norm_mod_store(const f32x4 (&v)[4], const float* g, const float* sh, const float* sc, bf16_t* orow, int lane) {
    float s = 0.f;
#pragma unroll
    for (int j = 0; j < 4; ++j) s += (v[j].x * v[j].x + v[j].y * v[j].y) + (v[j].z * v[j].z + v[j].w * v[j].w);
    const float rstd = 1.0f / sqrtf(wave_sum(s) * (1.f / 1024.f) + EPS);
#pragma unroll
    for (int j = 0; j < 4; ++j) { const int c = 4 * (lane + 64 * j); const f32x4 gv = *(const f32x4*)(g + c), sv = *(const f32x4*)(sh + c), cv = *(const f32x4*)(sc + c);
        const f32x4 o = v[j] * rstd * gv * (cv + 1.0f) + sv; u32x2 w; w.x = cvt_pk(o.x, o.y); w.y = cvt_pk(o.z, o.w); *(u32x2*)(orow + c) = w; }
}
DI const float* mod_row(const Frame& F, int l, int row) { const int r = row < LAT ? row / 4096 : 8; return WSP(float, WS_MOD) + ((size_t)l * 9 + r) * 6144; }
DI void init_norm_phase(const Frame& F) {
    const int gw = F.bid * NWAVES + F.wave, NGW = F.G * NWAVES;
    for (int row = gw; row < R; row += NGW) {
        const float* xr = row < LAT ? INP(0) + (size_t)row * 1024 : INP(2) + (size_t)(row - LAT) * 1024;
        f32x4 v[4];
#pragma unroll
        for (int j = 0; j < 4; ++j) v[j] = *(const f32x4*)(xr + 4 * (F.lane + 64 * j));
        const float* m = mod_row(F, 0, row);
        norm_mod_store(v, INP(6), m, m + 1024, WSP(bf16_t, WS_HB) + (size_t)row * 1024, F.lane);
    }
}
namespace g8 {
constexpr int BM = 256, BK = 64, HALF = 128, HTB = HALF * BK * 2, STAGE_BYTES = 8 * HTB;
DI int lds_byte(int r, int c) { const int st = (r >> 4) * 2 + (c >> 5), rr = r & 15, cc = c & 31, ob = rr * 64 + cc * 2; return st * 1024 + (ob ^ (((ob >> 9) & 1) << 5)); }
DI void stage_rc(int b, int& Rr, int& Cc) { const int st = b / 1024, sb = b % 1024, swz = sb ^ (((sb >> 9) & 1) << 5); Rr = (st >> 1) * 16 + swz / 64; Cc = (st & 1) * 32 + (swz % 64) / 2; }
DI int perm32(int rho) { const int n = rho >> 4, i = rho & 15; return 8 * (i >> 2) + 4 * n + (i & 3); }

typedef int i32x4 __attribute__((ext_vector_type(4)));
typedef int i32x8 __attribute__((ext_vector_type(8)));
struct Unit { int pm, pn, aux; const char* Bp; };

template <class Epi, class Sched>
DI void gemm_phase(const int tid, LAS unsigned char* lds, const char* Abase, int K, const Sched& S, const Epi& E) {
    asm volatile("" : "+s"(K));
    const int wid = __builtin_amdgcn_readfirstlane(tid >> 6), lane = tid & 63, wr = wid >> 2, wc = wid & 3, fr = lane & 15, fq = lane >> 4;
    const int nt = K / BK;
    int Rr[2], Cc[2]; unsigned voffB[2];
#pragma unroll
    for (int i = 0; i < 2; ++i) { int r_, c_; stage_rc(tid * 16 + i * 8192, r_, c_); Rr[i] = r_; Cc[i] = c_; const int Rb = Epi::PERM ? ((r_ & ~31) + perm32(r_ & 31)) : r_; voffB[i] = (unsigned)(Rb * K + c_) * 2u; }
    const size_t hstepB = (size_t)HALF * K * 2;
    const unsigned ldsw = (unsigned)wid * 1024u;
    const int aoff = lds_byte(wr * 64 + fr, fq * 8), boff = lds_byte(wc * 32 + fr, fq * 8);
#define G8_SA(b, h) (((b) * 2 + (h)) * HTB)
#define G8_SB(b, h) ((4 + (b) * 2 + (h)) * HTB)
#define G8_STAGE_A(bufoff, ao2, kt) do { _Pragma("unroll") for (int _i = 0; _i < 2; ++_i) \
        __builtin_amdgcn_global_load_lds((const unsigned*)(Abase + (size_t)(ao2)[_i] + (size_t)(kt) * 128), (LAS unsigned*)(lds + (bufoff) + ldsw + _i * 8192), 16, 0, 0); } while (0)
#define G8_STAGE_B(bufoff, bp, h, kt) do { _Pragma("unroll") for (int _i = 0; _i < 2; ++_i) \
        __builtin_amdgcn_global_load_lds((const unsigned*)((bp) + (size_t)(h) * hstepB + voffB[_i] + (size_t)(kt) * 128), (LAS unsigned*)(lds + (bufoff) + ldsw + _i * 8192), 16, 0, 0); } while (0)
#define G8_LD16(off) (*(const LAS i32x4*)(lds + (off)))
#define G8_LDA(dst, b, h) do { _Pragma("unroll") for (int m = 0; m < 4; ++m) { const i32x4 lo_ = G8_LD16(G8_SA(b, h) + aoff + m * 2048), hi_ = G8_LD16(G8_SA(b, h) + aoff + m * 2048 + 1024); dst[m] = __builtin_shufflevector(lo_, hi_, 0, 1, 2, 3, 4, 5, 6, 7); } } while (0)
#define G8_LDB(dst, b, h) do { _Pragma("unroll") for (int n = 0; n < 2; ++n) { const i32x4 lo_ = G8_LD16(G8_SB(b, h) + boff + n * 2048), hi_ = G8_LD16(G8_SB(b, h) + boff + n * 2048 + 1024); dst[n] = __builtin_shufflevector(lo_, hi_, 0, 1, 2, 3, 4, 5, 6, 7); } } while (0)
#define G8_HALF(v, k) __builtin_bit_cast(bf16x8, __builtin_shufflevector((v), (v), 4 * (k), 4 * (k) + 1, 4 * (k) + 2, 4 * (k) + 3))
#define G8_MMA(ai, bj, At, Bt) do { __builtin_amdgcn_s_setprio(1); _Pragma("unroll") for (int m = 0; m < 4; ++m) _Pragma("unroll") for (int n = 0; n < 2; ++n) { \
        if constexpr (Epi::FP8) asm volatile("v_mfma_scale_f32_16x16x128_f8f6f4 %0, %1, %2, %0, %3, %3 op_sel_hi:[0,0,0]" : "+v"(acc[ai][bj][m][n]) : "v"(Bt[n]), "v"(At[m]), "v"(fp8_scale)); \
        else { acc[ai][bj][m][n] = __builtin_amdgcn_mfma_f32_16x16x32_bf16(G8_HALF(Bt[n], 0), G8_HALF(At[m], 0), acc[ai][bj][m][n], 0, 0, 0); \
               acc[ai][bj][m][n] = __builtin_amdgcn_mfma_f32_16x16x32_bf16(G8_HALF(Bt[n], 1), G8_HALF(At[m], 1), acc[ai][bj][m][n], 0, 0, 0); } } __builtin_amdgcn_s_setprio(0); } while (0)
#define G8_WAIT_V(n) asm volatile("s_waitcnt vmcnt(" #n ")" ::: "memory")
#define G8_WAIT_L(n) asm volatile("s_waitcnt lgkmcnt(" #n ")" ::: "memory")
#define G8_BAR __builtin_amdgcn_s_barrier()
#define G8_SCHED __builtin_amdgcn_sched_barrier(0)
    const int fp8_scale = 0x7F7F7F7F;
    Unit cur, nxt; int ui = 0;
    if (!S.next(0, cur)) return;
    unsigned aoc[2][2], aon[2][2];
    S.aoffs(cur, Rr, Cc, aoc);
    f32x4 acc[2][2][4][2];
#pragma unroll
    for (int a = 0; a < 2; ++a)
#pragma unroll
        for (int b = 0; b < 2; ++b)
#pragma unroll
            for (int m = 0; m < 4; ++m)
#pragma unroll
                for (int n = 0; n < 2; ++n) acc[a][b][m][n] = (f32x4){0.f, 0.f, 0.f, 0.f};
    i32x8 At[4], B0[2], B1[2];
    const char* cB = cur.Bp;
    G8_STAGE_B(G8_SB(0, 0), cB, 0, 0); G8_STAGE_B(G8_SB(0, 1), cB, 1, 0); G8_STAGE_A(G8_SA(0, 0), aoc[0], 0); G8_STAGE_A(G8_SA(0, 1), aoc[1], 0);
    if (wr == 1) G8_BAR;
    G8_WAIT_V(2); G8_BAR;
    G8_STAGE_B(G8_SB(1, 0), cB, 0, 1); G8_STAGE_A(G8_SA(1, 0), aoc[0], 1); G8_STAGE_B(G8_SB(1, 1), cB, 1, 1);
    G8_WAIT_V(6); G8_BAR;
    for (;;) {
        const bool has_next = S.next(ui + 1, nxt);
        if (has_next) S.aoffs(nxt, Rr, Cc, aon);
        else {
#pragma unroll
            for (int h = 0; h < 2; ++h)
#pragma unroll
                for (int i = 0; i < 2; ++i) aon[h][i] = aoc[h][i]; }
        const char* nB = has_next ? nxt.Bp : cB;
        for (int t = 0; t < nt; t += 2) {
            const bool last = (t == nt - 2);
            unsigned a2[2][2];
#pragma unroll
            for (int h = 0; h < 2; ++h)
#pragma unroll
                for (int i = 0; i < 2; ++i) a2[h][i] = last ? aon[h][i] : aoc[h][i];
            const int kt2 = last ? 0 : t + 2; const char* b2 = last ? nB : cB;
            G8_LDB(B0, 0, 0); G8_LDB(B1, 0, 1); G8_SCHED; G8_LDA(At, 0, 0); G8_STAGE_A(G8_SA(1, 1), aoc[1], t + 1);
            G8_WAIT_V(8); G8_WAIT_L(0); G8_BAR; G8_MMA(0, 0, At, B0); G8_MMA(0, 1, At, B1); G8_BAR; G8_SCHED;
            G8_LDA(At, 0, 1); G8_STAGE_B(G8_SB(0, 0), b2, 0, kt2); G8_STAGE_B(G8_SB(0, 1), b2, 1, kt2); G8_STAGE_A(G8_SA(0, 0), a2[0], kt2);
            G8_WAIT_V(8); G8_WAIT_L(0); G8_BAR; G8_MMA(1, 0, At, B0); G8_MMA(1, 1, At, B1); G8_BAR; G8_SCHED;
            G8_LDB(B0, 1, 0); G8_LDB(B1, 1, 1); G8_SCHED; G8_LDA(At, 1, 0); G8_STAGE_A(G8_SA(0, 1), a2[1], kt2);
            G8_WAIT_V(8); G8_WAIT_L(0); G8_BAR; G8_MMA(0, 0, At, B0); G8_MMA(0, 1, At, B1); G8_BAR; G8_SCHED;
            G8_LDA(At, 1, 1); G8_STAGE_B(G8_SB(1, 0), b2, 0, kt2 + 1); G8_STAGE_B(G8_SB(1, 1), b2, 1, kt2 + 1); G8_STAGE_A(G8_SA(1, 0), a2[0], kt2 + 1);
            G8_WAIT_V(8); G8_WAIT_L(0); G8_BAR; G8_MMA(1, 0, At, B0); G8_MMA(1, 1, At, B1); G8_BAR; G8_SCHED;
        }
        if (wr == 0) G8_BAR;
        if constexpr (Epi::FP8) asm volatile("s_nop 15\n\ts_nop 15" ::: "memory");
        E(acc, cur, wr, wc, fr, fq);
        if (!has_next) break;
#pragma unroll
        for (int a = 0; a < 2; ++a)
#pragma unroll
            for (int b = 0; b < 2; ++b)
#pragma unroll
                for (int m = 0; m < 4; ++m)
#pragma unroll
                    for (int n = 0; n < 2; ++n) acc[a][b][m][n] = (f32x4){0.f, 0.f, 0.f, 0.f};
        cur = nxt; cB = nB;
#pragma unroll
        for (int h = 0; h < 2; ++h)
#pragma unroll
            for (int i = 0; i < 2; ++i) aoc[h][i] = aon[h][i];
        ++ui;
        if (wr == 1) G8_BAR;
    }
    G8_WAIT_V(0);
    G8_BAR;
#undef G8_SA
#undef G8_SB
#undef G8_STAGE_A
#undef G8_STAGE_B
#undef G8_LDA
#undef G8_LDB
#undef G8_MMA
#undef G8_HALF
#undef G8_LD16
#undef G8_WAIT_V
#undef G8_WAIT_L
#undef G8_BAR
#undef G8_SCHED
}

struct DenseSched {
    int nM, nN, nwg, G, c, K; const char* Bt;
    DI void init(int nM_, int nN_, int G_, int c_, int K_, const void* Bt_) { nM = nM_; nN = nN_; nwg = nM * nN; G = G_; c = c_; K = K_; Bt = (const char*)Bt_; }
    DI bool next(int i, Unit& u) const {
        const long L = (long)i * G + c; if (L >= nwg) return false;
        int wgid = (int)L; { const int q = nwg / 8, r = nwg % 8, xcd = wgid % 8, off = wgid / 8; wgid = (xcd < r ? xcd * (q + 1) : r * (q + 1) + (xcd - r) * q) + off; }
        const int WGM = 8, nig = WGM * nN, gid = wgid / nig, fm = gid * WGM, gsz = (nM - fm) < WGM ? (nM - fm) : WGM;
        u.pm = fm + ((wgid % nig) % gsz); u.pn = (wgid % nig) / gsz; u.aux = 0; u.Bp = Bt + (size_t)u.pn * 256 * K * 2; return true;
    }
    DI void aoffs(const Unit& u, const int (&Rr)[2], const int (&Cc)[2], unsigned (&ao)[2][2]) const {
#pragma unroll
        for (int h = 0; h < 2; ++h)
#pragma unroll
            for (int i = 0; i < 2; ++i) ao[h][i] = (unsigned)(((size_t)(u.pm * 256 + h * 128 + Rr[i]) * K + Cc[i]) * 2);
    }
};
template <bool GATHER>
struct MoeSched {
    int nN, tiles_per_e, nwg, G, c, K, NBt; const char* Bt; size_t estride; const int* gidx; bool with_ctx;
    DI void init(int nN_, bool with_ctx_, int G_, int c_, int K_, const void* Bt_, size_t estride_, const int* gidx_) {
        nN = nN_; with_ctx = with_ctx_; tiles_per_e = NB * 2 + (with_ctx_ ? 1 : 0); nwg = 16 * tiles_per_e * nN; G = G_; c = c_; K = K_; Bt = (const char*)Bt_; estride = estride_; gidx = gidx_; }
    DI bool next(int i, Unit& u) const {
        int mt;
        if (G % (8 * nN) == 0) {
            const int per = (G / 8) / nN, xcd = c & 7, j8 = c >> 3; mt = (i * 8 + xcd) * per + j8 / nN; u.pn = j8 % nN; if (mt >= 16 * tiles_per_e) return false;
        } else { const long L = (long)i * G + c; if (L >= nwg) return false; mt = (int)L / nN; u.pn = (int)L % nN; }
        const int e = mt / tiles_per_e, j = mt % tiles_per_e;
        const int rowbase = j < NB * 2 ? ((j >> 1) * 16 + e) * 512 + (j & 1) * 256 : MOE_LAT + e * 256;
        u.pm = rowbase / 256; u.aux = e; u.Bp = Bt + (size_t)e * estride + (size_t)u.pn * 256 * K * 2; return true;
    }
    DI void aoffs(const Unit& u, const int (&Rr)[2], const int (&Cc)[2], unsigned (&ao)[2][2]) const {
#pragma unroll
        for (int h = 0; h < 2; ++h)
#pragma unroll
            for (int i = 0; i < 2; ++i) { const int mrow = u.pm * 256 + h * 128 + Rr[i]; const int arow = GATHER ? gidx[mrow] : mrow; ao[h][i] = (unsigned)(((size_t)arow * K + Cc[i]) * 2); }
    }
};
}

typedef f32x4 Acc[2][2][4][2];
DI unsigned pk_fp8x4(float a, float b, float c, float d) { int w = __builtin_amdgcn_cvt_pk_fp8_f32(a, b, 0, false); w = __builtin_amdgcn_cvt_pk_fp8_f32(c, d, w, true); return (unsigned)w; }
DI unsigned pk_fp8v(const f32x4 v) { return pk_fp8x4(v.x, v.y, v.z, v.w); }
DI void st_bf16x4(bf16_t* p, const f32x4 v) { u32x2 w; w.x = cvt_pk(v.x, v.y); w.y = cvt_pk(v.z, v.w); *(u32x2*)p = w; }

DI void st_vt4(unsigned char* tile, int d0, int pos, const f32x4 v) { const unsigned w = pk_fp8v(v); unsigned char* p = tile + d0 * 64 + pos;
    p[0] = (unsigned char)w; p[64] = (unsigned char)(w >> 8); p[128] = (unsigned char)(w >> 16); p[192] = (unsigned char)(w >> 24); }
DI size_t vt_tile_of_rowgroup(int row64  ) {
    return row64 < LAT ? (size_t)(row64 / 4096) * 68 + 4 + (row64 % 4096) / 64 : (size_t)((row64 - LAT) / 256) * 68 + ((row64 - LAT) % 256) / 64; }
struct EpiInProj {
    static constexpr bool PERM = false, FP8 = false;
    unsigned char* ws; const LAS unsigned long long* in; int l; const LAS f32x2* tab64; const LAS f32x2* tab32;
    DI void operator()(const Acc& acc, const g8::Unit& u, int wr, int wc, int fr, int fq) const {
        asm volatile("" : "+v"(fr), "+v"(fq));
        const int slot = 4 * u.pn + wc; const int rowt = u.pm * 256 + wr * 64 + fr; const bool lat = (u.pm * 256) < LAT;
        int kind; bf16_t* dst; int ld, coff; const float* gain = nullptr; float qs = 1.f;
        if (slot < 6)       { kind = 0; dst = (bf16_t*)(ws + Z_QA); ld = 384; coff = slot * 64; gain = inp(in, 9) + l * 64; qs = QF64; }
        else if (slot < 8)  { kind = 0; dst = (bf16_t*)(ws + Z_KA); ld = 128; coff = (slot - 6) * 64; gain = inp(in, 10) + l * 64; }
        else if (slot < 10) { kind = 1; dst = (bf16_t*)(ws + Z_VA); ld = 128; coff = (slot - 8) * 64; }
        else if (slot < 15) { kind = 2; dst = (bf16_t*)(ws + Z_CRAW); ld = 384; coff = (slot - 10) * 64; }
        else if (slot < 19) { kind = 0; dst = (bf16_t*)(ws + Z_QC); ld = 256; coff = (slot - 15) * 64; gain = inp(in, 19) + l * 64; qs = QF64; }
        else if (slot < 21) { kind = 0; dst = (bf16_t*)(ws + Z_KC); ld = 128; coff = (slot - 19) * 64; gain = inp(in, 20) + l * 64; }
        else if (slot < 23) { kind = 1; dst = (bf16_t*)(ws + Z_VC); ld = 128; coff = (slot - 21) * 64; }
        else                { kind = 3; dst = (bf16_t*)(ws + Z_KB); ld = 576; coff = 64; gain = inp(in, 18) + l * 32; }
        if (kind == 0) {
            f32x4 g[2][2];
#pragma unroll
            for (int bj = 0; bj < 2; ++bj)
#pragma unroll
                for (int n = 0; n < 2; ++n) g[bj][n] = *(const f32x4*)(gain + 32 * bj + 16 * n + 4 * fq) * qs;
#pragma unroll
            for (int ai = 0; ai < 2; ++ai)
#pragma unroll
                for (int m = 0; m < 4; ++m) {
                    const int row = rowt + ai * 128 + m * 16; float s = 0.f;
#pragma unroll
                    for (int bj = 0; bj < 2; ++bj)
#pragma unroll
                        for (int n = 0; n < 2; ++n) { const f32x4 x = acc[ai][bj][m][n]; s += (x.x * x.x + x.y * x.y) + (x.z * x.z + x.w * x.w); }
                    s = add_xor32(add_xor16(s));
                    const float rstd = 1.0f / sqrtf(s * (1.f / 64.f) + EPS);
                    const int t = row & 4095, pr = t >> 6, pc = t & 63;
#pragma unroll
                    for (int bj = 0; bj < 2; ++bj) {
                        f32x4 x1 = acc[ai][bj][m][0] * rstd * g[bj][0], x2 = acc[ai][bj][m][1] * rstd * g[bj][1];
                        if (lat) { const LAS f32x2* tb = tab64 + (bj == 0 ? pr : pc) * 16 + 4 * fq; f32x4 o1, o2;
#pragma unroll
                            for (int i = 0; i < 4; ++i) { const f32x2 cs = tb[i]; o1[i] = x1[i] * cs.x - x2[i] * cs.y; o2[i] = x2[i] * cs.x + x1[i] * cs.y; }
                            x1 = o1; x2 = o2; }
                        unsigned char* p = (unsigned char*)dst + (size_t)row * ld + coff + 32 * bj + 4 * fq;
                        *(unsigned*)p = pk_fp8v(x1); *(unsigned*)(p + 16) = pk_fp8v(x2);
                    }
                    asm volatile("" ::: "memory");
                }
        } else if (kind == 1 || kind == 2) {
#pragma unroll
            for (int ai = 0; ai < 2; ++ai)
#pragma unroll
                for (int m = 0; m < 4; ++m) {
                    const int row = rowt + ai * 128 + m * 16; float s = 0.f;
#pragma unroll
                    for (int bj = 0; bj < 2; ++bj)
#pragma unroll
                        for (int n = 0; n < 2; ++n) { const f32x4 x = acc[ai][bj][m][n]; s += (x.x * x.x + x.y * x.y) + (x.z * x.z + x.w * x.w);
                            if (kind == 2) st_bf16x4(dst + (size_t)row * ld + coff + 32 * bj + 16 * n + 4 * fq, x);
                            else { const int row64 = u.pm * 256 + ai * 128 + wr * 64;
                                const size_t bt = vt_tile_of_rowgroup(row64); unsigned char* tile = (unsigned char*)dst + ((bt / 68) * 2 + coff / 64) * VT_HEAD + (bt % 68) * VT_TILE;
                                st_vt4(tile, 32 * bj + 16 * n + 4 * fq, vt_pos(16 * m + fr), x); } }
                    if (kind == 2) { s = add_xor32(add_xor16(s)); if (fq == 0) ((float*)(ws + WS_SSQ))[(size_t)row * 8 + (slot - 10)] = s; }
                }
        } else {
            const f32x4 g0 = *(const f32x4*)(gain + 4 * fq), g1 = *(const f32x4*)(gain + 16 + 4 * fq);
            bf16_t* craw = (bf16_t*)(ws + Z_CRAW);
#pragma unroll
            for (int ai = 0; ai < 2; ++ai)
#pragma unroll
                for (int m = 0; m < 4; ++m) {
                    const int row = rowt + ai * 128 + m * 16;
                    const f32x4 a0 = acc[ai][0][m][0], a1 = acc[ai][0][m][1];
                    float s = (a0.x * a0.x + a0.y * a0.y) + (a0.z * a0.z + a0.w * a0.w) + (a1.x * a1.x + a1.y * a1.y) + (a1.z * a1.z + a1.w * a1.w);
                    s = add_xor32(add_xor16(s));
                    const float rstd = 1.0f / sqrtf(s * (1.f / 32.f) + EPS);
                    f32x4 v0 = a0 * rstd * g0, v1 = a1 * rstd * g1;
                    if (lat) { const int t = row & 4095, pr = t >> 6, pc = t & 63;
                        f32x4 p0, p1;
#pragma unroll
                        for (int i = 0; i < 4; ++i) { p0[i] = other32(v0[i], fq >= 2); p1[i] = other32(v1[i], fq >= 2); }
                        const LAS f32x2* t0 = tab32 + pr * 8 + 4 * (fq & 1); const LAS f32x2* t1 = tab32 + pc * 8 + 4 * (fq & 1);
#pragma unroll
                        for (int i = 0; i < 4; ++i) { const f32x2 c0 = t0[i], c1 = t1[i];
                            v0[i] = fq < 2 ? v0[i] * c0.x - p0[i] * c0.y : v0[i] * c0.x + p0[i] * c0.y;
                            v1[i] = fq < 2 ? v1[i] * c1.x - p1[i] * c1.y : v1[i] * c1.x + p1[i] * c1.y; } }
                    const unsigned w0 = pk_fp8v(v0), w1 = pk_fp8v(v1);
#pragma unroll
                    for (int h = 0; h < 6; ++h) { unsigned char* p = (unsigned char*)dst + (size_t)row * 768 + h * 128 + 64 + 4 * fq; *(unsigned*)p = w0; *(unsigned*)(p + 16) = w1; *(unsigned*)(p + 32) = 0u; *(unsigned*)(p + 48) = 0u; }
                    const u32x2 z = {0u, 0u};
#pragma unroll
                    for (int q = 0; q < 4; ++q) *(u32x2*)(craw + (size_t)row * 384 + 320 + 16 * q + 4 * fq) = z;
                    asm volatile("" ::: "memory");
                }
        }
    }
};

struct EpiUpProj {
    static constexpr bool PERM = false, FP8 = false;
    unsigned char* ws; const LAS unsigned long long* in; int l; const LAS f32x2* tab32;
    DI void operator()(const Acc& acc, const g8::Unit& u, int wr, int wc, int fr, int fq) const {
        asm volatile("" : "+v"(fr), "+v"(fq));
        const int slot = 4 * u.pn + wc; if (slot >= 9 && slot < 12) return;
        const int rowt = u.pm * 256 + wr * 64 + fr; const bool lat = (u.pm * 256) < LAT;
        const float* ssq = (const float*)(ws + WS_SSQ);
        bf16_t* qB = (bf16_t*)(ws + Z_QB); bf16_t* kB = (bf16_t*)(ws + Z_KB); bf16_t* vB = (bf16_t*)(ws + Z_VB);
        const bool isq = slot < 9;
#pragma unroll
        for (int ai = 0; ai < 2; ++ai)
#pragma unroll
            for (int m = 0; m < 4; ++m) {
                const int row = rowt + ai * 128 + m * 16;
                const f32x4 sa = *(const f32x4*)(ssq + (size_t)row * 8); const float sb = ssq[(size_t)row * 8 + 4];
                const float r0 = isq ? 1.0f / sqrtf((sa.x + sa.y + sa.z) * (1.f / 192.f) + EPS) : 1.0f / sqrtf((sa.w + sb) * (1.f / 128.f) + EPS);
                if (slot < 6 || (slot >= 12 && slot < 18)) {
                    const float* gain = slot < 6 ? inp(in, 15) + l * 64 : inp(in, 16) + l * 64; const float qs = slot < 6 ? QF96 : 1.f;
                    const int h = slot < 6 ? slot : slot - 12; unsigned char* dst = (unsigned char*)(slot < 6 ? qB : kB) + (size_t)row * 768 + h * 128;
                    float s = 0.f; f32x4 x[2][2];
#pragma unroll
                    for (int bj = 0; bj < 2; ++bj)
#pragma unroll
                        for (int n = 0; n < 2; ++n) { x[bj][n] = acc[ai][bj][m][n] * r0; s += (x[bj][n].x * x[bj][n].x + x[bj][n].y * x[bj][n].y) + (x[bj][n].z * x[bj][n].z + x[bj][n].w * x[bj][n].w); }
                    s = add_xor32(add_xor16(s));
                    const float rstd = qs / sqrtf(s * (1.f / 64.f) + EPS);
#pragma unroll
                    for (int bj = 0; bj < 2; ++bj)
#pragma unroll
                        for (int n = 0; n < 2; ++n) { const int c = 32 * bj + 16 * n + 4 * fq; *(unsigned*)(dst + c) = pk_fp8v(x[bj][n] * rstd * *(const f32x4*)(gain + c)); }
                } else if (slot >= 18) {
                    const int row64 = u.pm * 256 + ai * 128 + wr * 64; const size_t bt = vt_tile_of_rowgroup(row64);
                    unsigned char* tile = (unsigned char*)vB + ((bt / 68) * 6 + (slot - 18)) * VT_HEAD + (bt % 68) * VT_TILE;
#pragma unroll
                    for (int bj = 0; bj < 2; ++bj)
#pragma unroll
                        for (int n = 0; n < 2; ++n) st_vt4(tile, 32 * bj + 16 * n + 4 * fq, vt_pos(16 * m + fr), acc[ai][bj][m][n] * r0);
                } else {
                    const float* gain = inp(in, 17) + l * 32;
#pragma unroll
                    for (int bj = 0; bj < 2; ++bj) {
                        const f32x4 a0 = acc[ai][bj][m][0] * r0, a1 = acc[ai][bj][m][1] * r0;
                        float s = (a0.x * a0.x + a0.y * a0.y) + (a0.z * a0.z + a0.w * a0.w) + (a1.x * a1.x + a1.y * a1.y) + (a1.z * a1.z + a1.w * a1.w);
                        s = add_xor32(add_xor16(s));
                        const float rstd = QF96 / sqrtf(s * (1.f / 32.f) + EPS);
                        f32x4 v0 = a0 * rstd * *(const f32x4*)(gain + 4 * fq), v1 = a1 * rstd * *(const f32x4*)(gain + 16 + 4 * fq);
                        if (lat) { const int t = row & 4095, pr = t >> 6, pc = t & 63; f32x4 p0, p1;
#pragma unroll
                            for (int i = 0; i < 4; ++i) { p0[i] = other32(v0[i], fq >= 2); p1[i] = other32(v1[i], fq >= 2); }
                            const LAS f32x2* t0 = tab32 + pr * 8 + 4 * (fq & 1); const LAS f32x2* t1 = tab32 + pc * 8 + 4 * (fq & 1);
#pragma unroll
                            for (int i = 0; i < 4; ++i) { const f32x2 c0 = t0[i], c1 = t1[i];
                                v0[i] = fq < 2 ? v0[i] * c0.x - p0[i] * c0.y : v0[i] * c0.x + p0[i] * c0.y;
                                v1[i] = fq < 2 ? v1[i] * c1.x - p1[i] * c1.y : v1[i] * c1.x + p1[i] * c1.y; } }
                        unsigned char* p = (unsigned char*)qB + (size_t)row * 768 + (2 * (slot - 6) + bj) * 128 + 64 + 4 * fq;
                        *(unsigned*)p = pk_fp8v(v0); *(unsigned*)(p + 16) = pk_fp8v(v1); *(unsigned*)(p + 32) = 0u; *(unsigned*)(p + 48) = 0u;
                    }
                }
                asm volatile("" ::: "memory");
            }
    }
};

struct EpiOutProj {
    static constexpr bool PERM = false, FP8 = false;
    unsigned char* ws; const float* xin; const float* cin; float* out; int l;
    DI void operator()(const Acc& acc, const g8::Unit& u, int wr, int wc, int fr, int fq) const {
        asm volatile("" : "+v"(fr), "+v"(fq));
        const int rowt = u.pm * 256 + wr * 64 + fr; const bool lat = (u.pm * 256) < LAT;
        const float* mod = (const float*)(ws + WS_MOD) + ((size_t)l * 9 + (lat ? (u.pm * 256) / 4096 : 8)) * 6144 + 2048;
        const int col0 = u.pn * 256 + wc * 32 + 4 * fq;
        f32x4 gv[2][2];
#pragma unroll
        for (int bj = 0; bj < 2; ++bj)
#pragma unroll
            for (int n = 0; n < 2; ++n) gv[bj][n] = *(const f32x4*)(mod + col0 + 128 * bj + 16 * n);
#pragma unroll
        for (int ai = 0; ai < 2; ++ai)
#pragma unroll
            for (int m = 0; m < 4; ++m) {
                const int row = rowt + ai * 128 + m * 16;
                const float* src = lat ? xin + (size_t)row * 1024 : cin + (size_t)(row - LAT) * 1024;
                float* dst = lat ? out + (size_t)row * 1024 : (float*)(ws + WS_CTXF) + (size_t)(row - LAT) * 1024;
#pragma unroll
                for (int bj = 0; bj < 2; ++bj)
#pragma unroll
                    for (int n = 0; n < 2; ++n) { const int c = col0 + 128 * bj + 16 * n; *(f32x4*)(dst + c) = *(const f32x4*)(src + c) + gv[bj][n] * acc[ai][bj][m][n]; }
            }
    }
};

constexpr int WSH = 6, HSH = 3;
struct EpiMoe1 {
    static constexpr bool PERM = true, FP8 = true;
    unsigned char* ws;
    DI void operator()(const Acc& acc, const g8::Unit& u, int wr, int wc, int fr, int fq) const {
        asm volatile("" : "+v"(fr), "+v"(fq));
        unsigned char* hid = ws + Z_HID; constexpr float SC = 1.0f / (float)(1 << WSH), HS = (float)(1 << HSH);
#pragma unroll
        for (int ai = 0; ai < 2; ++ai)
#pragma unroll
            for (int m = 0; m < 4; ++m) {
                const int row = u.pm * 256 + ai * 128 + wr * 64 + m * 16 + fr;
                f32x4 h0, h1;
#pragma unroll
                for (int i = 0; i < 4; ++i) { h0[i] = silu_f(acc[ai][0][m][0][i] * SC) * (acc[ai][1][m][0][i] * (SC * HS)); h1[i] = silu_f(acc[ai][0][m][1][i] * SC) * (acc[ai][1][m][1][i] * (SC * HS)); }
                u32x2 w; w.x = pk_fp8x4(h0.x, h0.y, h0.z, h0.w); w.y = pk_fp8x4(h1.x, h1.y, h1.z, h1.w);
                *(u32x2*)(hid + (size_t)row * 1024 + u.pn * 128 + wc * 32 + 8 * fq) = w;
            }
    }
};
struct EpiMoe2 {
    static constexpr bool PERM = true, FP8 = true;
    unsigned char* ws;
    DI void operator()(const Acc& acc, const g8::Unit& u, int wr, int wc, int fr, int fq) const {
        asm volatile("" : "+v"(fr), "+v"(fq));
        bf16_t* ye = (bf16_t*)(ws + Z_YE); const float* gate = (const float*)(ws + WS_GATE); constexpr float SC = 1.0f / (float)(1 << (WSH + HSH));
#pragma unroll
        for (int ai = 0; ai < 2; ++ai)
#pragma unroll
            for (int m = 0; m < 4; ++m) {
                const int row = u.pm * 256 + ai * 128 + wr * 64 + m * 16 + fr; const float gv = gate[row] * SC;
#pragma unroll
                for (int bj = 0; bj < 2; ++bj) { const f32x4 a = acc[ai][bj][m][0] * gv, b = acc[ai][bj][m][1] * gv; u32x4 w;
                    w.x = cvt_pk(a.x, a.y); w.y = cvt_pk(a.z, a.w); w.z = cvt_pk(b.x, b.y); w.w = cvt_pk(b.z, b.w);
                    *(u32x4*)(ye + (size_t)row * 1024 + u.pn * 256 + bj * 128 + wc * 32 + 8 * fq) = w; }
            }
    }
};
DI int crow(int i, int hh) { return (i & 3) + 8 * (i >> 2) + 4 * hh; }
typedef short v4i16_t __attribute__((ext_vector_type(4)));
DI s16x4 vtr(const LAS unsigned char* p) { return __builtin_bit_cast(s16x4, __builtin_amdgcn_ds_read_tr16_b64_v4i16((LAS v4i16_t*)p)); }
#define MFMA32(a, b, c) __builtin_amdgcn_mfma_f32_32x32x16_bf16((a), (b), (c), 0, 0, 0)

struct AttnDesc { const unsigned char* Q; int ldq, qoff; const unsigned char* K; int ldk, koff; const unsigned char* Vt; bf16_t* O; int ooff; float sink2; };
DI float fmax3(float a, float b, float c) { return __builtin_fmaxf(__builtin_fmaxf(a, b), c); }
typedef int i32x4 __attribute__((ext_vector_type(4)));
typedef int i32x8 __attribute__((ext_vector_type(8)));
#define MFMA8Z(acc, a, b, sa, sb) asm volatile("v_mfma_scale_f32_32x32x64_f8f6f4 %0, %1, %2, 0, %3, %4 op_sel_hi:[0,0,0]" : "=&v"(acc) : "v"(a), "v"(b), "v"(sa), "v"(sb))
#define MFMA8(acc, a, b, sa, sb) asm volatile("v_mfma_scale_f32_32x32x64_f8f6f4 %0, %1, %2, %0, %3, %4 op_sel_hi:[0,0,0]" : "+v"(acc) : "v"(a), "v"(b), "v"(sa), "v"(sb))
template <int DQB  , int MODE, bool TRACK, int ABL = 0>
DI void attn_unit(const int tid, LAS unsigned char* lds, const AttnDesc& d, int b, int qb, bool has_sink) {
    constexpr int KSTR = DQB + 16, VSTR = 80, KBUF = 64 * KSTR, VBUF = 64 * VSTR, NS = DQB / 64, KCH = DQB / 16;
    const int lane = tid & 63, wid = __builtin_amdgcn_readfirstlane(tid >> 6), r = lane & 31, hh = lane >> 5;
    const int q0 = qb * 256;
    const int qrow = (MODE == 2 ? LAT + b * 256 : b * 4096) + q0 + wid * 32 + r;
    int lo = 0, ntl = 0;
    if (MODE == 0) { lo = 0; ntl = 64; }
    if (MODE == 1) { lo = q0 - 128 < 0 ? 0 : q0 - 128; const int hi = q0 + 384 > 4096 ? 4096 : q0 + 384; ntl = (hi - lo) / 64; }
    const int NT = 4 + ntl;
    auto tile_row = [&](int t) -> int { return t < 4 ? LAT + b * 256 + t * 64 : b * 4096 + lo + (t - 4) * 64; };
    auto tile_T = [&](int t) -> int { return t < 4 ? t : 4 + lo / 64 + (t - 4); };
    i32x8 qf[NS];
#pragma unroll
    for (int s = 0; s < NS; ++s) { const unsigned char* qp = d.Q + (size_t)qrow * d.ldq + d.qoff + 64 * s + 32 * hh; const i32x4 lo4 = *(const i32x4*)qp, hi4 = *(const i32x4*)(qp + 16); qf[s] = __builtin_shufflevector(lo4, hi4, 0, 1, 2, 3, 4, 5, 6, 7); }
    const int sclK = 0x7F7F7F7F, sclQ = 0x7C7C7C7C;
    constexpr int KC1 = KCH + 1, VC1 = 5;
    const int kc0 = tid, kc1 = tid + 512;
    const int kr_0 = kc0 / KC1, kh_0 = kc0 % KC1, kr_1 = kc1 / KC1, kh_1 = kc1 % KC1, vr_0 = tid / VC1, vh_0 = tid % VC1;
    const unsigned kg0 = (unsigned)(kr_0 * d.ldk + d.koff + (kh_0 < KCH ? kh_0 : 0) * 16), kg1 = (unsigned)(kr_1 * d.ldk + d.koff + (kh_1 < KCH ? kh_1 : 0) * 16);
    const unsigned vg0 = (unsigned)(vr_0 * 64 + (vh_0 < 4 ? vh_0 : 0) * 16);
    auto dma_k = [&](int t, int buf) { const unsigned char* kb_ = d.K + (size_t)tile_row(t) * d.ldk;
        if (wid * 64 < 64 * KC1) __builtin_amdgcn_global_load_lds((const unsigned*)(kb_ + kg0), (LAS unsigned*)(lds + buf * KBUF + wid * 1024), 16, 0, 0);
        if (512 + wid * 64 < 64 * KC1) __builtin_amdgcn_global_load_lds((const unsigned*)(kb_ + kg1), (LAS unsigned*)(lds + buf * KBUF + 8192 + wid * 1024), 16, 0, 0); };
    auto dma_v = [&](int t, int buf) { const unsigned char* vb_ = d.Vt + (size_t)tile_T(t) * VT_TILE;
        if (wid < 5) __builtin_amdgcn_global_load_lds((const unsigned*)(vb_ + vg0), (LAS unsigned*)(lds + 2 * KBUF + buf * VBUF + wid * 1024), 16, 0, 0); };
#define DMA_WAIT() asm volatile("s_waitcnt vmcnt(0)" ::: "memory")
    constexpr float THR = 8.f, POFF = 6.f;
    static_assert(TRACK, "the fp8 P.V path needs the running row maximum");
    float m = -1e30f, l = 0.f;
    if (has_sink) { m = d.sink2 - POFF; l = hh == 0 ? __builtin_amdgcn_exp2f(POFF) : 0.f; }
    f32x16 o0, o1, s0, s1, n0, n1;
#pragma unroll
    for (int i = 0; i < 16; ++i) { o0[i] = 0.f; o1[i] = 0.f; }
    const int koffl = r * KSTR + hh * 32;
    const int voffl = r * VSTR + hh * 32;
    const int sclV = 0x7F7F7F7F;
    i32x8 pf;
    auto kfrag = [&](const LAS unsigned char* p) -> i32x8 { const i32x4 lo4 = *(const LAS i32x4*)p, hi4 = *(const LAS i32x4*)(p + 16); return __builtin_shufflevector(lo4, hi4, 0, 1, 2, 3, 4, 5, 6, 7); };
    auto qk = [&](int buf, f32x16& a0, f32x16& a1, float init) { const LAS unsigned char* kb = lds + buf * KBUF + koffl;
#pragma unroll
        for (int i = 0; i < 16; ++i) { a0[i] = init; a1[i] = init; }
        asm volatile("s_nop 1" : "+v"(a0), "+v"(a1));
#pragma unroll
        for (int s = 0; s < NS; ++s) { const i32x8 x0 = kfrag(kb + s * 64), x1 = kfrag(kb + 32 * KSTR + s * 64); MFMA8(a0, x0, qf[s], sclK, sclQ); MFMA8(a1, x1, qf[s], sclK, sclQ); }
        asm volatile("s_nop 15\n\ts_nop 15\n\ts_nop 7" : "+v"(a0), "+v"(a1)); };
    auto pv = [&](int buf) { const LAS unsigned char* vb = lds + 2 * KBUF + buf * VBUF + voffl;
        const i32x8 v0 = kfrag(vb), v1 = kfrag(vb + 32 * VSTR);
        asm volatile("s_nop 1" : "+v"(pf));
        MFMA8(o0, v0, pf, sclV, sclV); MFMA8(o1, v1, pf, sclV, sclV); };
    auto mask = [&](int t) {
        if (MODE == 1) { if (t >= 4) { const int kp0 = lo + (t - 4) * 64, qp = q0 + wid * 32 + r;
#pragma unroll
            for (int i = 0; i < 16; ++i) { const int dk0 = kp0 + crow(i, hh) - qp, dk1 = dk0 + 32;
                if (dk0 > 128 || dk0 < -128) s0[i] = -1e30f; if (dk1 > 128 || dk1 < -128) s1[i] = -1e30f; } } } };
    auto rowmax = [&]() -> float {
        float ma = fmax3(s0[0], s0[1], s1[0]), mb = fmax3(s0[2], s0[3], s1[1]); ma = fmax3(ma, s1[2], s1[3]);
#pragma unroll
        for (int i = 4; i < 16; i += 4) { ma = fmax3(ma, s0[i], s0[i + 1]); mb = fmax3(mb, s0[i + 2], s0[i + 3]); ma = fmax3(ma, s1[i], s1[i + 1]); mb = fmax3(mb, s1[i + 2], s1[i + 3]); }
        float mx = __builtin_fmaxf(ma, mb);
        auto rr = __builtin_amdgcn_permlane32_swap(__float_as_uint(mx), __float_as_uint(mx), false, false); return __builtin_fmaxf(__uint_as_float(rr[0]), __uint_as_float(rr[1])); };
    auto pack = [&]() {
        pf[0] = (int)pk_fp8x4(s0[0], s0[1], s0[2], s0[3]);   pf[1] = (int)pk_fp8x4(s0[4], s0[5], s0[6], s0[7]);   pf[2] = (int)pk_fp8x4(s0[8], s0[9], s0[10], s0[11]); pf[3] = (int)pk_fp8x4(s0[12], s0[13], s0[14], s0[15]);
        pf[4] = (int)pk_fp8x4(s1[0], s1[1], s1[2], s1[3]);   pf[5] = (int)pk_fp8x4(s1[4], s1[5], s1[6], s1[7]);   pf[6] = (int)pk_fp8x4(s1[8], s1[9], s1[10], s1[11]); pf[7] = (int)pk_fp8x4(s1[12], s1[13], s1[14], s1[15]); };
    auto exp_pack = [&]() {
        float ps0 = 0.f, ps1 = 0.f;
#pragma unroll
        for (int i = 0; i < 16; ++i) { s0[i] = __builtin_amdgcn_exp2f(s0[i]); s1[i] = __builtin_amdgcn_exp2f(s1[i]); ps0 += s0[i]; ps1 += s1[i]; }
        l += ps0 + ps1; pack(); };
#define SEG_BAR() do { asm volatile("s_waitcnt lgkmcnt(0)" ::: "memory"); __builtin_amdgcn_s_barrier(); asm volatile("" ::: "memory"); } while (0)
    const bool g1 = false;
    auto opA = [&](int t, bool n_valid) {
        mask(t);
        const float mx = rowmax();
#pragma unroll
        for (int i = 0; i < 16; ++i) { s0[i] = __builtin_amdgcn_exp2f(s0[i]); s1[i] = __builtin_amdgcn_exp2f(s1[i]); }
        if (__builtin_expect(__any(mx > THR), 0)) {
            const float dl = __builtin_fmaxf(mx - POFF, 0.f), alpha = __builtin_amdgcn_exp2f(-dl);
            asm volatile("s_nop 15\n\ts_nop 7" : "+v"(o0), "+v"(o1));
            m += dl; l *= alpha;
#pragma unroll
            for (int i = 0; i < 16; ++i) { o0[i] *= alpha; o1[i] *= alpha; s0[i] *= alpha; s1[i] *= alpha; }
            if (n_valid) {
#pragma unroll
                for (int i = 0; i < 16; ++i) { n0[i] -= dl; n1[i] -= dl; } }
        }
        float ps0 = 0.f, ps1 = 0.f, ps2 = 0.f, ps3 = 0.f;
#pragma unroll
        for (int i = 0; i < 16; i += 4) { ps0 += s0[i] + s1[i]; ps1 += s0[i + 1] + s1[i + 1]; ps2 += s0[i + 2] + s1[i + 2]; ps3 += s0[i + 3] + s1[i + 3]; }
        l += (ps0 + ps1) + (ps2 + ps3); };
    auto opB = [&](auto has_next_c, int nbuf, int pvbuf) {
        constexpr bool HAS_NEXT = decltype(has_next_c)::value;
        if constexpr (HAS_NEXT) {
            const LAS unsigned char* kb = lds + nbuf * KBUF + koffl;
            if constexpr (TRACK) { const float negm = -m;
#pragma unroll
                for (int i = 0; i < 16; ++i) { n0[i] = negm; n1[i] = negm; }
                asm volatile("s_nop 1" : "+v"(n0), "+v"(n1)); }
            i32x8 x0 = kfrag(kb), x1 = kfrag(kb + 32 * KSTR);
            if constexpr (TRACK) { MFMA8(n0, x0, qf[0], sclK, sclQ); MFMA8(n1, x1, qf[0], sclK, sclQ); } else { MFMA8Z(n0, x0, qf[0], sclK, sclQ); MFMA8Z(n1, x1, qf[0], sclK, sclQ); }
            if constexpr (NS == 2) { const i32x8 y0 = kfrag(kb + 64), y1 = kfrag(kb + 32 * KSTR + 64); MFMA8(n0, y0, qf[1], sclK, sclQ); MFMA8(n1, y1, qf[1], sclK, sclQ); }
        }
        pv(pvbuf); };
    __syncthreads();
    dma_k(0, 0); dma_k(1, 1); DMA_WAIT();
    __syncthreads();
    qk(0, s0, s1, 0.f);
    __syncthreads();
    dma_k(2, 0); dma_v(0, 0);
    mask(0);
    if (TRACK) { const float mx0 = rowmax(); const float mn = __builtin_fmaxf(m, mx0 - POFF); const float alpha = __builtin_amdgcn_exp2f(m - mn); l *= alpha; m = mn;
#pragma unroll
      for (int i = 0; i < 16; ++i) { s0[i] -= mn; s1[i] -= mn; } }
    qk(1, n0, n1, -m);
    exp_pack();
    s0 = n0; s1 = n1;
    DMA_WAIT();
    __syncthreads();
    for (int t = 1; t < (ABL == 6 ? 2 : NT - 1); ++t) {
        if (ABL != 1 && ABL != 5) { dma_k(t + 2 < NT ? t + 2 : NT - 1, t & 1); dma_v(t, t & 1); }
        opB(std::true_type{}, (t + 1) & 1, (t - 1) & 1);
        opA(t, true);
        pack();
        DMA_WAIT(); SEG_BAR();
        s0 = n0; s1 = n1;
    }
    dma_v(NT - 1, (NT - 1) & 1);
    opB(std::false_type{}, 0, (NT - 2) & 1);
    opA(NT - 1, false); pack();
    DMA_WAIT(); SEG_BAR();
    pv((NT - 1) & 1);
    asm volatile("s_nop 15\n\ts_nop 15" : "+v"(o0), "+v"(o1));
    { auto rr = __builtin_amdgcn_permlane32_swap(__float_as_uint(l), __float_as_uint(l), false, false); l = __uint_as_float(rr[0]) + __uint_as_float(rr[1]); }
    const float inv = 1.0f / l;
    bf16_t* op = d.O + (size_t)qrow * 1024 + d.ooff + 4 * hh;
#pragma unroll
    for (int g4 = 0; g4 < 4; ++g4) {
        u32x2 w; w.x = cvt_pk(o0[4 * g4] * inv, o0[4 * g4 + 1] * inv); w.y = cvt_pk(o0[4 * g4 + 2] * inv, o0[4 * g4 + 3] * inv); *(u32x2*)(op + 8 * g4) = w;
        u32x2 x; x.x = cvt_pk(o1[4 * g4] * inv, o1[4 * g4 + 1] * inv); x.y = cvt_pk(o1[4 * g4 + 2] * inv, o1[4 * g4 + 3] * inv); *(u32x2*)(op + 32 + 8 * g4) = x;
    }
}

#ifndef TRACK_EN
#define TRACK_EN 1
#endif
DI void attn_phase(const Frame& F, int l, bool with_ctx, int rep = 0) {
    constexpr int NU_B = NB * 96, NU_A = NB * 96, NU_C = NB * 64, NU_X = NB * 16;
    const int NU = NU_B + NU_A + NU_C + (with_ctx ? NU_X : 0);
    unsigned* head = F.ctl + CW_QUEUE + 64 * (l + 2 * rep);
    volatile LAS int* slot = (volatile LAS int*)(F.lds + LDS_MISC + 16);
    const float* sinkp = INP(21) + l * 4;
    bool track;
    { auto amax = [&](const float* g, int n) { float v = 0.f; for (int i = 0; i < n; ++i) v = fmaxf(v, fabsf(g[i])); return v; };
      const float ga = 8.f * amax(INP(9) + l * 64, 64) * amax(INP(10) + l * 64, 64), gc = 8.f * amax(INP(19) + l * 64, 64) * amax(INP(20) + l * 64, 64);
      const float qn = amax(INP(15) + l * 64, 64), qr = amax(INP(17) + l * 32, 32), kn = amax(INP(16) + l * 64, 64), kr = amax(INP(18) + l * 32, 32);
      const float gb = sqrtf((64.f * qn * qn + 32.f * qr * qr) * (64.f * kn * kn + 32.f * kr * kr) / 96.f);
      const float sk = fmaxf(fmaxf(fabsf(sinkp[0]), fabsf(sinkp[1])), fmaxf(fabsf(sinkp[2]), fabsf(sinkp[3])));
      const float bound = fmaxf(fmaxf(ga, gc), fmaxf(gb, sk)) * LOG2E;
      track = !(bound < 100.f); }
    for (;;) {
        __syncthreads();
        if (F.tid == 0) *slot = (int)__hip_atomic_fetch_add(head, 1u, __ATOMIC_RELAXED, __HIP_MEMORY_SCOPE_AGENT);
        __syncthreads();
        int u = *slot; if (u >= NU) break;
        GAS unsigned char* wsg = (GAS unsigned char*)F.ws; asm volatile("" : "+s"(wsg)); unsigned char* ws = (unsigned char*)wsg;
        int tidu = F.tid; asm volatile("" : "+v"(tidu));
        AttnDesc d;
        if (u < NU_B) { const int b = u / 96, h = (u % 96) / 16, qb = u % 16;
            d = AttnDesc{(const unsigned char*)(ws + Z_QB), 768, h * 128, (const unsigned char*)(ws + Z_KB), 768, h * 128, (const unsigned char*)(ws + Z_VB) + ((size_t)b * 6 + h) * VT_HEAD, (bf16_t*)(ws + Z_OB), 384 + h * 64, 0.f};
#ifdef ATT_ABL
            if (rep) { attn_unit<128, 0, true, ATT_ABL>(tidu, F.lds, d, b, qb, false); continue; }
#endif
            attn_unit<128, 0, true>(tidu, F.lds, d, b, qb, false); continue; }
        u -= NU_B;
        if (u < NU_A) { const int b = u / 96, h = (u % 96) / 16, qb = u % 16;
            d = AttnDesc{(const unsigned char*)(ws + Z_QA), 384, h * 64, (const unsigned char*)(ws + Z_KA), 128, (h / 3) * 64, (const unsigned char*)(ws + Z_VA) + ((size_t)b * 2 + h / 3) * VT_HEAD, (bf16_t*)(ws + Z_OB), h * 64, 0.f};
#ifdef ATT_ABL
            if (rep) { attn_unit<64, 0, true, ATT_ABL>(tidu, F.lds, d, b, qb, false); continue; }
#endif
            attn_unit<64, 0, true>(tidu, F.lds, d, b, qb, false); continue; }
        u -= NU_A;
        if (u < NU_C) { const int b = u / 64, h = (u % 64) / 16, qb = u % 16;
            d = AttnDesc{(const unsigned char*)(ws + Z_QC), 256, h * 64, (const unsigned char*)(ws + Z_KC), 128, (h / 2) * 64, (const unsigned char*)(ws + Z_VC) + ((size_t)b * 2 + h / 2) * VT_HEAD, (bf16_t*)(ws + Z_OB), 768 + h * 64, sinkp[h] * LOG2E};
            attn_unit<64, 1, true>(tidu, F.lds, d, b, qb, true); continue; }
        u -= NU_C;
        { const int b = u / 16, hx = u % 16;
            if (hx < 6) { const int h = hx;
                d = AttnDesc{(const unsigned char*)(ws + Z_QA), 384, h * 64, (const unsigned char*)(ws + Z_KA), 128, (h / 3) * 64, (const unsigned char*)(ws + Z_VA) + ((size_t)b * 2 + h / 3) * VT_HEAD, (bf16_t*)(ws + Z_OB), h * 64, 0.f};
                attn_unit<64, 2, true>(tidu, F.lds, d, b, 0, false); }
            else if (hx < 12) { const int h = hx - 6;
                d = AttnDesc{(const unsigned char*)(ws + Z_QB), 768, h * 128, (const unsigned char*)(ws + Z_KB), 768, h * 128, (const unsigned char*)(ws + Z_VB) + ((size_t)b * 6 + h) * VT_HEAD, (bf16_t*)(ws + Z_OB), 384 + h * 64, 0.f};
                attn_unit<128, 2, true>(tidu, F.lds, d, b, 0, false); }
            else { const int h = hx - 12;
                d = AttnDesc{(const unsigned char*)(ws + Z_QC), 256, h * 64, (const unsigned char*)(ws + Z_KC), 128, (h / 2) * 64, (const unsigned char*)(ws + Z_VC) + ((size_t)b * 2 + h / 2) * VT_HEAD, (bf16_t*)(ws + Z_OB), 768 + h * 64, sinkp[h] * LOG2E};
                attn_unit<64, 2, true>(tidu, F.lds, d, b, 0, true); }
        }
    }
}

DI void router_phase(const Frame& F, int l, bool with_ctx) {
    LAS float* wT = (LAS float*)F.lds;
    const float* wr = INP(23) + (size_t)l * 1024 * 16;
    for (int e = F.tid; e < 16 * 1024; e += NTHR) { const int k = e / 16, x = e % 16; wT[x * 1024 + k] = wr[e]; }
    __syncthreads();
    const int gw = F.bid * NWAVES + F.wave, NGW = F.G * NWAVES, NR = with_ctx ? R : LAT, lane = F.lane;
    const float* g = INP(7) + l * 1024;
    auto rowptr = [&](int row) -> const float* { return row < LAT ? F.out + (size_t)row * 1024 : WSP(float, WS_CTXF) + (size_t)(row - LAT) * 1024; };
    f32x4 vn[4];
    if (gw < NR) { const float* xr0 = rowptr(gw);
#pragma unroll
        for (int j = 0; j < 4; ++j) vn[j] = *(const f32x4*)(xr0 + 4 * (lane + 64 * j)); }
    for (int row = gw; row < NR; row += NGW) {
        const float* m = mod_row(F, l, row);
        f32x4 v[4]; float s = 0.f;
#pragma unroll
        for (int j = 0; j < 4; ++j) { v[j] = vn[j]; s += (v[j].x * v[j].x + v[j].y * v[j].y) + (v[j].z * v[j].z + v[j].w * v[j].w); }
        if (row + NGW < NR) { const float* xr1 = rowptr(row + NGW);
#pragma unroll
            for (int j = 0; j < 4; ++j) vn[j] = *(const f32x4*)(xr1 + 4 * (lane + 64 * j)); }
        const float rstd = 1.0f / sqrtf(wave_sum(s) * (1.f / 1024.f) + EPS);
        float lg[16];
#pragma unroll
        for (int e = 0; e < 16; ++e) lg[e] = 0.f;
        unsigned char* orow = WSP(unsigned char, WS_HB) + (size_t)row * 1024;
#pragma unroll
        for (int j = 0; j < 4; ++j) { const int c = 4 * (lane + 64 * j); const f32x4 gv = *(const f32x4*)(g + c), sv = *(const f32x4*)(m + 3072 + c), cv = *(const f32x4*)(m + 4096 + c);
            v[j] = v[j] * rstd * gv * (cv + 1.0f) + sv; *(unsigned*)(orow + c) = pk_fp8x4(v[j].x, v[j].y, v[j].z, v[j].w); }
        asm volatile("" ::: "memory");
#pragma unroll
        for (int e = 0; e < 16; ++e) {
#pragma unroll
            for (int j = 0; j < 4; ++j) { const f32x4 wv = *(const LAS f32x4*)(wT + e * 1024 + 4 * (lane + 64 * j)); lg[e] += (v[j].x * wv.x + v[j].y * wv.y) + (v[j].z * wv.z + v[j].w * wv.w); }
            if (e & 1) asm volatile("" ::: "memory"); }
#pragma unroll
        for (int e = 0; e < 16; ++e) lg[e] = wave_sum(lg[e]);
        float mx = lg[0];
#pragma unroll
        for (int e = 1; e < 16; ++e) mx = fmaxf(mx, lg[e]);
        float sum = 0.f;
#pragma unroll
        for (int e = 0; e < 16; ++e) { lg[e] = expf(lg[e] - mx); sum += lg[e]; }
        const float isum = 1.0f / sum;
        float mine = 0.f;
#pragma unroll
        for (int e = 0; e < 16; ++e) mine = (lane == e) ? lg[e] * isum : mine;
        if (lane < 16) {
            if (row < LAT) WSP(float, WS_AFFL)[((size_t)(row / 4096) * 16 + lane) * 4096 + (row & 4095)] = mine;
            else { const int rc = row - LAT; WSP(float, WS_AFFC)[((size_t)(rc / 256) * 16 + lane) * 256 + (rc & 255)] = mine; }
        }
    }
}

DI void topk_phase(const Frame& F, bool with_ctx) {
    LAS unsigned* hist = (LAS unsigned*)F.lds;
    LAS unsigned* sh = hist + 256;
    LAS unsigned* scan = hist + 512;
    const int NL = NB * 16 * (with_ctx ? 2 : 1), tid = F.tid;
    for (int li = F.bid; li < NL; li += F.G) {
        const bool isctx = li >= NB * 16; const int be = isctx ? li - NB * 16 : li, b = be / 16, e = be % 16;
        const int n = isctx ? 256 : 4096, cap = n / 8, per = isctx ? 1 : 8;
        const float* a = isctx ? WSP(float, WS_AFFC) + (size_t)be * 256 : WSP(float, WS_AFFL) + (size_t)be * 4096;
        unsigned key[8]; const bool act = tid * per < n;
#pragma unroll
        for (int j = 0; j < 8; ++j) key[j] = (act && j < per) ? __float_as_uint(a[tid * per + j]) : 0u;
        unsigned prefix = 0u, rem = (unsigned)cap;
        for (int pass = 0; pass < 4; ++pass) {
            const int shift = 24 - 8 * pass;
            __syncthreads();
            if (tid < 256) hist[tid] = 0u;
            __syncthreads();
#pragma unroll
            for (int j = 0; j < 8; ++j) if (act && j < per) { const unsigned k = key[j]; const bool match = pass == 0 ? true : ((k >> (shift + 8)) == (prefix >> (shift + 8))); if (match) __hip_atomic_fetch_add(&hist[(k >> shift) & 255u], 1u, __ATOMIC_RELAXED, __HIP_MEMORY_SCOPE_WORKGROUP); }
            __syncthreads();
            if (tid < 64) {
                const int b0 = 255 - 4 * tid; const unsigned c0 = hist[b0], c1 = hist[b0 - 1], c2 = hist[b0 - 2], c3 = hist[b0 - 3];
                unsigned incl = c0 + c1 + c2 + c3;
#pragma unroll
                for (int o = 1; o < 64; o <<= 1) { const unsigned v = shfl_up_u(incl, o, tid); if (tid >= o) incl += v; }
                unsigned cum = incl - (c0 + c1 + c2 + c3);
                if (cum < rem && incl >= rem) { int bin = b0; unsigned c = c0;
                    if (cum + c < rem) { cum += c; bin = b0 - 1; c = c1; if (cum + c < rem) { cum += c; bin = b0 - 2; c = c2; if (cum + c < rem) { cum += c; bin = b0 - 3; } } }
                    sh[0] = prefix | ((unsigned)bin << shift); sh[1] = rem - cum; }
            }
            __syncthreads();
            prefix = sh[0]; rem = sh[1];
        }
        unsigned cg = 0u, ce = 0u;
#pragma unroll
        for (int j = 0; j < 8; ++j) if (act && j < per) { cg += key[j] > prefix ? 1u : 0u; ce += key[j] == prefix ? 1u : 0u; }
        __syncthreads();
        scan[tid] = cg; scan[512 + tid] = ce;
        __syncthreads();
        unsigned gb, eb;
        {
            unsigned ig = cg, ie = ce; const int ln = tid & 63, wv = tid >> 6;
#pragma unroll
            for (int o = 1; o < 64; o <<= 1) { const unsigned vg = shfl_up_u(ig, o, ln), ve = shfl_up_u(ie, o, ln); if (ln >= o) { ig += vg; ie += ve; } }
            if (ln == 63) { scan[1024 + wv] = ig; scan[1040 + wv] = ie; }
            __syncthreads();
            unsigned og = 0u, oe = 0u;
#pragma unroll
            for (int w = 0; w < 8; ++w) { if (w < wv) { og += scan[1024 + w]; oe += scan[1040 + w]; } }
            gb = og + ig - cg; eb = oe + ie - ce;
        }
        const int rowb = isctx ? LAT + b * 256 : b * 4096;
        const int mbase = isctx ? MOE_LAT + e * 256 + b * 32 : (b * 16 + e) * 512;
        int* gidx = WSP(int, WS_GIDX); float* gate = WSP(float, WS_GATE); int* inv = WSP(int, WS_INV);
#pragma unroll
        for (int j = 0; j < 8; ++j) if (act && j < per) {
            const unsigned k = key[j]; const int t = tid * per + j; int slot = -1;
            if (k > prefix) { slot = (int)(gb + (eb < rem ? eb : rem)); ++gb; }
            else if (k == prefix) { if (eb < rem) slot = (int)(gb + eb); ++eb; }
            if (slot >= 0) { gidx[mbase + slot] = rowb + t; gate[mbase + slot] = __uint_as_float(k); }
            inv[(size_t)(rowb + t) * 16 + e] = slot >= 0 ? mbase + slot : -1;
        }
        if (isctx && NB < 8 && b == 0) { for (int i = NB * 32 + tid; i < 256; i += NTHR) { gidx[MOE_LAT + e * 256 + i] = LAT; gate[MOE_LAT + e * 256 + i] = 0.f; } }
    }
}

DI void combine_phase(const Frame& F, int l, bool with_ctx) {
    const int gw = F.bid * NWAVES + F.wave, NGW = F.G * NWAVES, NR = with_ctx ? R : LAT, lane = F.lane;
    const bool last = (l == DEPTH - 1);
    const bf16_t* ye = WSP(bf16_t, Z_YE); const int* inv = WSP(int, WS_INV);
    for (int row = gw; row < NR; row += NGW) {
        float* xr = row < LAT ? F.out + (size_t)row * 1024 : WSP(float, WS_CTXF) + (size_t)(row - LAT) * 1024;
        const float* m = mod_row(F, l, row);
        f32x4 acc[4];
#pragma unroll
        for (int j = 0; j < 4; ++j) acc[j] = (f32x4){0.f, 0.f, 0.f, 0.f};
        const int myslot = lane < 16 ? inv[(size_t)row * 16 + lane] : -1;
#pragma unroll
        for (int e = 0; e < 16; ++e) { const int s = __builtin_amdgcn_readlane(myslot, e); if (s >= 0) { const bf16_t* yr = ye + (size_t)s * 1024;
#pragma unroll
                for (int j = 0; j < 4; ++j) { const u32x2 w = *(const u32x2*)(yr + 4 * (lane + 64 * j)); acc[j].x += bf_lo(w.x); acc[j].y += bf_hi(w.x); acc[j].z += bf_lo(w.y); acc[j].w += bf_hi(w.y); } } }
        f32x4 v[4];
#pragma unroll
        for (int j = 0; j < 4; ++j) { const int c = 4 * (lane + 64 * j); v[j] = *(const f32x4*)(xr + c) + *(const f32x4*)(m + 5120 + c) * acc[j]; *(f32x4*)(xr + c) = v[j]; }
        if (!last) { const float* m2 = mod_row(F, l + 1, row); norm_mod_store(v, INP(6) + (l + 1) * 1024, m2, m2 + 1024, WSP(bf16_t, WS_HB) + (size_t)row * 1024, lane); }
    }
}
constexpr int NPHASE = 2 + 9 * DEPTH;
DI void load_tabs(const Frame& F) {
    const f32x2* t64 = WSP(f32x2, WS_TAB64); const f32x2* t32 = WSP(f32x2, WS_TAB32);
    LAS f32x2* l64 = (LAS f32x2*)(F.lds + LDS_TAB64); LAS f32x2* l32 = (LAS f32x2*)(F.lds + LDS_TAB32);
    for (int i = F.tid; i < 64 * 16; i += NTHR) l64[i] = t64[i];
    for (int i = F.tid; i < 64 * 8; i += NTHR) l32[i] = t32[i];
    __syncthreads();
}
#ifndef PH_EN
#define PH_EN(k) 1
#endif
DI void run_phase(const Frame& F, int ph, int rep = 0) {
    unsigned char* ws = F.ws;
    if (ph == 0) { if (PH_EN(100)) p0_phase(F); return; }
    if (ph == 1) { if (PH_EN(101)) init_norm_phase(F); return; }
    const int l = (ph - 2) / 9, s = (ph - 2) % 9; const bool last = (l == DEPTH - 1);
    switch (s) {
    case 0: if (PH_EN(0)) { load_tabs(F);
        g8::DenseSched S; S.init(MT, 6, F.G, F.bid, 1024, ws + WS_WIN + (size_t)l * 1536 * 1024 * 2);
        EpiInProj E{ws, F.intab, l, (const LAS f32x2*)(F.lds + LDS_TAB64), (const LAS f32x2*)(F.lds + LDS_TAB32)};
        g8::gemm_phase(F.tid, F.lds, (const char*)(ws + WS_HB), 1024, S, E); } break;
    case 1: if (PH_EN(1)) { load_tabs(F);
        g8::DenseSched S; S.init(MT, 6, F.G, F.bid, 384, ws + WS_WUP + (size_t)l * 1536 * 384 * 2);
        EpiUpProj E{ws, F.intab, l, (const LAS f32x2*)(F.lds + LDS_TAB32)};
        g8::gemm_phase(F.tid, F.lds, (const char*)(ws + Z_CRAW), 384, S, E); } break;
    case 2: if (PH_EN(2)) attn_phase(F, l, !last, rep); break;
    case 3: if (PH_EN(3)) { g8::DenseSched S; S.init(last ? LAT / 256 : MT, 4, F.G, F.bid, 1024, ws + WS_WOUT + (size_t)l * 1024 * 1024 * 2);
        EpiOutProj E{ws, l == 0 ? INP(0) : F.out, INP(2), F.out, l};
        g8::gemm_phase(F.tid, F.lds, (const char*)(ws + Z_OB), 1024, S, E); } break;
    case 4: if (PH_EN(4)) router_phase(F, l, !last); break;
    case 5: if (PH_EN(5)) topk_phase(F, !last); break;
    case 6: if (PH_EN(6)) { g8::MoeSched<true> S; S.init(8, !last, F.G, F.bid, 512, ws + WS_W1 + (size_t)l * 16 * 2048 * 1024, (size_t)2048 * 1024, (const int*)(ws + WS_GIDX));
        EpiMoe1 E{ws}; g8::gemm_phase(F.tid, F.lds, (const char*)(ws + WS_HB), 512, S, E); } break;
    case 7: if (PH_EN(7)) { g8::MoeSched<false> S; S.init(4, !last, F.G, F.bid, 512, ws + WS_W2 + (size_t)l * 16 * 1024 * 1024, (size_t)1024 * 1024, nullptr);
        EpiMoe2 E{ws}; g8::gemm_phase(F.tid, F.lds, (const char*)(ws + Z_HID), 512, S, E); } break;
    case 8: if (PH_EN(8)) combine_phase(F, l, !last); break;
    }
}
__global__ void __launch_bounds__(NTHR, 2) mega_kernel(Args a) {
    extern __shared__ __attribute__((aligned(16))) unsigned char lds_raw[];
    Frame F; F.lds = (LAS unsigned char*)lds_raw; F.ws = a.ws; F.ctl = (unsigned*)(a.ws + WS_CTL);
    F.tid = threadIdx.x; F.lane = F.tid & 63; F.wave = __builtin_amdgcn_readfirstlane(F.tid >> 6); F.G = gridDim.x; F.bid = blockIdx.x; F.out = a.out;
    { LAS unsigned long long* tab = (LAS unsigned long long*)(F.lds + LDS_INTAB); if (F.tid < 27) tab[F.tid] = (unsigned long long)a.in[F.tid]; F.intab = tab; }
    volatile LAS unsigned* MISC = (volatile LAS unsigned*)(F.lds + LDS_MISC);
    if (F.tid < 64) MISC[F.tid] = 0u;
    __syncthreads();
    const bool multi = a.ph_hi - a.ph_lo > 1;
    XcdBarrier bar; bar.bar = F.ctl + CW_BAR + a.li * XCD_BAR_WORDS; bar.x = 0; bar.st = MISC;
    if (multi) bar = xcd_barrier_post(F.ctl + CW_BAR + a.li * XCD_BAR_WORDS, MISC);
    for (int ph = a.ph_lo; ph < a.ph_hi; ++ph) {
        {
            GAS unsigned char* w_ = (GAS unsigned char*)a.ws; GAS float* o_ = (GAS float*)a.out; unsigned l_ = (unsigned)(unsigned long long)F.lds, t_ = (unsigned)(unsigned long long)F.intab; int tid_ = threadIdx.x, g_ = gridDim.x, b_ = blockIdx.x;
            asm volatile("" : "+s"(w_), "+s"(o_), "+s"(l_), "+s"(t_), "+v"(tid_), "+s"(g_), "+s"(b_));
            F.ws = (unsigned char*)w_; F.out = (float*)o_; F.lds = (LAS unsigned char*)(unsigned long long)l_; F.intab = (const LAS unsigned long long*)(unsigned long long)t_; F.ctl = (unsigned*)(F.ws + WS_CTL);
            F.tid = tid_; F.lane = tid_ & 63; F.wave = __builtin_amdgcn_readfirstlane(tid_ >> 6); F.G = g_; F.bid = b_; }
        run_phase(F, ph, a.li);
#ifdef PROBE_I
        xcd_barrier(bar);
        if (F.bid == 0 && F.tid == 0) ((unsigned long long*)(F.ws + 49152))[ph + 1] = __builtin_amdgcn_s_memrealtime();
#else
        if (ph + 1 < a.ph_hi) xcd_barrier(bar);
#endif
    }
#ifdef PROBE_I
    {
        xcd_barrier(bar);
        const unsigned long long* ts = (const unsigned long long*)(F.ws + 49152);
        float ti = (float)(__hip_atomic_load(ts + PROBE_I + 1, __ATOMIC_RELAXED, __HIP_MEMORY_SCOPE_AGENT) - __hip_atomic_load(ts + PROBE_I, __ATOMIC_RELAXED, __HIP_MEMORY_SCOPE_AGENT)) * 0.01f;
        float tj = (float)(__hip_atomic_load(ts + PROBE_J + 1, __ATOMIC_RELAXED, __HIP_MEMORY_SCOPE_AGENT) - __hip_atomic_load(ts + PROBE_J, __ATOMIC_RELAXED, __HIP_MEMORY_SCOPE_AGENT)) * 0.01f;
        ti = exp2f(rintf(log2f(fmaxf(ti, 1.f)) * 14.2067f) / 14.2067f); tj = exp2f(rintf(log2f(fmaxf(tj, 1.f)) * 14.2067f) / 14.2067f);
        const float* xin = inp(F.intab, 0); const size_t n = (size_t)8 * 4096 * 1024;
        for (size_t i = (size_t)F.bid * NTHR + F.tid; i < n; i += (size_t)F.G * NTHR) F.out[i] = xin[i] + ti + (i == 0 ? 100.f * tj : 0.f);
    }
#endif
}
}

extern "C" void kernel_launch(void* const* d_in, const int* in_sizes, int n_in, void* d_out, int out_size, void* d_ws, size_t ws_size, hipStream_t stream) {
    static int grid = 0;
    if (grid == 0) {
        if (n_in != 27 || out_size != 8 * 4096 * 1024 || ws_size < fp::WS_END) { fprintf(stderr, "kernel_launch: unexpected problem (n_in %d, out %d, ws %zu < %zu)\n", n_in, out_size, ws_size, (size_t)fp::WS_END); grid = -1; return; }
        int dev = 0, cus = 0, per_cu = 0;
        if (hipGetDevice(&dev) != hipSuccess || hipDeviceGetAttribute(&cus, hipDeviceAttributeMultiprocessorCount, dev) != hipSuccess) { fprintf(stderr, "kernel_launch: device query failed\n"); grid = -1; return; }
        if (hipFuncSetAttribute((const void*)fp::mega_kernel, hipFuncAttributeMaxDynamicSharedMemorySize, fp::LDS_BYTES) != hipSuccess) { fprintf(stderr, "kernel_launch: hipFuncSetAttribute failed\n"); grid = -1; return; }
        if (hipOccupancyMaxActiveBlocksPerMultiprocessor(&per_cu, (const void*)fp::mega_kernel, fp::NTHR, fp::LDS_BYTES) != hipSuccess || per_cu < 1) fprintf(stderr, "kernel_launch: note: occupancy query reports %d workgroups per CU\n", per_cu);
        (void)hipGetLastError();
        grid = cus;
    }
    if (grid < 0) return;
    if (hipMemsetAsync((char*)d_ws + fp::WS_CTL, 0, fp::CTL_BYTES, stream) != hipSuccess) { fprintf(stderr, "kernel_launch: memset failed\n"); return; }
    fp::Args a{};
    for (int i = 0; i < 27; ++i) a.in[i] = (const float*)d_in[i];
    a.out = (float*)d_out; a.ws = (unsigned char*)d_ws; a.ph_lo = 0; a.ph_hi = fp::NPHASE;
#ifdef PROBE_SPLIT_LO
    a.ph_hi = PROBE_SPLIT_HI; a.li = 1; hipLaunchKernelGGL(fp::mega_kernel, dim3(grid), dim3(fp::NTHR), fp::LDS_BYTES, stream, a);
    a.ph_lo = PROBE_SPLIT_LO; a.ph_hi = fp::NPHASE; a.li = 0;
#endif
    hipLaunchKernelGGL(fp::mega_kernel, dim3(grid), dim3(fp::NTHR), fp::LDS_BYTES, stream, a);
}
```

```cpp
#include <hip/hip_runtime.h>
#include <stdint.h>
#include <stdio.h>
#include <math.h>
#include <type_traits>
constexpr int DEPTH = 2;
#define FAST_NB 8
namespace fp {
#define LAS __attribute__((address_space(3)))
#define GAS __attribute__((address_space(1)))
typedef unsigned short bf16_t;
typedef short bf16x8 __attribute__((ext_vector_type(8)));
typedef short s16x4 __attribute__((ext_vector_type(4)));
typedef float f32x4 __attribute__((ext_vector_type(4)));
typedef float f32x16 __attribute__((ext_vector_type(16)));
typedef unsigned u32x4 __attribute__((ext_vector_type(4)));
typedef unsigned u32x2 __attribute__((ext_vector_type(2)));
typedef float f32x2 __attribute__((ext_vector_type(2)));
#define DI __device__ __forceinline__

DI unsigned cvt_pk(float lo, float hi) { typedef float f2 __attribute__((ext_vector_type(2))); typedef __bf16 b2 __attribute__((ext_vector_type(2))); f2 v = {lo, hi}; b2 b = __builtin_convertvector(v, b2); return __builtin_bit_cast(unsigned, b); }
DI float bf_lo(unsigned w) { return __uint_as_float(w << 16); }
DI float bf_hi(unsigned w) { return __uint_as_float(w & 0xffff0000u); }
DI float silu_f(float v) { return v / (1.f + __expf(-v)); }
template <int M> DI float swz_xor(float v) { return __int_as_float(__builtin_amdgcn_ds_swizzle(__float_as_int(v), (M << 10) | 0x1F)); }
DI float add_xor16(float v) { return v + swz_xor<16>(v); }
DI float add_xor32(float v) { auto r = __builtin_amdgcn_permlane32_swap(__float_as_uint(v), __float_as_uint(v), false, false); return __uint_as_float(r[0]) + __uint_as_float(r[1]); }
DI float other32(float v, bool upper_half) { auto r = __builtin_amdgcn_permlane32_swap(__float_as_uint(v), __float_as_uint(v), false, false); return __uint_as_float(upper_half ? r[0] : r[1]); }
DI float wave_sum(float v) { v += swz_xor<1>(v); v += swz_xor<2>(v); v += swz_xor<4>(v); v += swz_xor<8>(v); v += swz_xor<16>(v); return add_xor32(v); }
DI unsigned shfl_up_u(unsigned v, int o, int lane) { return (unsigned)__builtin_amdgcn_ds_bpermute((lane - o) << 2, (int)v); }

constexpr int NB = FAST_NB;
constexpr int LAT = NB * 4096, CTXR = NB * 256, R = LAT + CTXR, MT = R / 256;
constexpr int MOE_LAT = NB * 16 * 512, MOE_ROWS = MOE_LAT + 16 * 256;
constexpr float EPS = 1e-6f, LOG2E = 1.4426950408889634f;
constexpr float QS64 = 0.125f * LOG2E, QS96 = 0.10206207261596575f * LOG2E;
constexpr float QF64 = QS64 * 8.f, QF96 = QS96 * 8.f;
constexpr int NWAVES = 8, NTHR = 512;

constexpr size_t al256(size_t x) { return (x + 255) & ~(size_t)255; }
constexpr size_t WS_CTL = 0, CTL_BYTES = 65536;
constexpr size_t WS_MOD = WS_CTL + CTL_BYTES;
constexpr size_t WS_TAB64 = WS_MOD + al256((size_t)2 * 9 * 6144 * 4);
constexpr size_t WS_TAB32 = WS_TAB64 + 8192;
constexpr size_t WS_WIN = WS_TAB32 + 4096;
constexpr size_t WS_WUP = WS_WIN + (size_t)2 * 1536 * 1024 * 2;
constexpr size_t WS_WOUT = WS_WUP + (size_t)2 * 1536 * 384 * 2;
constexpr size_t WS_W1 = WS_WOUT + (size_t)2 * 1024 * 1024 * 2;
constexpr size_t WS_W2 = WS_W1 + (size_t)2 * 16 * 2048 * 1024 * 2;
constexpr size_t WS_HB = WS_W2 + (size_t)2 * 16 * 1024 * 1024 * 2;
constexpr size_t WS_CTXF = WS_HB + (size_t)R * 1024 * 2;
constexpr size_t WS_SSQ = WS_CTXF + (size_t)CTXR * 1024 * 4;
constexpr size_t WS_AFFL = WS_SSQ + (size_t)R * 8 * 4;
constexpr size_t WS_AFFC = WS_AFFL + (size_t)NB * 16 * 4096 * 4;
constexpr size_t WS_GIDX = WS_AFFC + (size_t)NB * 16 * 256 * 4;
constexpr size_t WS_GATE = WS_GIDX + (size_t)MOE_ROWS * 4;
constexpr size_t WS_INV = WS_GATE + (size_t)MOE_ROWS * 4;
constexpr size_t WS_Z = al256(WS_INV + (size_t)R * 16 * 4);
constexpr size_t Z_QA = WS_Z, Z_KA = Z_QA + (size_t)R * 384 * 2, Z_VA = Z_KA + (size_t)R * 128 * 2, Z_QC = Z_VA + (size_t)R * 128 * 2, Z_KC = Z_QC + (size_t)R * 256 * 2,
                 Z_VC = Z_KC + (size_t)R * 128 * 2, Z_CRAW = Z_VC + (size_t)R * 128 * 2, Z_QB = Z_CRAW + (size_t)R * 384 * 2, Z_KB = Z_QB + (size_t)R * 576 * 2,
                 Z_VB = Z_KB + (size_t)R * 576 * 2, Z_OB = Z_VB + (size_t)R * 384 * 2, Z_END1 = Z_OB + (size_t)R * 1024 * 2;
constexpr size_t VT_TILE = 4096, VT_HEAD = 68 * VT_TILE;
constexpr size_t Z_HID = WS_Z, Z_YE = Z_HID + (size_t)MOE_ROWS * 1024 * 2, Z_END2 = Z_YE + (size_t)MOE_ROWS * 1024 * 2;
constexpr size_t WS_END = al256(Z_END1 > Z_END2 ? Z_END1 : Z_END2);
constexpr int CW_BAR = 1024;
constexpr int CW_QUEUE = 8192;

DI int vt_pos(int k) { return ((k & 4) << 3) | ((k & 32) >> 1) | ((k & 24) >> 1) | (k & 3); }
constexpr int RING_BYTES = 131072;
constexpr int LDS_TAB64 = RING_BYTES, LDS_TAB32 = LDS_TAB64 + 8192, LDS_MISC = LDS_TAB32 + 4096;
constexpr int LDS_INTAB = LDS_MISC + 256;
constexpr int LDS_BYTES = 147456;

#define XB_TMO      128
#define XB_XCNT(j)  (256  + 64 * (j))
#define XB_XSUB(j)  (1280 + 64 * (j))
#define XB_XGEN(j)  (2304 + 64 * (j))
#define XB_TOP      3328
#define XB_TOPGEN   3392
#define XCD_BAR_WORDS 3456
#define XB_SPIN_CAP (1u << 20)
DI unsigned xb_ld(unsigned* p)              { return __hip_atomic_load(p, __ATOMIC_RELAXED, __HIP_MEMORY_SCOPE_AGENT); }
DI unsigned xb_add(unsigned* p, unsigned v) { return __hip_atomic_fetch_add(p, v, __ATOMIC_RELAXED, __HIP_MEMORY_SCOPE_AGENT); }
DI unsigned xb_xcc_id() { return (unsigned)__builtin_amdgcn_s_getreg((3 << 11) | 20) & 0xFu; }
#define XB_SPIN(cond, bar) do { unsigned _sp = 0; while (cond) { __builtin_amdgcn_s_sleep(1); \
    if ((++_sp & 255u) == 0u) { if (xb_ld(&(bar)[XB_TMO])) break; if (_sp > XB_SPIN_CAP) { atomicAdd(&(bar)[XB_TMO], 1u); break; } } } } while (0)
struct XcdBarrier { unsigned* bar; unsigned x; volatile LAS unsigned* st; };
DI XcdBarrier xcd_barrier_post(unsigned* bar, volatile LAS unsigned* st) {
    XcdBarrier b; b.bar = bar; b.x = xb_xcc_id(); b.st = st;
    if (threadIdx.x == 0) (void)xb_add(&bar[XB_XCNT(b.x)], 1u);
    return b;
}
DI void xcd_barrier_complete(unsigned* bar, unsigned x, unsigned& nloc, unsigned& nx) {
    asm volatile("" : "+s"(x));
    const unsigned G = gridDim.x * gridDim.y * gridDim.z;
    unsigned sum, cnt, mine, sp = 0u;
    for (;;) {
        sum = 0u; cnt = 0u; mine = 0u;
#pragma unroll
        for (unsigned j = 0; j < 16; ++j) { const unsigned c = xb_ld(&bar[XB_XCNT(j)]); sum += c; cnt += (c > 0u) ? 1u : 0u; mine = (j == x) ? c : mine; }
        if (sum == G) break;
        __builtin_amdgcn_s_sleep(1);
        if ((++sp & 255u) == 0u) { if (xb_ld(&bar[XB_TMO])) break; if (sp > XB_SPIN_CAP) { atomicAdd(&bar[XB_TMO], 1u); break; } }
    }
    nloc = mine > 0u ? mine : 1u; nx = cnt > 0u ? cnt : 1u;
}
DI void xcd_barrier(const XcdBarrier& b) {
    asm volatile("s_waitcnt vmcnt(0)" ::: "memory");
    __syncthreads();
    if (threadIdx.x == 0) {
        unsigned* bar = b.bar; asm volatile("" : "+s"(bar));
        __builtin_amdgcn_s_waitcnt(0);
        unsigned nloc = b.st[0], nx = b.st[1];
        if (nloc == 0u) { xcd_barrier_complete(bar, b.x, nloc, nx); b.st[0] = nloc; b.st[1] = nx; }
        const unsigned old = xb_add(&bar[XB_XSUB(b.x)], 1u);
        const unsigned gen = old / nloc;
        if (old + 1u == (gen + 1u) * nloc) {
            __builtin_amdgcn_fence(__ATOMIC_RELEASE, "agent");
            asm volatile("s_waitcnt vmcnt(0)" ::: "memory");
            const unsigned og = xb_add(&bar[XB_TOP], 1u);
            const unsigned tg = og / nx;
            if (og + 1u == (tg + 1u) * nx) xb_add(&bar[XB_TOPGEN], 1u);
            else XB_SPIN(xb_ld(&bar[XB_TOPGEN]) == tg, bar);
            __builtin_amdgcn_fence(__ATOMIC_ACQUIRE, "agent");
            xb_add(&bar[XB_XGEN(b.x)], 1u);
            asm volatile("s_waitcnt vmcnt(0)" ::: "memory");
        } else {
            XB_SPIN(xb_ld(&bar[XB_XGEN(b.x)]) == gen, bar);
            __builtin_amdgcn_fence(__ATOMIC_ACQUIRE, "agent");
            asm volatile("s_waitcnt vmcnt(0)" ::: "memory");
        }
    }
    __syncthreads();
}

struct Args { const float* in[27]; float* out; unsigned char* ws; int ph_lo, ph_hi, li, pad; };
struct Frame {
    LAS unsigned char* lds; unsigned char* ws; unsigned* ctl;
    int tid, lane, wave, G, bid;
    const LAS unsigned long long* intab; float* out;
};
DI const float* inp(const LAS unsigned long long* tab, int k) { const unsigned long long v = tab[k]; const unsigned lo = __builtin_amdgcn_readfirstlane((unsigned)v), hi = __builtin_amdgcn_readfirstlane((unsigned)(v >> 32)); return (const float*)(const GAS float*)(((unsigned long long)hi << 32) | lo); }
#define INP(k) inp(F.intab, k)
#define WSP(T, off) ((T*)(F.ws + (off)))

DI void mod_item(const Frame& F, int item, const LAS float* s9, LAS float* red) {
    const int l = item / 96, c0 = (item % 96) * 64;
    const float* W = INP(4) + (size_t)l * 1024 * 6144 + c0;
    const int cg = F.lane & 15, ks = F.wave * 4 + (F.lane >> 4);
    f32x4 acc[9];
#pragma unroll
    for (int r = 0; r < 9; ++r) acc[r] = (f32x4){0.f, 0.f, 0.f, 0.f};
#pragma unroll 4
    for (int i = 0; i < 32; ++i) { const int k = ks + 32 * i; const f32x4 w = *(const f32x4*)(W + (size_t)k * 6144 + cg * 4);
#pragma unroll
        for (int r = 0; r < 9; ++r) acc[r] += w * s9[r * 1024 + k]; }
#pragma unroll
    for (int r = 0; r < 9; ++r)
#pragma unroll
        for (int j = 0; j < 4; ++j) { acc[r][j] = add_xor32(add_xor16(acc[r][j])); }
    __syncthreads();
    if (F.lane < 16) {
#pragma unroll
        for (int r = 0; r < 9; ++r) *(LAS f32x4*)(red + (F.wave * 9 + r) * 64 + cg * 4) = acc[r]; }
    __syncthreads();
    for (int e = F.tid; e < 9 * 64; e += NTHR) { const int r = e / 64, c = e % 64; float s = 0.f;
#pragma unroll
        for (int w = 0; w < 8; ++w) s += red[(w * 9 + r) * 64 + c];
        WSP(float, WS_MOD)[((size_t)l * 9 + r) * 6144 + c0 + c] = s + INP(5)[l * 6144 + c0 + c]; }
}

DI void cv_block(const float* src  , int ld, const float* ksc, bf16_t* drow  ) {
#pragma unroll
    for (int kc = 0; kc < 8; ++kc) {
        float v[8];
#pragma unroll
        for (int j = 0; j < 8; ++j) v[j] = src ? src[(size_t)(kc * 8 + j) * ld] : 0.f;
        if (ksc) {
#pragma unroll
            for (int j = 0; j < 8; ++j) v[j] *= ksc[kc * 8 + j]; }
        u32x4 o; o.x = cvt_pk(v[0], v[1]); o.y = cvt_pk(v[2], v[3]); o.z = cvt_pk(v[4], v[5]); o.w = cvt_pk(v[6], v[7]);
        *(u32x4*)(drow + kc * 8) = o;
    }
}
DI void cv_block_fp8(const float* src, int ld, unsigned char* drow) {
#pragma unroll
    for (int kc = 0; kc < 4; ++kc) {
        float v[16];
#pragma unroll
        for (int j = 0; j < 16; ++j) v[j] = src[(size_t)(kc * 16 + j) * ld] * 64.0f;
        u32x4 o;
        { int w = __builtin_amdgcn_cvt_pk_fp8_f32(v[0], v[1], 0, false); w = __builtin_amdgcn_cvt_pk_fp8_f32(v[2], v[3], w, true); o.x = (unsigned)w; }
        { int w = __builtin_amdgcn_cvt_pk_fp8_f32(v[4], v[5], 0, false); w = __builtin_amdgcn_cvt_pk_fp8_f32(v[6], v[7], w, true); o.y = (unsigned)w; }
        { int w = __builtin_amdgcn_cvt_pk_fp8_f32(v[8], v[9], 0, false); w = __builtin_amdgcn_cvt_pk_fp8_f32(v[10], v[11], w, true); o.z = (unsigned)w; }
        { int w = __builtin_amdgcn_cvt_pk_fp8_f32(v[12], v[13], 0, false); w = __builtin_amdgcn_cvt_pk_fp8_f32(v[14], v[15], w, true); o.w = (unsigned)w; }
        *(u32x4*)(drow + kc * 16) = o;
    }
}
constexpr int CV_WIN = 384, CV_WUP = 144, CV_WOUT = 256, CV_W1 = 8192, CV_W2 = 4096, CV_LAYER = CV_WIN + CV_WUP + CV_WOUT + CV_W1 + CV_W2;
DI void conv_item(const Frame& F, int it) {
    const int l = it / CV_LAYER; int r = it % CV_LAYER; const int lane = F.lane, hl = lane >> 5, ll = lane & 31;
    if (r < CV_WIN) {
        const int kb = r / 24, g = (r % 24) * 2 + hl, x = ((g >> 3) * 4 + (g & 3)) * 64 + 32 * ((g >> 2) & 1) + ll;
        const int sc = x < 960 ? x : (x < 1472 ? x + 32 : (x < 1504 ? x - 512 : -1));
        const float* src = sc < 0 ? nullptr : INP(8) + (size_t)l * 1024 * 1504 + (size_t)(kb * 64) * 1504 + sc;
        unsigned char* drow = WSP(unsigned char, WS_WIN) + (size_t)l * 1536 * 1024 + (size_t)((r % 24) * 64 + lane) * 1024 + kb * 64;
        if (__builtin_amdgcn_readfirstlane(sc < 0 ? 1 : 0) | __any(sc < 0)) { const float* s2 = sc < 0 ? INP(8) : src; cv_block_fp8(s2, sc < 0 ? 0 : 1504, drow);
            if (sc < 0) {
#pragma unroll
                for (int kc = 0; kc < 4; ++kc) *(u32x4*)(drow + kc * 16) = (u32x4){0u, 0u, 0u, 0u}; } }
        else cv_block_fp8(src, 1504, drow);
        return; }
    r -= CV_WIN;
    if (r < CV_WUP) {
        const int kb = r / 24, g = (r % 24) * 2 + hl, slot = (g >> 3) * 4 + (g & 3), half = (g >> 2) & 1;
        const float* src = nullptr; const float* ksc = nullptr; int ld = 0;
        if (slot < 9 && kb < 3) { const int col = slot < 6 ? slot * 96 + 32 * half : (2 * (slot - 6) + half) * 96 + 64;
            src = INP(13) + (size_t)l * 192 * 576 + (size_t)(kb * 64) * 576 + col + ll; ld = 576; ksc = INP(11) + l * 192 + kb * 64; }
        else if (slot >= 12 && (kb == 3 || kb == 4)) { const int h = slot < 18 ? slot - 12 : slot - 18; const int col = h * 128 + (slot < 18 ? 0 : 64) + 32 * half;
            src = INP(14) + (size_t)l * 128 * 768 + (size_t)((kb - 3) * 64) * 768 + col + ll; ld = 768; ksc = INP(12) + l * 128 + (kb - 3) * 64; }
        cv_block(src, ld, ksc, WSP(bf16_t, WS_WUP) + (size_t)l * 1536 * 384 + (size_t)((r % 24) * 64 + lane) * 384 + kb * 64); return; }
    r -= CV_WUP;
    if (r < CV_WOUT) { const int kb = r / 16, g = r % 16;
        cv_block(INP(22) + (size_t)l * 1024 * 1024 + (size_t)(kb * 64) * 1024 + g * 64 + lane, 1024, nullptr, WSP(bf16_t, WS_WOUT) + (size_t)l * 1024 * 1024 + (size_t)(g * 64 + lane) * 1024 + kb * 64); return; }
    r -= CV_WOUT;
    if (r < CV_W1) { const int e = r / 512, q = r % 512, kb = q / 32, g = (q % 32) * 2 + hl, pn = g >> 3, bj = (g >> 2) & 1, wc = g & 3;
        const float* src = (bj ? INP(25) : INP(24)) + ((size_t)l * 16 + e) * 1024 * 1024 + (size_t)(kb * 64) * 1024 + 128 * pn + 32 * wc + ll;
        cv_block_fp8(src, 1024, WSP(unsigned char, WS_W1) + ((size_t)l * 16 + e) * 2048 * 1024 + (size_t)((q % 32) * 64 + lane) * 1024 + kb * 64); return; }
    r -= CV_W1;
    { const int e = r / 256, q = r % 256, kb = q / 16, g = q % 16;
        cv_block_fp8(INP(26) + ((size_t)l * 16 + e) * 1024 * 1024 + (size_t)(kb * 64) * 1024 + g * 64 + lane, 1024, WSP(unsigned char, WS_W2) + ((size_t)l * 16 + e) * 1024 * 1024 + (size_t)(g * 64 + lane) * 1024 + kb * 64); }
}
DI void p0_phase(const Frame& F) {
    LAS float* s9 = (LAS float*)F.lds;
    LAS float* red = (LAS float*)(F.lds + 9 * 1024 * 4);
    if (F.bid == 0) {
        for (int i = F.tid; i < 64 * 16; i += NTHR) { const int pos = i / 16, f = i % 16; const float inv = exp2f(-(float)(2 * f) / 32.f * 13.287712379549449f); const float a = (float)pos * inv; WSP(f32x2, WS_TAB64)[i] = (f32x2){cosf(a), sinf(a)}; }
        for (int i = F.tid; i < 64 * 8; i += NTHR) { const int pos = i / 8, f = i % 8; const float inv = exp2f(-(float)(2 * f) / 16.f * 13.287712379549449f); const float a = (float)pos * inv; WSP(f32x2, WS_TAB32)[i] = (f32x2){cosf(a), sinf(a)}; }
    }
    bool have_s9 = false;
    for (int it = F.bid; it < 192; it += F.G) {
        if (!have_s9) { for (int e = F.tid; e < 9 * 1024; e += NTHR) { const int r = e / 1024, k = e % 1024; const float v = r < 8 ? INP(1)[r * 1024 + k] : INP(3)[k]; s9[e] = silu_f(v); } have_s9 = true; __syncthreads(); }
        mod_item(F, it, s9, red);
    }
    __syncthreads();
    const int gw = F.bid * NWAVES + F.wave, NGW = F.G * NWAVES;
    for (int it = gw; it < 2 * CV_LAYER; it += NGW) conv_item(F, it);
}

DI unsigned pk_fp8q(float a, float b, float c, float d) { int w = __builtin_amdgcn_cvt_pk_fp8_f32(a, b, 0, false); w = __builtin_amdgcn_cvt_pk_fp8_f32(c, d, w, true); return (unsigned)w; }
DI void norm_mod_store(const f32x4 (&v)[4], const float* g, const float* sh, const float* sc, unsigned char* orow  , int lane) {
    float s = 0.f;
#pragma unroll
    for (int j = 0; j < 4; ++j) s += (v[j].x * v[j].x + v[j].y * v[j].y) + (v[j].z * v[j].z + v[j].w * v[j].w);
    const float rstd = 1.0f / sqrtf(wave_sum(s) * (1.f / 1024.f) + EPS);
#pragma unroll
    for (int j = 0; j < 4; ++j) { const int c = 4 * (lane + 64 * j); const f32x4 gv = *(const f32x4*)(g + c), sv = *(const f32x4*)(sh + c), cv = *(const f32x4*)(sc + c);
        const f32x4 o = v[j] * rstd * gv * (cv + 1.0f) + sv; *(unsigned*)(orow + c) = pk_fp8q(o.x, o.y, o.z, o.w); }
}
DI const float* mod_row(const Frame& F, int l, int row) { const int r = row < LAT ? row / 4096 : 8; return WSP(float, WS_MOD) + ((size_t)l * 9 + r) * 6144; }
DI void init_norm_phase(const Frame& F) {
    const int gw = F.bid * NWAVES + F.wave, NGW = F.G * NWAVES;
    for (int row = gw; row < R; row += NGW) {
        const float* xr = row < LAT ? INP(0) + (size_t)row * 1024 : INP(2) + (size_t)(row - LAT) * 1024;
        f32x4 v[4];
#pragma unroll
        for (int j = 0; j < 4; ++j) v[j] = *(const f32x4*)(xr + 4 * (F.lane + 64 * j));
        const float* m = mod_row(F, 0, row);
        norm_mod_store(v, INP(6), m, m + 1024, WSP(unsigned char, WS_HB) + (size_t)row * 1024, F.lane);
    }
}
namespace g8 {
constexpr int BM = 256, BK = 64, HALF = 128, HTB = HALF * BK * 2, STAGE_BYTES = 8 * HTB;
DI int lds_byte(int r, int c) { const int st = (r >> 4) * 2 + (c >> 5), rr = r & 15, cc = c & 31, ob = rr * 64 + cc * 2; return st * 1024 + (ob ^ (((ob >> 9) & 1) << 5)); }
DI void stage_rc(int b, int& Rr, int& Cc) { const int st = b / 1024, sb = b % 1024, swz = sb ^ (((sb >> 9) & 1) << 5); Rr = (st >> 1) * 16 + swz / 64; Cc = (st & 1) * 32 + (swz % 64) / 2; }
DI int perm32(int rho) { const int n = rho >> 4, i = rho & 15; return 8 * (i >> 2) + 4 * n + (i & 3); }

typedef int i32x4 __attribute__((ext_vector_type(4)));
typedef int i32x8 __attribute__((ext_vector_type(8)));
struct Unit { int pm, pn, aux; const char* Bp; };

template <class Epi, class Sched>
DI void gemm_phase(const int tid, LAS unsigned char* lds, const char* Abase, int K, const Sched& S, const Epi& E) {
    asm volatile("" : "+s"(K));
    const int wid = __builtin_amdgcn_readfirstlane(tid >> 6), lane = tid & 63, wr = wid >> 2, wc = wid & 3, fr = lane & 15, fq = lane >> 4;
    const int nt = K / BK;
    int Rr[2], Cc[2]; unsigned voffB[2];
#pragma unroll
    for (int i = 0; i < 2; ++i) { int r_, c_; stage_rc(tid * 16 + i * 8192, r_, c_); Rr[i] = r_; Cc[i] = c_; const int Rb = Epi::PERM ? ((r_ & ~31) + perm32(r_ & 31)) : r_; voffB[i] = (unsigned)(Rb * K + c_) * 2u; }
    const size_t hstepB = (size_t)HALF * K * 2;
    const unsigned ldsw = (unsigned)wid * 1024u;
    const int aoff = lds_byte(wr * 64 + fr, fq * 8), boff = lds_byte(wc * 32 + fr, fq * 8);
#define G8_SA(b, h) (((b) * 2 + (h)) * HTB)
#define G8_SB(b, h) ((4 + (b) * 2 + (h)) * HTB)
#define G8_STAGE_A(bufoff, ao2, kt) do { _Pragma("unroll") for (int _i = 0; _i < 2; ++_i) \
        __builtin_amdgcn_global_load_lds((const unsigned*)(Abase + (size_t)(ao2)[_i] + (size_t)(kt) * 128), (LAS unsigned*)(lds + (bufoff) + ldsw + _i * 8192), 16, 0, 0); } while (0)
#define G8_STAGE_B(bufoff, bp, h, kt) do { _Pragma("unroll") for (int _i = 0; _i < 2; ++_i) \
        __builtin_amdgcn_global_load_lds((const unsigned*)((bp) + (size_t)(h) * hstepB + voffB[_i] + (size_t)(kt) * 128), (LAS unsigned*)(lds + (bufoff) + ldsw + _i * 8192), 16, 0, 0); } while (0)
#define G8_LD16(off) (*(const LAS i32x4*)(lds + (off)))
#define G8_LDA(dst, b, h) do { _Pragma("unroll") for (int m = 0; m < 4; ++m) { const i32x4 lo_ = G8_LD16(G8_SA(b, h) + aoff + m * 2048), hi_ = G8_LD16(G8_SA(b, h) + aoff + m * 2048 + 1024); dst[m] = __builtin_shufflevector(lo_, hi_, 0, 1, 2, 3, 4, 5, 6, 7); } } while (0)
#define G8_LDB(dst, b, h) do { _Pragma("unroll") for (int n = 0; n < 2; ++n) { const i32x4 lo_ = G8_LD16(G8_SB(b, h) + boff + n * 2048), hi_ = G8_LD16(G8_SB(b, h) + boff + n * 2048 + 1024); dst[n] = __builtin_shufflevector(lo_, hi_, 0, 1, 2, 3, 4, 5, 6, 7); } } while (0)
#define G8_HALF(v, k) __builtin_bit_cast(bf16x8, __builtin_shufflevector((v), (v), 4 * (k), 4 * (k) + 1, 4 * (k) + 2, 4 * (k) + 3))
#define G8_MMA(ai, bj, At, Bt) do { __builtin_amdgcn_s_setprio(1); _Pragma("unroll") for (int m = 0; m < 4; ++m) _Pragma("unroll") for (int n = 0; n < 2; ++n) { \
        if constexpr (Epi::FP8) asm volatile("v_mfma_scale_f32_16x16x128_f8f6f4 %0, %1, %2, %0, %3, %3 op_sel_hi:[0,0,0]" : "+v"(acc[ai][bj][m][n]) : "v"(Bt[n]), "v"(At[m]), "v"(fp8_scale)); \
        else { acc[ai][bj][m][n] = __builtin_amdgcn_mfma_f32_16x16x32_bf16(G8_HALF(Bt[n], 0), G8_HALF(At[m], 0), acc[ai][bj][m][n], 0, 0, 0); \
               acc[ai][bj][m][n] = __builtin_amdgcn_mfma_f32_16x16x32_bf16(G8_HALF(Bt[n], 1), G8_HALF(At[m], 1), acc[ai][bj][m][n], 0, 0, 0); } } __builtin_amdgcn_s_setprio(0); } while (0)
#define G8_WAIT_V(n) asm volatile("s_waitcnt vmcnt(" #n ")" ::: "memory")
#define G8_WAIT_L(n) asm volatile("s_waitcnt lgkmcnt(" #n ")" ::: "memory")
#define G8_BAR __builtin_amdgcn_s_barrier()
#define G8_SCHED __builtin_amdgcn_sched_barrier(0)
    const int fp8_scale = 0x7F7F7F7F;
    Unit cur, nxt; int ui = 0;
    if (!S.next(0, cur)) return;
    unsigned aoc[2][2], aon[2][2];
    S.aoffs(cur, Rr, Cc, aoc);
    f32x4 acc[2][2][4][2];
#pragma unroll
    for (int a = 0; a < 2; ++a)
#pragma unroll
        for (int b = 0; b < 2; ++b)
#pragma unroll
            for (int m = 0; m < 4; ++m)
#pragma unroll
                for (int n = 0; n < 2; ++n) acc[a][b][m][n] = (f32x4){0.f, 0.f, 0.f, 0.f};
    i32x8 At[4], B0[2], B1[2];
    const char* cB = cur.Bp;
    G8_STAGE_B(G8_SB(0, 0), cB, 0, 0); G8_STAGE_B(G8_SB(0, 1), cB, 1, 0); G8_STAGE_A(G8_SA(0, 0), aoc[0], 0); G8_STAGE_A(G8_SA(0, 1), aoc[1], 0);
    if (wr == 1) G8_BAR;
    G8_WAIT_V(2); G8_BAR;
    G8_STAGE_B(G8_SB(1, 0), cB, 0, 1); G8_STAGE_A(G8_SA(1, 0), aoc[0], 1); G8_STAGE_B(G8_SB(1, 1), cB, 1, 1);
    G8_WAIT_V(6); G8_BAR;
    for (;;) {
        const bool has_next = S.next(ui + 1, nxt);
        if (has_next) S.aoffs(nxt, Rr, Cc, aon);
        else {
#pragma unroll
            for (int h = 0; h < 2; ++h)
#pragma unroll
                for (int i = 0; i < 2; ++i) aon[h][i] = aoc[h][i]; }
        const char* nB = has_next ? nxt.Bp : cB;
        for (int t = 0; t < nt; t += 2) {
            const bool last = (t == nt - 2);
            unsigned a2[2][2];
#pragma unroll
            for (int h = 0; h < 2; ++h)
#pragma unroll
                for (int i = 0; i < 2; ++i) a2[h][i] = last ? aon[h][i] : aoc[h][i];
            const int kt2 = last ? 0 : t + 2; const char* b2 = last ? nB : cB;
            G8_LDB(B0, 0, 0); G8_LDB(B1, 0, 1); G8_SCHED; G8_LDA(At, 0, 0); G8_STAGE_A(G8_SA(1, 1), aoc[1], t + 1);
            G8_WAIT_V(8); G8_WAIT_L(0); G8_BAR; G8_MMA(0, 0, At, B0); G8_MMA(0, 1, At, B1); G8_BAR; G8_SCHED;
            G8_LDA(At, 0, 1); G8_STAGE_B(G8_SB(0, 0), b2, 0, kt2); G8_STAGE_B(G8_SB(0, 1), b2, 1, kt2); G8_STAGE_A(G8_SA(0, 0), a2[0], kt2);
            G8_WAIT_V(8); G8_WAIT_L(0); G8_BAR; G8_MMA(1, 0, At, B0); G8_MMA(1, 1, At, B1); G8_BAR; G8_SCHED;
            G8_LDB(B0, 1, 0); G8_LDB(B1, 1, 1); G8_SCHED; G8_LDA(At, 1, 0); G8_STAGE_A(G8_SA(0, 1), a2[1], kt2);
            G8_WAIT_V(8); G8_WAIT_L(0); G8_BAR; G8_MMA(0, 0, At, B0); G8_MMA(0, 1, At, B1); G8_BAR; G8_SCHED;
            G8_LDA(At, 1, 1); G8_STAGE_B(G8_SB(1, 0), b2, 0, kt2 + 1); G8_STAGE_B(G8_SB(1, 1), b2, 1, kt2 + 1); G8_STAGE_A(G8_SA(1, 0), a2[0], kt2 + 1);
            G8_WAIT_V(8); G8_WAIT_L(0); G8_BAR; G8_MMA(1, 0, At, B0); G8_MMA(1, 1, At, B1); G8_BAR; G8_SCHED;
        }
        if (wr == 0) G8_BAR;
        if constexpr (Epi::FP8) asm volatile("s_nop 15\n\ts_nop 15" ::: "memory");
        E(acc, cur, wr, wc, fr, fq);
        if (!has_next) break;
#pragma unroll
        for (int a = 0; a < 2; ++a)
#pragma unroll
            for (int b = 0; b < 2; ++b)
#pragma unroll
                for (int m = 0; m < 4; ++m)
#pragma unroll
                    for (int n = 0; n < 2; ++n) acc[a][b][m][n] = (f32x4){0.f, 0.f, 0.f, 0.f};
        cur = nxt; cB = nB;
#pragma unroll
        for (int h = 0; h < 2; ++h)
#pragma unroll
            for (int i = 0; i < 2; ++i) aoc[h][i] = aon[h][i];
        ++ui;
        if (wr == 1) G8_BAR;
    }
    G8_WAIT_V(0);
    G8_BAR;
#undef G8_SA
#undef G8_SB
#undef G8_STAGE_A
#undef G8_STAGE_B
#undef G8_LDA
#undef G8_LDB
#undef G8_MMA
#undef G8_HALF
#undef G8_LD16
#undef G8_WAIT_V
#undef G8_WAIT_L
#undef G8_BAR
#undef G8_SCHED
}

struct DenseSched {
    int nM, nN, nwg, G, c, K; const char* Bt;
    DI void init(int nM_, int nN_, int G_, int c_, int K_, const void* Bt_) { nM = nM_; nN = nN_; nwg = nM * nN; G = G_; c = c_; K = K_; Bt = (const char*)Bt_; }
    DI bool next(int i, Unit& u) const {
        const long L = (long)i * G + c; if (L >= nwg) return false;
        int wgid = (int)L; { const int q = nwg / 8, r = nwg % 8, xcd = wgid % 8, off = wgid / 8; wgid = (xcd < r ? xcd * (q + 1) : r * (q + 1) + (xcd - r) * q) + off; }
        const int WGM = 8, nig = WGM * nN, gid = wgid / nig, fm = gid * WGM, gsz = (nM - fm) < WGM ? (nM - fm) : WGM;
        u.pm = fm + ((wgid % nig) % gsz); u.pn = (wgid % nig) / gsz; u.aux = 0; u.Bp = Bt + (size_t)u.pn * 256 * K * 2; return true;
    }
    DI void aoffs(const Unit& u, const int (&Rr)[2], const int (&Cc)[2], unsigned (&ao)[2][2]) const {
#pragma unroll
        for (int h = 0; h < 2; ++h)
#pragma unroll
            for (int i = 0; i < 2; ++i) ao[h][i] = (unsigned)(((size_t)(u.pm * 256 + h * 128 + Rr[i]) * K + Cc[i]) * 2);
    }
};
template <bool GATHER>
struct MoeSched {
    int nN, tiles_per_e, nwg, G, c, K, NBt; const char* Bt; size_t estride; const int* gidx; bool with_ctx;
    DI void init(int nN_, bool with_ctx_, int G_, int c_, int K_, const void* Bt_, size_t estride_, const int* gidx_) {
        nN = nN_; with_ctx = with_ctx_; tiles_per_e = NB * 2 + (with_ctx_ ? 1 : 0); nwg = 16 * tiles_per_e * nN; G = G_; c = c_; K = K_; Bt = (const char*)Bt_; estride = estride_; gidx = gidx_; }
    DI bool next(int i, Unit& u) const {
        int mt;
        if (G % (8 * nN) == 0) {
            const int per = (G / 8) / nN, xcd = c & 7, j8 = c >> 3; mt = (i * 8 + xcd) * per + j8 / nN; u.pn = j8 % nN; if (mt >= 16 * tiles_per_e) return false;
        } else { const long L = (long)i * G + c; if (L >= nwg) return false; mt = (int)L / nN; u.pn = (int)L % nN; }
        const int e = mt / tiles_per_e, j = mt % tiles_per_e;
        const int rowbase = j < NB * 2 ? ((j >> 1) * 16 + e) * 512 + (j & 1) * 256 : MOE_LAT + e * 256;
        u.pm = rowbase / 256; u.aux = e; u.Bp = Bt + (size_t)e * estride + (size_t)u.pn * 256 * K * 2; return true;
    }
    DI void aoffs(const Unit& u, const int (&Rr)[2], const int (&Cc)[2], unsigned (&ao)[2][2]) const {
#pragma unroll
        for (int h = 0; h < 2; ++h)
#pragma unroll
            for (int i = 0; i < 2; ++i) { const int mrow = u.pm * 256 + h * 128 + Rr[i]; const int arow = GATHER ? gidx[mrow] : mrow; ao[h][i] = (unsigned)(((size_t)arow * K + Cc[i]) * 2); }
    }
};
}

typedef f32x4 Acc[2][2][4][2];
DI unsigned pk_fp8x4(float a, float b, float c, float d) { int w = __builtin_amdgcn_cvt_pk_fp8_f32(a, b, 0, false); w = __builtin_amdgcn_cvt_pk_fp8_f32(c, d, w, true); return (unsigned)w; }
DI unsigned pk_fp8v(const f32x4 v) { return pk_fp8x4(v.x, v.y, v.z, v.w); }
DI void st_bf16x4(bf16_t* p, const f32x4 v) { u32x2 w; w.x = cvt_pk(v.x, v.y); w.y = cvt_pk(v.z, v.w); *(u32x2*)p = w; }

DI void st_vt4(unsigned char* tile, int d0, int pos, const f32x4 v) { const unsigned w = pk_fp8v(v); unsigned char* p = tile + d0 * 64 + pos;
    p[0] = (unsigned char)w; p[64] = (unsigned char)(w >> 8); p[128] = (unsigned char)(w >> 16); p[192] = (unsigned char)(w >> 24); }
DI size_t vt_tile_of_rowgroup(int row64  ) {
    return row64 < LAT ? (size_t)(row64 / 4096) * 68 + 4 + (row64 % 4096) / 64 : (size_t)((row64 - LAT) / 256) * 68 + ((row64 - LAT) % 256) / 64; }
struct EpiInProj {
    static constexpr bool PERM = false, FP8 = true;
    unsigned char* ws; const LAS unsigned long long* in; int l; const LAS f32x2* tab64; const LAS f32x2* tab32;
    DI void operator()(const Acc& acc, const g8::Unit& u, int wr, int wc, int fr, int fq) const {
        asm volatile("" : "+v"(fr), "+v"(fq));
        constexpr float SC = 1.0f / 64.0f;
        const int slot = 4 * u.pn + wc; const int rowt = u.pm * 256 + wr * 64 + fr; const bool lat = (u.pm * 256) < LAT;
        int kind; bf16_t* dst; int ld, coff; const float* gain = nullptr; float qs = 1.f;
        if (slot < 6)       { kind = 0; dst = (bf16_t*)(ws + Z_QA); ld = 384; coff = slot * 64; gain = inp(in, 9) + l * 64; qs = QF64; }
        else if (slot < 8)  { kind = 0; dst = (bf16_t*)(ws + Z_KA); ld = 128; coff = (slot - 6) * 64; gain = inp(in, 10) + l * 64; }
        else if (slot < 10) { kind = 1; dst = (bf16_t*)(ws + Z_VA); ld = 128; coff = (slot - 8) * 64; }
        else if (slot < 15) { kind = 2; dst = (bf16_t*)(ws + Z_CRAW); ld = 384; coff = (slot - 10) * 64; }
        else if (slot < 19) { kind = 0; dst = (bf16_t*)(ws + Z_QC); ld = 256; coff = (slot - 15) * 64; gain = inp(in, 19) + l * 64; qs = QF64; }
        else if (slot < 21) { kind = 0; dst = (bf16_t*)(ws + Z_KC); ld = 128; coff = (slot - 19) * 64; gain = inp(in, 20) + l * 64; }
        else if (slot < 23) { kind = 1; dst = (bf16_t*)(ws + Z_VC); ld = 128; coff = (slot - 21) * 64; }
        else                { kind = 3; dst = (bf16_t*)(ws + Z_KB); ld = 576; coff = 64; gain = inp(in, 18) + l * 32; }
        if (kind == 0) {
            f32x4 g[2][2];
#pragma unroll
            for (int bj = 0; bj < 2; ++bj)
#pragma unroll
                for (int n = 0; n < 2; ++n) g[bj][n] = *(const f32x4*)(gain + 32 * bj + 16 * n + 4 * fq) * qs;
#pragma unroll
            for (int ai = 0; ai < 2; ++ai)
#pragma unroll
                for (int m = 0; m < 4; ++m) {
                    const int row = rowt + ai * 128 + m * 16; float s = 0.f;
#pragma unroll
                    for (int bj = 0; bj < 2; ++bj)
#pragma unroll
                        for (int n = 0; n < 2; ++n) { const f32x4 x = acc[ai][bj][m][n] * SC; s += (x.x * x.x + x.y * x.y) + (x.z * x.z + x.w * x.w); }
                    s = add_xor32(add_xor16(s));
                    const float rstd = SC / sqrtf(s * (1.f / 64.f) + EPS);
                    const int t = row & 4095, pr = t >> 6, pc = t & 63;
#pragma unroll
                    for (int bj = 0; bj < 2; ++bj) {
                        f32x4 x1 = acc[ai][bj][m][0] * rstd * g[bj][0], x2 = acc[ai][bj][m][1] * rstd * g[bj][1];
                        if (lat) { const LAS f32x2* tb = tab64 + (bj == 0 ? pr : pc) * 16 + 4 * fq; f32x4 o1, o2;
#pragma unroll
                            for (int i = 0; i < 4; ++i) { const f32x2 cs = tb[i]; o1[i] = x1[i] * cs.x - x2[i] * cs.y; o2[i] = x2[i] * cs.x + x1[i] * cs.y; }
                            x1 = o1; x2 = o2; }
                        unsigned char* p = (unsigned char*)dst + (size_t)row * ld + coff + 32 * bj + 4 * fq;
                        *(unsigned*)p = pk_fp8v(x1); *(unsigned*)(p + 16) = pk_fp8v(x2);
                    }
                    asm volatile("" ::: "memory");
                }
        } else if (kind == 1 || kind == 2) {
#pragma unroll
            for (int ai = 0; ai < 2; ++ai)
#pragma unroll
                for (int m = 0; m < 4; ++m) {
                    const int row = rowt + ai * 128 + m * 16; float s = 0.f;
#pragma unroll
                    for (int bj = 0; bj < 2; ++bj)
#pragma unroll
                        for (int n = 0; n < 2; ++n) { const f32x4 x = acc[ai][bj][m][n] * SC; s += (x.x * x.x + x.y * x.y) + (x.z * x.z + x.w * x.w);
                            if (kind == 2) st_bf16x4(dst + (size_t)row * ld + coff + 32 * bj + 16 * n + 4 * fq, x);
                            else { const int row64 = u.pm * 256 + ai * 128 + wr * 64;
                                const size_t bt = vt_tile_of_rowgroup(row64); unsigned char* tile = (unsigned char*)dst + ((bt / 68) * 2 + coff / 64) * VT_HEAD + (bt % 68) * VT_TILE;
                                st_vt4(tile, 32 * bj + 16 * n + 4 * fq, vt_pos(16 * m + fr), x); } }
                    if (kind == 2) { s = add_xor32(add_xor16(s)); if (fq == 0) ((float*)(ws + WS_SSQ))[(size_t)row * 8 + (slot - 10)] = s; }
                }
        } else {
            const f32x4 g0 = *(const f32x4*)(gain + 4 * fq), g1 = *(const f32x4*)(gain + 16 + 4 * fq);
            bf16_t* craw = (bf16_t*)(ws + Z_CRAW);
#pragma unroll
            for (int ai = 0; ai < 2; ++ai)
#pragma unroll
                for (int m = 0; m < 4; ++m) {
                    const int row = rowt + ai * 128 + m * 16;
                    const f32x4 a0 = acc[ai][0][m][0] * SC, a1 = acc[ai][0][m][1] * SC;
                    float s = (a0.x * a0.x + a0.y * a0.y) + (a0.z * a0.z + a0.w * a0.w) + (a1.x * a1.x + a1.y * a1.y) + (a1.z * a1.z + a1.w * a1.w);
                    s = add_xor32(add_xor16(s));
                    const float rstd = 1.0f / sqrtf(s * (1.f / 32.f) + EPS);
                    f32x4 v0 = a0 * rstd * g0, v1 = a1 * rstd * g1;
                    if (lat) { const int t = row & 4095, pr = t >> 6, pc = t & 63;
                        f32x4 p0, p1;
#pragma unroll
                        for (int i = 0; i < 4; ++i) { p0[i] = other32(v0[i], fq >= 2); p1[i] = other32(v1[i], fq >= 2); }
                        const LAS f32x2* t0 = tab32 + pr * 8 + 4 * (fq & 1); const LAS f32x2* t1 = tab32 + pc * 8 + 4 * (fq & 1);
#pragma unroll
                        for (int i = 0; i < 4; ++i) { const f32x2 c0 = t0[i], c1 = t1[i];
                            v0[i] = fq < 2 ? v0[i] * c0.x - p0[i] * c0.y : v0[i] * c0.x + p0[i] * c0.y;
                            v1[i] = fq < 2 ? v1[i] * c1.x - p1[i] * c1.y : v1[i] * c1.x + p1[i] * c1.y; } }
                    const unsigned w0 = pk_fp8v(v0), w1 = pk_fp8v(v1);
#pragma unroll
                    for (int h = 0; h < 6; ++h) { unsigned char* p = (unsigned char*)dst + (size_t)row * 768 + h * 128 + 64 + 4 * fq; *(unsigned*)p = w0; *(unsigned*)(p + 16) = w1; *(unsigned*)(p + 32) = 0u; *(unsigned*)(p + 48) = 0u; }
                    const u32x2 z = {0u, 0u};
#pragma unroll
                    for (int q = 0; q < 4; ++q) *(u32x2*)(craw + (size_t)row * 384 + 320 + 16 * q + 4 * fq) = z;
                    asm volatile("" ::: "memory");
                }
        }
    }
};

struct EpiUpProj {
    static constexpr bool PERM = false, FP8 = false;
    unsigned char* ws; const LAS unsigned long long* in; int l; const LAS f32x2* tab32;
    DI void operator()(const Acc& acc, const g8::Unit& u, int wr, int wc, int fr, int fq) const {
        asm volatile("" : "+v"(fr), "+v"(fq));
        const int slot = 4 * u.pn + wc; if (slot >= 9 && slot < 12) return;
        const int rowt = u.pm * 256 + wr * 64 + fr; const bool lat = (u.pm * 256) < LAT;
        const float* ssq = (const float*)(ws + WS_SSQ);
        bf16_t* qB = (bf16_t*)(ws + Z_QB); bf16_t* kB = (bf16_t*)(ws + Z_KB); bf16_t* vB = (bf16_t*)(ws + Z_VB);
        const bool isq = slot < 9;
#pragma unroll
        for (int ai = 0; ai < 2; ++ai)
#pragma unroll
            for (int m = 0; m < 4; ++m) {
                const int row = rowt + ai * 128 + m * 16;
                const f32x4 sa = *(const f32x4*)(ssq + (size_t)row * 8); const float sb = ssq[(size_t)row * 8 + 4];
                const float r0 = isq ? 1.0f / sqrtf((sa.x + sa.y + sa.z) * (1.f / 192.f) + EPS) : 1.0f / sqrtf((sa.w + sb) * (1.f / 128.f) + EPS);
                if (slot < 6 || (slot >= 12 && slot < 18)) {
                    const float* gain = slot < 6 ? inp(in, 15) + l * 64 : inp(in, 16) + l * 64; const float qs = slot < 6 ? QF96 : 1.f;
                    const int h = slot < 6 ? slot : slot - 12; unsigned char* dst = (unsigned char*)(slot < 6 ? qB : kB) + (size_t)row * 768 + h * 128;
                    float s = 0.f; f32x4 x[2][2];
#pragma unroll
                    for (int bj = 0; bj < 2; ++bj)
#pragma unroll
                        for (int n = 0; n < 2; ++n) { x[bj][n] = acc[ai][bj][m][n] * r0; s += (x[bj][n].x * x[bj][n].x + x[bj][n].y * x[bj][n].y) + (x[bj][n].z * x[bj][n].z + x[bj][n].w * x[bj][n].w); }
                    s = add_xor32(add_xor16(s));
                    const float rstd = qs / sqrtf(s * (1.f / 64.f) + EPS);
#pragma unroll
                    for (int bj = 0; bj < 2; ++bj)
#pragma unroll
                        for (int n = 0; n < 2; ++n) { const int c = 32 * bj + 16 * n + 4 * fq; *(unsigned*)(dst + c) = pk_fp8v(x[bj][n] * rstd * *(const f32x4*)(gain + c)); }
                } else if (slot >= 18) {
                    const int row64 = u.pm * 256 + ai * 128 + wr * 64; const size_t bt = vt_tile_of_rowgroup(row64);
                    unsigned char* tile = (unsigned char*)vB + ((bt / 68) * 6 + (slot - 18)) * VT_HEAD + (bt % 68) * VT_TILE;
#pragma unroll
                    for (int bj = 0; bj < 2; ++bj)
#pragma unroll
                        for (int n = 0; n < 2; ++n) st_vt4(tile, 32 * bj + 16 * n + 4 * fq, vt_pos(16 * m + fr), acc[ai][bj][m][n] * r0);
                } else {
                    const float* gain = inp(in, 17) + l * 32;
#pragma unroll
                    for (int bj = 0; bj < 2; ++bj) {
                        const f32x4 a0 = acc[ai][bj][m][0] * r0, a1 = acc[ai][bj][m][1] * r0;
                        float s = (a0.x * a0.x + a0.y * a0.y) + (a0.z * a0.z + a0.w * a0.w) + (a1.x * a1.x + a1.y * a1.y) + (a1.z * a1.z + a1.w * a1.w);
                        s = add_xor32(add_xor16(s));
                        const float rstd = QF96 / sqrtf(s * (1.f / 32.f) + EPS);
                        f32x4 v0 = a0 * rstd * *(const f32x4*)(gain + 4 * fq), v1 = a1 * rstd * *(const f32x4*)(gain + 16 + 4 * fq);
                        if (lat) { const int t = row & 4095, pr = t >> 6, pc = t & 63; f32x4 p0, p1;
#pragma unroll
                            for (int i = 0; i < 4; ++i) { p0[i] = other32(v0[i], fq >= 2); p1[i] = other32(v1[i], fq >= 2); }
                            const LAS f32x2* t0 = tab32 + pr * 8 + 4 * (fq & 1); const LAS f32x2* t1 = tab32 + pc * 8 + 4 * (fq & 1);
#pragma unroll
                            for (int i = 0; i < 4; ++i) { const f32x2 c0 = t0[i], c1 = t1[i];
                                v0[i] = fq < 2 ? v0[i] * c0.x - p0[i] * c0.y : v0[i] * c0.x + p0[i] * c0.y;
                                v1[i] = fq < 2 ? v1[i] * c1.x - p1[i] * c1.y : v1[i] * c1.x + p1[i] * c1.y; } }
                        unsigned char* p = (unsigned char*)qB + (size_t)row * 768 + (2 * (slot - 6) + bj) * 128 + 64 + 4 * fq;
                        *(unsigned*)p = pk_fp8v(v0); *(unsigned*)(p + 16) = pk_fp8v(v1); *(unsigned*)(p + 32) = 0u; *(unsigned*)(p + 48) = 0u;
                    }
                }
                asm volatile("" ::: "memory");
            }
    }
};

struct EpiOutProj {
    static constexpr bool PERM = false, FP8 = false;
    unsigned char* ws; const float* xin; const float* cin; float* out; int l;
    DI void operator()(const Acc& acc, const g8::Unit& u, int wr, int wc, int fr, int fq) const {
        asm volatile("" : "+v"(fr), "+v"(fq));
        const int rowt = u.pm * 256 + wr * 64 + fr; const bool lat = (u.pm * 256) < LAT;
        const float* mod = (const float*)(ws + WS_MOD) + ((size_t)l * 9 + (lat ? (u.pm * 256) / 4096 : 8)) * 6144 + 2048;
        const int col0 = u.pn * 256 + wc * 32 + 4 * fq;
        f32x4 gv[2][2];
#pragma unroll
        for (int bj = 0; bj < 2; ++bj)
#pragma unroll
            for (int n = 0; n < 2; ++n) gv[bj][n] = *(const f32x4*)(mod + col0 + 128 * bj + 16 * n);
#pragma unroll
        for (int ai = 0; ai < 2; ++ai)
#pragma unroll
            for (int m = 0; m < 4; ++m) {
                const int row = rowt + ai * 128 + m * 16;
                const float* src = lat ? xin + (size_t)row * 1024 : cin + (size_t)(row - LAT) * 1024;
                float* dst = lat ? out + (size_t)row * 1024 : (float*)(ws + WS_CTXF) + (size_t)(row - LAT) * 1024;
#pragma unroll
                for (int bj = 0; bj < 2; ++bj)
#pragma unroll
                    for (int n = 0; n < 2; ++n) { const int c = col0 + 128 * bj + 16 * n; *(f32x4*)(dst + c) = *(const f32x4*)(src + c) + gv[bj][n] * acc[ai][bj][m][n]; }
            }
    }
};

constexpr int WSH = 6, HSH = 3;
struct EpiMoe1 {
    static constexpr bool PERM = true, FP8 = true;
    unsigned char* ws;
    DI void operator()(const Acc& acc, const g8::Unit& u, int wr, int wc, int fr, int fq) const {
        asm volatile("" : "+v"(fr), "+v"(fq));
        unsigned char* hid = ws + Z_HID; constexpr float SC = 1.0f / (float)(1 << WSH), HS = (float)(1 << HSH);
#pragma unroll
        for (int ai = 0; ai < 2; ++ai)
#pragma unroll
            for (int m = 0; m < 4; ++m) {
                const int row = u.pm * 256 + ai * 128 + wr * 64 + m * 16 + fr;
                f32x4 h0, h1;
#pragma unroll
                for (int i = 0; i < 4; ++i) { h0[i] = silu_f(acc[ai][0][m][0][i] * SC) * (acc[ai][1][m][0][i] * (SC * HS)); h1[i] = silu_f(acc[ai][0][m][1][i] * SC) * (acc[ai][1][m][1][i] * (SC * HS)); }
                u32x2 w; w.x = pk_fp8x4(h0.x, h0.y, h0.z, h0.w); w.y = pk_fp8x4(h1.x, h1.y, h1.z, h1.w);
                *(u32x2*)(hid + (size_t)row * 1024 + u.pn * 128 + wc * 32 + 8 * fq) = w;
            }
    }
};
struct EpiMoe2 {
    static constexpr bool PERM = true, FP8 = true;
    unsigned char* ws;
    DI void operator()(const Acc& acc, const g8::Unit& u, int wr, int wc, int fr, int fq) const {
        asm volatile("" : "+v"(fr), "+v"(fq));
        bf16_t* ye = (bf16_t*)(ws + Z_YE); const float* gate = (const float*)(ws + WS_GATE); constexpr float SC = 1.0f / (float)(1 << (WSH + HSH));
#pragma unroll
        for (int ai = 0; ai < 2; ++ai)
#pragma unroll
            for (int m = 0; m < 4; ++m) {
                const int row = u.pm * 256 + ai * 128 + wr * 64 + m * 16 + fr; const float gv = gate[row] * SC;
#pragma unroll
                for (int bj = 0; bj < 2; ++bj) { const f32x4 a = acc[ai][bj][m][0] * gv, b = acc[ai][bj][m][1] * gv; u32x4 w;
                    w.x = cvt_pk(a.x, a.y); w.y = cvt_pk(a.z, a.w); w.z = cvt_pk(b.x, b.y); w.w = cvt_pk(b.z, b.w);
                    *(u32x4*)(ye + (size_t)row * 1024 + u.pn * 256 + bj * 128 + wc * 32 + 8 * fq) = w; }
            }
    }
};
DI int crow(int i, int hh) { return (i & 3) + 8 * (i >> 2) + 4 * hh; }
typedef short v4i16_t __attribute__((ext_vector_type(4)));
DI s16x4 vtr(const LAS unsigned char* p) { return __builtin_bit_cast(s16x4, __builtin_amdgcn_ds_read_tr16_b64_v4i16((LAS v4i16_t*)p)); }
#define MFMA32(a, b, c) __builtin_amdgcn_mfma_f32_32x32x16_bf16((a), (b), (c), 0, 0, 0)

struct AttnDesc { const unsigned char* Q; int ldq, qoff; const unsigned char* K; int ldk, koff; const unsigned char* Vt; bf16_t* O; int ooff; float sink2; };
DI float fmax3(float a, float b, float c) { return __builtin_fmaxf(__builtin_fmaxf(a, b), c); }
typedef int i32x4 __attribute__((ext_vector_type(4)));
typedef int i32x8 __attribute__((ext_vector_type(8)));
#define MFMA8Z(acc, a, b, sa, sb) asm volatile("v_mfma_scale_f32_32x32x64_f8f6f4 %0, %1, %2, 0, %3, %4 op_sel_hi:[0,0,0]" : "=&v"(acc) : "v"(a), "v"(b), "v"(sa), "v"(sb))
#define MFMA8(acc, a, b, sa, sb) asm volatile("v_mfma_scale_f32_32x32x64_f8f6f4 %0, %1, %2, %0, %3, %4 op_sel_hi:[0,0,0]" : "+v"(acc) : "v"(a), "v"(b), "v"(sa), "v"(sb))
template <int DQB  , int MODE, bool TRACK, int ABL = 0>
DI void attn_unit(const int tid, LAS unsigned char* lds, const AttnDesc& d, int b, int qb, bool has_sink) {
    constexpr int KSTR = DQB + 16, VSTR = 80, KBUF = 64 * KSTR, VBUF = 64 * VSTR, NS = DQB / 64, KCH = DQB / 16;
    const int lane = tid & 63, wid = __builtin_amdgcn_readfirstlane(tid >> 6), r = lane & 31, hh = lane >> 5;
    const int q0 = qb * 256;
    const int qrow = (MODE == 2 ? LAT + b * 256 : b * 4096) + q0 + wid * 32 + r;
    int lo = 0, ntl = 0;
    if (MODE == 0) { lo = 0; ntl = 64; }
    if (MODE == 1) { lo = q0 - 128 < 0 ? 0 : q0 - 128; const int hi = q0 + 384 > 4096 ? 4096 : q0 + 384; ntl = (hi - lo) / 64; }
    const int NT = 4 + ntl;
    auto tile_row = [&](int t) -> int { return t < 4 ? LAT + b * 256 + t * 64 : b * 4096 + lo + (t - 4) * 64; };
    auto tile_T = [&](int t) -> int { return t < 4 ? t : 4 + lo / 64 + (t - 4); };
    i32x8 qf[NS];
#pragma unroll
    for (int s = 0; s < NS; ++s) { const unsigned char* qp = d.Q + (size_t)qrow * d.ldq + d.qoff + 64 * s + 32 * hh; const i32x4 lo4 = *(const i32x4*)qp, hi4 = *(const i32x4*)(qp + 16); qf[s] = __builtin_shufflevector(lo4, hi4, 0, 1, 2, 3, 4, 5, 6, 7); }
    const int sclK = 0x7F7F7F7F, sclQ = 0x7C7C7C7C;
    constexpr int KC1 = KCH + 1, VC1 = 5;
    const int kc0 = tid, kc1 = tid + 512;
    const int kr_0 = kc0 / KC1, kh_0 = kc0 % KC1, kr_1 = kc1 / KC1, kh_1 = kc1 % KC1, vr_0 = tid / VC1, vh_0 = tid % VC1;
    const unsigned kg0 = (unsigned)(kr_0 * d.ldk + d.koff + (kh_0 < KCH ? kh_0 : 0) * 16), kg1 = (unsigned)(kr_1 * d.ldk + d.koff + (kh_1 < KCH ? kh_1 : 0) * 16);
    const unsigned vg0 = (unsigned)(vr_0 * 64 + (vh_0 < 4 ? vh_0 : 0) * 16);
    auto dma_k = [&](int t, int buf) { const unsigned char* kb_ = d.K + (size_t)tile_row(t) * d.ldk;
        if (wid * 64 < 64 * KC1) __builtin_amdgcn_global_load_lds((const unsigned*)(kb_ + kg0), (LAS unsigned*)(lds + buf * KBUF + wid * 1024), 16, 0, 0);
        if (512 + wid * 64 < 64 * KC1) __builtin_amdgcn_global_load_lds((const unsigned*)(kb_ + kg1), (LAS unsigned*)(lds + buf * KBUF + 8192 + wid * 1024), 16, 0, 0); };
    auto dma_v = [&](int t, int buf) { const unsigned char* vb_ = d.Vt + (size_t)tile_T(t) * VT_TILE;
        if (wid < 5) __builtin_amdgcn_global_load_lds((const unsigned*)(vb_ + vg0), (LAS unsigned*)(lds + 2 * KBUF + buf * VBUF + wid * 1024), 16, 0, 0); };
#define DMA_WAIT() asm volatile("s_waitcnt vmcnt(0)" ::: "memory")
    constexpr float THR = 8.f, POFF = 6.f;
    static_assert(TRACK, "the fp8 P.V path needs the running row maximum");
    float m = -1e30f, l = 0.f;
    if (has_sink) { m = d.sink2 - POFF; l = hh == 0 ? __builtin_amdgcn_exp2f(POFF) : 0.f; }
    f32x16 o0, o1, s0, s1, n0, n1;
#pragma unroll
    for (int i = 0; i < 16; ++i) { o0[i] = 0.f; o1[i] = 0.f; }
    const int koffl = r * KSTR + hh * 32;
    const int voffl = r * VSTR + hh * 32;
    const int sclV = 0x7F7F7F7F;
    i32x8 pf;
    auto kfrag = [&](const LAS unsigned char* p) -> i32x8 { const i32x4 lo4 = *(const LAS i32x4*)p, hi4 = *(const LAS i32x4*)(p + 16); return __builtin_shufflevector(lo4, hi4, 0, 1, 2, 3, 4, 5, 6, 7); };
    auto qk = [&](int buf, f32x16& a0, f32x16& a1, float init) { const LAS unsigned char* kb = lds + buf * KBUF + koffl;
#pragma unroll
        for (int i = 0; i < 16; ++i) { a0[i] = init; a1[i] = init; }
        asm volatile("s_nop 1" : "+v"(a0), "+v"(a1));
#pragma unroll
        for (int s = 0; s < NS; ++s) { const i32x8 x0 = kfrag(kb + s * 64), x1 = kfrag(kb + 32 * KSTR + s * 64); MFMA8(a0, x0, qf[s], sclK, sclQ); MFMA8(a1, x1, qf[s], sclK, sclQ); }
        asm volatile("s_nop 15\n\ts_nop 15\n\ts_nop 7" : "+v"(a0), "+v"(a1)); };
    auto pv = [&](int buf) { const LAS unsigned char* vb = lds + 2 * KBUF + buf * VBUF + voffl;
        const i32x8 v0 = kfrag(vb), v1 = kfrag(vb + 32 * VSTR);
        asm volatile("s_nop 1" : "+v"(pf));
        MFMA8(o0, v0, pf, sclV, sclV); MFMA8(o1, v1, pf, sclV, sclV); };
    auto mask = [&](int t) {
        if (MODE == 1) { if (t >= 4) { const int kp0 = lo + (t - 4) * 64, qp = q0 + wid * 32 + r;
#pragma unroll
            for (int i = 0; i < 16; ++i) { const int dk0 = kp0 + crow(i, hh) - qp, dk1 = dk0 + 32;
                if (dk0 > 128 || dk0 < -128) s0[i] = -1e30f; if (dk1 > 128 || dk1 < -128) s1[i] = -1e30f; } } } };
    auto rowmax = [&]() -> float {
        float ma = fmax3(s0[0], s0[1], s1[0]), mb = fmax3(s0[2], s0[3], s1[1]); ma = fmax3(ma, s1[2], s1[3]);
#pragma unroll
        for (int i = 4; i < 16; i += 4) { ma = fmax3(ma, s0[i], s0[i + 1]); mb = fmax3(mb, s0[i + 2], s0[i + 3]); ma = fmax3(ma, s1[i], s1[i + 1]); mb = fmax3(mb, s1[i + 2], s1[i + 3]); }
        float mx = __builtin_fmaxf(ma, mb);
        auto rr = __builtin_amdgcn_permlane32_swap(__float_as_uint(mx), __float_as_uint(mx), false, false); return __builtin_fmaxf(__uint_as_float(rr[0]), __uint_as_float(rr[1])); };
    auto pack = [&]() {
        pf[0] = (int)pk_fp8x4(s0[0], s0[1], s0[2], s0[3]);   pf[1] = (int)pk_fp8x4(s0[4], s0[5], s0[6], s0[7]);   pf[2] = (int)pk_fp8x4(s0[8], s0[9], s0[10], s0[11]); pf[3] = (int)pk_fp8x4(s0[12], s0[13], s0[14], s0[15]);
        pf[4] = (int)pk_fp8x4(s1[0], s1[1], s1[2], s1[3]);   pf[5] = (int)pk_fp8x4(s1[4], s1[5], s1[6], s1[7]);   pf[6] = (int)pk_fp8x4(s1[8], s1[9], s1[10], s1[11]); pf[7] = (int)pk_fp8x4(s1[12], s1[13], s1[14], s1[15]); };
    auto exp_pack = [&]() {
        float ps0 = 0.f, ps1 = 0.f;
#pragma unroll
        for (int i = 0; i < 16; ++i) { s0[i] = __builtin_amdgcn_exp2f(s0[i]); s1[i] = __builtin_amdgcn_exp2f(s1[i]); ps0 += s0[i]; ps1 += s1[i]; }
        l += ps0 + ps1; pack(); };
#define SEG_BAR() do { asm volatile("s_waitcnt lgkmcnt(0)" ::: "memory"); __builtin_amdgcn_s_barrier(); asm volatile("" ::: "memory"); } while (0)
    const bool g1 = false;
    auto opA = [&](int t, bool n_valid) {
        mask(t);
        const float mx = rowmax();
#pragma unroll
        for (int i = 0; i < 16; ++i) { s0[i] = __builtin_amdgcn_exp2f(s0[i]); s1[i] = __builtin_amdgcn_exp2f(s1[i]); }
        if (__builtin_expect(__any(mx > THR), 0)) {
            const float dl = __builtin_fmaxf(mx - POFF, 0.f), alpha = __builtin_amdgcn_exp2f(-dl);
            asm volatile("s_nop 15\n\ts_nop 7" : "+v"(o0), "+v"(o1));
            m += dl; l *= alpha;
#pragma unroll
            for (int i = 0; i < 16; ++i) { o0[i] *= alpha; o1[i] *= alpha; s0[i] *= alpha; s1[i] *= alpha; }
            if (n_valid) {
#pragma unroll
                for (int i = 0; i < 16; ++i) { n0[i] -= dl; n1[i] -= dl; } }
        }
        float ps0 = 0.f, ps1 = 0.f, ps2 = 0.f, ps3 = 0.f;
#pragma unroll
        for (int i = 0; i < 16; i += 4) { ps0 += s0[i] + s1[i]; ps1 += s0[i + 1] + s1[i + 1]; ps2 += s0[i + 2] + s1[i + 2]; ps3 += s0[i + 3] + s1[i + 3]; }
        l += (ps0 + ps1) + (ps2 + ps3); };
    auto opB = [&](auto has_next_c, int nbuf, int pvbuf) {
        constexpr bool HAS_NEXT = decltype(has_next_c)::value;
        if constexpr (HAS_NEXT) {
            const LAS unsigned char* kb = lds + nbuf * KBUF + koffl;
            if constexpr (TRACK) { const float negm = -m;
#pragma unroll
                for (int i = 0; i < 16; ++i) { n0[i] = negm; n1[i] = negm; }
                asm volatile("s_nop 1" : "+v"(n0), "+v"(n1)); }
            i32x8 x0 = kfrag(kb), x1 = kfrag(kb + 32 * KSTR);
            if constexpr (TRACK) { MFMA8(n0, x0, qf[0], sclK, sclQ); MFMA8(n1, x1, qf[0], sclK, sclQ); } else { MFMA8Z(n0, x0, qf[0], sclK, sclQ); MFMA8Z(n1, x1, qf[0], sclK, sclQ); }
            if constexpr (NS == 2) { const i32x8 y0 = kfrag(kb + 64), y1 = kfrag(kb + 32 * KSTR + 64); MFMA8(n0, y0, qf[1], sclK, sclQ); MFMA8(n1, y1, qf[1], sclK, sclQ); }
        }
        pv(pvbuf); };
    __syncthreads();
    dma_k(0, 0); dma_k(1, 1); DMA_WAIT();
    __syncthreads();
    qk(0, s0, s1, 0.f);
    __syncthreads();
    dma_k(2, 0); dma_v(0, 0);
    mask(0);
    if (TRACK) { const float mx0 = rowmax(); const float mn = __builtin_fmaxf(m, mx0 - POFF); const float alpha = __builtin_amdgcn_exp2f(m - mn); l *= alpha; m = mn;
#pragma unroll
      for (int i = 0; i < 16; ++i) { s0[i] -= mn; s1[i] -= mn; } }
    qk(1, n0, n1, -m);
    exp_pack();
    s0 = n0; s1 = n1;
    DMA_WAIT();
    __syncthreads();
    for (int t = 1; t < (ABL == 6 ? 2 : NT - 1); ++t) {
        if (ABL != 1 && ABL != 5) { dma_k(t + 2 < NT ? t + 2 : NT - 1, t & 1); dma_v(t, t & 1); }
        opB(std::true_type{}, (t + 1) & 1, (t - 1) & 1);
        opA(t, true);
        pack();
        DMA_WAIT(); SEG_BAR();
        s0 = n0; s1 = n1;
    }
    dma_v(NT - 1, (NT - 1) & 1);
    opB(std::false_type{}, 0, (NT - 2) & 1);
    opA(NT - 1, false); pack();
    DMA_WAIT(); SEG_BAR();
    pv((NT - 1) & 1);
    asm volatile("s_nop 15\n\ts_nop 15" : "+v"(o0), "+v"(o1));
    { auto rr = __builtin_amdgcn_permlane32_swap(__float_as_uint(l), __float_as_uint(l), false, false); l = __uint_as_float(rr[0]) + __uint_as_float(rr[1]); }
    const float inv = 1.0f / l;
    bf16_t* op = d.O + (size_t)qrow * 1024 + d.ooff + 4 * hh;
#pragma unroll
    for (int g4 = 0; g4 < 4; ++g4) {
        u32x2 w; w.x = cvt_pk(o0[4 * g4] * inv, o0[4 * g4 + 1] * inv); w.y = cvt_pk(o0[4 * g4 + 2] * inv, o0[4 * g4 + 3] * inv); *(u32x2*)(op + 8 * g4) = w;
        u32x2 x; x.x = cvt_pk(o1[4 * g4] * inv, o1[4 * g4 + 1] * inv); x.y = cvt_pk(o1[4 * g4 + 2] * inv, o1[4 * g4 + 3] * inv); *(u32x2*)(op + 32 + 8 * g4) = x;
    }
}

#ifndef TRACK_EN
#define TRACK_EN 1
#endif
DI void attn_phase(const Frame& F, int l, bool with_ctx, int rep = 0) {
    constexpr int NU_B = NB * 96, NU_A = NB * 96, NU_C = NB * 64, NU_X = NB * 16;
    const int NU = NU_B + NU_A + NU_C + (with_ctx ? NU_X : 0);
    unsigned* head = F.ctl + CW_QUEUE + 64 * (l + 2 * rep);
    volatile LAS int* slot = (volatile LAS int*)(F.lds + LDS_MISC + 16);
    const float* sinkp = INP(21) + l * 4;
    bool track;
    { auto amax = [&](const float* g, int n) { float v = 0.f; for (int i = 0; i < n; ++i) v = fmaxf(v, fabsf(g[i])); return v; };
      const float ga = 8.f * amax(INP(9) + l * 64, 64) * amax(INP(10) + l * 64, 64), gc = 8.f * amax(INP(19) + l * 64, 64) * amax(INP(20) + l * 64, 64);
      const float qn = amax(INP(15) + l * 64, 64), qr = amax(INP(17) + l * 32, 32), kn = amax(INP(16) + l * 64, 64), kr = amax(INP(18) + l * 32, 32);
      const float gb = sqrtf((64.f * qn * qn + 32.f * qr * qr) * (64.f * kn * kn + 32.f * kr * kr) / 96.f);
      const float sk = fmaxf(fmaxf(fabsf(sinkp[0]), fabsf(sinkp[1])), fmaxf(fabsf(sinkp[2]), fabsf(sinkp[3])));
      const float bound = fmaxf(fmaxf(ga, gc), fmaxf(gb, sk)) * LOG2E;
      track = !(bound < 100.f); }
    for (;;) {
        __syncthreads();
        if (F.tid == 0) *slot = (int)__hip_atomic_fetch_add(head, 1u, __ATOMIC_RELAXED, __HIP_MEMORY_SCOPE_AGENT);
        __syncthreads();
        int u = *slot; if (u >= NU) break;
        GAS unsigned char* wsg = (GAS unsigned char*)F.ws; asm volatile("" : "+s"(wsg)); unsigned char* ws = (unsigned char*)wsg;
        int tidu = F.tid; asm volatile("" : "+v"(tidu));
        AttnDesc d;
        if (u < NU_B) { const int b = u / 96, h = (u % 96) / 16, qb = u % 16;
            d = AttnDesc{(const unsigned char*)(ws + Z_QB), 768, h * 128, (const unsigned char*)(ws + Z_KB), 768, h * 128, (const unsigned char*)(ws + Z_VB) + ((size_t)b * 6 + h) * VT_HEAD, (bf16_t*)(ws + Z_OB), 384 + h * 64, 0.f};
#ifdef ATT_ABL
            if (rep) { attn_unit<128, 0, true, ATT_ABL>(tidu, F.lds, d, b, qb, false); continue; }
#endif
            attn_unit<128, 0, true>(tidu, F.lds, d, b, qb, false); continue; }
        u -= NU_B;
        if (u < NU_A) { const int b = u / 96, h = (u % 96) / 16, qb = u % 16;
            d = AttnDesc{(const unsigned char*)(ws + Z_QA), 384, h * 64, (const unsigned char*)(ws + Z_KA), 128, (h / 3) * 64, (const unsigned char*)(ws + Z_VA) + ((size_t)b * 2 + h / 3) * VT_HEAD, (bf16_t*)(ws + Z_OB), h * 64, 0.f};
#ifdef ATT_ABL
            if (rep) { attn_unit<64, 0, true, ATT_ABL>(tidu, F.lds, d, b, qb, false); continue; }
#endif
            attn_unit<64, 0, true>(tidu, F.lds, d, b, qb, false); continue; }
        u -= NU_A;
        if (u < NU_C) { const int b = u / 64, h = (u % 64) / 16, qb = u % 16;
            d = AttnDesc{(const unsigned char*)(ws + Z_QC), 256, h * 64, (const unsigned char*)(ws + Z_KC), 128, (h / 2) * 64, (const unsigned char*)(ws + Z_VC) + ((size_t)b * 2 + h / 2) * VT_HEAD, (bf16_t*)(ws + Z_OB), 768 + h * 64, sinkp[h] * LOG2E};
            attn_unit<64, 1, true>(tidu, F.lds, d, b, qb, true); continue; }
        u -= NU_C;
        { const int b = u / 16, hx = u % 16;
            if (hx < 6) { const int h = hx;
                d = AttnDesc{(const unsigned char*)(ws + Z_QA), 384, h * 64, (const unsigned char*)(ws + Z_KA), 128, (h / 3) * 64, (const unsigned char*)(ws + Z_VA) + ((size_t)b * 2 + h / 3) * VT_HEAD, (bf16_t*)(ws + Z_OB), h * 64, 0.f};
                attn_unit<64, 2, true>(tidu, F.lds, d, b, 0, false); }
            else if (hx < 12) { const int h = hx - 6;
                d = AttnDesc{(const unsigned char*)(ws + Z_QB), 768, h * 128, (const unsigned char*)(ws + Z_KB), 768, h * 128, (const unsigned char*)(ws + Z_VB) + ((size_t)b * 6 + h) * VT_HEAD, (bf16_t*)(ws + Z_OB), 384 + h * 64, 0.f};
                attn_unit<128, 2, true>(tidu, F.lds, d, b, 0, false); }
            else { const int h = hx - 12;
                d = AttnDesc{(const unsigned char*)(ws + Z_QC), 256, h * 64, (const unsigned char*)(ws + Z_KC), 128, (h / 2) * 64, (const unsigned char*)(ws + Z_VC) + ((size_t)b * 2 + h / 2) * VT_HEAD, (bf16_t*)(ws + Z_OB), 768 + h * 64, sinkp[h] * LOG2E};
                attn_unit<64, 2, true>(tidu, F.lds, d, b, 0, true); }
        }
    }
}

DI void router_phase(const Frame& F, int l, bool with_ctx) {
    LAS float* wT = (LAS float*)F.lds;
    const float* wr = INP(23) + (size_t)l * 1024 * 16;
    for (int e = F.tid; e < 16 * 1024; e += NTHR) { const int k = e / 16, x = e % 16; wT[x * 1024 + k] = wr[e]; }
    __syncthreads();
    const int gw = F.bid * NWAVES + F.wave, NGW = F.G * NWAVES, NR = with_ctx ? R : LAT, lane = F.lane;
    const float* g = INP(7) + l * 1024;
    auto rowptr = [&](int row) -> const float* { return row < LAT ? F.out + (size_t)row * 1024 : WSP(float, WS_CTXF) + (size_t)(row - LAT) * 1024; };
    f32x4 vn[4];
    if (gw < NR) { const float* xr0 = rowptr(gw);
#pragma unroll
        for (int j = 0; j < 4; ++j) vn[j] = *(const f32x4*)(xr0 + 4 * (lane + 64 * j)); }
    for (int row = gw; row < NR; row += NGW) {
        const float* m = mod_row(F, l, row);
        f32x4 v[4]; float s = 0.f;
#pragma unroll
        for (int j = 0; j < 4; ++j) { v[j] = vn[j]; s += (v[j].x * v[j].x + v[j].y * v[j].y) + (v[j].z * v[j].z + v[j].w * v[j].w); }
        if (row + NGW < NR) { const float* xr1 = rowptr(row + NGW);
#pragma unroll
            for (int j = 0; j < 4; ++j) vn[j] = *(const f32x4*)(xr1 + 4 * (lane + 64 * j)); }
        const float rstd = 1.0f / sqrtf(wave_sum(s) * (1.f / 1024.f) + EPS);
        float lg[16];
#pragma unroll
        for (int e = 0; e < 16; ++e) lg[e] = 0.f;
        unsigned char* orow = WSP(unsigned char, WS_HB) + (size_t)row * 1024;
#pragma unroll
        for (int j = 0; j < 4; ++j) { const int c = 4 * (lane + 64 * j); const f32x4 gv = *(const f32x4*)(g + c), sv = *(const f32x4*)(m + 3072 + c), cv = *(const f32x4*)(m + 4096 + c);
            v[j] = v[j] * rstd * gv * (cv + 1.0f) + sv; *(unsigned*)(orow + c) = pk_fp8x4(v[j].x, v[j].y, v[j].z, v[j].w); }
        asm volatile("" ::: "memory");
#pragma unroll
        for (int e = 0; e < 16; ++e) {
#pragma unroll
            for (int j = 0; j < 4; ++j) { const f32x4 wv = *(const LAS f32x4*)(wT + e * 1024 + 4 * (lane + 64 * j)); lg[e] += (v[j].x * wv.x + v[j].y * wv.y) + (v[j].z * wv.z + v[j].w * wv.w); }
            if (e & 1) asm volatile("" ::: "memory"); }
#pragma unroll
        for (int e = 0; e < 16; ++e) lg[e] = wave_sum(lg[e]);
        float mx = lg[0];
#pragma unroll
        for (int e = 1; e < 16; ++e) mx = fmaxf(mx, lg[e]);
        float sum = 0.f;
#pragma unroll
        for (int e = 0; e < 16; ++e) { lg[e] = expf(lg[e] - mx); sum += lg[e]; }
        const float isum = 1.0f / sum;
        float mine = 0.f;
#pragma unroll
        for (int e = 0; e < 16; ++e) mine = (lane == e) ? lg[e] * isum : mine;
        if (lane < 16) {
            if (row < LAT) WSP(float, WS_AFFL)[((size_t)(row / 4096) * 16 + lane) * 4096 + (row & 4095)] = mine;
            else { const int rc = row - LAT; WSP(float, WS_AFFC)[((size_t)(rc / 256) * 16 + lane) * 256 + (rc & 255)] = mine; }
        }
    }
}

DI void topk_phase(const Frame& F, bool with_ctx) {
    LAS unsigned* hist = (LAS unsigned*)F.lds;
    LAS unsigned* sh = hist + 256;
    LAS unsigned* scan = hist + 512;
    const int NL = NB * 16 * (with_ctx ? 2 : 1), tid = F.tid;
    for (int li = F.bid; li < NL; li += F.G) {
        const bool isctx = li >= NB * 16; const int be = isctx ? li - NB * 16 : li, b = be / 16, e = be % 16;
        const int n = isctx ? 256 : 4096, cap = n / 8, per = isctx ? 1 : 8;
        const float* a = isctx ? WSP(float, WS_AFFC) + (size_t)be * 256 : WSP(float, WS_AFFL) + (size_t)be * 4096;
        unsigned key[8]; const bool act = tid * per < n;
#pragma unroll
        for (int j = 0; j < 8; ++j) key[j] = (act && j < per) ? __float_as_uint(a[tid * per + j]) : 0u;
        unsigned prefix = 0u, rem = (unsigned)cap;
        for (int pass = 0; pass < 4; ++pass) {
            const int shift = 24 - 8 * pass;
            __syncthreads();
            if (tid < 256) hist[tid] = 0u;
            __syncthreads();
#pragma unroll
            for (int j = 0; j < 8; ++j) if (act && j < per) { const unsigned k = key[j]; const bool match = pass == 0 ? true : ((k >> (shift + 8)) == (prefix >> (shift + 8))); if (match) __hip_atomic_fetch_add(&hist[(k >> shift) & 255u], 1u, __ATOMIC_RELAXED, __HIP_MEMORY_SCOPE_WORKGROUP); }
            __syncthreads();
            if (tid < 64) {
                const int b0 = 255 - 4 * tid; const unsigned c0 = hist[b0], c1 = hist[b0 - 1], c2 = hist[b0 - 2], c3 = hist[b0 - 3];
                unsigned incl = c0 + c1 + c2 + c3;
#pragma unroll
                for (int o = 1; o < 64; o <<= 1) { const unsigned v = shfl_up_u(incl, o, tid); if (tid >= o) incl += v; }
                unsigned cum = incl - (c0 + c1 + c2 + c3);
                if (cum < rem && incl >= rem) { int bin = b0; unsigned c = c0;
                    if (cum + c < rem) { cum += c; bin = b0 - 1; c = c1; if (cum + c < rem) { cum += c; bin = b0 - 2; c = c2; if (cum + c < rem) { cum += c; bin = b0 - 3; } } }
                    sh[0] = prefix | ((unsigned)bin << shift); sh[1] = rem - cum; }
            }
            __syncthreads();
            prefix = sh[0]; rem = sh[1];
        }
        unsigned cg = 0u, ce = 0u;
#pragma unroll
        for (int j = 0; j < 8; ++j) if (act && j < per) { cg += key[j] > prefix ? 1u : 0u; ce += key[j] == prefix ? 1u : 0u; }
        __syncthreads();
        scan[tid] = cg; scan[512 + tid] = ce;
        __syncthreads();
        unsigned gb, eb;
        {
            unsigned ig = cg, ie = ce; const int ln = tid & 63, wv = tid >> 6;
#pragma unroll
            for (int o = 1; o < 64; o <<= 1) { const unsigned vg = shfl_up_u(ig, o, ln), ve = shfl_up_u(ie, o, ln); if (ln >= o) { ig += vg; ie += ve; } }
            if (ln == 63) { scan[1024 + wv] = ig; scan[1040 + wv] = ie; }
            __syncthreads();
            unsigned og = 0u, oe = 0u;
#pragma unroll
            for (int w = 0; w < 8; ++w) { if (w < wv) { og += scan[1024 + w]; oe += scan[1040 + w]; } }
            gb = og + ig - cg; eb = oe + ie - ce;
        }
        const int rowb = isctx ? LAT + b * 256 : b * 4096;
        const int mbase = isctx ? MOE_LAT + e * 256 + b * 32 : (b * 16 + e) * 512;
        int* gidx = WSP(int, WS_GIDX); float* gate = WSP(float, WS_GATE); int* inv = WSP(int, WS_INV);
#pragma unroll
        for (int j = 0; j < 8; ++j) if (act && j < per) {
            const unsigned k = key[j]; const int t = tid * per + j; int slot = -1;
            if (k > prefix) { slot = (int)(gb + (eb < rem ? eb : rem)); ++gb; }
            else if (k == prefix) { if (eb < rem) slot = (int)(gb + eb); ++eb; }
            if (slot >= 0) { gidx[mbase + slot] = rowb + t; gate[mbase + slot] = __uint_as_float(k); }
            inv[(size_t)(rowb + t) * 16 + e] = slot >= 0 ? mbase + slot : -1;
        }
        if (isctx && NB < 8 && b == 0) { for (int i = NB * 32 + tid; i < 256; i += NTHR) { gidx[MOE_LAT + e * 256 + i] = LAT; gate[MOE_LAT + e * 256 + i] = 0.f; } }
    }
}

DI void combine_phase(const Frame& F, int l, bool with_ctx) {
    const int gw = F.bid * NWAVES + F.wave, NGW = F.G * NWAVES, NR = with_ctx ? R : LAT, lane = F.lane;
    const bool last = (l == DEPTH - 1);
    const bf16_t* ye = WSP(bf16_t, Z_YE); const int* inv = WSP(int, WS_INV);
    for (int row = gw; row < NR; row += NGW) {
        float* xr = row < LAT ? F.out + (size_t)row * 1024 : WSP(float, WS_CTXF) + (size_t)(row - LAT) * 1024;
        const float* m = mod_row(F, l, row);
        f32x4 acc[4];
#pragma unroll
        for (int j = 0; j < 4; ++j) acc[j] = (f32x4){0.f, 0.f, 0.f, 0.f};
        const int myslot = lane < 16 ? inv[(size_t)row * 16 + lane] : -1;
#pragma unroll
        for (int e = 0; e < 16; ++e) { const int s = __builtin_amdgcn_readlane(myslot, e); if (s >= 0) { const bf16_t* yr = ye + (size_t)s * 1024;
#pragma unroll
                for (int j = 0; j < 4; ++j) { const u32x2 w = *(const u32x2*)(yr + 4 * (lane + 64 * j)); acc[j].x += bf_lo(w.x); acc[j].y += bf_hi(w.x); acc[j].z += bf_lo(w.y); acc[j].w += bf_hi(w.y); } } }
        f32x4 v[4];
#pragma unroll
        for (int j = 0; j < 4; ++j) { const int c = 4 * (lane + 64 * j); v[j] = *(const f32x4*)(xr + c) + *(const f32x4*)(m + 5120 + c) * acc[j]; *(f32x4*)(xr + c) = v[j]; }
        if (!last) { const float* m2 = mod_row(F, l + 1, row); norm_mod_store(v, INP(6) + (l + 1) * 1024, m2, m2 + 1024, WSP(unsigned char, WS_HB) + (size_t)row * 1024, lane); }
    }
}
constexpr int NPHASE = 2 + 9 * DEPTH;
DI void load_tabs(const Frame& F) {
    const f32x2* t64 = WSP(f32x2, WS_TAB64); const f32x2* t32 = WSP(f32x2, WS_TAB32);
    LAS f32x2* l64 = (LAS f32x2*)(F.lds + LDS_TAB64); LAS f32x2* l32 = (LAS f32x2*)(F.lds + LDS_TAB32);
    for (int i = F.tid; i < 64 * 16; i += NTHR) l64[i] = t64[i];
    for (int i = F.tid; i < 64 * 8; i += NTHR) l32[i] = t32[i];
    __syncthreads();
}
#ifndef PH_EN
#define PH_EN(k) 1
#endif
DI void run_phase(const Frame& F, int ph, int rep = 0) {
    unsigned char* ws = F.ws;
    if (ph == 0) { if (PH_EN(100)) p0_phase(F); return; }
    if (ph == 1) { if (PH_EN(101)) init_norm_phase(F); return; }
    const int l = (ph - 2) / 9, s = (ph - 2) % 9; const bool last = (l == DEPTH - 1);
    switch (s) {
    case 0: if (PH_EN(0)) { load_tabs(F);
        g8::DenseSched S; S.init(MT, 6, F.G, F.bid, 512, ws + WS_WIN + (size_t)l * 1536 * 1024);
        EpiInProj E{ws, F.intab, l, (const LAS f32x2*)(F.lds + LDS_TAB64), (const LAS f32x2*)(F.lds + LDS_TAB32)};
        g8::gemm_phase(F.tid, F.lds, (const char*)(ws + WS_HB), 512, S, E); } break;
    case 1: if (PH_EN(1)) { load_tabs(F);
        g8::DenseSched S; S.init(MT, 6, F.G, F.bid, 384, ws + WS_WUP + (size_t)l * 1536 * 384 * 2);
        EpiUpProj E{ws, F.intab, l, (const LAS f32x2*)(F.lds + LDS_TAB32)};
        g8::gemm_phase(F.tid, F.lds, (const char*)(ws + Z_CRAW), 384, S, E); } break;
    case 2: if (PH_EN(2)) attn_phase(F, l, !last, rep); break;
    case 3: if (PH_EN(3)) { g8::DenseSched S; S.init(last ? LAT / 256 : MT, 4, F.G, F.bid, 1024, ws + WS_WOUT + (size_t)l * 1024 * 1024 * 2);
        EpiOutProj E{ws, l == 0 ? INP(0) : F.out, INP(2), F.out, l};
        g8::gemm_phase(F.tid, F.lds, (const char*)(ws + Z_OB), 1024, S, E); } break;
    case 4: if (PH_EN(4)) router_phase(F, l, !last); break;
    case 5: if (PH_EN(5)) topk_phase(F, !last); break;
    case 6: if (PH_EN(6)) { g8::MoeSched<true> S; S.init(8, !last, F.G, F.bid, 512, ws + WS_W1 + (size_t)l * 16 * 2048 * 1024, (size_t)2048 * 1024, (const int*)(ws + WS_GIDX));
        EpiMoe1 E{ws}; g8::gemm_phase(F.tid, F.lds, (const char*)(ws + WS_HB), 512, S, E); } break;
    case 7: if (PH_EN(7)) { g8::MoeSched<false> S; S.init(4, !last, F.G, F.bid, 512, ws + WS_W2 + (size_t)l * 16 * 1024 * 1024, (size_t)1024 * 1024, nullptr);
        EpiMoe2 E{ws}; g8::gemm_phase(F.tid, F.lds, (const char*)(ws + Z_HID), 512, S, E); } break;
    case 8: if (PH_EN(8)) combine_phase(F, l, !last); break;
    }
}
__global__ void __launch_bounds__(NTHR, 2) mega_kernel(Args a) {
    extern __shared__ __attribute__((aligned(16))) unsigned char lds_raw[];
    Frame F; F.lds = (LAS unsigned char*)lds_raw; F.ws = a.ws; F.ctl = (unsigned*)(a.ws + WS_CTL);
    F.tid = threadIdx.x; F.lane = F.tid & 63; F.wave = __builtin_amdgcn_readfirstlane(F.tid >> 6); F.G = gridDim.x; F.bid = blockIdx.x; F.out = a.out;
    { LAS unsigned long long* tab = (LAS unsigned long long*)(F.lds + LDS_INTAB); if (F.tid < 27) tab[F.tid] = (unsigned long long)a.in[F.tid]; F.intab = tab; }
    volatile LAS unsigned* MISC = (volatile LAS unsigned*)(F.lds + LDS_MISC);
    if (F.tid < 64) MISC[F.tid] = 0u;
    __syncthreads();
    const bool multi = a.ph_hi - a.ph_lo > 1;
    XcdBarrier bar; bar.bar = F.ctl + CW_BAR + a.li * XCD_BAR_WORDS; bar.x = 0; bar.st = MISC;
    if (multi) bar = xcd_barrier_post(F.ctl + CW_BAR + a.li * XCD_BAR_WORDS, MISC);
    for (int ph = a.ph_lo; ph < a.ph_hi; ++ph) {
        {
            GAS unsigned char* w_ = (GAS unsigned char*)a.ws; GAS float* o_ = (GAS float*)a.out; unsigned l_ = (unsigned)(unsigned long long)F.lds, t_ = (unsigned)(unsigned long long)F.intab; int tid_ = threadIdx.x, g_ = gridDim.x, b_ = blockIdx.x;
            asm volatile("" : "+s"(w_), "+s"(o_), "+s"(l_), "+s"(t_), "+v"(tid_), "+s"(g_), "+s"(b_));
            F.ws = (unsigned char*)w_; F.out = (float*)o_; F.lds = (LAS unsigned char*)(unsigned long long)l_; F.intab = (const LAS unsigned long long*)(unsigned long long)t_; F.ctl = (unsigned*)(F.ws + WS_CTL);
            F.tid = tid_; F.lane = tid_ & 63; F.wave = __builtin_amdgcn_readfirstlane(tid_ >> 6); F.G = g_; F.bid = b_; }
        run_phase(F, ph, a.li);
#ifdef PROBE_I
        xcd_barrier(bar);
        if (F.bid == 0 && F.tid == 0) ((unsigned long long*)(F.ws + 49152))[ph + 1] = __builtin_amdgcn_s_memrealtime();
#else
        if (ph + 1 < a.ph_hi) xcd_barrier(bar);
#endif
    }
#ifdef PROBE_I
    {
        xcd_barrier(bar);
        const unsigned long long* ts = (const unsigned long long*)(F.ws + 49152);
        float ti = (float)(__hip_atomic_load(ts + PROBE_I + 1, __ATOMIC_RELAXED, __HIP_MEMORY_SCOPE_AGENT) - __hip_atomic_load(ts + PROBE_I, __ATOMIC_RELAXED, __HIP_MEMORY_SCOPE_AGENT)) * 0.01f;
        float tj = (float)(__hip_atomic_load(ts + PROBE_J + 1, __ATOMIC_RELAXED, __HIP_MEMORY_SCOPE_AGENT) - __hip_atomic_load(ts + PROBE_J, __ATOMIC_RELAXED, __HIP_MEMORY_SCOPE_AGENT)) * 0.01f;
        ti = exp2f(rintf(log2f(fmaxf(ti, 1.f)) * 14.2067f) / 14.2067f); tj = exp2f(rintf(log2f(fmaxf(tj, 1.f)) * 14.2067f) / 14.2067f);
        const float* xin = inp(F.intab, 0); const size_t n = (size_t)8 * 4096 * 1024;
        for (size_t i = (size_t)F.bid * NTHR + F.tid; i < n; i += (size_t)F.G * NTHR) F.out[i] = xin[i] + ti + (i == 0 ? 100.f * tj : 0.f);
    }
#endif
}
}

extern "C" void kernel_launch(void* const* d_in, const int* in_sizes, int n_in, void* d_out, int out_size, void* d_ws, size_t ws_size, hipStream_t stream) {
    static int grid = 0;
    if (grid == 0) {
        if (n_in != 27 || out_size != 8 * 4096 * 1024 || ws_size < fp::WS_END) { fprintf(stderr, "kernel_launch: unexpected problem (n_in %d, out %d, ws %zu < %zu)\n", n_in, out_size, ws_size, (size_t)fp::WS_END); grid = -1; return; }
        int dev = 0, cus = 0, per_cu = 0;
        if (hipGetDevice(&dev) != hipSuccess || hipDeviceGetAttribute(&cus, hipDeviceAttributeMultiprocessorCount, dev) != hipSuccess) { fprintf(stderr, "kernel_launch: device query failed\n"); grid = -1; return; }
        if (hipFuncSetAttribute((const void*)fp::mega_kernel, hipFuncAttributeMaxDynamicSharedMemorySize, fp::LDS_BYTES) != hipSuccess) { fprintf(stderr, "kernel_launch: hipFuncSetAttribute failed\n"); grid = -1; return; }
        if (hipOccupancyMaxActiveBlocksPerMultiprocessor(&per_cu, (const void*)fp::mega_kernel, fp::NTHR, fp::LDS_BYTES) != hipSuccess || per_cu < 1) fprintf(stderr, "kernel_launch: note: occupancy query reports %d workgroups per CU\n", per_cu);
        (void)hipGetLastError();
        grid = cus;
    }
    if (grid < 0) return;
    if (hipMemsetAsync((char*)d_ws + fp::WS_CTL, 0, fp::CTL_BYTES, stream) != hipSuccess) { fprintf(stderr, "kernel_launch: memset failed\n"); return; }
    fp::Args a{};
    for (int i = 0; i < 27; ++i) a.in[i] = (const float*)d_in[i];
    a.out = (float*)d_out; a.ws = (unsigned char*)d_ws; a.ph_lo = 0; a.ph_hi = fp::NPHASE;
#ifdef PROBE_SPLIT_LO
    a.ph_hi = PROBE_SPLIT_HI; a.li = 1; hipLaunchKernelGGL(fp::mega_kernel, dim3(grid), dim3(fp::NTHR), fp::LDS_BYTES, stream, a);
    a.ph_lo = PROBE_SPLIT_LO; a.ph_hi = fp::NPHASE; a.li = 0;
#endif
    hipLaunchKernelGGL(fp::mega_kernel, dim3(grid), dim3(fp::NTHR), fp::LDS_BYTES, stream, a);
}
```

```cpp
#include <hip/hip_runtime.h>
#include <stdint.h>
#include <stdio.h>
#include <math.h>
#include <type_traits>
constexpr int DEPTH = 2;
#define FAST_NB 8
namespace fp {
#define LAS __attribute__((address_space(3)))
#define GAS __attribute__((address_space(1)))
typedef unsigned short bf16_t;
typedef short bf16x8 __attribute__((ext_vector_type(8)));
typedef short s16x4 __attribute__((ext_vector_type(4)));
typedef float f32x4 __attribute__((ext_vector_type(4)));
typedef float f32x16 __attribute__((ext_vector_type(16)));
typedef unsigned u32x4 __attribute__((ext_vector_type(4)));
typedef unsigned u32x2 __attribute__((ext_vector_type(2)));
typedef float f32x2 __attribute__((ext_vector_type(2)));
#define DI __device__ __forceinline__

DI unsigned cvt_pk(float lo, float hi) { typedef float f2 __attribute__((ext_vector_type(2))); typedef __bf16 b2 __attribute__((ext_vector_type(2))); f2 v = {lo, hi}; b2 b = __builtin_convertvector(v, b2); return __builtin_bit_cast(unsigned, b); }
DI float bf_lo(unsigned w) { return __uint_as_float(w << 16); }
DI float bf_hi(unsigned w) { return __uint_as_float(w & 0xffff0000u); }
DI float silu_f(float v) { return v / (1.f + __expf(-v)); }
template <int M> DI float swz_xor(float v) { return __int_as_float(__builtin_amdgcn_ds_swizzle(__float_as_int(v), (M << 10) | 0x1F)); }
DI float add_xor16(float v) { return v + swz_xor<16>(v); }
DI float add_xor32(float v) { auto r = __builtin_amdgcn_permlane32_swap(__float_as_uint(v), __float_as_uint(v), false, false); return __uint_as_float(r[0]) + __uint_as_float(r[1]); }
DI float other32(float v, bool upper_half) { auto r = __builtin_amdgcn_permlane32_swap(__float_as_uint(v), __float_as_uint(v), false, false); return __uint_as_float(upper_half ? r[0] : r[1]); }
DI float wave_sum(float v) { v += swz_xor<1>(v); v += swz_xor<2>(v); v += swz_xor<4>(v); v += swz_xor<8>(v); v += swz_xor<16>(v); return add_xor32(v); }
DI unsigned shfl_up_u(unsigned v, int o, int lane) { return (unsigned)__builtin_amdgcn_ds_bpermute((lane - o) << 2, (int)v); }

constexpr int NB = FAST_NB;
constexpr int LAT = NB * 4096, CTXR = NB * 256, R = LAT + CTXR, MT = R / 256;
constexpr int MOE_LAT = NB * 16 * 512, MOE_ROWS = MOE_LAT + 16 * 256;
constexpr float EPS = 1e-6f, LOG2E = 1.4426950408889634f;
constexpr float QS64 = 0.125f * LOG2E, QS96 = 0.10206207261596575f * LOG2E;
constexpr float QF64 = QS64 * 8.f, QF96 = QS96 * 8.f;
constexpr int NWAVES = 8, NTHR = 512;

constexpr size_t al256(size_t x) { return (x + 255) & ~(size_t)255; }
constexpr size_t WS_CTL = 0, CTL_BYTES = 65536;
constexpr size_t WS_MOD = WS_CTL + CTL_BYTES;
constexpr size_t WS_TAB64 = WS_MOD + al256((size_t)2 * 9 * 6144 * 4);
constexpr size_t WS_TAB32 = WS_TAB64 + 8192;
constexpr size_t WS_WIN = WS_TAB32 + 4096;
constexpr size_t WS_WUP = WS_WIN + (size_t)2 * 1536 * 1024 * 2;
constexpr size_t WS_WOUT = WS_WUP + (size_t)2 * 1536 * 384 * 2;
constexpr size_t WS_W1 = WS_WOUT + (size_t)2 * 1024 * 1024 * 2;
constexpr size_t WS_W2 = WS_W1 + (size_t)2 * 16 * 2048 * 1024 * 2;
constexpr size_t WS_HB = WS_W2 + (size_t)2 * 16 * 1024 * 1024 * 2;
constexpr size_t WS_CTXF = WS_HB + (size_t)R * 1024 * 2;
constexpr size_t WS_SSQ = WS_CTXF + (size_t)CTXR * 1024 * 4;
constexpr size_t WS_AFFL = WS_SSQ + (size_t)R * 8 * 4;
constexpr size_t WS_AFFC = WS_AFFL + (size_t)NB * 16 * 4096 * 4;
constexpr size_t WS_GIDX = WS_AFFC + (size_t)NB * 16 * 256 * 4;
constexpr size_t WS_GATE = WS_GIDX + (size_t)MOE_ROWS * 4;
constexpr size_t WS_INV = WS_GATE + (size_t)MOE_ROWS * 4;
constexpr size_t WS_Z = al256(WS_INV + (size_t)R * 16 * 4);
constexpr size_t Z_QA = WS_Z, Z_KA = Z_QA + (size_t)R * 384 * 2, Z_VA = Z_KA + (size_t)R * 128 * 2, Z_QC = Z_VA + (size_t)R * 128 * 2, Z_KC = Z_QC + (size_t)R * 256 * 2,
                 Z_VC = Z_KC + (size_t)R * 128 * 2, Z_CRAW = Z_VC + (size_t)R * 128 * 2, Z_QB = Z_CRAW + (size_t)R * 384 * 2, Z_KB = Z_QB + (size_t)R * 576 * 2,
                 Z_VB = Z_KB + (size_t)R * 576 * 2, Z_OB = Z_VB + (size_t)R * 384 * 2, Z_END1 = Z_OB + (size_t)R * 1024 * 2;
constexpr size_t VT_TILE = 4096, VT_HEAD = 68 * VT_TILE;
constexpr size_t Z_HID = WS_Z, Z_YE = Z_HID + (size_t)MOE_ROWS * 1024 * 2, Z_END2 = Z_YE + (size_t)MOE_ROWS * 1024 * 2;
constexpr size_t WS_END = al256(Z_END1 > Z_END2 ? Z_END1 : Z_END2);
constexpr int CW_BAR = 1024;
constexpr int CW_QUEUE = 8192;

DI int vt_pos(int k) { return ((k & 4) << 3) | ((k & 32) >> 1) | ((k & 24) >> 1) | (k & 3); }
constexpr int RING_BYTES = 131072;
constexpr int LDS_TAB64 = RING_BYTES, LDS_TAB32 = LDS_TAB64 + 8192, LDS_MISC = LDS_TAB32 + 4096;
constexpr int LDS_INTAB = LDS_MISC + 256;
constexpr int LDS_BYTES = 147456;

#define XB_TMO      128
#define XB_XCNT(j)  (256  + 64 * (j))
#define XB_XSUB(j)  (1280 + 64 * (j))
#define XB_XGEN(j)  (2304 + 64 * (j))
#define XB_TOP      3328
#define XB_TOPGEN   3392
#define XCD_BAR_WORDS 3456
#define XB_SPIN_CAP (1u << 20)
DI unsigned xb_ld(unsigned* p)              { return __hip_atomic_load(p, __ATOMIC_RELAXED, __HIP_MEMORY_SCOPE_AGENT); }
DI unsigned xb_add(unsigned* p, unsigned v) { return __hip_atomic_fetch_add(p, v, __ATOMIC_RELAXED, __HIP_MEMORY_SCOPE_AGENT); }
DI unsigned xb_xcc_id() { return (unsigned)__builtin_amdgcn_s_getreg((3 << 11) | 20) & 0xFu; }
#define XB_SPIN(cond, bar) do { unsigned _sp = 0; while (cond) { __builtin_amdgcn_s_sleep(1); \
    if ((++_sp & 255u) == 0u) { if (xb_ld(&(bar)[XB_TMO])) break; if (_sp > XB_SPIN_CAP) { atomicAdd(&(bar)[XB_TMO], 1u); break; } } } } while (0)
struct XcdBarrier { unsigned* bar; unsigned x; volatile LAS unsigned* st; };
DI XcdBarrier xcd_barrier_post(unsigned* bar, volatile LAS unsigned* st) {
    XcdBarrier b; b.bar = bar; b.x = xb_xcc_id(); b.st = st;
    if (threadIdx.x == 0) (void)xb_add(&bar[XB_XCNT(b.x)], 1u);
    return b;
}
DI void xcd_barrier_complete(unsigned* bar, unsigned x, unsigned& nloc, unsigned& nx) {
    asm volatile("" : "+s"(x));
    const unsigned G = gridDim.x * gridDim.y * gridDim.z;
    unsigned sum, cnt, mine, sp = 0u;
    for (;;) {
        sum = 0u; cnt = 0u; mine = 0u;
#pragma unroll
        for (unsigned j = 0; j < 16; ++j) { const unsigned c = xb_ld(&bar[XB_XCNT(j)]); sum += c; cnt += (c > 0u) ? 1u : 0u; mine = (j == x) ? c : mine; }
        if (sum == G) break;
        __builtin_amdgcn_s_sleep(1);
        if ((++sp & 255u) == 0u) { if (xb_ld(&bar[XB_TMO])) break; if (sp > XB_SPIN_CAP) { atomicAdd(&bar[XB_TMO], 1u); break; } }
    }
    nloc = mine > 0u ? mine : 1u; nx = cnt > 0u ? cnt : 1u;
}
DI void xcd_barrier(const XcdBarrier& b) {
    asm volatile("s_waitcnt vmcnt(0)" ::: "memory");
    __syncthreads();
    if (threadIdx.x == 0) {
        unsigned* bar = b.bar; asm volatile("" : "+s"(bar));
        __builtin_amdgcn_s_waitcnt(0);
        unsigned nloc = b.st[0], nx = b.st[1];
        if (nloc == 0u) { xcd_barrier_complete(bar, b.x, nloc, nx); b.st[0] = nloc; b.st[1] = nx; }
        const unsigned old = xb_add(&bar[XB_XSUB(b.x)], 1u);
        const unsigned gen = old / nloc;
        if (old + 1u == (gen + 1u) * nloc) {
            __builtin_amdgcn_fence(__ATOMIC_RELEASE, "agent");
            asm volatile("s_waitcnt vmcnt(0)" ::: "memory");
            const unsigned og = xb_add(&bar[XB_TOP], 1u);
            const unsigned tg = og / nx;
            if (og + 1u == (tg + 1u) * nx) xb_add(&bar[XB_TOPGEN], 1u);
            else XB_SPIN(xb_ld(&bar[XB_TOPGEN]) == tg, bar);
            __builtin_amdgcn_fence(__ATOMIC_ACQUIRE, "agent");
            xb_add(&bar[XB_XGEN(b.x)], 1u);
            asm volatile("s_waitcnt vmcnt(0)" ::: "memory");
        } else {
            XB_SPIN(xb_ld(&bar[XB_XGEN(b.x)]) == gen, bar);
            __builtin_amdgcn_fence(__ATOMIC_ACQUIRE, "agent");
            asm volatile("s_waitcnt vmcnt(0)" ::: "memory");
        }
    }
    __syncthreads();
}

struct Args { const float* in[27]; float* out; unsigned char* ws; int ph_lo, ph_hi, li, pad; };
struct Frame {
    LAS unsigned char* lds; unsigned char* ws; unsigned* ctl;
    int tid, lane, wave, G, bid;
    const LAS unsigned long long* intab; float* out;
};
DI const float* inp(const LAS unsigned long long* tab, int k) { const unsigned long long v = tab[k]; const unsigned lo = __builtin_amdgcn_readfirstlane((unsigned)v), hi = __builtin_amdgcn_readfirstlane((unsigned)(v >> 32)); return (const float*)(const GAS float*)(((unsigned long long)hi << 32) | lo); }
#define INP(k) inp(F.intab, k)
#define WSP(T, off) ((T*)(F.ws + (off)))

DI void mod_item(const Frame& F, int item, const LAS float* s9, LAS float* red) {
    const int l = item / 96, c0 = (item % 96) * 64;
    const float* W = INP(4) + (size_t)l * 1024 * 6144 + c0;
    const int cg = F.lane & 15, ks = F.wave * 4 + (F.lane >> 4);
    f32x4 acc[9];
#pragma unroll
    for (int r = 0; r < 9; ++r) acc[r] = (f32x4){0.f, 0.f, 0.f, 0.f};
#pragma unroll 4
    for (int i = 0; i < 32; ++i) { const int k = ks + 32 * i; const f32x4 w = *(const f32x4*)(W + (size_t)k * 6144 + cg * 4);
#pragma unroll
        for (int r = 0; r < 9; ++r) acc[r] += w * s9[r * 1024 + k]; }
#pragma unroll
    for (int r = 0; r < 9; ++r)
#pragma unroll
        for (int j = 0; j < 4; ++j) { acc[r][j] = add_xor32(add_xor16(acc[r][j])); }
    __syncthreads();
    if (F.lane < 16) {
#pragma unroll
        for (int r = 0; r < 9; ++r) *(LAS f32x4*)(red + (F.wave * 9 + r) * 64 + cg * 4) = acc[r]; }
    __syncthreads();
    for (int e = F.tid; e < 9 * 64; e += NTHR) { const int r = e / 64, c = e % 64; float s = 0.f;
#pragma unroll
        for (int w = 0; w < 8; ++w) s += red[(w * 9 + r) * 64 + c];
        WSP(float, WS_MOD)[((size_t)l * 9 + r) * 6144 + c0 + c] = s + INP(5)[l * 6144 + c0 + c]; }
}

DI void cv_block(const float* src  , int ld, const float* ksc, bf16_t* drow  ) {
#pragma unroll
    for (int kc = 0; kc < 8; ++kc) {
        float v[8];
#pragma unroll
        for (int j = 0; j < 8; ++j) v[j] = src ? src[(size_t)(kc * 8 + j) * ld] : 0.f;
        if (ksc) {
#pragma unroll
            for (int j = 0; j < 8; ++j) v[j] *= ksc[kc * 8 + j]; }
        u32x4 o; o.x = cvt_pk(v[0], v[1]); o.y = cvt_pk(v[2], v[3]); o.z = cvt_pk(v[4], v[5]); o.w = cvt_pk(v[6], v[7]);
        *(u32x4*)(drow + kc * 8) = o;
    }
}
DI void cv_block_fp8(const float* src, int ld, unsigned char* drow) {
#pragma unroll
    for (int kc = 0; kc < 4; ++kc) {
        float v[16];
#pragma unroll
        for (int j = 0; j < 16; ++j) v[j] = src[(size_t)(kc * 16 + j) * ld] * 64.0f;
        u32x4 o;
        { int w = __builtin_amdgcn_cvt_pk_fp8_f32(v[0], v[1], 0, false); w = __builtin_amdgcn_cvt_pk_fp8_f32(v[2], v[3], w, true); o.x = (unsigned)w; }
        { int w = __builtin_amdgcn_cvt_pk_fp8_f32(v[4], v[5], 0, false); w = __builtin_amdgcn_cvt_pk_fp8_f32(v[6], v[7], w, true); o.y = (unsigned)w; }
        { int w = __builtin_amdgcn_cvt_pk_fp8_f32(v[8], v[9], 0, false); w = __builtin_amdgcn_cvt_pk_fp8_f32(v[10], v[11], w, true); o.z = (unsigned)w; }
        { int w = __builtin_amdgcn_cvt_pk_fp8_f32(v[12], v[13], 0, false); w = __builtin_amdgcn_cvt_pk_fp8_f32(v[14], v[15], w, true); o.w = (unsigned)w; }
        *(u32x4*)(drow + kc * 16) = o;
    }
}
constexpr int CV_WIN = 384, CV_WUP = 144, CV_WOUT = 256, CV_W1 = 8192, CV_W2 = 4096, CV_LAYER = CV_WIN + CV_WUP + CV_WOUT + CV_W1 + CV_W2;
DI void conv_item(const Frame& F, int it) {
    const int l = it / CV_LAYER; int r = it % CV_LAYER; const int lane = F.lane, hl = lane >> 5, ll = lane & 31;
    if (r < CV_WIN) {
        const int kb = r / 24, g = (r % 24) * 2 + hl, x = ((g >> 3) * 4 + (g & 3)) * 64 + 32 * ((g >> 2) & 1) + ll;
        const int sc = x < 960 ? x : (x < 1472 ? x + 32 : (x < 1504 ? x - 512 : -1));
        const float* src = sc < 0 ? nullptr : INP(8) + (size_t)l * 1024 * 1504 + (size_t)(kb * 64) * 1504 + sc;
        unsigned char* drow = WSP(unsigned char, WS_WIN) + (size_t)l * 1536 * 1024 + (size_t)((r % 24) * 64 + lane) * 1024 + kb * 64;
        if (__builtin_amdgcn_readfirstlane(sc < 0 ? 1 : 0) | __any(sc < 0)) { const float* s2 = sc < 0 ? INP(8) : src; cv_block_fp8(s2, sc < 0 ? 0 : 1504, drow);
            if (sc < 0) {
#pragma unroll
                for (int kc = 0; kc < 4; ++kc) *(u32x4*)(drow + kc * 16) = (u32x4){0u, 0u, 0u, 0u}; } }
        else cv_block_fp8(src, 1504, drow);
        return; }
    r -= CV_WIN;
    if (r < CV_WUP) {
        const int kb = r / 24, g = (r % 24) * 2 + hl, slot = (g >> 3) * 4 + (g & 3), half = (g >> 2) & 1;
        const float* src = nullptr; const float* ksc = nullptr; int ld = 0;
        if (slot < 9 && kb < 3) { const int col = slot < 6 ? slot * 96 + 32 * half : (2 * (slot - 6) + half) * 96 + 64;
            src = INP(13) + (size_t)l * 192 * 576 + (size_t)(kb * 64) * 576 + col + ll; ld = 576; ksc = INP(11) + l * 192 + kb * 64; }
        else if (slot >= 12 && (kb == 3 || kb == 4)) { const int h = slot < 18 ? slot - 12 : slot - 18; const int col = h * 128 + (slot < 18 ? 0 : 64) + 32 * half;
            src = INP(14) + (size_t)l * 128 * 768 + (size_t)((kb - 3) * 64) * 768 + col + ll; ld = 768; ksc = INP(12) + l * 128 + (kb - 3) * 64; }
        cv_block(src, ld, ksc, WSP(bf16_t, WS_WUP) + (size_t)l * 1536 * 384 + (size_t)((r % 24) * 64 + lane) * 384 + kb * 64); return; }
    r -= CV_WUP;
    if (r < CV_WOUT) { const int kb = r / 16, g = r % 16;
        cv_block(INP(22) + (size_t)l * 1024 * 1024 + (size_t)(kb * 64) * 1024 + g * 64 + lane, 1024, nullptr, WSP(bf16_t, WS_WOUT) + (size_t)l * 1024 * 1024 + (size_t)(g * 64 + lane) * 1024 + kb * 64); return; }
    r -= CV_WOUT;
    if (r < CV_W1) { const int e = r / 512, q = r % 512, kb = q / 32, g = (q % 32) * 2 + hl, pn = g >> 3, bj = (g >> 2) & 1, wc = g & 3;
        const float* src = (bj ? INP(25) : INP(24)) + ((size_t)l * 16 + e) * 1024 * 1024 + (size_t)(kb * 64) * 1024 + 128 * pn + 32 * wc + ll;
        cv_block_fp8(src, 1024, WSP(unsigned char, WS_W1) + ((size_t)l * 16 + e) * 2048 * 1024 + (size_t)((q % 32) * 64 + lane) * 1024 + kb * 64); return; }
    r -= CV_W1;
    { const int e = r / 256, q = r % 256, kb = q / 16, g = q % 16;
        cv_block_fp8(INP(26) + ((size_t)l * 16 + e) * 1024 * 1024 + (size_t)(kb * 64) * 1024 + g * 64 + lane, 1024, WSP(unsigned char, WS_W2) + ((size_t)l * 16 + e) * 1024 * 1024 + (size_t)(g * 64 + lane) * 1024 + kb * 64); }
}
DI void p0_phase(const Frame& F) {
    LAS float* s9 = (LAS float*)F.lds;
    LAS float* red = (LAS float*)(F.lds + 9 * 1024 * 4);
    if (F.bid == 0) {
        for (int i = F.tid; i < 64 * 16; i += NTHR) { const int pos = i / 16, f = i % 16; const float inv = exp2f(-(float)(2 * f) / 32.f * 13.287712379549449f); const float a = (float)pos * inv; WSP(f32x2, WS_TAB64)[i] = (f32x2){cosf(a), sinf(a)}; }
        for (int i = F.tid; i < 64 * 8; i += NTHR) { const int pos = i / 8, f = i % 8; const float inv = exp2f(-(float)(2 * f) / 16.f * 13.287712379549449f); const float a = (float)pos * inv; WSP(f32x2, WS_TAB32)[i] = (f32x2){cosf(a), sinf(a)}; }
    }
    bool have_s9 = false;
    for (int it = F.bid; it < 192; it += F.G) {
        if (!have_s9) { for (int e = F.tid; e < 9 * 1024; e += NTHR) { const int r = e / 1024, k = e % 1024; const float v = r < 8 ? INP(1)[r * 1024 + k] : INP(3)[k]; s9[e] = silu_f(v); } have_s9 = true; __syncthreads(); }
        mod_item(F, it, s9, red);
    }
    __syncthreads();
    const int gw = F.bid * NWAVES + F.wave, NGW = F.G * NWAVES;
    for (int it = gw; it < 2 * CV_LAYER; it += NGW) conv_item(F, it);
}

DI unsigned pk_fp8q(float a, float b, float c, float d) { int w = __builtin_amdgcn_cvt_pk_fp8_f32(a, b, 0, false); w = __builtin_amdgcn_cvt_pk_fp8_f32(c, d, w, true); return (unsigned)w; }
DI void norm_mod_store(const f32x4 (&v)[4], const float* g, const float* sh, const float* sc, unsigned char* orow  , int lane) {
    float s = 0.f;
#pragma unroll
    for (int j = 0; j < 4; ++j) s += (v[j].x * v[j].x + v[j].y * v[j].y) + (v[j].z * v[j].z + v[j].w * v[j].w);
    const float rstd = 1.0f / sqrtf(wave_sum(s) * (1.f / 1024.f) + EPS);
#pragma unroll
    for (int j = 0; j < 4; ++j) { const int c = 4 * (lane + 64 * j); const f32x4 gv = *(const f32x4*)(g + c), sv = *(const f32x4*)(sh + c), cv = *(const f32x4*)(sc + c);
        const f32x4 o = v[j] * rstd * gv * (cv + 1.0f) + sv; *(unsigned*)(orow + c) = pk_fp8q(o.x, o.y, o.z, o.w); }
}
DI const float* mod_row(const Frame& F, int l, int row) { const int r = row < LAT ? row / 4096 : 8; return WSP(float, WS_MOD) + ((size_t)l * 9 + r) * 6144; }
DI void init_norm_phase(const Frame& F) {
    const int gw = F.bid * NWAVES + F.wave, NGW = F.G * NWAVES;
    for (int row = gw; row < R; row += NGW) {
        const float* xr = row < LAT ? INP(0) + (size_t)row * 1024 : INP(2) + (size_t)(row - LAT) * 1024;
        f32x4 v[4];
#pragma unroll
        for (int j = 0; j < 4; ++j) v[j] = *(const f32x4*)(xr + 4 * (F.lane + 64 * j));
        const float* m = mod_row(F, 0, row);
        norm_mod_store(v, INP(6), m, m + 1024, WSP(unsigned char, WS_HB) + (size_t)row * 1024, F.lane);
    }
}
namespace g8 {
constexpr int BM = 256, BK = 64, HALF = 128, HTB = HALF * BK * 2, STAGE_BYTES = 8 * HTB;
DI int lds_byte(int r, int c) { const int st = (r >> 4) * 2 + (c >> 5), rr = r & 15, cc = c & 31, ob = rr * 64 + cc * 2; return st * 1024 + (ob ^ (((ob >> 9) & 1) << 5)); }
DI void stage_rc(int b, int& Rr, int& Cc) { const int st = b / 1024, sb = b % 1024, swz = sb ^ (((sb >> 9) & 1) << 5); Rr = (st >> 1) * 16 + swz / 64; Cc = (st & 1) * 32 + (swz % 64) / 2; }
DI int perm32(int rho) { const int n = rho >> 4, i = rho & 15; return 8 * (i >> 2) + 4 * n + (i & 3); }

typedef int i32x4 __attribute__((ext_vector_type(4)));
typedef int i32x8 __attribute__((ext_vector_type(8)));
struct Unit { int pm, pn, aux; const char* Bp; };

template <class Epi, class Sched>
DI void gemm_phase(const int tid, LAS unsigned char* lds, const char* Abase, int K, const Sched& S, const Epi& E) {
    asm volatile("" : "+s"(K));
    const int wid = __builtin_amdgcn_readfirstlane(tid >> 6), lane = tid & 63, wr = wid >> 2, wc = wid & 3, fr = lane & 15, fq = lane >> 4;
    const int nt = K / BK;
    int Rr[2], Cc[2]; unsigned voffB[2];
#pragma unroll
    for (int i = 0; i < 2; ++i) { int r_, c_; stage_rc(tid * 16 + i * 8192, r_, c_); Rr[i] = r_; Cc[i] = c_; const int Rb = Epi::PERM ? ((r_ & ~31) + perm32(r_ & 31)) : r_; voffB[i] = (unsigned)(Rb * K + c_) * 2u; }
    const size_t hstepB = (size_t)HALF * K * 2;
    const unsigned ldsw = (unsigned)wid * 1024u;
    const int aoff = lds_byte(wr * 64 + fr, fq * 8), boff = lds_byte(wc * 32 + fr, fq * 8);
#define G8_SA(b, h) (((b) * 2 + (h)) * HTB)
#define G8_SB(b, h) ((4 + (b) * 2 + (h)) * HTB)
#define G8_STAGE_A(bufoff, ao2, kt) do { _Pragma("unroll") for (int _i = 0; _i < 2; ++_i) \
        __builtin_amdgcn_global_load_lds((const unsigned*)(Abase + (size_t)(ao2)[_i] + (size_t)(kt) * 128), (LAS unsigned*)(lds + (bufoff) + ldsw + _i * 8192), 16, 0, 0); } while (0)
#define G8_STAGE_B(bufoff, bp, h, kt) do { _Pragma("unroll") for (int _i = 0; _i < 2; ++_i) \
        __builtin_amdgcn_global_load_lds((const unsigned*)((bp) + (size_t)(h) * hstepB + voffB[_i] + (size_t)(kt) * 128), (LAS unsigned*)(lds + (bufoff) + ldsw + _i * 8192), 16, 0, 0); } while (0)
#define G8_LD16(off) (*(const LAS i32x4*)(lds + (off)))
#define G8_LDA(dst, b, h) do { _Pragma("unroll") for (int m = 0; m < 4; ++m) { const i32x4 lo_ = G8_LD16(G8_SA(b, h) + aoff + m * 2048), hi_ = G8_LD16(G8_SA(b, h) + aoff + m * 2048 + 1024); dst[m] = __builtin_shufflevector(lo_, hi_, 0, 1, 2, 3, 4, 5, 6, 7); } } while (0)
#define G8_LDB(dst, b, h) do { _Pragma("unroll") for (int n = 0; n < 2; ++n) { const i32x4 lo_ = G8_LD16(G8_SB(b, h) + boff + n * 2048), hi_ = G8_LD16(G8_SB(b, h) + boff + n * 2048 + 1024); dst[n] = __builtin_shufflevector(lo_, hi_, 0, 1, 2, 3, 4, 5, 6, 7); } } while (0)
#define G8_HALF(v, k) __builtin_bit_cast(bf16x8, __builtin_shufflevector((v), (v), 4 * (k), 4 * (k) + 1, 4 * (k) + 2, 4 * (k) + 3))
#define G8_MMA(ai, bj, At, Bt) do { __builtin_amdgcn_s_setprio(1); _Pragma("unroll") for (int m = 0; m < 4; ++m) _Pragma("unroll") for (int n = 0; n < 2; ++n) { \
        if constexpr (Epi::FP8) asm volatile("v_mfma_scale_f32_16x16x128_f8f6f4 %0, %1, %2, %0, %3, %3 op_sel_hi:[0,0,0]" : "+v"(acc[ai][bj][m][n]) : "v"(Bt[n]), "v"(At[m]), "v"(fp8_scale)); \
        else { acc[ai][bj][m][n] = __builtin_amdgcn_mfma_f32_16x16x32_bf16(G8_HALF(Bt[n], 0), G8_HALF(At[m], 0), acc[ai][bj][m][n], 0, 0, 0); \
               acc[ai][bj][m][n] = __builtin_amdgcn_mfma_f32_16x16x32_bf16(G8_HALF(Bt[n], 1), G8_HALF(At[m], 1), acc[ai][bj][m][n], 0, 0, 0); } } __builtin_amdgcn_s_setprio(0); } while (0)
#define G8_WAIT_V(n) asm volatile("s_waitcnt vmcnt(" #n ")" ::: "memory")
#define G8_WAIT_L(n) asm volatile("s_waitcnt lgkmcnt(" #n ")" ::: "memory")
#define G8_BAR __builtin_amdgcn_s_barrier()
#define G8_SCHED __builtin_amdgcn_sched_barrier(0)
    const int fp8_scale = 0x7F7F7F7F;
    Unit cur, nxt; int ui = 0;
    if (!S.next(0, cur)) return;
    unsigned aoc[2][2], aon[2][2];
    S.aoffs(cur, Rr, Cc, aoc);
    f32x4 acc[2][2][4][2];
#pragma unroll
    for (int a = 0; a < 2; ++a)
#pragma unroll
        for (int b = 0; b < 2; ++b)
#pragma unroll
            for (int m = 0; m < 4; ++m)
#pragma unroll
                for (int n = 0; n < 2; ++n) acc[a][b][m][n] = (f32x4){0.f, 0.f, 0.f, 0.f};
    i32x8 At[4], B0[2], B1[2];
    const char* cB = cur.Bp;
    G8_STAGE_B(G8_SB(0, 0), cB, 0, 0); G8_STAGE_B(G8_SB(0, 1), cB, 1, 0); G8_STAGE_A(G8_SA(0, 0), aoc[0], 0); G8_STAGE_A(G8_SA(0, 1), aoc[1], 0);
    if (wr == 1) G8_BAR;
    G8_WAIT_V(2); G8_BAR;
    G8_STAGE_B(G8_SB(1, 0), cB, 0, 1); G8_STAGE_A(G8_SA(1, 0), aoc[0], 1); G8_STAGE_B(G8_SB(1, 1), cB, 1, 1);
    G8_WAIT_V(6); G8_BAR;
    for (;;) {
        const bool has_next = S.next(ui + 1, nxt);
        if (has_next) S.aoffs(nxt, Rr, Cc, aon);
        else {
#pragma unroll
            for (int h = 0; h < 2; ++h)
#pragma unroll
                for (int i = 0; i < 2; ++i) aon[h][i] = aoc[h][i]; }
        const char* nB = has_next ? nxt.Bp : cB;
        for (int t = 0; t < nt; t += 2) {
            const bool last = (t == nt - 2);
            unsigned a2[2][2];
#pragma unroll
            for (int h = 0; h < 2; ++h)
#pragma unroll
                for (int i = 0; i < 2; ++i) a2[h][i] = last ? aon[h][i] : aoc[h][i];
            const int kt2 = last ? 0 : t + 2; const char* b2 = last ? nB : cB;
            G8_LDB(B0, 0, 0); G8_LDB(B1, 0, 1); G8_SCHED; G8_LDA(At, 0, 0); G8_STAGE_A(G8_SA(1, 1), aoc[1], t + 1);
            G8_WAIT_V(8); G8_WAIT_L(0); G8_BAR; G8_MMA(0, 0, At, B0); G8_MMA(0, 1, At, B1); G8_BAR; G8_SCHED;
            G8_LDA(At, 0, 1); G8_STAGE_B(G8_SB(0, 0), b2, 0, kt2); G8_STAGE_B(G8_SB(0, 1), b2, 1, kt2); G8_STAGE_A(G8_SA(0, 0), a2[0], kt2);
            G8_WAIT_V(8); G8_WAIT_L(0); G8_BAR; G8_MMA(1, 0, At, B0); G8_MMA(1, 1, At, B1); G8_BAR; G8_SCHED;
            G8_LDB(B0, 1, 0); G8_LDB(B1, 1, 1); G8_SCHED; G8_LDA(At, 1, 0); G8_STAGE_A(G8_SA(0, 1), a2[1], kt2);
            G8_WAIT_V(8); G8_WAIT_L(0); G8_BAR; G8_MMA(0, 0, At, B0); G8_MMA(0, 1, At, B1); G8_BAR; G8_SCHED;
            G8_LDA(At, 1, 1); G8_STAGE_B(G8_SB(1, 0), b2, 0, kt2 + 1); G8_STAGE_B(G8_SB(1, 1), b2, 1, kt2 + 1); G8_STAGE_A(G8_SA(1, 0), a2[0], kt2 + 1);
            G8_WAIT_V(8); G8_WAIT_L(0); G8_BAR; G8_MMA(1, 0, At, B0); G8_MMA(1, 1, At, B1); G8_BAR; G8_SCHED;
        }
        if (wr == 0) G8_BAR;
        if constexpr (Epi::FP8) asm volatile("s_nop 15\n\ts_nop 15" ::: "memory");
        E(acc, cur, wr, wc, fr, fq);
        if (!has_next) break;
#pragma unroll
        for (int a = 0; a < 2; ++a)
#pragma unroll
            for (int b = 0; b < 2; ++b)
#pragma unroll
                for (int m = 0; m < 4; ++m)
#pragma unroll
                    for (int n = 0; n < 2; ++n) acc[a][b][m][n] = (f32x4){0.f, 0.f, 0.f, 0.f};
        cur = nxt; cB = nB;
#pragma unroll
        for (int h = 0; h < 2; ++h)
#pragma unroll
            for (int i = 0; i < 2; ++i) aoc[h][i] = aon[h][i];
        ++ui;
        if (wr == 1) G8_BAR;
    }
    G8_WAIT_V(0);
    G8_BAR;
#undef G8_SA
#undef G8_SB
#undef G8_STAGE_A
#undef G8_STAGE_B
#undef G8_LDA
#undef G8_LDB
#undef G8_MMA
#undef G8_HALF
#undef G8_LD16
#undef G8_WAIT_V
#undef G8_WAIT_L
#undef G8_BAR
#undef G8_SCHED
}

struct DenseSched {
    int nM, nN, nwg, G, c, K; const char* Bt;
    DI void init(int nM_, int nN_, int G_, int c_, int K_, const void* Bt_) { nM = nM_; nN = nN_; nwg = nM * nN; G = G_; c = c_; K = K_; Bt = (const char*)Bt_; }
    DI bool next(int i, Unit& u) const {
        const long L = (long)i * G + c; if (L >= nwg) return false;
        int wgid = (int)L; { const int q = nwg / 8, r = nwg % 8, xcd = wgid % 8, off = wgid / 8; wgid = (xcd < r ? xcd * (q + 1) : r * (q + 1) + (xcd - r) * q) + off; }
        const int WGM = 8, nig = WGM * nN, gid = wgid / nig, fm = gid * WGM, gsz = (nM - fm) < WGM ? (nM - fm) : WGM;
        u.pm = fm + ((wgid % nig) % gsz); u.pn = (wgid % nig) / gsz; u.aux = 0; u.Bp = Bt + (size_t)u.pn * 256 * K * 2; return true;
    }
    DI void aoffs(const Unit& u, const int (&Rr)[2], const int (&Cc)[2], unsigned (&ao)[2][2]) const {
#pragma unroll
        for (int h = 0; h < 2; ++h)
#pragma unroll
            for (int i = 0; i < 2; ++i) ao[h][i] = (unsigned)(((size_t)(u.pm * 256 + h * 128 + Rr[i]) * K + Cc[i]) * 2);
    }
};
template <bool GATHER>
struct MoeSched {
    int nN, tiles_per_e, nwg, G, c, K, NBt; const char* Bt; size_t estride; const int* gidx; bool with_ctx;
    DI void init(int nN_, bool with_ctx_, int G_, int c_, int K_, const void* Bt_, size_t estride_, const int* gidx_) {
        nN = nN_; with_ctx = with_ctx_; tiles_per_e = NB * 2 + (with_ctx_ ? 1 : 0); nwg = 16 * tiles_per_e * nN; G = G_; c = c_; K = K_; Bt = (const char*)Bt_; estride = estride_; gidx = gidx_; }
    DI bool next(int i, Unit& u) const {
        int mt;
        if (G % (8 * nN) == 0) {
            const int per = (G / 8) / nN, xcd = c & 7, j8 = c >> 3; mt = (i * 8 + xcd) * per + j8 / nN; u.pn = j8 % nN; if (mt >= 16 * tiles_per_e) return false;
        } else { const long L = (long)i * G + c; if (L >= nwg) return false; mt = (int)L / nN; u.pn = (int)L % nN; }
        const int e = mt / tiles_per_e, j = mt % tiles_per_e;
        const int rowbase = j < NB * 2 ? ((j >> 1) * 16 + e) * 512 + (j & 1) * 256 : MOE_LAT + e * 256;
        u.pm = rowbase / 256; u.aux = e; u.Bp = Bt + (size_t)e * estride + (size_t)u.pn * 256 * K * 2; return true;
    }
    DI void aoffs(const Unit& u, const int (&Rr)[2], const int (&Cc)[2], unsigned (&ao)[2][2]) const {
#pragma unroll
        for (int h = 0; h < 2; ++h)
#pragma unroll
            for (int i = 0; i < 2; ++i) { const int mrow = u.pm * 256 + h * 128 + Rr[i]; const int arow = GATHER ? gidx[mrow] : mrow; ao[h][i] = (unsigned)(((size_t)arow * K + Cc[i]) * 2); }
    }
};
}

typedef f32x4 Acc[2][2][4][2];
DI unsigned pk_fp8x4(float a, float b, float c, float d) { int w = __builtin_amdgcn_cvt_pk_fp8_f32(a, b, 0, false); w = __builtin_amdgcn_cvt_pk_fp8_f32(c, d, w, true); return (unsigned)w; }
DI unsigned pk_fp8v(const f32x4 v) { return pk_fp8x4(v.x, v.y, v.z, v.w); }
DI void st_bf16x4(bf16_t* p, const f32x4 v) { u32x2 w; w.x = cvt_pk(v.x, v.y); w.y = cvt_pk(v.z, v.w); *(u32x2*)p = w; }

DI void st_vt4(unsigned char* tile, int d0, int pos, const f32x4 v) { const unsigned w = pk_fp8v(v); unsigned char* p = tile + d0 * 64 + pos;
    p[0] = (unsigned char)w; p[64] = (unsigned char)(w >> 8); p[128] = (unsigned char)(w >> 16); p[192] = (unsigned char)(w >> 24); }
DI size_t vt_tile_of_rowgroup(int row64  ) {
    return row64 < LAT ? (size_t)(row64 / 4096) * 68 + 4 + (row64 % 4096) / 64 : (size_t)((row64 - LAT) / 256) * 68 + ((row64 - LAT) % 256) / 64; }
struct EpiInProj {
    static constexpr bool PERM = false, FP8 = true;
    unsigned char* ws; const LAS unsigned long long* in; int l; const LAS f32x2* tab64; const LAS f32x2* tab32;
    DI void operator()(const Acc& acc, const g8::Unit& u, int wr, int wc, int fr, int fq) const {
        asm volatile("" : "+v"(fr), "+v"(fq));
        constexpr float SC = 1.0f / 64.0f;
        const int slot = 4 * u.pn + wc; const int rowt = u.pm * 256 + wr * 64 + fr; const bool lat = (u.pm * 256) < LAT;
        int kind; bf16_t* dst; int ld, coff; const float* gain = nullptr; float qs = 1.f;
        if (slot < 6)       { kind = 0; dst = (bf16_t*)(ws + Z_QA); ld = 384; coff = slot * 64; gain = inp(in, 9) + l * 64; qs = QF64; }
        else if (slot < 8)  { kind = 0; dst = (bf16_t*)(ws + Z_KA); ld = 128; coff = (slot - 6) * 64; gain = inp(in, 10) + l * 64; }
        else if (slot < 10) { kind = 1; dst = (bf16_t*)(ws + Z_VA); ld = 128; coff = (slot - 8) * 64; }
        else if (slot < 15) { kind = 2; dst = (bf16_t*)(ws + Z_CRAW); ld = 384; coff = (slot - 10) * 64; }
        else if (slot < 19) { kind = 0; dst = (bf16_t*)(ws + Z_QC); ld = 256; coff = (slot - 15) * 64; gain = inp(in, 19) + l * 64; qs = QF64; }
        else if (slot < 21) { kind = 0; dst = (bf16_t*)(ws + Z_KC); ld = 128; coff = (slot - 19) * 64; gain = inp(in, 20) + l * 64; }
        else if (slot < 23) { kind = 1; dst = (bf16_t*)(ws + Z_VC); ld = 128; coff = (slot - 21) * 64; }
        else                { kind = 3; dst = (bf16_t*)(ws + Z_KB); ld = 576; coff = 64; gain = inp(in, 18) + l * 32; }
        if (kind == 0) {
            f32x4 g[2][2];
#pragma unroll
            for (int bj = 0; bj < 2; ++bj)
#pragma unroll
                for (int n = 0; n < 2; ++n) g[bj][n] = *(const f32x4*)(gain + 32 * bj + 16 * n + 4 * fq) * qs;
#pragma unroll
            for (int ai = 0; ai < 2; ++ai)
#pragma unroll
                for (int m = 0; m < 4; ++m) {
                    const int row = rowt + ai * 128 + m * 16; float s = 0.f;
#pragma unroll
                    for (int bj = 0; bj < 2; ++bj)
#pragma unroll
                        for (int n = 0; n < 2; ++n) { const f32x4 x = acc[ai][bj][m][n] * SC; s += (x.x * x.x + x.y * x.y) + (x.z * x.z + x.w * x.w); }
                    s = add_xor32(add_xor16(s));
                    const float rstd = SC / sqrtf(s * (1.f / 64.f) + EPS);
                    const int t = row & 4095, pr = t >> 6, pc = t & 63;
#pragma unroll
                    for (int bj = 0; bj < 2; ++bj) {
                        f32x4 x1 = acc[ai][bj][m][0] * rstd * g[bj][0], x2 = acc[ai][bj][m][1] * rstd * g[bj][1];
                        if (lat) { const LAS f32x2* tb = tab64 + (bj == 0 ? pr : pc) * 16 + 4 * fq; f32x4 o1, o2;
#pragma unroll
                            for (int i = 0; i < 4; ++i) { const f32x2 cs = tb[i]; o1[i] = x1[i] * cs.x - x2[i] * cs.y; o2[i] = x2[i] * cs.x + x1[i] * cs.y; }
                            x1 = o1; x2 = o2; }
                        unsigned char* p = (unsigned char*)dst + (size_t)row * ld + coff + 32 * bj + 4 * fq;
                        *(unsigned*)p = pk_fp8v(x1); *(unsigned*)(p + 16) = pk_fp8v(x2);
                    }
                    asm volatile("" ::: "memory");
                }
        } else if (kind == 1 || kind == 2) {
#pragma unroll
            for (int ai = 0; ai < 2; ++ai)
#pragma unroll
                for (int m = 0; m < 4; ++m) {
                    const int row = rowt + ai * 128 + m * 16; float s = 0.f;
#pragma unroll
                    for (int bj = 0; bj < 2; ++bj)
#pragma unroll
                        for (int n = 0; n < 2; ++n) { const f32x4 x = acc[ai][bj][m][n] * SC; s += (x.x * x.x + x.y * x.y) + (x.z * x.z + x.w * x.w);
                            if (kind == 2) st_bf16x4(dst + (size_t)row * ld + coff + 32 * bj + 16 * n + 4 * fq, x);
                            else { const int row64 = u.pm * 256 + ai * 128 + wr * 64;
                                const size_t bt = vt_tile_of_rowgroup(row64); unsigned char* tile = (unsigned char*)dst + ((bt / 68) * 2 + coff / 64) * VT_HEAD + (bt % 68) * VT_TILE;
                                st_vt4(tile, 32 * bj + 16 * n + 4 * fq, vt_pos(16 * m + fr), x); } }
                    if (kind == 2) { s = add_xor32(add_xor16(s)); if (fq == 0) ((float*)(ws + WS_SSQ))[(size_t)row * 8 + (slot - 10)] = s; }
                }
        } else {
            const f32x4 g0 = *(const f32x4*)(gain + 4 * fq), g1 = *(const f32x4*)(gain + 16 + 4 * fq);
            bf16_t* craw = (bf16_t*)(ws + Z_CRAW);
#pragma unroll
            for (int ai = 0; ai < 2; ++ai)
#pragma unroll
                for (int m = 0; m < 4; ++m) {
                    const int row = rowt + ai * 128 + m * 16;
                    const f32x4 a0 = acc[ai][0][m][0] * SC, a1 = acc[ai][0][m][1] * SC;
                    float s = (a0.x * a0.x + a0.y * a0.y) + (a0.z * a0.z + a0.w * a0.w) + (a1.x * a1.x + a1.y * a1.y) + (a1.z * a1.z + a1.w * a1.w);
                    s = add_xor32(add_xor16(s));
                    const float rstd = 1.0f / sqrtf(s * (1.f / 32.f) + EPS);
                    f32x4 v0 = a0 * rstd * g0, v1 = a1 * rstd * g1;
                    if (lat) { const int t = row & 4095, pr = t >> 6, pc = t & 63;
                        f32x4 p0, p1;
#pragma unroll
                        for (int i = 0; i < 4; ++i) { p0[i] = other32(v0[i], fq >= 2); p1[i] = other32(v1[i], fq >= 2); }
                        const LAS f32x2* t0 = tab32 + pr * 8 + 4 * (fq & 1); const LAS f32x2* t1 = tab32 + pc * 8 + 4 * (fq & 1);
#pragma unroll
                        for (int i = 0; i < 4; ++i) { const f32x2 c0 = t0[i], c1 = t1[i];
                            v0[i] = fq < 2 ? v0[i] * c0.x - p0[i] * c0.y : v0[i] * c0.x + p0[i] * c0.y;
                            v1[i] = fq < 2 ? v1[i] * c1.x - p1[i] * c1.y : v1[i] * c1.x + p1[i] * c1.y; } }
                    const unsigned w0 = pk_fp8v(v0), w1 = pk_fp8v(v1);
#pragma unroll
                    for (int h = 0; h < 6; ++h) { unsigned char* p = (unsigned char*)dst + (size_t)row * 768 + h * 128 + 64 + 4 * fq; *(unsigned*)p = w0; *(unsigned*)(p + 16) = w1; *(unsigned*)(p + 32) = 0u; *(unsigned*)(p + 48) = 0u; }
                    const u32x2 z = {0u, 0u};
#pragma unroll
                    for (int q = 0; q < 4; ++q) *(u32x2*)(craw + (size_t)row * 384 + 320 + 16 * q + 4 * fq) = z;
                    asm volatile("" ::: "memory");
                }
        }
    }
};

struct EpiUpProj {
    static constexpr bool PERM = false, FP8 = false;
    unsigned char* ws; const LAS unsigned long long* in; int l; const LAS f32x2* tab32;
    DI void operator()(const Acc& acc, const g8::Unit& u, int wr, int wc, int fr, int fq) const {
        asm volatile("" : "+v"(fr), "+v"(fq));
        const int slot = 4 * u.pn + wc; if (slot >= 9 && slot < 12) return;
        const int rowt = u.pm * 256 + wr * 64 + fr; const bool lat = (u.pm * 256) < LAT;
        const float* ssq = (const float*)(ws + WS_SSQ);
        bf16_t* qB = (bf16_t*)(ws + Z_QB); bf16_t* kB = (bf16_t*)(ws + Z_KB); bf16_t* vB = (bf16_t*)(ws + Z_VB);
        const bool isq = slot < 9;
#pragma unroll
        for (int ai = 0; ai < 2; ++ai)
#pragma unroll
            for (int m = 0; m < 4; ++m) {
                const int row = rowt + ai * 128 + m * 16;
                const f32x4 sa = *(const f32x4*)(ssq + (size_t)row * 8); const float sb = ssq[(size_t)row * 8 + 4];
                const float r0 = isq ? 1.0f / sqrtf((sa.x + sa.y + sa.z) * (1.f / 192.f) + EPS) : 1.0f / sqrtf((sa.w + sb) * (1.f / 128.f) + EPS);
                if (slot < 6 || (slot >= 12 && slot < 18)) {
                    const float* gain = slot < 6 ? inp(in, 15) + l * 64 : inp(in, 16) + l * 64; const float qs = slot < 6 ? QF96 : 1.f;
                    const int h = slot < 6 ? slot : slot - 12; unsigned char* dst = (unsigned char*)(slot < 6 ? qB : kB) + (size_t)row * 768 + h * 128;
                    float s = 0.f; f32x4 x[2][2];
#pragma unroll
                    for (int bj = 0; bj < 2; ++bj)
#pragma unroll
                        for (int n = 0; n < 2; ++n) { x[bj][n] = acc[ai][bj][m][n] * r0; s += (x[bj][n].x * x[bj][n].x + x[bj][n].y * x[bj][n].y) + (x[bj][n].z * x[bj][n].z + x[bj][n].w * x[bj][n].w); }
                    s = add_xor32(add_xor16(s));
                    const float rstd = qs / sqrtf(s * (1.f / 64.f) + EPS);
#pragma unroll
                    for (int bj = 0; bj < 2; ++bj)
#pragma unroll
                        for (int n = 0; n < 2; ++n) { const int c = 32 * bj + 16 * n + 4 * fq; *(unsigned*)(dst + c) = pk_fp8v(x[bj][n] * rstd * *(const f32x4*)(gain + c)); }
                } else if (slot >= 18) {
                    const int row64 = u.pm * 256 + ai * 128 + wr * 64; const size_t bt = vt_tile_of_rowgroup(row64);
                    unsigned char* tile = (unsigned char*)vB + ((bt / 68) * 6 + (slot - 18)) * VT_HEAD + (bt % 68) * VT_TILE;
#pragma unroll
                    for (int bj = 0; bj < 2; ++bj)
#pragma unroll
                        for (int n = 0; n < 2; ++n) st_vt4(tile, 32 * bj + 16 * n + 4 * fq, vt_pos(16 * m + fr), acc[ai][bj][m][n] * r0);
                } else {
                    const float* gain = inp(in, 17) + l * 32;
#pragma unroll
                    for (int bj = 0; bj < 2; ++bj) {
                        const f32x4 a0 = acc[ai][bj][m][0] * r0, a1 = acc[ai][bj][m][1] * r0;
                        float s = (a0.x * a0.x + a0.y * a0.y) + (a0.z * a0.z + a0.w * a0.w) + (a1.x * a1.x + a1.y * a1.y) + (a1.z * a1.z + a1.w * a1.w);
                        s = add_xor32(add_xor16(s));
                        const float rstd = QF96 / sqrtf(s * (1.f / 32.f) + EPS);
                        f32x4 v0 = a0 * rstd * *(const f32x4*)(gain + 4 * fq), v1 = a1 * rstd * *(const f32x4*)(gain + 16 + 4 * fq);
                        if (lat) { const int t = row & 4095, pr = t >> 6, pc = t & 63; f32x4 p0, p1;
#pragma unroll
                            for (int i = 0; i < 4; ++i) { p0[i] = other32(v0[i], fq >= 2); p1[i] = other32(v1[i], fq >= 2); }
                            const LAS f32x2* t0 = tab32 + pr * 8 + 4 * (fq & 1); const LAS f32x2* t1 = tab32 + pc * 8 + 4 * (fq & 1);
#pragma unroll
                            for (int i = 0; i < 4; ++i) { const f32x2 c0 = t0[i], c1 = t1[i];
                                v0[i] = fq < 2 ? v0[i] * c0.x - p0[i] * c0.y : v0[i] * c0.x + p0[i] * c0.y;
                                v1[i] = fq < 2 ? v1[i] * c1.x - p1[i] * c1.y : v1[i] * c1.x + p1[i] * c1.y; } }
                        unsigned char* p = (unsigned char*)qB + (size_t)row * 768 + (2 * (slot - 6) + bj) * 128 + 64 + 4 * fq;
                        *(unsigned*)p = pk_fp8v(v0); *(unsigned*)(p + 16) = pk_fp8v(v1); *(unsigned*)(p + 32) = 0u; *(unsigned*)(p + 48) = 0u;
                    }
                }
                asm volatile("" ::: "memory");
            }
    }
};

struct EpiOutProj {
    static constexpr bool PERM = false, FP8 = false;
    unsigned char* ws; const float* xin; const float* cin; float* out; int l;
    DI void operator()(const Acc& acc, const g8::Unit& u, int wr, int wc, int fr, int fq) const {
        asm volatile("" : "+v"(fr), "+v"(fq));
        const int rowt = u.pm * 256 + wr * 64 + fr; const bool lat = (u.pm * 256) < LAT;
        const float* mod = (const float*)(ws + WS_MOD) + ((size_t)l * 9 + (lat ? (u.pm * 256) / 4096 : 8)) * 6144 + 2048;
        const int col0 = u.pn * 256 + wc * 32 + 4 * fq;
        f32x4 gv[2][2];
#pragma unroll
        for (int bj = 0; bj < 2; ++bj)
#pragma unroll
            for (int n = 0; n < 2; ++n) gv[bj][n] = *(const f32x4*)(mod + col0 + 128 * bj + 16 * n);
#pragma unroll
        for (int ai = 0; ai < 2; ++ai)
#pragma unroll
            for (int m = 0; m < 4; ++m) {
                const int row = rowt + ai * 128 + m * 16;
                const float* src = lat ? xin + (size_t)row * 1024 : cin + (size_t)(row - LAT) * 1024;
                float* dst = lat ? out + (size_t)row * 1024 : (float*)(ws + WS_CTXF) + (size_t)(row - LAT) * 1024;
#pragma unroll
                for (int bj = 0; bj < 2; ++bj)
#pragma unroll
                    for (int n = 0; n < 2; ++n) { const int c = col0 + 128 * bj + 16 * n; *(f32x4*)(dst + c) = *(const f32x4*)(src + c) + gv[bj][n] * acc[ai][bj][m][n]; }
            }
    }
};

constexpr int WSH = 6, HSH = 3;
struct EpiMoe1 {
    static constexpr bool PERM = true, FP8 = true;
    unsigned char* ws;
    DI void operator()(const Acc& acc, const g8::Unit& u, int wr, int wc, int fr, int fq) const {
        asm volatile("" : "+v"(fr), "+v"(fq));
        unsigned char* hid = ws + Z_HID; constexpr float SC = 1.0f / (float)(1 << WSH), HS = (float)(1 << HSH);
#pragma unroll
        for (int ai = 0; ai < 2; ++ai)
#pragma unroll
            for (int m = 0; m < 4; ++m) {
                const int row = u.pm * 256 + ai * 128 + wr * 64 + m * 16 + fr;
                f32x4 h0, h1;
#pragma unroll
                for (int i = 0; i < 4; ++i) { h0[i] = silu_f(acc[ai][0][m][0][i] * SC) * (acc[ai][1][m][0][i] * (SC * HS)); h1[i] = silu_f(acc[ai][0][m][1][i] * SC) * (acc[ai][1][m][1][i] * (SC * HS)); }
                u32x2 w; w.x = pk_fp8x4(h0.x, h0.y, h0.z, h0.w); w.y = pk_fp8x4(h1.x, h1.y, h1.z, h1.w);
                *(u32x2*)(hid + (size_t)row * 1024 + u.pn * 128 + wc * 32 + 8 * fq) = w;
            }
    }
};
struct EpiMoe2 {
    static constexpr bool PERM = true, FP8 = true;
    unsigned char* ws;
    DI void operator()(const Acc& acc, const g8::Unit& u, int wr, int wc, int fr, int fq) const {
        asm volatile("" : "+v"(fr), "+v"(fq));
        bf16_t* ye = (bf16_t*)(ws + Z_YE); const float* gate = (const float*)(ws + WS_GATE); constexpr float SC = 1.0f / (float)(1 << (WSH + HSH));
#pragma unroll
        for (int ai = 0; ai < 2; ++ai)
#pragma unroll
            for (int m = 0; m < 4; ++m) {
                const int row = u.pm * 256 + ai * 128 + wr * 64 + m * 16 + fr; const float gv = gate[row] * SC;
#pragma unroll
                for (int bj = 0; bj < 2; ++bj) { const f32x4 a = acc[ai][bj][m][0] * gv, b = acc[ai][bj][m][1] * gv; u32x4 w;
                    w.x = cvt_pk(a.x, a.y); w.y = cvt_pk(a.z, a.w); w.z = cvt_pk(b.x, b.y); w.w = cvt_pk(b.z, b.w);
                    *(u32x4*)(ye + (size_t)row * 1024 + u.pn * 256 + bj * 128 + wc * 32 + 8 * fq) = w; }
            }
    }
};
DI int crow(int i, int hh) { return (i & 3) + 8 * (i >> 2) + 4 * hh; }
typedef short v4i16_t __attribute__((ext_vector_type(4)));
DI s16x4 vtr(const LAS unsigned char* p) { return __builtin_bit_cast(s16x4, __builtin_amdgcn_ds_read_tr16_b64_v4i16((LAS v4i16_t*)p)); }
#define MFMA32(a, b, c) __builtin_amdgcn_mfma_f32_32x32x16_bf16((a), (b), (c), 0, 0, 0)

struct AttnDesc { const unsigned char* Q; int ldq, qoff; const unsigned char* K; int ldk, koff; const unsigned char* Vt; bf16_t* O; int ooff; float sink2; };
DI float fmax3(float a, float b, float c) { return __builtin_fmaxf(__builtin_fmaxf(a, b), c); }
typedef int i32x4 __attribute__((ext_vector_type(4)));
typedef int i32x8 __attribute__((ext_vector_type(8)));
#define MFMA8Z(acc, a, b, sa, sb) asm volatile("v_mfma_scale_f32_32x32x64_f8f6f4 %0, %1, %2, 0, %3, %4 op_sel_hi:[0,0,0]" : "=&v"(acc) : "v"(a), "v"(b), "v"(sa), "v"(sb))
#define MFMA8(acc, a, b, sa, sb) asm volatile("v_mfma_scale_f32_32x32x64_f8f6f4 %0, %1, %2, %0, %3, %4 op_sel_hi:[0,0,0]" : "+v"(acc) : "v"(a), "v"(b), "v"(sa), "v"(sb))
template <int DQB  , int MODE, bool TRACK, int ABL = 0>
DI void attn_unit(const int tid, LAS unsigned char* lds, const AttnDesc& d, int b, int qb, bool has_sink) {
    constexpr int KSTR = DQB + 16, VSTR = 80, KBUF = 128 * KSTR, VTILE = 64 * VSTR, VBUF = 2 * VTILE, NS = DQB / 64, KCH = DQB / 16, KC1 = KCH + 1, VC1 = 5;
    const int lane = tid & 63, wid = __builtin_amdgcn_readfirstlane(tid >> 6), r = lane & 31, hh = lane >> 5;
    const int q0 = qb * 256;
    const int qrow = (MODE == 2 ? LAT + b * 256 : b * 4096) + q0 + wid * 32 + r;
    int lo = 0, ntl = 0;
    if (MODE == 0) { lo = 0; ntl = 64; }
    if (MODE == 1) { lo = q0 - 128 < 0 ? 0 : q0 - 128; const int hi = q0 + 384 > 4096 ? 4096 : q0 + 384; ntl = (hi - lo) / 64; }
    const int NSTEP = (4 + ntl) / 2;
    auto step_row = [&](int st) -> int { return st < 2 ? LAT + b * 256 + st * 128 : b * 4096 + lo + (st - 2) * 128; };
    auto step_T = [&](int st) -> int { return st < 2 ? 2 * st : 4 + lo / 64 + 2 * (st - 2); };
    i32x8 qf[NS];
#pragma unroll
    for (int s = 0; s < NS; ++s) { const unsigned char* qp = d.Q + (size_t)qrow * d.ldq + d.qoff + 64 * s + 32 * hh; const i32x4 lo4 = *(const i32x4*)qp, hi4 = *(const i32x4*)(qp + 16); qf[s] = __builtin_shufflevector(lo4, hi4, 0, 1, 2, 3, 4, 5, 6, 7); }
    const int sclK = 0x7F7F7F7F, sclQ = 0x7C7C7C7C;
    constexpr int NKC = 128 * KC1, NVC = 128 * VC1, NKI = (NKC + 511) / 512, NVI = (NVC + 511) / 512;
    auto dma_step = [&](int st, int buf) {
        const unsigned char* kb_ = d.K + (size_t)step_row(st) * d.ldk; const unsigned char* vb_ = d.Vt + (size_t)step_T(st) * VT_TILE;
#pragma unroll
        for (int i = 0; i < NKI; ++i) { if (i * 512 + wid * 64 < NKC) { const int c = i * 512 + tid, row = c / KC1, ch = c % KC1;
            __builtin_amdgcn_global_load_lds((const unsigned*)(kb_ + (unsigned)(row * d.ldk + d.koff + (ch < KCH ? ch : 0) * 16)), (LAS unsigned*)(lds + buf * KBUF + i * 8192 + wid * 1024), 16, 0, 0); } }
#pragma unroll
        for (int i = 0; i < NVI; ++i) { if (i * 512 + wid * 64 < NVC) { const int c = i * 512 + tid, row = c / VC1, ch = c % VC1;
            __builtin_amdgcn_global_load_lds((const unsigned*)(vb_ + (unsigned)(row * 64 + (ch < 4 ? ch : 0) * 16)), (LAS unsigned*)(lds + 2 * KBUF + buf * VBUF + i * 8192 + wid * 1024), 16, 0, 0); } } };
    constexpr float THR = 8.f, POFF = 6.f;
    static_assert(TRACK, "the fp8 P.V path needs the running row maximum");
    float m = 0.f, l = 0.f;
    if (has_sink) { m = d.sink2 - POFF; l = hh == 0 ? __builtin_amdgcn_exp2f(POFF) : 0.f; }
    f32x16 o0, o1, sc[4];
#pragma unroll
    for (int i = 0; i < 16; ++i) { o0[i] = 0.f; o1[i] = 0.f; }
    const int koffl = r * KSTR + hh * 32, voffl = r * VSTR + hh * 32, sclV = 0x7F7F7F7F;
    auto frag = [&](const LAS unsigned char* p) -> i32x8 { const i32x4 lo4 = *(const LAS i32x4*)p, hi4 = *(const LAS i32x4*)(p + 16); return __builtin_shufflevector(lo4, hi4, 0, 1, 2, 3, 4, 5, 6, 7); };
    __syncthreads();
    dma_step(0, 0); asm volatile("s_waitcnt vmcnt(0)" ::: "memory");
    __syncthreads();
    for (int st = 0; st < NSTEP; ++st) {
        const int buf = st & 1;
        if (st + 1 < NSTEP) dma_step(st + 1, buf ^ 1);
        { const LAS unsigned char* kb = lds + buf * KBUF + koffl; const float negm = -m;
#pragma unroll
          for (int j = 0; j < 4; ++j) {
#pragma unroll
              for (int i = 0; i < 16; ++i) sc[j][i] = negm; }
          asm volatile("s_nop 1" : "+v"(sc[0]), "+v"(sc[1]), "+v"(sc[2]), "+v"(sc[3]));
#pragma unroll
          for (int j = 0; j < 4; ++j) {
#pragma unroll
              for (int s = 0; s < NS; ++s) { const i32x8 x = frag(kb + (32 * j) * KSTR + s * 64); MFMA8(sc[j], x, qf[s], sclK, sclQ); } }
          asm volatile("s_nop 15\n\ts_nop 7" : "+v"(sc[0]), "+v"(sc[1]), "+v"(sc[2]), "+v"(sc[3])); }
        if (MODE == 1) { if (st >= 2) { const int kp0 = lo + (st - 2) * 128, qp = q0 + wid * 32 + r;
#pragma unroll
            for (int j = 0; j < 4; ++j)
#pragma unroll
                for (int i = 0; i < 16; ++i) { const int dk = kp0 + 32 * j + crow(i, hh) - qp; if (dk > 128 || dk < -128) sc[j][i] = -1e30f; } } }
        { float ma = fmax3(sc[0][0], sc[1][0], sc[2][0]), mb = fmax3(sc[3][0], sc[0][1], sc[1][1]);
#pragma unroll
          for (int i = 0; i < 16; ++i) { if (i >= 1) ma = fmax3(ma, sc[0][i], sc[1][i]); if (i >= 2) mb = fmax3(mb, sc[2][i], sc[3][i]); }
          mb = fmax3(mb, sc[2][1], sc[3][1]);
          float mx = __builtin_fmaxf(ma, mb);
          { auto rr = __builtin_amdgcn_permlane32_swap(__float_as_uint(mx), __float_as_uint(mx), false, false); mx = __builtin_fmaxf(__uint_as_float(rr[0]), __uint_as_float(rr[1])); }
          if (st == 0 && !has_sink) {
              const float dl = mx - POFF; m = dl;
#pragma unroll
              for (int j = 0; j < 4; ++j)
#pragma unroll
                  for (int i = 0; i < 16; ++i) sc[j][i] -= dl;
          } else if (__any(mx > THR)) {
              const float dl = __builtin_fmaxf(mx - POFF, 0.f), alpha = __builtin_amdgcn_exp2f(-dl);
              asm volatile("s_nop 15\n\ts_nop 7" : "+v"(o0), "+v"(o1));
              m += dl; l *= alpha;
#pragma unroll
              for (int i = 0; i < 16; ++i) { o0[i] *= alpha; o1[i] *= alpha; }
#pragma unroll
              for (int j = 0; j < 4; ++j)
#pragma unroll
                  for (int i = 0; i < 16; ++i) sc[j][i] -= dl; } }
        float ps0 = 0.f, ps1 = 0.f, ps2 = 0.f, ps3 = 0.f;
#pragma unroll
        for (int j = 0; j < 4; ++j)
#pragma unroll
            for (int i = 0; i < 16; i += 4) { sc[j][i] = __builtin_amdgcn_exp2f(sc[j][i]); sc[j][i + 1] = __builtin_amdgcn_exp2f(sc[j][i + 1]); sc[j][i + 2] = __builtin_amdgcn_exp2f(sc[j][i + 2]); sc[j][i + 3] = __builtin_amdgcn_exp2f(sc[j][i + 3]);
                ps0 += sc[j][i]; ps1 += sc[j][i + 1]; ps2 += sc[j][i + 2]; ps3 += sc[j][i + 3]; }
        l += (ps0 + ps1) + (ps2 + ps3);
        i32x8 pf[2];
#pragma unroll
        for (int t2 = 0; t2 < 2; ++t2) {
#pragma unroll
            for (int q4 = 0; q4 < 4; ++q4) { pf[t2][q4] = (int)pk_fp8x4(sc[2 * t2][4 * q4], sc[2 * t2][4 * q4 + 1], sc[2 * t2][4 * q4 + 2], sc[2 * t2][4 * q4 + 3]);
                                             pf[t2][4 + q4] = (int)pk_fp8x4(sc[2 * t2 + 1][4 * q4], sc[2 * t2 + 1][4 * q4 + 1], sc[2 * t2 + 1][4 * q4 + 2], sc[2 * t2 + 1][4 * q4 + 3]); } }
        asm volatile("s_nop 1" : "+v"(pf[0]), "+v"(pf[1]));
        { const LAS unsigned char* vb = lds + 2 * KBUF + buf * VBUF + voffl;
#pragma unroll
          for (int t2 = 0; t2 < 2; ++t2) { const i32x8 v0 = frag(vb + t2 * VTILE), v1 = frag(vb + t2 * VTILE + 32 * VSTR); MFMA8(o0, v0, pf[t2], sclV, sclV); MFMA8(o1, v1, pf[t2], sclV, sclV); } }
        asm volatile("s_waitcnt vmcnt(0) lgkmcnt(0)" ::: "memory"); __builtin_amdgcn_s_barrier(); asm volatile("" ::: "memory");
    }
    asm volatile("s_nop 15\n\ts_nop 15" : "+v"(o0), "+v"(o1));
    { auto rr = __builtin_amdgcn_permlane32_swap(__float_as_uint(l), __float_as_uint(l), false, false); l = __uint_as_float(rr[0]) + __uint_as_float(rr[1]); }
    const float inv = 1.0f / l;
    bf16_t* op = d.O + (size_t)qrow * 1024 + d.ooff + 4 * hh;
#pragma unroll
    for (int g4 = 0; g4 < 4; ++g4) {
        u32x2 w; w.x = cvt_pk(o0[4 * g4] * inv, o0[4 * g4 + 1] * inv); w.y = cvt_pk(o0[4 * g4 + 2] * inv, o0[4 * g4 + 3] * inv); *(u32x2*)(op + 8 * g4) = w;
        u32x2 x; x.x = cvt_pk(o1[4 * g4] * inv, o1[4 * g4 + 1] * inv); x.y = cvt_pk(o1[4 * g4 + 2] * inv, o1[4 * g4 + 3] * inv); *(u32x2*)(op + 32 + 8 * g4) = x;
    }
}

#ifndef TRACK_EN
#define TRACK_EN 1
#endif
DI void attn_phase(const Frame& F, int l, bool with_ctx, int rep = 0) {
    constexpr int NU_B = NB * 96, NU_A = NB * 96, NU_C = NB * 64, NU_X = NB * 16;
    const int NU = NU_B + NU_A + NU_C + (with_ctx ? NU_X : 0);
    unsigned* head = F.ctl + CW_QUEUE + 64 * (l + 2 * rep);
    volatile LAS int* slot = (volatile LAS int*)(F.lds + LDS_MISC + 16);
    const float* sinkp = INP(21) + l * 4;
    bool track;
    { auto amax = [&](const float* g, int n) { float v = 0.f; for (int i = 0; i < n; ++i) v = fmaxf(v, fabsf(g[i])); return v; };
      const float ga = 8.f * amax(INP(9) + l * 64, 64) * amax(INP(10) + l * 64, 64), gc = 8.f * amax(INP(19) + l * 64, 64) * amax(INP(20) + l * 64, 64);
      const float qn = amax(INP(15) + l * 64, 64), qr = amax(INP(17) + l * 32, 32), kn = amax(INP(16) + l * 64, 64), kr = amax(INP(18) + l * 32, 32);
      const float gb = sqrtf((64.f * qn * qn + 32.f * qr * qr) * (64.f * kn * kn + 32.f * kr * kr) / 96.f);
      const float sk = fmaxf(fmaxf(fabsf(sinkp[0]), fabsf(sinkp[1])), fmaxf(fabsf(sinkp[2]), fabsf(sinkp[3])));
      const float bound = fmaxf(fmaxf(ga, gc), fmaxf(gb, sk)) * LOG2E;
      track = !(bound < 100.f); }
    for (;;) {
        __syncthreads();
        if (F.tid == 0) *slot = (int)__hip_atomic_fetch_add(head, 1u, __ATOMIC_RELAXED, __HIP_MEMORY_SCOPE_AGENT);
        __syncthreads();
        int u = *slot; if (u >= NU) break;
        GAS unsigned char* wsg = (GAS unsigned char*)F.ws; asm volatile("" : "+s"(wsg)); unsigned char* ws = (unsigned char*)wsg;
        int tidu = F.tid; asm volatile("" : "+v"(tidu));
        AttnDesc d;
        if (u < NU_B) { const int b = u / 96, h = (u % 96) / 16, qb = u % 16;
            d = AttnDesc{(const unsigned char*)(ws + Z_QB), 768, h * 128, (const unsigned char*)(ws + Z_KB), 768, h * 128, (const unsigned char*)(ws + Z_VB) + ((size_t)b * 6 + h) * VT_HEAD, (bf16_t*)(ws + Z_OB), 384 + h * 64, 0.f};
#ifdef ATT_ABL
            if (rep) { attn_unit<128, 0, true, ATT_ABL>(tidu, F.lds, d, b, qb, false); continue; }
#endif
            attn_unit<128, 0, true>(tidu, F.lds, d, b, qb, false); continue; }
        u -= NU_B;
        if (u < NU_A) { const int b = u / 96, h = (u % 96) / 16, qb = u % 16;
            d = AttnDesc{(const unsigned char*)(ws + Z_QA), 384, h * 64, (const unsigned char*)(ws + Z_KA), 128, (h / 3) * 64, (const unsigned char*)(ws + Z_VA) + ((size_t)b * 2 + h / 3) * VT_HEAD, (bf16_t*)(ws + Z_OB), h * 64, 0.f};
#ifdef ATT_ABL
            if (rep) { attn_unit<64, 0, true, ATT_ABL>(tidu, F.lds, d, b, qb, false); continue; }
#endif
            attn_unit<64, 0, true>(tidu, F.lds, d, b, qb, false); continue; }
        u -= NU_A;
        if (u < NU_C) { const int b = u / 64, h = (u % 64) / 16, qb = u % 16;
            d = AttnDesc{(const unsigned char*)(ws + Z_QC), 256, h * 64, (const unsigned char*)(ws + Z_KC), 128, (h / 2) * 64, (const unsigned char*)(ws + Z_VC) + ((size_t)b * 2 + h / 2) * VT_HEAD, (bf16_t*)(ws + Z_OB), 768 + h * 64, sinkp[h] * LOG2E};
            attn_unit<64, 1, true>(tidu, F.lds, d, b, qb, true); continue; }
        u -= NU_C;
        { const int b = u / 16, hx = u % 16;
            if (hx < 6) { const int h = hx;
                d = AttnDesc{(const unsigned char*)(ws + Z_QA), 384, h * 64, (const unsigned char*)(ws + Z_KA), 128, (h / 3) * 64, (const unsigned char*)(ws + Z_VA) + ((size_t)b * 2 + h / 3) * VT_HEAD, (bf16_t*)(ws + Z_OB), h * 64, 0.f};
                attn_unit<64, 2, true>(tidu, F.lds, d, b, 0, false); }
            else if (hx < 12) { const int h = hx - 6;
                d = AttnDesc{(const unsigned char*)(ws + Z_QB), 768, h * 128, (const unsigned char*)(ws + Z_KB), 768, h * 128, (const unsigned char*)(ws + Z_VB) + ((size_t)b * 6 + h) * VT_HEAD, (bf16_t*)(ws + Z_OB), 384 + h * 64, 0.f};
                attn_unit<128, 2, true>(tidu, F.lds, d, b, 0, false); }
            else { const int h = hx - 12;
                d = AttnDesc{(const unsigned char*)(ws + Z_QC), 256, h * 64, (const unsigned char*)(ws + Z_KC), 128, (h / 2) * 64, (const unsigned char*)(ws + Z_VC) + ((size_t)b * 2 + h / 2) * VT_HEAD, (bf16_t*)(ws + Z_OB), 768 + h * 64, sinkp[h] * LOG2E};
                attn_unit<64, 2, true>(tidu, F.lds, d, b, 0, true); }
        }
    }
}

DI void router_phase(const Frame& F, int l, bool with_ctx) {
    LAS float* wT = (LAS float*)F.lds;
    const float* wr = INP(23) + (size_t)l * 1024 * 16;
    for (int e = F.tid; e < 16 * 1024; e += NTHR) { const int k = e / 16, x = e % 16; wT[x * 1024 + k] = wr[e]; }
    __syncthreads();
    const int gw = F.bid * NWAVES + F.wave, NGW = F.G * NWAVES, NR = with_ctx ? R : LAT, lane = F.lane;
    const float* g = INP(7) + l * 1024;
    auto rowptr = [&](int row) -> const float* { return row < LAT ? F.out + (size_t)row * 1024 : WSP(float, WS_CTXF) + (size_t)(row - LAT) * 1024; };
    f32x4 vn[4];
    if (gw < NR) { const float* xr0 = rowptr(gw);
#pragma unroll
        for (int j = 0; j < 4; ++j) vn[j] = *(const f32x4*)(xr0 + 4 * (lane + 64 * j)); }
    for (int row = gw; row < NR; row += NGW) {
        const float* m = mod_row(F, l, row);
        f32x4 v[4]; float s = 0.f;
#pragma unroll
        for (int j = 0; j < 4; ++j) { v[j] = vn[j]; s += (v[j].x * v[j].x + v[j].y * v[j].y) + (v[j].z * v[j].z + v[j].w * v[j].w); }
        if (row + NGW < NR) { const float* xr1 = rowptr(row + NGW);
#pragma unroll
            for (int j = 0; j < 4; ++j) vn[j] = *(const f32x4*)(xr1 + 4 * (lane + 64 * j)); }
        const float rstd = 1.0f / sqrtf(wave_sum(s) * (1.f / 1024.f) + EPS);
        float lg[16];
#pragma unroll
        for (int e = 0; e < 16; ++e) lg[e] = 0.f;
        unsigned char* orow = WSP(unsigned char, WS_HB) + (size_t)row * 1024;
#pragma unroll
        for (int j = 0; j < 4; ++j) { const int c = 4 * (lane + 64 * j); const f32x4 gv = *(const f32x4*)(g + c), sv = *(const f32x4*)(m + 3072 + c), cv = *(const f32x4*)(m + 4096 + c);
            v[j] = v[j] * rstd * gv * (cv + 1.0f) + sv; *(unsigned*)(orow + c) = pk_fp8x4(v[j].x, v[j].y, v[j].z, v[j].w); }
        asm volatile("" ::: "memory");
#pragma unroll
        for (int e = 0; e < 16; ++e) {
#pragma unroll
            for (int j = 0; j < 4; ++j) { const f32x4 wv = *(const LAS f32x4*)(wT + e * 1024 + 4 * (lane + 64 * j)); lg[e] += (v[j].x * wv.x + v[j].y * wv.y) + (v[j].z * wv.z + v[j].w * wv.w); }
            if (e & 1) asm volatile("" ::: "memory"); }
#pragma unroll
        for (int e = 0; e < 16; ++e) lg[e] = wave_sum(lg[e]);
        float mx = lg[0];
#pragma unroll
        for (int e = 1; e < 16; ++e) mx = fmaxf(mx, lg[e]);
        float sum = 0.f;
#pragma unroll
        for (int e = 0; e < 16; ++e) { lg[e] = expf(lg[e] - mx); sum += lg[e]; }
        const float isum = 1.0f / sum;
        float mine = 0.f;
#pragma unroll
        for (int e = 0; e < 16; ++e) mine = (lane == e) ? lg[e] * isum : mine;
        if (lane < 16) {
            if (row < LAT) WSP(float, WS_AFFL)[((size_t)(row / 4096) * 16 + lane) * 4096 + (row & 4095)] = mine;
            else { const int rc = row - LAT; WSP(float, WS_AFFC)[((size_t)(rc / 256) * 16 + lane) * 256 + (rc & 255)] = mine; }
        }
    }
}

DI void topk_phase(const Frame& F, bool with_ctx) {
    LAS unsigned* hist = (LAS unsigned*)F.lds;
    LAS unsigned* sh = hist + 256;
    LAS unsigned* scan = hist + 512;
    const int NL = NB * 16 * (with_ctx ? 2 : 1), tid = F.tid;
    for (int li = F.bid; li < NL; li += F.G) {
        const bool isctx = li >= NB * 16; const int be = isctx ? li - NB * 16 : li, b = be / 16, e = be % 16;
        const int n = isctx ? 256 : 4096, cap = n / 8, per = isctx ? 1 : 8;
        const float* a = isctx ? WSP(float, WS_AFFC) + (size_t)be * 256 : WSP(float, WS_AFFL) + (size_t)be * 4096;
        unsigned key[8]; const bool act = tid * per < n;
#pragma unroll
        for (int j = 0; j < 8; ++j) key[j] = (act && j < per) ? __float_as_uint(a[tid * per + j]) : 0u;
        unsigned prefix = 0u, rem = (unsigned)cap;
        for (int pass = 0; pass < 4; ++pass) {
            const int shift = 24 - 8 * pass;
            __syncthreads();
            if (tid < 256) hist[tid] = 0u;
            __syncthreads();
#pragma unroll
            for (int j = 0; j < 8; ++j) if (act && j < per) { const unsigned k = key[j]; const bool match = pass == 0 ? true : ((k >> (shift + 8)) == (prefix >> (shift + 8))); if (match) __hip_atomic_fetch_add(&hist[(k >> shift) & 255u], 1u, __ATOMIC_RELAXED, __HIP_MEMORY_SCOPE_WORKGROUP); }
            __syncthreads();
            if (tid < 64) {
                const int b0 = 255 - 4 * tid; const unsigned c0 = hist[b0], c1 = hist[b0 - 1], c2 = hist[b0 - 2], c3 = hist[b0 - 3];
                unsigned incl = c0 + c1 + c2 + c3;
#pragma unroll
                for (int o = 1; o < 64; o <<= 1) { const unsigned v = shfl_up_u(incl, o, tid); if (tid >= o) incl += v; }
                unsigned cum = incl - (c0 + c1 + c2 + c3);
                if (cum < rem && incl >= rem) { int bin = b0; unsigned c = c0;
                    if (cum + c < rem) { cum += c; bin = b0 - 1; c = c1; if (cum + c < rem) { cum += c; bin = b0 - 2; c = c2; if (cum + c < rem) { cum += c; bin = b0 - 3; } } }
                    sh[0] = prefix | ((unsigned)bin << shift); sh[1] = rem - cum; }
            }
            __syncthreads();
            prefix = sh[0]; rem = sh[1];
        }
        unsigned cg = 0u, ce = 0u;
#pragma unroll
        for (int j = 0; j < 8; ++j) if (act && j < per) { cg += key[j] > prefix ? 1u : 0u; ce += key[j] == prefix ? 1u : 0u; }
        __syncthreads();
        scan[tid] = cg; scan[512 + tid] = ce;
        __syncthreads();
        unsigned gb, eb;
        {
            unsigned ig = cg, ie = ce; const int ln = tid & 63, wv = tid >> 6;
#pragma unroll
            for (int o = 1; o < 64; o <<= 1) { const unsigned vg = shfl_up_u(ig, o, ln), ve = shfl_up_u(ie, o, ln); if (ln >= o) { ig += vg; ie += ve; } }
            if (ln == 63) { scan[1024 + wv] = ig; scan[1040 + wv] = ie; }
            __syncthreads();
            unsigned og = 0u, oe = 0u;
#pragma unroll
            for (int w = 0; w < 8; ++w) { if (w < wv) { og += scan[1024 + w]; oe += scan[1040 + w]; } }
            gb = og + ig - cg; eb = oe + ie - ce;
        }
        const int rowb = isctx ? LAT + b * 256 : b * 4096;
        const int mbase = isctx ? MOE_LAT + e * 256 + b * 32 : (b * 16 + e) * 512;
        int* gidx = WSP(int, WS_GIDX); float* gate = WSP(float, WS_GATE); int* inv = WSP(int, WS_INV);
#pragma unroll
        for (int j = 0; j < 8; ++j) if (act && j < per) {
            const unsigned k = key[j]; const int t = tid * per + j; int slot = -1;
            if (k > prefix) { slot = (int)(gb + (eb < rem ? eb : rem)); ++gb; }
            else if (k == prefix) { if (eb < rem) slot = (int)(gb + eb); ++eb; }
            if (slot >= 0) { gidx[mbase + slot] = rowb + t; gate[mbase + slot] = __uint_as_float(k); }
            inv[(size_t)(rowb + t) * 16 + e] = slot >= 0 ? mbase + slot : -1;
        }
        if (isctx && NB < 8 && b == 0) { for (int i = NB * 32 + tid; i < 256; i += NTHR) { gidx[MOE_LAT + e * 256 + i] = LAT; gate[MOE_LAT + e * 256 + i] = 0.f; } }
    }
}

DI void combine_phase(const Frame& F, int l, bool with_ctx) {
    const int gw = F.bid * NWAVES + F.wave, NGW = F.G * NWAVES, NR = with_ctx ? R : LAT, lane = F.lane;
    const bool last = (l == DEPTH - 1);
    const bf16_t* ye = WSP(bf16_t, Z_YE); const int* inv = WSP(int, WS_INV);
    for (int row = gw; row < NR; row += NGW) {
        float* xr = row < LAT ? F.out + (size_t)row * 1024 : WSP(float, WS_CTXF) + (size_t)(row - LAT) * 1024;
        const float* m = mod_row(F, l, row);
        f32x4 acc[4];
#pragma unroll
        for (int j = 0; j < 4; ++j) acc[j] = (f32x4){0.f, 0.f, 0.f, 0.f};
        const int myslot = lane < 16 ? inv[(size_t)row * 16 + lane] : -1;
#pragma unroll
        for (int e = 0; e < 16; ++e) { const int s = __builtin_amdgcn_readlane(myslot, e); if (s >= 0) { const bf16_t* yr = ye + (size_t)s * 1024;
#pragma unroll
                for (int j = 0; j < 4; ++j) { const u32x2 w = *(const u32x2*)(yr + 4 * (lane + 64 * j)); acc[j].x += bf_lo(w.x); acc[j].y += bf_hi(w.x); acc[j].z += bf_lo(w.y); acc[j].w += bf_hi(w.y); } } }
        f32x4 v[4];
#pragma unroll
        for (int j = 0; j < 4; ++j) { const int c = 4 * (lane + 64 * j); v[j] = *(const f32x4*)(xr + c) + *(const f32x4*)(m + 5120 + c) * acc[j]; *(f32x4*)(xr + c) = v[j]; }
        if (!last) { const float* m2 = mod_row(F, l + 1, row); norm_mod_store(v, INP(6) + (l + 1) * 1024, m2, m2 + 1024, WSP(unsigned char, WS_HB) + (size_t)row * 1024, lane); }
    }
}
constexpr int NPHASE = 2 + 9 * DEPTH;
DI void load_tabs(const Frame& F) {
    const f32x2* t64 = WSP(f32x2, WS_TAB64); const f32x2* t32 = WSP(f32x2, WS_TAB32);
    LAS f32x2* l64 = (LAS f32x2*)(F.lds + LDS_TAB64); LAS f32x2* l32 = (LAS f32x2*)(F.lds + LDS_TAB32);
    for (int i = F.tid; i < 64 * 16; i += NTHR) l64[i] = t64[i];
    for (int i = F.tid; i < 64 * 8; i += NTHR) l32[i] = t32[i];
    __syncthreads();
}
#ifndef PH_EN
#define PH_EN(k) 1
#endif
DI void run_phase(const Frame& F, int ph, int rep = 0) {
    unsigned char* ws = F.ws;
    if (ph == 0) { if (PH_EN(100)) p0_phase(F); return; }
    if (ph == 1) { if (PH_EN(101)) init_norm_phase(F); return; }
    const int l = (ph - 2) / 9, s = (ph - 2) % 9; const bool last = (l == DEPTH - 1);
    switch (s) {
    case 0: if (PH_EN(0)) { load_tabs(F);
        g8::DenseSched S; S.init(MT, 6, F.G, F.bid, 512, ws + WS_WIN + (size_t)l * 1536 * 1024);
        EpiInProj E{ws, F.intab, l, (const LAS f32x2*)(F.lds + LDS_TAB64), (const LAS f32x2*)(F.lds + LDS_TAB32)};
        g8::gemm_phase(F.tid, F.lds, (const char*)(ws + WS_HB), 512, S, E); } break;
    case 1: if (PH_EN(1)) { load_tabs(F);
        g8::DenseSched S; S.init(MT, 6, F.G, F.bid, 384, ws + WS_WUP + (size_t)l * 1536 * 384 * 2);
        EpiUpProj E{ws, F.intab, l, (const LAS f32x2*)(F.lds + LDS_TAB32)};
        g8::gemm_phase(F.tid, F.lds, (const char*)(ws + Z_CRAW), 384, S, E); } break;
    case 2: if (PH_EN(2)) attn_phase(F, l, !last, rep); break;
    case 3: if (PH_EN(3)) { g8::DenseSched S; S.init(last ? LAT / 256 : MT, 4, F.G, F.bid, 1024, ws + WS_WOUT + (size_t)l * 1024 * 1024 * 2);
        EpiOutProj E{ws, l == 0 ? INP(0) : F.out, INP(2), F.out, l};
        g8::gemm_phase(F.tid, F.lds, (const char*)(ws + Z_OB), 1024, S, E); } break;
    case 4: if (PH_EN(4)) router_phase(F, l, !last); break;
    case 5: if (PH_EN(5)) topk_phase(F, !last); break;
    case 6: if (PH_EN(6)) { g8::MoeSched<true> S; S.init(8, !last, F.G, F.bid, 512, ws + WS_W1 + (size_t)l * 16 * 2048 * 1024, (size_t)2048 * 1024, (const int*)(ws + WS_GIDX));
        EpiMoe1 E{ws}; g8::gemm_phase(F.tid, F.lds, (const char*)(ws + WS_HB), 512, S, E); } break;
    case 7: if (PH_EN(7)) { g8::MoeSched<false> S; S.init(4, !last, F.G, F.bid, 512, ws + WS_W2 + (size_t)l * 16 * 1024 * 1024, (size_t)1024 * 1024, nullptr);
        EpiMoe2 E{ws}; g8::gemm_phase(F.tid, F.lds, (const char*)(ws + Z_HID), 512, S, E); } break;
    case 8: if (PH_EN(8)) combine_phase(F, l, !last); break;
    }
}
__global__ void __launch_bounds__(NTHR, 2) mega_kernel(Args a) {
    extern __shared__ __attribute__((aligned(16))) unsigned char lds_raw[];
    Frame F; F.lds = (LAS unsigned char*)lds_raw; F.ws = a.ws; F.ctl = (unsigned*)(a.ws + WS_CTL);
    F.tid = threadIdx.x; F.lane = F.tid & 63; F.wave = __builtin_amdgcn_readfirstlane(F.tid >> 6); F.G = gridDim.x; F.bid = blockIdx.x; F.out = a.out;
    { LAS unsigned long long* tab = (LAS unsigned long long*)(F.lds + LDS_INTAB); if (F.tid < 27) tab[F.tid] = (unsigned long long)a.in[F.tid]; F.intab = tab; }
    volatile LAS unsigned* MISC = (volatile LAS unsigned*)(F.lds + LDS_MISC);
    if (F.tid < 64) MISC[F.tid] = 0u;
    __syncthreads();
    const bool multi = a.ph_hi - a.ph_lo > 1;
    XcdBarrier bar; bar.bar = F.ctl + CW_BAR + a.li * XCD_BAR_WORDS; bar.x = 0; bar.st = MISC;
    if (multi) bar = xcd_barrier_post(F.ctl + CW_BAR + a.li * XCD_BAR_WORDS, MISC);
    for (int ph = a.ph_lo; ph < a.ph_hi; ++ph) {
        {
            GAS unsigned char* w_ = (GAS unsigned char*)a.ws; GAS float* o_ = (GAS float*)a.out; unsigned l_ = (unsigned)(unsigned long long)F.lds, t_ = (unsigned)(unsigned long long)F.intab; int tid_ = threadIdx.x, g_ = gridDim.x, b_ = blockIdx.x;
            asm volatile("" : "+s"(w_), "+s"(o_), "+s"(l_), "+s"(t_), "+v"(tid_), "+s"(g_), "+s"(b_));
            F.ws = (unsigned char*)w_; F.out = (float*)o_; F.lds = (LAS unsigned char*)(unsigned long long)l_; F.intab = (const LAS unsigned long long*)(unsigned long long)t_; F.ctl = (unsigned*)(F.ws + WS_CTL);
            F.tid = tid_; F.lane = tid_ & 63; F.wave = __builtin_amdgcn_readfirstlane(tid_ >> 6); F.G = g_; F.bid = b_; }
        run_phase(F, ph, a.li);
#ifdef PROBE_I
        xcd_barrier(bar);
        if (F.bid == 0 && F.tid == 0) ((unsigned long long*)(F.ws + 49152))[ph + 1] = __builtin_amdgcn_s_memrealtime();
#else
        if (ph + 1 < a.ph_hi) xcd_barrier(bar);
#endif
    }
#ifdef PROBE_I
    {
        xcd_barrier(bar);
        const unsigned long long* ts = (const unsigned long long*)(F.ws + 49152);
        float ti = (float)(__hip_atomic_load(ts + PROBE_I + 1, __ATOMIC_RELAXED, __HIP_MEMORY_SCOPE_AGENT) - __hip_atomic_load(ts + PROBE_I, __ATOMIC_RELAXED, __HIP_MEMORY_SCOPE_AGENT)) * 0.01f;
        float tj = (float)(__hip_atomic_load(ts + PROBE_J + 1, __ATOMIC_RELAXED, __HIP_MEMORY_SCOPE_AGENT) - __hip_atomic_load(ts + PROBE_J, __ATOMIC_RELAXED, __HIP_MEMORY_SCOPE_AGENT)) * 0.01f;
        ti = exp2f(rintf(log2f(fmaxf(ti, 1.f)) * 14.2067f) / 14.2067f); tj = exp2f(rintf(log2f(fmaxf(tj, 1.f)) * 14.2067f) / 14.2067f);
        const float* xin = inp(F.intab, 0); const size_t n = (size_t)8 * 4096 * 1024;
        for (size_t i = (size_t)F.bid * NTHR + F.tid; i < n; i += (size_t)F.G * NTHR) F.out[i] = xin[i] + ti + (i == 0 ? 100.f * tj : 0.f);
    }
#endif
}
}

extern "C" void kernel_launch(void* const* d_in, const int* in_sizes, int n_in, void* d_out, int out_size, void* d_ws, size_t ws_size, hipStream_t stream) {
    static int grid = 0;
    if (grid == 0) {
        if (n_in != 27 || out_size != 8 * 4096 * 1024 || ws_size < fp::WS_END) { fprintf(stderr, "kernel_launch: unexpected problem (n_in %d, out %d, ws %zu < %zu)\n", n_in, out_size, ws_size, (size_t)fp::WS_END); grid = -1; return; }
        int dev = 0, cus = 0, per_cu = 0;
        if (hipGetDevice(&dev) != hipSuccess || hipDeviceGetAttribute(&cus, hipDeviceAttributeMultiprocessorCount, dev) != hipSuccess) { fprintf(stderr, "kernel_launch: device query failed\n"); grid = -1; return; }
        if (hipFuncSetAttribute((const void*)fp::mega_kernel, hipFuncAttributeMaxDynamicSharedMemorySize, fp::LDS_BYTES) != hipSuccess) { fprintf(stderr, "kernel_launch: hipFuncSetAttribute failed\n"); grid = -1; return; }
        if (hipOccupancyMaxActiveBlocksPerMultiprocessor(&per_cu, (const void*)fp::mega_kernel, fp::NTHR, fp::LDS_BYTES) != hipSuccess || per_cu < 1) fprintf(stderr, "kernel_launch: note: occupancy query reports %d workgroups per CU\n", per_cu);
        (void)hipGetLastError();
        grid = cus;
    }
    if (grid < 0) return;
    if (hipMemsetAsync((char*)d_ws + fp::WS_CTL, 0, fp::CTL_BYTES, stream) != hipSuccess) { fprintf(stderr, "kernel_launch: memset failed\n"); return; }
    fp::Args a{};
    for (int i = 0; i < 27; ++i) a.in[i] = (const float*)d_in[i];
    a.out = (float*)d_out; a.ws = (unsigned char*)d_ws; a.ph_lo = 0; a.ph_hi = fp::NPHASE;
#ifdef PROBE_SPLIT_LO
    a.ph_hi = PROBE_SPLIT_HI; a.li = 1; hipLaunchKernelGGL(fp::mega_kernel, dim3(grid), dim3(fp::NTHR), fp::LDS_BYTES, stream, a);
    a.ph_lo = PROBE_SPLIT_LO; a.ph_hi = fp::NPHASE; a.li = 0;
#endif
    hipLaunchKernelGGL(fp::mega_kernel, dim3(grid), dim3(fp::NTHR), fp::LDS_BYTES, stream, a);
}
```

```cpp
#include <hip/hip_runtime.h>
#include <stdint.h>
#include <stdio.h>
#include <math.h>
#include <type_traits>
constexpr int DEPTH = 2;
#define FAST_NB 8
namespace fp {
#define LAS __attribute__((address_space(3)))
#define GAS __attribute__((address_space(1)))
typedef unsigned short bf16_t;
typedef short bf16x8 __attribute__((ext_vector_type(8)));
typedef short s16x4 __attribute__((ext_vector_type(4)));
typedef float f32x4 __attribute__((ext_vector_type(4)));
typedef float f32x16 __attribute__((ext_vector_type(16)));
typedef unsigned u32x4 __attribute__((ext_vector_type(4)));
typedef unsigned u32x2 __attribute__((ext_vector_type(2)));
typedef float f32x2 __attribute__((ext_vector_type(2)));
#define DI __device__ __forceinline__

DI unsigned cvt_pk(float lo, float hi) { typedef float f2 __attribute__((ext_vector_type(2))); typedef __bf16 b2 __attribute__((ext_vector_type(2))); f2 v = {lo, hi}; b2 b = __builtin_convertvector(v, b2); return __builtin_bit_cast(unsigned, b); }
DI float bf_lo(unsigned w) { return __uint_as_float(w << 16); }
DI float bf_hi(unsigned w) { return __uint_as_float(w & 0xffff0000u); }
DI float silu_f(float v) { return v / (1.f + __expf(-v)); }
template <int M> DI float swz_xor(float v) { return __int_as_float(__builtin_amdgcn_ds_swizzle(__float_as_int(v), (M << 10) | 0x1F)); }
DI float add_xor16(float v) { return v + swz_xor<16>(v); }
DI float add_xor32(float v) { auto r = __builtin_amdgcn_permlane32_swap(__float_as_uint(v), __float_as_uint(v), false, false); return __uint_as_float(r[0]) + __uint_as_float(r[1]); }
DI float other32(float v, bool upper_half) { auto r = __builtin_amdgcn_permlane32_swap(__float_as_uint(v), __float_as_uint(v), false, false); return __uint_as_float(upper_half ? r[0] : r[1]); }
DI float wave_sum(float v) { v += swz_xor<1>(v); v += swz_xor<2>(v); v += swz_xor<4>(v); v += swz_xor<8>(v); v += swz_xor<16>(v); return add_xor32(v); }
DI unsigned shfl_up_u(unsigned v, int o, int lane) { return (unsigned)__builtin_amdgcn_ds_bpermute((lane - o) << 2, (int)v); }

constexpr int NB = FAST_NB;
constexpr int LAT = NB * 4096, CTXR = NB * 256, R = LAT + CTXR, MT = R / 256;
constexpr int MOE_LAT = NB * 16 * 512, MOE_ROWS = MOE_LAT + 16 * 256;
constexpr float EPS = 1e-6f, LOG2E = 1.4426950408889634f;
constexpr float QS64 = 0.125f * LOG2E, QS96 = 0.10206207261596575f * LOG2E;
constexpr float QF64 = QS64 * 8.f, QF96 = QS96 * 8.f;
constexpr int NWAVES = 8, NTHR = 512;

constexpr size_t al256(size_t x) { return (x + 255) & ~(size_t)255; }
constexpr size_t WS_CTL = 0, CTL_BYTES = 65536;
constexpr size_t WS_MOD = WS_CTL + CTL_BYTES;
constexpr size_t WS_TAB64 = WS_MOD + al256((size_t)2 * 9 * 6144 * 4);
constexpr size_t WS_TAB32 = WS_TAB64 + 8192;
constexpr size_t WS_WIN = WS_TAB32 + 4096;
constexpr size_t WS_WUP = WS_WIN + (size_t)2 * 1536 * 1024 * 2;
constexpr size_t WS_WOUT = WS_WUP + (size_t)2 * 1536 * 384 * 2;
constexpr size_t WS_W1 = WS_WOUT + (size_t)2 * 1024 * 1024 * 2;
constexpr size_t WS_W2 = WS_W1 + (size_t)2 * 16 * 2048 * 1024 * 2;
constexpr size_t WS_HB = WS_W2 + (size_t)2 * 16 * 1024 * 1024 * 2;
constexpr size_t WS_CTXF = WS_HB + (size_t)R * 1024 * 2;
constexpr size_t WS_SSQ = WS_CTXF + (size_t)CTXR * 1024 * 4;
constexpr size_t WS_AFFL = WS_SSQ + (size_t)R * 8 * 4;
constexpr size_t WS_AFFC = WS_AFFL + (size_t)NB * 16 * 4096 * 4;
constexpr size_t WS_GIDX = WS_AFFC + (size_t)NB * 16 * 256 * 4;
constexpr size_t WS_GATE = WS_GIDX + (size_t)MOE_ROWS * 4;
constexpr size_t WS_INV = WS_GATE + (size_t)MOE_ROWS * 4;
constexpr size_t WS_Z = al256(WS_INV + (size_t)R * 16 * 4);
constexpr size_t Z_QA = WS_Z, Z_KA = Z_QA + (size_t)R * 384 * 2, Z_VA = Z_KA + (size_t)R * 128 * 2, Z_QC = Z_VA + (size_t)R * 128 * 2, Z_KC = Z_QC + (size_t)R * 256 * 2,
                 Z_VC = Z_KC + (size_t)R * 128 * 2, Z_CRAW = Z_VC + (size_t)R * 128 * 2, Z_QB = Z_CRAW + (size_t)R * 384 * 2, Z_KB = Z_QB + (size_t)R * 576 * 2,
                 Z_VB = Z_KB + (size_t)R * 576 * 2, Z_OB = Z_VB + (size_t)R * 384 * 2, Z_END1 = Z_OB + (size_t)R * 1024 * 2;
constexpr size_t VT_TILE = 4096, VT_HEAD = 68 * VT_TILE;
constexpr size_t Z_HID = WS_Z, Z_YE = Z_HID + (size_t)MOE_ROWS * 1024 * 2, Z_END2 = Z_YE + (size_t)MOE_ROWS * 1024 * 2;
constexpr size_t WS_END = al256(Z_END1 > Z_END2 ? Z_END1 : Z_END2);
constexpr int CW_BAR = 1024;
constexpr int CW_QUEUE = 8192;

DI int vt_pos(int k) { return ((k & 4) << 3) | ((k & 32) >> 1) | ((k & 24) >> 1) | (k & 3); }
constexpr int RING_BYTES = 131072;
constexpr int LDS_TAB64 = RING_BYTES, LDS_TAB32 = LDS_TAB64 + 8192, LDS_MISC = LDS_TAB32 + 4096;
constexpr int LDS_INTAB = LDS_MISC + 256;
constexpr int LDS_BYTES = 147456;

#define XB_TMO      128
#define XB_XCNT(j)  (256  + 64 * (j))
#define XB_XSUB(j)  (1280 + 64 * (j))
#define XB_XGEN(j)  (2304 + 64 * (j))
#define XB_TOP      3328
#define XB_TOPGEN   3392
#define XCD_BAR_WORDS 3456
#define XB_SPIN_CAP (1u << 20)
DI unsigned xb_ld(unsigned* p)              { return __hip_atomic_load(p, __ATOMIC_RELAXED, __HIP_MEMORY_SCOPE_AGENT); }
DI unsigned xb_add(unsigned* p, unsigned v) { return __hip_atomic_fetch_add(p, v, __ATOMIC_RELAXED, __HIP_MEMORY_SCOPE_AGENT); }
DI unsigned xb_xcc_id() { return (unsigned)__builtin_amdgcn_s_getreg((3 << 11) | 20) & 0xFu; }
#define XB_SPIN(cond, bar) do { unsigned _sp = 0; while (cond) { __builtin_amdgcn_s_sleep(1); \
    if ((++_sp & 255u) == 0u) { if (xb_ld(&(bar)[XB_TMO])) break; if (_sp > XB_SPIN_CAP) { atomicAdd(&(bar)[XB_TMO], 1u); break; } } } } while (0)
struct XcdBarrier { unsigned* bar; unsigned x; volatile LAS unsigned* st; };
DI XcdBarrier xcd_barrier_post(unsigned* bar, volatile LAS unsigned* st) {
    XcdBarrier b; b.bar = bar; b.x = xb_xcc_id(); b.st = st;
    if (threadIdx.x == 0) (void)xb_add(&bar[XB_XCNT(b.x)], 1u);
    return b;
}
DI void xcd_barrier_complete(unsigned* bar, unsigned x, unsigned& nloc, unsigned& nx) {
    asm volatile("" : "+s"(x));
    const unsigned G = gridDim.x * gridDim.y * gridDim.z;
    unsigned sum, cnt, mine, sp = 0u;
    for (;;) {
        sum = 0u; cnt = 0u; mine = 0u;
#pragma unroll
        for (unsigned j = 0; j < 16; ++j) { const unsigned c = xb_ld(&bar[XB_XCNT(j)]); sum += c; cnt += (c > 0u) ? 1u : 0u; mine = (j == x) ? c : mine; }
        if (sum == G) break;
        __builtin_amdgcn_s_sleep(1);
        if ((++sp & 255u) == 0u) { if (xb_ld(&bar[XB_TMO])) break; if (sp > XB_SPIN_CAP) { atomicAdd(&bar[XB_TMO], 1u); break; } }
    }
    nloc = mine > 0u ? mine : 1u; nx = cnt > 0u ? cnt : 1u;
}
DI void xcd_barrier(const XcdBarrier& b) {
    asm volatile("s_waitcnt vmcnt(0)" ::: "memory");
    __syncthreads();
    if (threadIdx.x == 0) {
        unsigned* bar = b.bar; asm volatile("" : "+s"(bar));
        __builtin_amdgcn_s_waitcnt(0);
        unsigned nloc = b.st[0], nx = b.st[1];
        if (nloc == 0u) { xcd_barrier_complete(bar, b.x, nloc, nx); b.st[0] = nloc; b.st[1] = nx; }
        const unsigned old = xb_add(&bar[XB_XSUB(b.x)], 1u);
        const unsigned gen = old / nloc;
        if (old + 1u == (gen + 1u) * nloc) {
            __builtin_amdgcn_fence(__ATOMIC_RELEASE, "agent");
            asm volatile("s_waitcnt vmcnt(0)" ::: "memory");
            const unsigned og = xb_add(&bar[XB_TOP], 1u);
            const unsigned tg = og / nx;
            if (og + 1u == (tg + 1u) * nx) xb_add(&bar[XB_TOPGEN], 1u);
            else XB_SPIN(xb_ld(&bar[XB_TOPGEN]) == tg, bar);
            __builtin_amdgcn_fence(__ATOMIC_ACQUIRE, "agent");
            xb_add(&bar[XB_XGEN(b.x)], 1u);
            asm volatile("s_waitcnt vmcnt(0)" ::: "memory");
        } else {
            XB_SPIN(xb_ld(&bar[XB_XGEN(b.x)]) == gen, bar);
            __builtin_amdgcn_fence(__ATOMIC_ACQUIRE, "agent");
            asm volatile("s_waitcnt vmcnt(0)" ::: "memory");
        }
    }
    __syncthreads();
}

struct Args { const float* in[27]; float* out; unsigned char* ws; int ph_lo, ph_hi, li, pad; };
struct Frame {
    LAS unsigned char* lds; unsigned char* ws; unsigned* ctl;
    int tid, lane, wave, G, bid;
    const LAS unsigned long long* intab; float* out;
};
DI const float* inp(const LAS unsigned long long* tab, int k) { const unsigned long long v = tab[k]; const unsigned lo = __builtin_amdgcn_readfirstlane((unsigned)v), hi = __builtin_amdgcn_readfirstlane((unsigned)(v >> 32)); return (const float*)(const GAS float*)(((unsigned long long)hi << 32) | lo); }
#define INP(k) inp(F.intab, k)
#define WSP(T, off) ((T*)(F.ws + (off)))

DI void mod_item(const Frame& F, int item, const LAS float* s9, LAS float* red) {
    const int l = item / 96, c0 = (item % 96) * 64;
    const float* W = INP(4) + (size_t)l * 1024 * 6144 + c0;
    const int cg = F.lane & 15, ks = F.wave * 4 + (F.lane >> 4);
    f32x4 acc[9];
#pragma unroll
    for (int r = 0; r < 9; ++r) acc[r] = (f32x4){0.f, 0.f, 0.f, 0.f};
#pragma unroll 4
    for (int i = 0; i < 32; ++i) { const int k = ks + 32 * i; const f32x4 w = *(const f32x4*)(W + (size_t)k * 6144 + cg * 4);
#pragma unroll
        for (int r = 0; r < 9; ++r) acc[r] += w * s9[r * 1024 + k]; }
#pragma unroll
    for (int r = 0; r < 9; ++r)
#pragma unroll
        for (int j = 0; j < 4; ++j) { acc[r][j] = add_xor32(add_xor16(acc[r][j])); }
    __syncthreads();
    if (F.lane < 16) {
#pragma unroll
        for (int r = 0; r < 9; ++r) *(LAS f32x4*)(red + (F.wave * 9 + r) * 64 + cg * 4) = acc[r]; }
    __syncthreads();
    for (int e = F.tid; e < 9 * 64; e += NTHR) { const int r = e / 64, c = e % 64; float s = 0.f;
#pragma unroll
        for (int w = 0; w < 8; ++w) s += red[(w * 9 + r) * 64 + c];
        WSP(float, WS_MOD)[((size_t)l * 9 + r) * 6144 + c0 + c] = s + INP(5)[l * 6144 + c0 + c]; }
}

DI void cv_block(const float* src  , int ld, const float* ksc, bf16_t* drow  ) {
#pragma unroll
    for (int kc = 0; kc < 8; ++kc) {
        float v[8];
#pragma unroll
        for (int j = 0; j < 8; ++j) v[j] = src ? src[(size_t)(kc * 8 + j) * ld] : 0.f;
        if (ksc) {
#pragma unroll
            for (int j = 0; j < 8; ++j) v[j] *= ksc[kc * 8 + j]; }
        u32x4 o; o.x = cvt_pk(v[0], v[1]); o.y = cvt_pk(v[2], v[3]); o.z = cvt_pk(v[4], v[5]); o.w = cvt_pk(v[6], v[7]);
        *(u32x4*)(drow + kc * 8) = o;
    }
}
DI void cv_block_fp8(const float* src, int ld, unsigned char* drow) {
#pragma unroll
    for (int kc = 0; kc < 4; ++kc) {
        float v[16];
#pragma unroll
        for (int j = 0; j < 16; ++j) v[j] = src[(size_t)(kc * 16 + j) * ld] * 64.0f;
        u32x4 o;
        { int w = __builtin_amdgcn_cvt_pk_fp8_f32(v[0], v[1], 0, false); w = __builtin_amdgcn_cvt_pk_fp8_f32(v[2], v[3], w, true); o.x = (unsigned)w; }
        { int w = __builtin_amdgcn_cvt_pk_fp8_f32(v[4], v[5], 0, false); w = __builtin_amdgcn_cvt_pk_fp8_f32(v[6], v[7], w, true); o.y = (unsigned)w; }
        { int w = __builtin_amdgcn_cvt_pk_fp8_f32(v[8], v[9], 0, false); w = __builtin_amdgcn_cvt_pk_fp8_f32(v[10], v[11], w, true); o.z = (unsigned)w; }
        { int w = __builtin_amdgcn_cvt_pk_fp8_f32(v[12], v[13], 0, false); w = __builtin_amdgcn_cvt_pk_fp8_f32(v[14], v[15], w, true); o.w = (unsigned)w; }
        *(u32x4*)(drow + kc * 16) = o;
    }
}
constexpr int CV_WIN = 384, CV_WUP = 144, CV_WOUT = 256, CV_W1 = 8192, CV_W2 = 4096, CV_LAYER = CV_WIN + CV_WUP + CV_WOUT + CV_W1 + CV_W2;
DI void conv_item(const Frame& F, int it) {
    const int l = it / CV_LAYER; int r = it % CV_LAYER; const int lane = F.lane, hl = lane >> 5, ll = lane & 31;
    if (r < CV_WIN) {
        const int kb = r / 24, g = (r % 24) * 2 + hl, x = ((g >> 3) * 4 + (g & 3)) * 64 + 32 * ((g >> 2) & 1) + ll;
        const int sc = x < 960 ? x : (x < 1472 ? x + 32 : (x < 1504 ? x - 512 : -1));
        const float* src = sc < 0 ? nullptr : INP(8) + (size_t)l * 1024 * 1504 + (size_t)(kb * 64) * 1504 + sc;
        unsigned char* drow = WSP(unsigned char, WS_WIN) + (size_t)l * 1536 * 1024 + (size_t)((r % 24) * 64 + lane) * 1024 + kb * 64;
        if (__builtin_amdgcn_readfirstlane(sc < 0 ? 1 : 0) | __any(sc < 0)) { const float* s2 = sc < 0 ? INP(8) : src; cv_block_fp8(s2, sc < 0 ? 0 : 1504, drow);
            if (sc < 0) {
#pragma unroll
                for (int kc = 0; kc < 4; ++kc) *(u32x4*)(drow + kc * 16) = (u32x4){0u, 0u, 0u, 0u}; } }
        else cv_block_fp8(src, 1504, drow);
        return; }
    r -= CV_WIN;
    if (r < CV_WUP) {
        const int kb = r / 24, g = (r % 24) * 2 + hl, slot = (g >> 3) * 4 + (g & 3), half = (g >> 2) & 1;
        const float* src = nullptr; const float* ksc = nullptr; int ld = 0;
        if (slot < 9 && kb < 3) { const int col = slot < 6 ? slot * 96 + 32 * half : (2 * (slot - 6) + half) * 96 + 64;
            src = INP(13) + (size_t)l * 192 * 576 + (size_t)(kb * 64) * 576 + col + ll; ld = 576; ksc = INP(11) + l * 192 + kb * 64; }
        else if (slot >= 12 && (kb == 3 || kb == 4)) { const int h = slot < 18 ? slot - 12 : slot - 18; const int col = h * 128 + (slot < 18 ? 0 : 64) + 32 * half;
            src = INP(14) + (size_t)l * 128 * 768 + (size_t)((kb - 3) * 64) * 768 + col + ll; ld = 768; ksc = INP(12) + l * 128 + (kb - 3) * 64; }
        cv_block(src, ld, ksc, WSP(bf16_t, WS_WUP) + (size_t)l * 1536 * 384 + (size_t)((r % 24) * 64 + lane) * 384 + kb * 64); return; }
    r -= CV_WUP;
    if (r < CV_WOUT) { const int kb = r / 16, g = r % 16;
        cv_block(INP(22) + (size_t)l * 1024 * 1024 + (size_t)(kb * 64) * 1024 + g * 64 + lane, 1024, nullptr, WSP(bf16_t, WS_WOUT) + (size_t)l * 1024 * 1024 + (size_t)(g * 64 + lane) * 1024 + kb * 64); return; }
    r -= CV_WOUT;
    if (r < CV_W1) { const int e = r / 512, q = r % 512, kb = q / 32, g = (q % 32) * 2 + hl, pn = g >> 3, bj = (g >> 2) & 1, wc = g & 3;
        const float* src = (bj ? INP(25) : INP(24)) + ((size_t)l * 16 + e) * 1024 * 1024 + (size_t)(kb * 64) * 1024 + 128 * pn + 32 * wc + ll;
        cv_block_fp8(src, 1024, WSP(unsigned char, WS_W1) + ((size_t)l * 16 + e) * 2048 * 1024 + (size_t)((q % 32) * 64 + lane) * 1024 + kb * 64); return; }
    r -= CV_W1;
    { const int e = r / 256, q = r % 256, kb = q / 16, g = q % 16;
        cv_block_fp8(INP(26) + ((size_t)l * 16 + e) * 1024 * 1024 + (size_t)(kb * 64) * 1024 + g * 64 + lane, 1024, WSP(unsigned char, WS_W2) + ((size_t)l * 16 + e) * 1024 * 1024 + (size_t)(g * 64 + lane) * 1024 + kb * 64); }
}
DI void p0_phase(const Frame& F) {
    LAS float* s9 = (LAS float*)F.lds;
    LAS float* red = (LAS float*)(F.lds + 9 * 1024 * 4);
    if (F.bid == 0) {
        for (int i = F.tid; i < 64 * 16; i += NTHR) { const int pos = i / 16, f = i % 16; const float inv = exp2f(-(float)(2 * f) / 32.f * 13.287712379549449f); const float a = (float)pos * inv; WSP(f32x2, WS_TAB64)[i] = (f32x2){cosf(a), sinf(a)}; }
        for (int i = F.tid; i < 64 * 8; i += NTHR) { const int pos = i / 8, f = i % 8; const float inv = exp2f(-(float)(2 * f) / 16.f * 13.287712379549449f); const float a = (float)pos * inv; WSP(f32x2, WS_TAB32)[i] = (f32x2){cosf(a), sinf(a)}; }
    }
    bool have_s9 = false;
    for (int it = F.bid; it < 192; it += F.G) {
        if (!have_s9) { for (int e = F.tid; e < 9 * 1024; e += NTHR) { const int r = e / 1024, k = e % 1024; const float v = r < 8 ? INP(1)[r * 1024 + k] : INP(3)[k]; s9[e] = silu_f(v); } have_s9 = true; __syncthreads(); }
        mod_item(F, it, s9, red);
    }
    __syncthreads();
    const int gw = F.bid * NWAVES + F.wave, NGW = F.G * NWAVES;
    for (int it = gw; it < 2 * CV_LAYER; it += NGW) conv_item(F, it);
}

DI unsigned pk_fp8q(float a, float b, float c, float d) { int w = __builtin_amdgcn_cvt_pk_fp8_f32(a, b, 0, false); w = __builtin_amdgcn_cvt_pk_fp8_f32(c, d, w, true); return (unsigned)w; }
DI void norm_mod_store(const f32x4 (&v)[4], const float* g, const float* sh, const float* sc, unsigned char* orow  , int lane) {
    float s = 0.f;
#pragma unroll
    for (int j = 0; j < 4; ++j) s += (v[j].x * v[j].x + v[j].y * v[j].y) + (v[j].z * v[j].z + v[j].w * v[j].w);
    const float rstd = 1.0f / sqrtf(wave_sum(s) * (1.f / 1024.f) + EPS);
#pragma unroll
    for (int j = 0; j < 4; ++j) { const int c = 4 * (lane + 64 * j); const f32x4 gv = *(const f32x4*)(g + c), sv = *(const f32x4*)(sh + c), cv = *(const f32x4*)(sc + c);
        const f32x4 o = v[j] * rstd * gv * (cv + 1.0f) + sv; *(unsigned*)(orow + c) = pk_fp8q(o.x, o.y, o.z, o.w); }
}
DI const float* mod_row(const Frame& F, int l, int row) { const int r = row < LAT ? row / 4096 : 8; return WSP(float, WS_MOD) + ((size_t)l * 9 + r) * 6144; }
DI void init_norm_phase(const Frame& F) {
    const int gw = F.bid * NWAVES + F.wave, NGW = F.G * NWAVES;
    auto rowptr = [&](int row) -> const float* { return row < LAT ? INP(0) + (size_t)row * 1024 : INP(2) + (size_t)(row - LAT) * 1024; };
    f32x4 vn[4];
    if (gw < R) { const float* x0 = rowptr(gw);
#pragma unroll
        for (int j = 0; j < 4; ++j) vn[j] = *(const f32x4*)(x0 + 4 * (F.lane + 64 * j)); }
    for (int row = gw; row < R; row += NGW) {
        f32x4 v[4];
#pragma unroll
        for (int j = 0; j < 4; ++j) v[j] = vn[j];
        if (row + NGW < R) { const float* x1 = rowptr(row + NGW);
#pragma unroll
            for (int j = 0; j < 4; ++j) vn[j] = *(const f32x4*)(x1 + 4 * (F.lane + 64 * j)); }
        const float* m = mod_row(F, 0, row);
        norm_mod_store(v, INP(6), m, m + 1024, WSP(unsigned char, WS_HB) + (size_t)row * 1024, F.lane);
    }
}
namespace g8 {
constexpr int BM = 256, BK = 64, HALF = 128, HTB = HALF * BK * 2, STAGE_BYTES = 8 * HTB;
DI int lds_byte(int r, int c) { const int st = (r >> 4) * 2 + (c >> 5), rr = r & 15, cc = c & 31, ob = rr * 64 + cc * 2; return st * 1024 + (ob ^ (((ob >> 9) & 1) << 5)); }
DI void stage_rc(int b, int& Rr, int& Cc) { const int st = b / 1024, sb = b % 1024, swz = sb ^ (((sb >> 9) & 1) << 5); Rr = (st >> 1) * 16 + swz / 64; Cc = (st & 1) * 32 + (swz % 64) / 2; }
DI int perm32(int rho) { const int n = rho >> 4, i = rho & 15; return 8 * (i >> 2) + 4 * n + (i & 3); }

typedef int i32x4 __attribute__((ext_vector_type(4)));
typedef int i32x8 __attribute__((ext_vector_type(8)));
struct Unit { int pm, pn, aux, kt0, nt; const char* Bp; };

template <class Epi, class Sched>
DI void gemm_phase(const int tid, LAS unsigned char* lds, const char* Abase, int K, const Sched& S, const Epi& E) {
    asm volatile("" : "+s"(K));
    const int wid = __builtin_amdgcn_readfirstlane(tid >> 6), lane = tid & 63, wr = wid >> 2, wc = wid & 3, fr = lane & 15, fq = lane >> 4;
    int Rr[2], Cc[2]; unsigned voffB[2];
#pragma unroll
    for (int i = 0; i < 2; ++i) { int r_, c_; stage_rc(tid * 16 + i * 8192, r_, c_); Rr[i] = r_; Cc[i] = c_; const int Rb = Epi::PERM ? ((r_ & ~31) + perm32(r_ & 31)) : r_; voffB[i] = (unsigned)(Rb * K + c_) * 2u; }
    const size_t hstepB = (size_t)HALF * K * 2;
    const unsigned ldsw = (unsigned)wid * 1024u;
    const int aoff = lds_byte(wr * 64 + fr, fq * 8), boff = lds_byte(wc * 32 + fr, fq * 8);
#define G8_SA(b, h) (((b) * 2 + (h)) * HTB)
#define G8_SB(b, h) ((4 + (b) * 2 + (h)) * HTB)
#define G8_STAGE_A(bufoff, ao2, kt) do { _Pragma("unroll") for (int _i = 0; _i < 2; ++_i) \
        __builtin_amdgcn_global_load_lds((const unsigned*)(Abase + (size_t)(ao2)[_i] + (size_t)(kt) * 128), (LAS unsigned*)(lds + (bufoff) + ldsw + _i * 8192), 16, 0, 0); } while (0)
#define G8_STAGE_B(bufoff, bp, h, kt) do { _Pragma("unroll") for (int _i = 0; _i < 2; ++_i) \
        __builtin_amdgcn_global_load_lds((const unsigned*)((bp) + (size_t)(h) * hstepB + voffB[_i] + (size_t)(kt) * 128), (LAS unsigned*)(lds + (bufoff) + ldsw + _i * 8192), 16, 0, 0); } while (0)
#define G8_LD16(off) (*(const LAS i32x4*)(lds + (off)))
#define G8_LDA(dst, b, h) do { _Pragma("unroll") for (int m = 0; m < 4; ++m) { const i32x4 lo_ = G8_LD16(G8_SA(b, h) + aoff + m * 2048), hi_ = G8_LD16(G8_SA(b, h) + aoff + m * 2048 + 1024); dst[m] = __builtin_shufflevector(lo_, hi_, 0, 1, 2, 3, 4, 5, 6, 7); } } while (0)
#define G8_LDB(dst, b, h) do { _Pragma("unroll") for (int n = 0; n < 2; ++n) { const i32x4 lo_ = G8_LD16(G8_SB(b, h) + boff + n * 2048), hi_ = G8_LD16(G8_SB(b, h) + boff + n * 2048 + 1024); dst[n] = __builtin_shufflevector(lo_, hi_, 0, 1, 2, 3, 4, 5, 6, 7); } } while (0)
#define G8_HALF(v, k) __builtin_bit_cast(bf16x8, __builtin_shufflevector((v), (v), 4 * (k), 4 * (k) + 1, 4 * (k) + 2, 4 * (k) + 3))
#define G8_MMA(ai, bj, At, Bt) do { __builtin_amdgcn_s_setprio(1); _Pragma("unroll") for (int m = 0; m < 4; ++m) _Pragma("unroll") for (int n = 0; n < 2; ++n) { \
        if constexpr (Epi::FP8) asm volatile("v_mfma_scale_f32_16x16x128_f8f6f4 %0, %1, %2, %0, %3, %3 op_sel_hi:[0,0,0]" : "+v"(acc[ai][bj][m][n]) : "v"(Bt[n]), "v"(At[m]), "v"(fp8_scale)); \
        else { acc[ai][bj][m][n] = __builtin_amdgcn_mfma_f32_16x16x32_bf16(G8_HALF(Bt[n], 0), G8_HALF(At[m], 0), acc[ai][bj][m][n], 0, 0, 0); \
               acc[ai][bj][m][n] = __builtin_amdgcn_mfma_f32_16x16x32_bf16(G8_HALF(Bt[n], 1), G8_HALF(At[m], 1), acc[ai][bj][m][n], 0, 0, 0); } } __builtin_amdgcn_s_setprio(0); } while (0)
#define G8_WAIT_V(n) asm volatile("s_waitcnt vmcnt(" #n ")" ::: "memory")
#define G8_WAIT_L(n) asm volatile("s_waitcnt lgkmcnt(" #n ")" ::: "memory")
#define G8_BAR __builtin_amdgcn_s_barrier()
#define G8_SCHED __builtin_amdgcn_sched_barrier(0)
    const int fp8_scale = 0x7F7F7F7F;
    Unit cur, nxt; int ui = 0;
    if (!S.next(0, cur)) return;
    unsigned aoc[2][2], aon[2][2];
    S.aoffs(cur, Rr, Cc, aoc);
    f32x4 acc[2][2][4][2];
#pragma unroll
    for (int a = 0; a < 2; ++a)
#pragma unroll
        for (int b = 0; b < 2; ++b)
#pragma unroll
            for (int m = 0; m < 4; ++m)
#pragma unroll
                for (int n = 0; n < 2; ++n) acc[a][b][m][n] = (f32x4){0.f, 0.f, 0.f, 0.f};
    i32x8 At[4], B0[2], B1[2];
    const char* cB = cur.Bp;
    G8_STAGE_B(G8_SB(0, 0), cB, 0, 0); G8_STAGE_B(G8_SB(0, 1), cB, 1, 0); G8_STAGE_A(G8_SA(0, 0), aoc[0], 0); G8_STAGE_A(G8_SA(0, 1), aoc[1], 0);
    if (wr == 1) G8_BAR;
    G8_WAIT_V(2); G8_BAR;
    G8_STAGE_B(G8_SB(1, 0), cB, 0, 1); G8_STAGE_A(G8_SA(1, 0), aoc[0], 1); G8_STAGE_B(G8_SB(1, 1), cB, 1, 1);
    G8_WAIT_V(6); G8_BAR;
    for (;;) {
        const bool has_next = S.next(ui + 1, nxt);
        if (has_next) S.aoffs(nxt, Rr, Cc, aon);
        else {
#pragma unroll
            for (int h = 0; h < 2; ++h)
#pragma unroll
                for (int i = 0; i < 2; ++i) aon[h][i] = aoc[h][i]; }
        const char* nB = has_next ? nxt.Bp : cB;
        const int nt = cur.nt;
        for (int t = 0; t < nt; t += 2) {
            const bool last = (t == nt - 2);
            unsigned a2[2][2];
#pragma unroll
            for (int h = 0; h < 2; ++h)
#pragma unroll
                for (int i = 0; i < 2; ++i) a2[h][i] = last ? aon[h][i] : aoc[h][i];
            const int kt2 = last ? 0 : t + 2; const char* b2 = last ? nB : cB;
            G8_LDB(B0, 0, 0); G8_LDB(B1, 0, 1); G8_SCHED; G8_LDA(At, 0, 0); G8_STAGE_A(G8_SA(1, 1), aoc[1], t + 1);
            G8_WAIT_V(8); G8_WAIT_L(0); G8_BAR; G8_MMA(0, 0, At, B0); G8_MMA(0, 1, At, B1); G8_BAR; G8_SCHED;
            G8_LDA(At, 0, 1); G8_STAGE_B(G8_SB(0, 0), b2, 0, kt2); G8_STAGE_B(G8_SB(0, 1), b2, 1, kt2); G8_STAGE_A(G8_SA(0, 0), a2[0], kt2);
            G8_WAIT_V(8); G8_WAIT_L(0); G8_BAR; G8_MMA(1, 0, At, B0); G8_MMA(1, 1, At, B1); G8_BAR; G8_SCHED;
            G8_LDB(B0, 1, 0); G8_LDB(B1, 1, 1); G8_SCHED; G8_LDA(At, 1, 0); G8_STAGE_A(G8_SA(0, 1), a2[1], kt2);
            G8_WAIT_V(8); G8_WAIT_L(0); G8_BAR; G8_MMA(0, 0, At, B0); G8_MMA(0, 1, At, B1); G8_BAR; G8_SCHED;
            G8_LDA(At, 1, 1); G8_STAGE_B(G8_SB(1, 0), b2, 0, kt2 + 1); G8_STAGE_B(G8_SB(1, 1), b2, 1, kt2 + 1); G8_STAGE_A(G8_SA(1, 0), a2[0], kt2 + 1);
            G8_WAIT_V(8); G8_WAIT_L(0); G8_BAR; G8_MMA(1, 0, At, B0); G8_MMA(1, 1, At, B1); G8_BAR; G8_SCHED;
        }
        if (wr == 0) G8_BAR;
        if constexpr (Epi::FP8) asm volatile("s_nop 15\n\ts_nop 15" ::: "memory");
        E(acc, cur, wr, wc, fr, fq);
        if (!has_next) break;
#pragma unroll
        for (int a = 0; a < 2; ++a)
#pragma unroll
            for (int b = 0; b < 2; ++b)
#pragma unroll
                for (int m = 0; m < 4; ++m)
#pragma unroll
                    for (int n = 0; n < 2; ++n) acc[a][b][m][n] = (f32x4){0.f, 0.f, 0.f, 0.f};
        cur = nxt; cB = nB;
#pragma unroll
        for (int h = 0; h < 2; ++h)
#pragma unroll
            for (int i = 0; i < 2; ++i) aoc[h][i] = aon[h][i];
        ++ui;
        if (wr == 1) G8_BAR;
    }
    G8_WAIT_V(0);
    G8_BAR;
#undef G8_SA
#undef G8_SB
#undef G8_STAGE_A
#undef G8_STAGE_B
#undef G8_LDA
#undef G8_LDB
#undef G8_MMA
#undef G8_HALF
#undef G8_LD16
#undef G8_WAIT_V
#undef G8_WAIT_L
#undef G8_BAR
#undef G8_SCHED
}

struct DenseSched {
    int nM, nN, nwg, G, c, K; const char* Bt; bool split3;
    DI void init(int nM_, int nN_, int G_, int c_, int K_, const void* Bt_, bool split3_ = false) { nM = nM_; nN = nN_; nwg = nM * nN; G = G_; c = c_; K = K_; Bt = (const char*)Bt_; split3 = split3_; }
    DI bool next(int i, Unit& u) const {
        const long L = (long)i * G + c; if (L >= nwg) return false;
        int wgid = (int)L; { const int q = nwg / 8, r = nwg % 8, xcd = wgid % 8, off = wgid / 8; wgid = (xcd < r ? xcd * (q + 1) : r * (q + 1) + (xcd - r) * q) + off; }
        const int WGM = 8, nig = WGM * nN, gid = wgid / nig, fm = gid * WGM, gsz = (nM - fm) < WGM ? (nM - fm) : WGM;
        u.pm = fm + ((wgid % nig) % gsz); u.pn = (wgid % nig) / gsz; u.aux = 0; u.kt0 = 0; u.nt = K / 64;
        if (split3) { if (u.pn < 3) { u.nt = 4; } else { u.kt0 = 3; u.nt = 2; } }
        u.Bp = Bt + (size_t)u.pn * 256 * K * 2 + u.kt0 * 128; return true;
    }
    DI void aoffs(const Unit& u, const int (&Rr)[2], const int (&Cc)[2], unsigned (&ao)[2][2]) const {
#pragma unroll
        for (int h = 0; h < 2; ++h)
#pragma unroll
            for (int i = 0; i < 2; ++i) ao[h][i] = (unsigned)(((size_t)(u.pm * 256 + h * 128 + Rr[i]) * K + Cc[i]) * 2 + u.kt0 * 128);
    }
};
template <bool GATHER>
struct MoeSched {
    int nN, tiles_per_e, nwg, G, c, K, NBt; const char* Bt; size_t estride; const int* gidx; bool with_ctx;
    DI void init(int nN_, bool with_ctx_, int G_, int c_, int K_, const void* Bt_, size_t estride_, const int* gidx_) {
        nN = nN_; with_ctx = with_ctx_; tiles_per_e = NB * 2 + (with_ctx_ ? 1 : 0); nwg = 16 * tiles_per_e * nN; G = G_; c = c_; K = K_; Bt = (const char*)Bt_; estride = estride_; gidx = gidx_; }
    DI bool next(int i, Unit& u) const {
        int mt;
        if (G % (8 * nN) == 0) {
            const int per = (G / 8) / nN, xcd = c & 7, j8 = c >> 3; mt = (i * 8 + xcd) * per + j8 / nN; u.pn = j8 % nN; if (mt >= 16 * tiles_per_e) return false;
        } else { const long L = (long)i * G + c; if (L >= nwg) return false; mt = (int)L / nN; u.pn = (int)L % nN; }
        const int e = mt / tiles_per_e, j = mt % tiles_per_e;
        const int rowbase = j < NB * 2 ? ((j >> 1) * 16 + e) * 512 + (j & 1) * 256 : MOE_LAT + e * 256;
        u.pm = rowbase / 256; u.aux = e; u.kt0 = 0; u.nt = K / 64; u.Bp = Bt + (size_t)e * estride + (size_t)u.pn * 256 * K * 2; return true;
    }
    DI void aoffs(const Unit& u, const int (&Rr)[2], const int (&Cc)[2], unsigned (&ao)[2][2]) const {
#pragma unroll
        for (int h = 0; h < 2; ++h)
#pragma unroll
            for (int i = 0; i < 2; ++i) { const int mrow = u.pm * 256 + h * 128 + Rr[i]; const int arow = GATHER ? gidx[mrow] : mrow; ao[h][i] = (unsigned)(((size_t)arow * K + Cc[i]) * 2); }
    }
};
}

typedef f32x4 Acc[2][2][4][2];
DI unsigned pk_fp8x4(float a, float b, float c, float d) { int w = __builtin_amdgcn_cvt_pk_fp8_f32(a, b, 0, false); w = __builtin_amdgcn_cvt_pk_fp8_f32(c, d, w, true); return (unsigned)w; }
DI unsigned pk_fp8v(const f32x4 v) { return pk_fp8x4(v.x, v.y, v.z, v.w); }
DI void st_bf16x4(bf16_t* p, const f32x4 v) { u32x2 w; w.x = cvt_pk(v.x, v.y); w.y = cvt_pk(v.z, v.w); *(u32x2*)p = w; }

DI void st_vt4(unsigned char* tile, int d0, int pos, const f32x4 v) { const unsigned w = pk_fp8v(v); unsigned char* p = tile + d0 * 64 + pos;
    p[0] = (unsigned char)w; p[64] = (unsigned char)(w >> 8); p[128] = (unsigned char)(w >> 16); p[192] = (unsigned char)(w >> 24); }
DI size_t vt_tile_of_rowgroup(int row64  ) {
    return row64 < LAT ? (size_t)(row64 / 4096) * 68 + 4 + (row64 % 4096) / 64 : (size_t)((row64 - LAT) / 256) * 68 + ((row64 - LAT) % 256) / 64; }
struct EpiInProj {
    static constexpr bool PERM = false, FP8 = true;
    unsigned char* ws; const LAS unsigned long long* in; int l; const LAS f32x2* tab64; const LAS f32x2* tab32;
    DI void operator()(const Acc& acc, const g8::Unit& u, int wr, int wc, int fr, int fq) const {
        asm volatile("" : "+v"(fr), "+v"(fq));
        constexpr float SC = 1.0f / 64.0f;
        const int slot = 4 * u.pn + wc; const int rowt = u.pm * 256 + wr * 64 + fr; const bool lat = (u.pm * 256) < LAT;
        int kind; bf16_t* dst; int ld, coff; const float* gain = nullptr; float qs = 1.f;
        if (slot < 6)       { kind = 0; dst = (bf16_t*)(ws + Z_QA); ld = 384; coff = slot * 64; gain = inp(in, 9) + l * 64; qs = QF64; }
        else if (slot < 8)  { kind = 0; dst = (bf16_t*)(ws + Z_KA); ld = 128; coff = (slot - 6) * 64; gain = inp(in, 10) + l * 64; }
        else if (slot < 10) { kind = 1; dst = (bf16_t*)(ws + Z_VA); ld = 128; coff = (slot - 8) * 64; }
        else if (slot < 15) { kind = 2; dst = (bf16_t*)(ws + Z_CRAW); ld = 384; coff = (slot - 10) * 64; }
        else if (slot < 19) { kind = 0; dst = (bf16_t*)(ws + Z_QC); ld = 256; coff = (slot - 15) * 64; gain = inp(in, 19) + l * 64; qs = QF64; }
        else if (slot < 21) { kind = 0; dst = (bf16_t*)(ws + Z_KC); ld = 128; coff = (slot - 19) * 64; gain = inp(in, 20) + l * 64; }
        else if (slot < 23) { kind = 1; dst = (bf16_t*)(ws + Z_VC); ld = 128; coff = (slot - 21) * 64; }
        else                { kind = 3; dst = (bf16_t*)(ws + Z_KB); ld = 576; coff = 64; gain = inp(in, 18) + l * 32; }
        if (kind == 0) {
            f32x4 g[2][2];
#pragma unroll
            for (int bj = 0; bj < 2; ++bj)
#pragma unroll
                for (int n = 0; n < 2; ++n) g[bj][n] = *(const f32x4*)(gain + 32 * bj + 16 * n + 4 * fq) * qs;
#pragma unroll
            for (int ai = 0; ai < 2; ++ai)
#pragma unroll
                for (int m = 0; m < 4; ++m) {
                    const int row = rowt + ai * 128 + m * 16; float s = 0.f;
#pragma unroll
                    for (int bj = 0; bj < 2; ++bj)
#pragma unroll
                        for (int n = 0; n < 2; ++n) { const f32x4 x = acc[ai][bj][m][n] * SC; s += (x.x * x.x + x.y * x.y) + (x.z * x.z + x.w * x.w); }
                    s = add_xor32(add_xor16(s));
                    const float rstd = SC / sqrtf(s * (1.f / 64.f) + EPS);
                    const int t = row & 4095, pr = t >> 6, pc = t & 63;
#pragma unroll
                    for (int bj = 0; bj < 2; ++bj) {
                        f32x4 x1 = acc[ai][bj][m][0] * rstd * g[bj][0], x2 = acc[ai][bj][m][1] * rstd * g[bj][1];
                        if (lat) { const LAS f32x2* tb = tab64 + (bj == 0 ? pr : pc) * 16 + 4 * fq; f32x4 o1, o2;
#pragma unroll
                            for (int i = 0; i < 4; ++i) { const f32x2 cs = tb[i]; o1[i] = x1[i] * cs.x - x2[i] * cs.y; o2[i] = x2[i] * cs.x + x1[i] * cs.y; }
                            x1 = o1; x2 = o2; }
                        unsigned char* p = (unsigned char*)dst + (size_t)row * ld + coff + 32 * bj + 4 * fq;
                        *(unsigned*)p = pk_fp8v(x1); *(unsigned*)(p + 16) = pk_fp8v(x2);
                    }
                    asm volatile("" ::: "memory");
                }
        } else if (kind == 1 || kind == 2) {
#pragma unroll
            for (int ai = 0; ai < 2; ++ai)
#pragma unroll
                for (int m = 0; m < 4; ++m) {
                    const int row = rowt + ai * 128 + m * 16; float s = 0.f;
#pragma unroll
                    for (int bj = 0; bj < 2; ++bj)
#pragma unroll
                        for (int n = 0; n < 2; ++n) { const f32x4 x = acc[ai][bj][m][n] * SC; s += (x.x * x.x + x.y * x.y) + (x.z * x.z + x.w * x.w);
                            if (kind == 2) st_bf16x4(dst + (size_t)row * ld + coff + 32 * bj + 16 * n + 4 * fq, x);
                            else { const int row64 = u.pm * 256 + ai * 128 + wr * 64;
                                const size_t bt = vt_tile_of_rowgroup(row64); unsigned char* tile = (unsigned char*)dst + ((bt / 68) * 2 + coff / 64) * VT_HEAD + (bt % 68) * VT_TILE;
                                st_vt4(tile, 32 * bj + 16 * n + 4 * fq, vt_pos(16 * m + fr), x); } }
                    if (kind == 2) { s = add_xor32(add_xor16(s)); if (fq == 0) ((float*)(ws + WS_SSQ))[(size_t)row * 8 + (slot - 10)] = s; }
                }
        } else {
            const f32x4 g0 = *(const f32x4*)(gain + 4 * fq), g1 = *(const f32x4*)(gain + 16 + 4 * fq);
            bf16_t* craw = (bf16_t*)(ws + Z_CRAW);
#pragma unroll
            for (int ai = 0; ai < 2; ++ai)
#pragma unroll
                for (int m = 0; m < 4; ++m) {
                    const int row = rowt + ai * 128 + m * 16;
                    const f32x4 a0 = acc[ai][0][m][0] * SC, a1 = acc[ai][0][m][1] * SC;
                    float s = (a0.x * a0.x + a0.y * a0.y) + (a0.z * a0.z + a0.w * a0.w) + (a1.x * a1.x + a1.y * a1.y) + (a1.z * a1.z + a1.w * a1.w);
                    s = add_xor32(add_xor16(s));
                    const float rstd = 1.0f / sqrtf(s * (1.f / 32.f) + EPS);
                    f32x4 v0 = a0 * rstd * g0, v1 = a1 * rstd * g1;
                    if (lat) { const int t = row & 4095, pr = t >> 6, pc = t & 63;
                        f32x4 p0, p1;
#pragma unroll
                        for (int i = 0; i < 4; ++i) { p0[i] = other32(v0[i], fq >= 2); p1[i] = other32(v1[i], fq >= 2); }
                        const LAS f32x2* t0 = tab32 + pr * 8 + 4 * (fq & 1); const LAS f32x2* t1 = tab32 + pc * 8 + 4 * (fq & 1);
#pragma unroll
                        for (int i = 0; i < 4; ++i) { const f32x2 c0 = t0[i], c1 = t1[i];
                            v0[i] = fq < 2 ? v0[i] * c0.x - p0[i] * c0.y : v0[i] * c0.x + p0[i] * c0.y;
                            v1[i] = fq < 2 ? v1[i] * c1.x - p1[i] * c1.y : v1[i] * c1.x + p1[i] * c1.y; } }
                    const unsigned w0 = pk_fp8v(v0), w1 = pk_fp8v(v1);
#pragma unroll
                    for (int h = 0; h < 6; ++h) { unsigned char* p = (unsigned char*)dst + (size_t)row * 768 + h * 128 + 64 + 4 * fq; *(unsigned*)p = w0; *(unsigned*)(p + 16) = w1; *(unsigned*)(p + 32) = 0u; *(unsigned*)(p + 48) = 0u; }
                    const u32x2 z = {0u, 0u};
#pragma unroll
                    for (int q = 0; q < 4; ++q) *(u32x2*)(craw + (size_t)row * 384 + 320 + 16 * q + 4 * fq) = z;
                    asm volatile("" ::: "memory");
                }
        }
    }
};

struct EpiUpProj {
    static constexpr bool PERM = false, FP8 = false;
    unsigned char* ws; const LAS unsigned long long* in; int l; const LAS f32x2* tab32;
    DI void operator()(const Acc& acc, const g8::Unit& u, int wr, int wc, int fr, int fq) const {
        asm volatile("" : "+v"(fr), "+v"(fq));
        const int slot = 4 * u.pn + wc; if (slot >= 9 && slot < 12) return;
        const int rowt = u.pm * 256 + wr * 64 + fr; const bool lat = (u.pm * 256) < LAT;
        const float* ssq = (const float*)(ws + WS_SSQ);
        bf16_t* qB = (bf16_t*)(ws + Z_QB); bf16_t* kB = (bf16_t*)(ws + Z_KB); bf16_t* vB = (bf16_t*)(ws + Z_VB);
        const bool isq = slot < 9;
#pragma unroll
        for (int ai = 0; ai < 2; ++ai)
#pragma unroll
            for (int m = 0; m < 4; ++m) {
                const int row = rowt + ai * 128 + m * 16;
                const f32x4 sa = *(const f32x4*)(ssq + (size_t)row * 8); const float sb = ssq[(size_t)row * 8 + 4];
                const float r0 = isq ? 1.0f / sqrtf((sa.x + sa.y + sa.z) * (1.f / 192.f) + EPS) : 1.0f / sqrtf((sa.w + sb) * (1.f / 128.f) + EPS);
                if (slot < 6 || (slot >= 12 && slot < 18)) {
                    const float* gain = slot < 6 ? inp(in, 15) + l * 64 : inp(in, 16) + l * 64; const float qs = slot < 6 ? QF96 : 1.f;
                    const int h = slot < 6 ? slot : slot - 12; unsigned char* dst = (unsigned char*)(slot < 6 ? qB : kB) + (size_t)row * 768 + h * 128;
                    float s = 0.f; f32x4 x[2][2];
#pragma unroll
                    for (int bj = 0; bj < 2; ++bj)
#pragma unroll
                        for (int n = 0; n < 2; ++n) { x[bj][n] = acc[ai][bj][m][n] * r0; s += (x[bj][n].x * x[bj][n].x + x[bj][n].y * x[bj][n].y) + (x[bj][n].z * x[bj][n].z + x[bj][n].w * x[bj][n].w); }
                    s = add_xor32(add_xor16(s));
                    const float rstd = qs / sqrtf(s * (1.f / 64.f) + EPS);
#pragma unroll
                    for (int bj = 0; bj < 2; ++bj)
#pragma unroll
                        for (int n = 0; n < 2; ++n) { const int c = 32 * bj + 16 * n + 4 * fq; *(unsigned*)(dst + c) = pk_fp8v(x[bj][n] * rstd * *(const f32x4*)(gain + c)); }
                } else if (slot >= 18) {
                    const int row64 = u.pm * 256 + ai * 128 + wr * 64; const size_t bt = vt_tile_of_rowgroup(row64);
                    unsigned char* tile = (unsigned char*)vB + ((bt / 68) * 6 + (slot - 18)) * VT_HEAD + (bt % 68) * VT_TILE;
#pragma unroll
                    for (int bj = 0; bj < 2; ++bj)
#pragma unroll
                        for (int n = 0; n < 2; ++n) st_vt4(tile, 32 * bj + 16 * n + 4 * fq, vt_pos(16 * m + fr), acc[ai][bj][m][n] * r0);
                } else {
                    const float* gain = inp(in, 17) + l * 32;
#pragma unroll
                    for (int bj = 0; bj < 2; ++bj) {
                        const f32x4 a0 = acc[ai][bj][m][0] * r0, a1 = acc[ai][bj][m][1] * r0;
                        float s = (a0.x * a0.x + a0.y * a0.y) + (a0.z * a0.z + a0.w * a0.w) + (a1.x * a1.x + a1.y * a1.y) + (a1.z * a1.z + a1.w * a1.w);
                        s = add_xor32(add_xor16(s));
                        const float rstd = QF96 / sqrtf(s * (1.f / 32.f) + EPS);
                        f32x4 v0 = a0 * rstd * *(const f32x4*)(gain + 4 * fq), v1 = a1 * rstd * *(const f32x4*)(gain + 16 + 4 * fq);
                        if (lat) { const int t = row & 4095, pr = t >> 6, pc = t & 63; f32x4 p0, p1;
#pragma unroll
                            for (int i = 0; i < 4; ++i) { p0[i] = other32(v0[i], fq >= 2); p1[i] = other32(v1[i], fq >= 2); }
                            const LAS f32x2* t0 = tab32 + pr * 8 + 4 * (fq & 1); const LAS f32x2* t1 = tab32 + pc * 8 + 4 * (fq & 1);
#pragma unroll
                            for (int i = 0; i < 4; ++i) { const f32x2 c0 = t0[i], c1 = t1[i];
                                v0[i] = fq < 2 ? v0[i] * c0.x - p0[i] * c0.y : v0[i] * c0.x + p0[i] * c0.y;
                                v1[i] = fq < 2 ? v1[i] * c1.x - p1[i] * c1.y : v1[i] * c1.x + p1[i] * c1.y; } }
                        unsigned char* p = (unsigned char*)qB + (size_t)row * 768 + (2 * (slot - 6) + bj) * 128 + 64 + 4 * fq;
                        *(unsigned*)p = pk_fp8v(v0); *(unsigned*)(p + 16) = pk_fp8v(v1); *(unsigned*)(p + 32) = 0u; *(unsigned*)(p + 48) = 0u;
                    }
                }
                asm volatile("" ::: "memory");
            }
    }
};

struct EpiOutProj {
    static constexpr bool PERM = false, FP8 = false;
    unsigned char* ws; const float* xin; const float* cin; float* out; int l;
    DI void operator()(const Acc& acc, const g8::Unit& u, int wr, int wc, int fr, int fq) const {
        asm volatile("" : "+v"(fr), "+v"(fq));
        const int rowt = u.pm * 256 + wr * 64 + fr; const bool lat = (u.pm * 256) < LAT;
        const float* mod = (const float*)(ws + WS_MOD) + ((size_t)l * 9 + (lat ? (u.pm * 256) / 4096 : 8)) * 6144 + 2048;
        const int col0 = u.pn * 256 + wc * 32 + 4 * fq;
        f32x4 gv[2][2];
#pragma unroll
        for (int bj = 0; bj < 2; ++bj)
#pragma unroll
            for (int n = 0; n < 2; ++n) gv[bj][n] = *(const f32x4*)(mod + col0 + 128 * bj + 16 * n);
#pragma unroll
        for (int ai = 0; ai < 2; ++ai)
#pragma unroll
            for (int m = 0; m < 4; ++m) {
                const int row = rowt + ai * 128 + m * 16;
                const float* src = lat ? xin + (size_t)row * 1024 : cin + (size_t)(row - LAT) * 1024;
                float* dst = lat ? out + (size_t)row * 1024 : (float*)(ws + WS_CTXF) + (size_t)(row - LAT) * 1024;
#pragma unroll
                for (int bj = 0; bj < 2; ++bj)
#pragma unroll
                    for (int n = 0; n < 2; ++n) { const int c = col0 + 128 * bj + 16 * n; *(f32x4*)(dst + c) = *(const f32x4*)(src + c) + gv[bj][n] * acc[ai][bj][m][n]; }
            }
    }
};

constexpr int WSH = 6, HSH = 3;
struct EpiMoe1 {
    static constexpr bool PERM = true, FP8 = true;
    unsigned char* ws;
    DI void operator()(const Acc& acc, const g8::Unit& u, int wr, int wc, int fr, int fq) const {
        asm volatile("" : "+v"(fr), "+v"(fq));
        unsigned char* hid = ws + Z_HID; constexpr float SC = 1.0f / (float)(1 << WSH), HS = (float)(1 << HSH);
#pragma unroll
        for (int ai = 0; ai < 2; ++ai)
#pragma unroll
            for (int m = 0; m < 4; ++m) {
                const int row = u.pm * 256 + ai * 128 + wr * 64 + m * 16 + fr;
                f32x4 h0, h1;
#pragma unroll
                for (int i = 0; i < 4; ++i) { h0[i] = silu_f(acc[ai][0][m][0][i] * SC) * (acc[ai][1][m][0][i] * (SC * HS)); h1[i] = silu_f(acc[ai][0][m][1][i] * SC) * (acc[ai][1][m][1][i] * (SC * HS)); }
                u32x2 w; w.x = pk_fp8x4(h0.x, h0.y, h0.z, h0.w); w.y = pk_fp8x4(h1.x, h1.y, h1.z, h1.w);
                *(u32x2*)(hid + (size_t)row * 1024 + u.pn * 128 + wc * 32 + 8 * fq) = w;
            }
    }
};
struct EpiMoe2 {
    static constexpr bool PERM = true, FP8 = true;
    unsigned char* ws;
    DI void operator()(const Acc& acc, const g8::Unit& u, int wr, int wc, int fr, int fq) const {
        asm volatile("" : "+v"(fr), "+v"(fq));
        bf16_t* ye = (bf16_t*)(ws + Z_YE); const float* gate = (const float*)(ws + WS_GATE); constexpr float SC = 1.0f / (float)(1 << (WSH + HSH));
#pragma unroll
        for (int ai = 0; ai < 2; ++ai)
#pragma unroll
            for (int m = 0; m < 4; ++m) {
                const int row = u.pm * 256 + ai * 128 + wr * 64 + m * 16 + fr; const float gv = gate[row] * SC;
#pragma unroll
                for (int bj = 0; bj < 2; ++bj) { const f32x4 a = acc[ai][bj][m][0] * gv, b = acc[ai][bj][m][1] * gv; u32x4 w;
                    w.x = cvt_pk(a.x, a.y); w.y = cvt_pk(a.z, a.w); w.z = cvt_pk(b.x, b.y); w.w = cvt_pk(b.z, b.w);
                    *(u32x4*)(ye + (size_t)row * 1024 + u.pn * 256 + bj * 128 + wc * 32 + 8 * fq) = w; }
            }
    }
};
DI int crow(int i, int hh) { return (i & 3) + 8 * (i >> 2) + 4 * hh; }
typedef short v4i16_t __attribute__((ext_vector_type(4)));
DI s16x4 vtr(const LAS unsigned char* p) { return __builtin_bit_cast(s16x4, __builtin_amdgcn_ds_read_tr16_b64_v4i16((LAS v4i16_t*)p)); }
#define MFMA32(a, b, c) __builtin_amdgcn_mfma_f32_32x32x16_bf16((a), (b), (c), 0, 0, 0)

struct AttnDesc { const unsigned char* Q; int ldq, qoff; const unsigned char* K; int ldk, koff; const unsigned char* Vt; bf16_t* O; int ooff; float sink2; };
DI float fmax3(float a, float b, float c) { return __builtin_fmaxf(__builtin_fmaxf(a, b), c); }
typedef int i32x4 __attribute__((ext_vector_type(4)));
typedef int i32x8 __attribute__((ext_vector_type(8)));
#define MFMA8Z(acc, a, b, sa, sb) asm volatile("v_mfma_scale_f32_32x32x64_f8f6f4 %0, %1, %2, 0, %3, %4 op_sel_hi:[0,0,0]" : "=&v"(acc) : "v"(a), "v"(b), "v"(sa), "v"(sb))
#define MFMA8(acc, a, b, sa, sb) asm volatile("v_mfma_scale_f32_32x32x64_f8f6f4 %0, %1, %2, %0, %3, %4 op_sel_hi:[0,0,0]" : "+v"(acc) : "v"(a), "v"(b), "v"(sa), "v"(sb))
template <int DQB  , int MODE, bool TRACK, int ABL = 0>
DI void attn_unit(const int tid, LAS unsigned char* lds, const AttnDesc& d, int b, int qb, bool has_sink) {
    constexpr int KSTR = DQB + 16, VSTR = 80, KBUF = 128 * KSTR, VTILE = 64 * VSTR, VBUF = 2 * VTILE, NS = DQB / 64, KCH = DQB / 16, KC1 = KCH + 1, VC1 = 5;
    const int lane = tid & 63, wid = __builtin_amdgcn_readfirstlane(tid >> 6), r = lane & 31, hh = lane >> 5;
    const int q0 = qb * 256;
    const int qrow = (MODE == 2 ? LAT + b * 256 : b * 4096) + q0 + wid * 32 + r;
    int lo = 0, ntl = 0;
    if (MODE == 0) { lo = 0; ntl = 64; }
    if (MODE == 1) { lo = q0 - 128 < 0 ? 0 : q0 - 128; const int hi = q0 + 384 > 4096 ? 4096 : q0 + 384; ntl = (hi - lo) / 64; }
    const int NSTEP = (4 + ntl) / 2;
    auto step_row = [&](int st) -> int { return st < 2 ? LAT + b * 256 + st * 128 : b * 4096 + lo + (st - 2) * 128; };
    auto step_T = [&](int st) -> int { return st < 2 ? 2 * st : 4 + lo / 64 + 2 * (st - 2); };
    i32x8 qf[NS];
#pragma unroll
    for (int s = 0; s < NS; ++s) { const unsigned char* qp = d.Q + (size_t)qrow * d.ldq + d.qoff + 64 * s + 32 * hh; const i32x4 lo4 = *(const i32x4*)qp, hi4 = *(const i32x4*)(qp + 16); qf[s] = __builtin_shufflevector(lo4, hi4, 0, 1, 2, 3, 4, 5, 6, 7); }
    const int sclK = 0x7F7F7F7F, sclQ = 0x7C7C7C7C;
    constexpr int NKC = 128 * KC1, NVC = 128 * VC1, NKI = (NKC + 511) / 512, NVI = (NVC + 511) / 512;
    auto dma_step = [&](int st, int buf) {
        const unsigned char* kb_ = d.K + (size_t)step_row(st) * d.ldk; const unsigned char* vb_ = d.Vt + (size_t)step_T(st) * VT_TILE;
#pragma unroll
        for (int i = 0; i < NKI; ++i) { if (i * 512 + wid * 64 < NKC) { const int c = i * 512 + tid, row = c / KC1, ch = c % KC1;
            __builtin_amdgcn_global_load_lds((const unsigned*)(kb_ + (unsigned)(row * d.ldk + d.koff + (ch < KCH ? ch : 0) * 16)), (LAS unsigned*)(lds + buf * KBUF + i * 8192 + wid * 1024), 16, 0, 0); } }
#pragma unroll
        for (int i = 0; i < NVI; ++i) { if (i * 512 + wid * 64 < NVC) { const int c = i * 512 + tid, row = c / VC1, ch = c % VC1;
            __builtin_amdgcn_global_load_lds((const unsigned*)(vb_ + (unsigned)(row * 64 + (ch < 4 ? ch : 0) * 16)), (LAS unsigned*)(lds + 2 * KBUF + buf * VBUF + i * 8192 + wid * 1024), 16, 0, 0); } } };
    constexpr float THR = 8.f, POFF = 6.f;
    static_assert(TRACK, "the fp8 P.V path needs the running row maximum");
    float m = 0.f, l = 0.f;
    if (has_sink) { m = d.sink2 - POFF; l = hh == 0 ? __builtin_amdgcn_exp2f(POFF) : 0.f; }
    f32x16 o0, o1, sc[4];
#pragma unroll
    for (int i = 0; i < 16; ++i) { o0[i] = 0.f; o1[i] = 0.f; }
    const int koffl = r * KSTR + hh * 32, voffl = r * VSTR + hh * 32, sclV = 0x7F7F7F7F;
    auto frag = [&](const LAS unsigned char* p) -> i32x8 { const i32x4 lo4 = *(const LAS i32x4*)p, hi4 = *(const LAS i32x4*)(p + 16); return __builtin_shufflevector(lo4, hi4, 0, 1, 2, 3, 4, 5, 6, 7); };
    __syncthreads();
    dma_step(0, 0); asm volatile("s_waitcnt vmcnt(0)" ::: "memory");
    __syncthreads();
    for (int st = 0; st < NSTEP; ++st) {
        const int buf = st & 1;
        if (st + 1 < NSTEP) dma_step(st + 1, buf ^ 1);
        { const LAS unsigned char* kb = lds + buf * KBUF + koffl; const float negm = -m;
#pragma unroll
          for (int j = 0; j < 4; ++j) {
#pragma unroll
              for (int i = 0; i < 16; ++i) sc[j][i] = negm; }
          asm volatile("s_nop 1" : "+v"(sc[0]), "+v"(sc[1]), "+v"(sc[2]), "+v"(sc[3]));
#pragma unroll
          for (int j = 0; j < 4; ++j) {
#pragma unroll
              for (int s = 0; s < NS; ++s) { const i32x8 x = frag(kb + (32 * j) * KSTR + s * 64); MFMA8(sc[j], x, qf[s], sclK, sclQ); } }
          asm volatile("s_nop 15\n\ts_nop 7" : "+v"(sc[0]), "+v"(sc[1]), "+v"(sc[2]), "+v"(sc[3])); }
        if (MODE == 1) { if (st >= 2) { const int kp0 = lo + (st - 2) * 128, qp = q0 + wid * 32 + r;
#pragma unroll
            for (int j = 0; j < 4; ++j)
#pragma unroll
                for (int i = 0; i < 16; ++i) { const int dk = kp0 + 32 * j + crow(i, hh) - qp; if (dk > 128 || dk < -128) sc[j][i] = -1e30f; } } }
        { float ma = fmax3(sc[0][0], sc[1][0], sc[2][0]), mb = fmax3(sc[3][0], sc[0][1], sc[1][1]);
#pragma unroll
          for (int i = 0; i < 16; ++i) { if (i >= 1) ma = fmax3(ma, sc[0][i], sc[1][i]); if (i >= 2) mb = fmax3(mb, sc[2][i], sc[3][i]); }
          mb = fmax3(mb, sc[2][1], sc[3][1]);
          float mx = __builtin_fmaxf(ma, mb);
          { auto rr = __builtin_amdgcn_permlane32_swap(__float_as_uint(mx), __float_as_uint(mx), false, false); mx = __builtin_fmaxf(__uint_as_float(rr[0]), __uint_as_float(rr[1])); }
          if (st == 0 && !has_sink) {
              const float dl = mx - POFF; m = dl;
#pragma unroll
              for (int j = 0; j < 4; ++j)
#pragma unroll
                  for (int i = 0; i < 16; ++i) sc[j][i] -= dl;
          } else if (__any(mx > THR)) {
              const float dl = __builtin_fmaxf(mx - POFF, 0.f), alpha = __builtin_amdgcn_exp2f(-dl);
              asm volatile("s_nop 15\n\ts_nop 7" : "+v"(o0), "+v"(o1));
              m += dl; l *= alpha;
#pragma unroll
              for (int i = 0; i < 16; ++i) { o0[i] *= alpha; o1[i] *= alpha; }
#pragma unroll
              for (int j = 0; j < 4; ++j)
#pragma unroll
                  for (int i = 0; i < 16; ++i) sc[j][i] -= dl; } }
        float ps0 = 0.f, ps1 = 0.f, ps2 = 0.f, ps3 = 0.f;
#pragma unroll
        for (int j = 0; j < 4; ++j)
#pragma unroll
            for (int i = 0; i < 16; i += 4) { sc[j][i] = __builtin_amdgcn_exp2f(sc[j][i]); sc[j][i + 1] = __builtin_amdgcn_exp2f(sc[j][i + 1]); sc[j][i + 2] = __builtin_amdgcn_exp2f(sc[j][i + 2]); sc[j][i + 3] = __builtin_amdgcn_exp2f(sc[j][i + 3]);
                ps0 += sc[j][i]; ps1 += sc[j][i + 1]; ps2 += sc[j][i + 2]; ps3 += sc[j][i + 3]; }
        l += (ps0 + ps1) + (ps2 + ps3);
        i32x8 pf[2];
#pragma unroll
        for (int t2 = 0; t2 < 2; ++t2) {
#pragma unroll
            for (int q4 = 0; q4 < 4; ++q4) { pf[t2][q4] = (int)pk_fp8x4(sc[2 * t2][4 * q4], sc[2 * t2][4 * q4 + 1], sc[2 * t2][4 * q4 + 2], sc[2 * t2][4 * q4 + 3]);
                                             pf[t2][4 + q4] = (int)pk_fp8x4(sc[2 * t2 + 1][4 * q4], sc[2 * t2 + 1][4 * q4 + 1], sc[2 * t2 + 1][4 * q4 + 2], sc[2 * t2 + 1][4 * q4 + 3]); } }
        asm volatile("s_nop 1" : "+v"(pf[0]), "+v"(pf[1]));
        { const LAS unsigned char* vb = lds + 2 * KBUF + buf * VBUF + voffl;
#pragma unroll
          for (int t2 = 0; t2 < 2; ++t2) { const i32x8 v0 = frag(vb + t2 * VTILE), v1 = frag(vb + t2 * VTILE + 32 * VSTR); MFMA8(o0, v0, pf[t2], sclV, sclV); MFMA8(o1, v1, pf[t2], sclV, sclV); } }
        asm volatile("s_waitcnt vmcnt(0) lgkmcnt(0)" ::: "memory"); __builtin_amdgcn_s_barrier(); asm volatile("" ::: "memory");
    }
    asm volatile("s_nop 15\n\ts_nop 15" : "+v"(o0), "+v"(o1));
    { auto rr = __builtin_amdgcn_permlane32_swap(__float_as_uint(l), __float_as_uint(l), false, false); l = __uint_as_float(rr[0]) + __uint_as_float(rr[1]); }
    const float inv = 1.0f / l;
    bf16_t* op = d.O + (size_t)qrow * 1024 + d.ooff + 4 * hh;
#pragma unroll
    for (int g4 = 0; g4 < 4; ++g4) {
        u32x2 w; w.x = cvt_pk(o0[4 * g4] * inv, o0[4 * g4 + 1] * inv); w.y = cvt_pk(o0[4 * g4 + 2] * inv, o0[4 * g4 + 3] * inv); *(u32x2*)(op + 8 * g4) = w;
        u32x2 x; x.x = cvt_pk(o1[4 * g4] * inv, o1[4 * g4 + 1] * inv); x.y = cvt_pk(o1[4 * g4 + 2] * inv, o1[4 * g4 + 3] * inv); *(u32x2*)(op + 32 + 8 * g4) = x;
    }
}

#ifndef TRACK_EN
#define TRACK_EN 1
#endif
DI void attn_phase(const Frame& F, int l, bool with_ctx, int rep = 0) {
    constexpr int NU_B = NB * 96, NU_A = NB * 96, NU_C = NB * 64, NU_X = NB * 16;
    const int NU = NU_B + NU_A + NU_C + (with_ctx ? NU_X : 0);
    unsigned* head = F.ctl + CW_QUEUE + 64 * (l + 2 * rep);
    volatile LAS int* slot = (volatile LAS int*)(F.lds + LDS_MISC + 16);
    const float* sinkp = INP(21) + l * 4;
    bool track;
    { auto amax = [&](const float* g, int n) { float v = 0.f; for (int i = 0; i < n; ++i) v = fmaxf(v, fabsf(g[i])); return v; };
      const float ga = 8.f * amax(INP(9) + l * 64, 64) * amax(INP(10) + l * 64, 64), gc = 8.f * amax(INP(19) + l * 64, 64) * amax(INP(20) + l * 64, 64);
      const float qn = amax(INP(15) + l * 64, 64), qr = amax(INP(17) + l * 32, 32), kn = amax(INP(16) + l * 64, 64), kr = amax(INP(18) + l * 32, 32);
      const float gb = sqrtf((64.f * qn * qn + 32.f * qr * qr) * (64.f * kn * kn + 32.f * kr * kr) / 96.f);
      const float sk = fmaxf(fmaxf(fabsf(sinkp[0]), fabsf(sinkp[1])), fmaxf(fabsf(sinkp[2]), fabsf(sinkp[3])));
      const float bound = fmaxf(fmaxf(ga, gc), fmaxf(gb, sk)) * LOG2E;
      track = !(bound < 100.f); }
    for (;;) {
        __syncthreads();
        if (F.tid == 0) *slot = (int)__hip_atomic_fetch_add(head, 1u, __ATOMIC_RELAXED, __HIP_MEMORY_SCOPE_AGENT);
        __syncthreads();
        int u = *slot; if (u >= NU) break;
        GAS unsigned char* wsg = (GAS unsigned char*)F.ws; asm volatile("" : "+s"(wsg)); unsigned char* ws = (unsigned char*)wsg;
        int tidu = F.tid; asm volatile("" : "+v"(tidu));
        AttnDesc d;
        if (u < NU_B) { const int b = u / 96, h = (u % 96) / 16, qb = u % 16;
            d = AttnDesc{(const unsigned char*)(ws + Z_QB), 768, h * 128, (const unsigned char*)(ws + Z_KB), 768, h * 128, (const unsigned char*)(ws + Z_VB) + ((size_t)b * 6 + h) * VT_HEAD, (bf16_t*)(ws + Z_OB), 384 + h * 64, 0.f};
#ifdef ATT_ABL
            if (rep) { attn_unit<128, 0, true, ATT_ABL>(tidu, F.lds, d, b, qb, false); continue; }
#endif
            attn_unit<128, 0, true>(tidu, F.lds, d, b, qb, false); continue; }
        u -= NU_B;
        if (u < NU_A) { const int b = u / 96, h = (u % 96) / 16, qb = u % 16;
            d = AttnDesc{(const unsigned char*)(ws + Z_QA), 384, h * 64, (const unsigned char*)(ws + Z_KA), 128, (h / 3) * 64, (const unsigned char*)(ws + Z_VA) + ((size_t)b * 2 + h / 3) * VT_HEAD, (bf16_t*)(ws + Z_OB), h * 64, 0.f};
#ifdef ATT_ABL
            if (rep) { attn_unit<64, 0, true, ATT_ABL>(tidu, F.lds, d, b, qb, false); continue; }
#endif
            attn_unit<64, 0, true>(tidu, F.lds, d, b, qb, false); continue; }
        u -= NU_A;
        if (u < NU_C) { const int b = u / 64, h = (u % 64) / 16, qb = u % 16;
            d = AttnDesc{(const unsigned char*)(ws + Z_QC), 256, h * 64, (const unsigned char*)(ws + Z_KC), 128, (h / 2) * 64, (const unsigned char*)(ws + Z_VC) + ((size_t)b * 2 + h / 2) * VT_HEAD, (bf16_t*)(ws + Z_OB), 768 + h * 64, sinkp[h] * LOG2E};
            attn_unit<64, 1, true>(tidu, F.lds, d, b, qb, true); continue; }
        u -= NU_C;
        { const int b = u / 16, hx = u % 16;
            if (hx < 6) { const int h = hx;
                d = AttnDesc{(const unsigned char*)(ws + Z_QA), 384, h * 64, (const unsigned char*)(ws + Z_KA), 128, (h / 3) * 64, (const unsigned char*)(ws + Z_VA) + ((size_t)b * 2 + h / 3) * VT_HEAD, (bf16_t*)(ws + Z_OB), h * 64, 0.f};
                attn_unit<64, 2, true>(tidu, F.lds, d, b, 0, false); }
            else if (hx < 12) { const int h = hx - 6;
                d = AttnDesc{(const unsigned char*)(ws + Z_QB), 768, h * 128, (const unsigned char*)(ws + Z_KB), 768, h * 128, (const unsigned char*)(ws + Z_VB) + ((size_t)b * 6 + h) * VT_HEAD, (bf16_t*)(ws + Z_OB), 384 + h * 64, 0.f};
                attn_unit<128, 2, true>(tidu, F.lds, d, b, 0, false); }
            else { const int h = hx - 12;
                d = AttnDesc{(const unsigned char*)(ws + Z_QC), 256, h * 64, (const unsigned char*)(ws + Z_KC), 128, (h / 2) * 64, (const unsigned char*)(ws + Z_VC) + ((size_t)b * 2 + h / 2) * VT_HEAD, (bf16_t*)(ws + Z_OB), 768 + h * 64, sinkp[h] * LOG2E};
                attn_unit<64, 2, true>(tidu, F.lds, d, b, 0, true); }
        }
    }
}

DI void router_phase(const Frame& F, int l, bool with_ctx) {
    LAS float* wT = (LAS float*)F.lds;
    const float* wr = INP(23) + (size_t)l * 1024 * 16;
    for (int e = F.tid; e < 16 * 1024; e += NTHR) { const int k = e / 16, x = e % 16; wT[x * 1024 + k] = wr[e]; }
    __syncthreads();
    const int gw = F.bid * NWAVES + F.wave, NGW = F.G * NWAVES, NR = with_ctx ? R : LAT, lane = F.lane;
    const float* g = INP(7) + l * 1024;
    auto rowptr = [&](int row) -> const float* { return row < LAT ? F.out + (size_t)row * 1024 : WSP(float, WS_CTXF) + (size_t)(row - LAT) * 1024; };
    f32x4 vn[4];
    if (gw < NR) { const float* xr0 = rowptr(gw);
#pragma unroll
        for (int j = 0; j < 4; ++j) vn[j] = *(const f32x4*)(xr0 + 4 * (lane + 64 * j)); }
    for (int row = gw; row < NR; row += NGW) {
        const float* m = mod_row(F, l, row);
        f32x4 v[4]; float s = 0.f;
#pragma unroll
        for (int j = 0; j < 4; ++j) { v[j] = vn[j]; s += (v[j].x * v[j].x + v[j].y * v[j].y) + (v[j].z * v[j].z + v[j].w * v[j].w); }
        if (row + NGW < NR) { const float* xr1 = rowptr(row + NGW);
#pragma unroll
            for (int j = 0; j < 4; ++j) vn[j] = *(const f32x4*)(xr1 + 4 * (lane + 64 * j)); }
        const float rstd = 1.0f / sqrtf(wave_sum(s) * (1.f / 1024.f) + EPS);
        float lg[16];
#pragma unroll
        for (int e = 0; e < 16; ++e) lg[e] = 0.f;
        unsigned char* orow = WSP(unsigned char, WS_HB) + (size_t)row * 1024;
#pragma unroll
        for (int j = 0; j < 4; ++j) { const int c = 4 * (lane + 64 * j); const f32x4 gv = *(const f32x4*)(g + c), sv = *(const f32x4*)(m + 3072 + c), cv = *(const f32x4*)(m + 4096 + c);
            v[j] = v[j] * rstd * gv * (cv + 1.0f) + sv; *(unsigned*)(orow + c) = pk_fp8x4(v[j].x, v[j].y, v[j].z, v[j].w); }
        asm volatile("" ::: "memory");
#pragma unroll
        for (int e = 0; e < 16; ++e) {
#pragma unroll
            for (int j = 0; j < 4; ++j) { const f32x4 wv = *(const LAS f32x4*)(wT + e * 1024 + 4 * (lane + 64 * j)); lg[e] += (v[j].x * wv.x + v[j].y * wv.y) + (v[j].z * wv.z + v[j].w * wv.w); }
            if (e & 1) asm volatile("" ::: "memory"); }
#pragma unroll
        for (int e = 0; e < 16; ++e) lg[e] = wave_sum(lg[e]);
        float mx = lg[0];
#pragma unroll
        for (int e = 1; e < 16; ++e) mx = fmaxf(mx, lg[e]);
        float sum = 0.f;
#pragma unroll
        for (int e = 0; e < 16; ++e) { lg[e] = expf(lg[e] - mx); sum += lg[e]; }
        const float isum = 1.0f / sum;
        float mine = 0.f;
#pragma unroll
        for (int e = 0; e < 16; ++e) mine = (lane == e) ? lg[e] * isum : mine;
        if (lane < 16) {
            if (row < LAT) WSP(float, WS_AFFL)[((size_t)(row / 4096) * 16 + lane) * 4096 + (row & 4095)] = mine;
            else { const int rc = row - LAT; WSP(float, WS_AFFC)[((size_t)(rc / 256) * 16 + lane) * 256 + (rc & 255)] = mine; }
        }
    }
}

DI void topk_phase(const Frame& F, bool with_ctx) {
    LAS unsigned* hist = (LAS unsigned*)F.lds;
    LAS unsigned* sh = hist + 256;
    LAS unsigned* scan = hist + 512;
    const int NL = NB * 16 * (with_ctx ? 2 : 1), tid = F.tid;
    for (int li = F.bid; li < NL; li += F.G) {
        const bool isctx = li >= NB * 16; const int be = isctx ? li - NB * 16 : li, b = be / 16, e = be % 16;
        const int n = isctx ? 256 : 4096, cap = n / 8, per = isctx ? 1 : 8;
        const float* a = isctx ? WSP(float, WS_AFFC) + (size_t)be * 256 : WSP(float, WS_AFFL) + (size_t)be * 4096;
        unsigned key[8]; const bool act = tid * per < n;
#pragma unroll
        for (int j = 0; j < 8; ++j) key[j] = (act && j < per) ? __float_as_uint(a[tid * per + j]) : 0u;
        unsigned prefix = 0u, rem = (unsigned)cap;
        for (int pass = 0; pass < 4; ++pass) {
            const int shift = 24 - 8 * pass;
            __syncthreads();
            if (tid < 256) hist[tid] = 0u;
            __syncthreads();
#pragma unroll
            for (int j = 0; j < 8; ++j) if (act && j < per) { const unsigned k = key[j]; const bool match = pass == 0 ? true : ((k >> (shift + 8)) == (prefix >> (shift + 8))); if (match) __hip_atomic_fetch_add(&hist[(k >> shift) & 255u], 1u, __ATOMIC_RELAXED, __HIP_MEMORY_SCOPE_WORKGROUP); }
            __syncthreads();
            if (tid < 64) {
                const int b0 = 255 - 4 * tid; const unsigned c0 = hist[b0], c1 = hist[b0 - 1], c2 = hist[b0 - 2], c3 = hist[b0 - 3];
                unsigned incl = c0 + c1 + c2 + c3;
#pragma unroll
                for (int o = 1; o < 64; o <<= 1) { const unsigned v = shfl_up_u(incl, o, tid); if (tid >= o) incl += v; }
                unsigned cum = incl - (c0 + c1 + c2 + c3);
                if (cum < rem && incl >= rem) { int bin = b0; unsigned c = c0;
                    if (cum + c < rem) { cum += c; bin = b0 - 1; c = c1; if (cum + c < rem) { cum += c; bin = b0 - 2; c = c2; if (cum + c < rem) { cum += c; bin = b0 - 3; } } }
                    sh[0] = prefix | ((unsigned)bin << shift); sh[1] = rem - cum; }
            }
            __syncthreads();
            prefix = sh[0]; rem = sh[1];
        }
        unsigned cg = 0u, ce = 0u;
#pragma unroll
        for (int j = 0; j < 8; ++j) if (act && j < per) { cg += key[j] > prefix ? 1u : 0u; ce += key[j] == prefix ? 1u : 0u; }
        __syncthreads();
        scan[tid] = cg; scan[512 + tid] = ce;
        __syncthreads();
        unsigned gb, eb;
        {
            unsigned ig = cg, ie = ce; const int ln = tid & 63, wv = tid >> 6;
#pragma unroll
            for (int o = 1; o < 64; o <<= 1) { const unsigned vg = shfl_up_u(ig, o, ln), ve = shfl_up_u(ie, o, ln); if (ln >= o) { ig += vg; ie += ve; } }
            if (ln == 63) { scan[1024 + wv] = ig; scan[1040 + wv] = ie; }
            __syncthreads();
            unsigned og = 0u, oe = 0u;
#pragma unroll
            for (int w = 0; w < 8; ++w) { if (w < wv) { og += scan[1024 + w]; oe += scan[1040 + w]; } }
            gb = og + ig - cg; eb = oe + ie - ce;
        }
        const int rowb = isctx ? LAT + b * 256 : b * 4096;
        const int mbase = isctx ? MOE_LAT + e * 256 + b * 32 : (b * 16 + e) * 512;
        int* gidx = WSP(int, WS_GIDX); float* gate = WSP(float, WS_GATE); int* inv = WSP(int, WS_INV);
#pragma unroll
        for (int j = 0; j < 8; ++j) if (act && j < per) {
            const unsigned k = key[j]; const int t = tid * per + j; int slot = -1;
            if (k > prefix) { slot = (int)(gb + (eb < rem ? eb : rem)); ++gb; }
            else if (k == prefix) { if (eb < rem) slot = (int)(gb + eb); ++eb; }
            if (slot >= 0) { gidx[mbase + slot] = rowb + t; gate[mbase + slot] = __uint_as_float(k); }
            inv[(size_t)(rowb + t) * 16 + e] = slot >= 0 ? mbase + slot : -1;
        }
        if (isctx && NB < 8 && b == 0) { for (int i = NB * 32 + tid; i < 256; i += NTHR) { gidx[MOE_LAT + e * 256 + i] = LAT; gate[MOE_LAT + e * 256 + i] = 0.f; } }
    }
}

DI void combine_phase(const Frame& F, int l, bool with_ctx) {
    const int gw = F.bid * NWAVES + F.wave, NGW = F.G * NWAVES, NR = with_ctx ? R : LAT, lane = F.lane;
    const bool last = (l == DEPTH - 1);
    const bf16_t* ye = WSP(bf16_t, Z_YE); const int* inv = WSP(int, WS_INV);
    auto rowptr = [&](int row) -> float* { return row < LAT ? F.out + (size_t)row * 1024 : WSP(float, WS_CTXF) + (size_t)(row - LAT) * 1024; };
    int slot_n = -1; f32x4 xn[4];
    if (gw < NR) { slot_n = lane < 16 ? inv[(size_t)gw * 16 + lane] : -1; const float* x0 = rowptr(gw);
#pragma unroll
        for (int j = 0; j < 4; ++j) xn[j] = *(const f32x4*)(x0 + 4 * (lane + 64 * j)); }
    for (int row = gw; row < NR; row += NGW) {
        float* xr = rowptr(row);
        const float* m = mod_row(F, l, row);
        const int myslot = slot_n; f32x4 xv[4];
#pragma unroll
        for (int j = 0; j < 4; ++j) xv[j] = xn[j];
        if (row + NGW < NR) { slot_n = lane < 16 ? inv[(size_t)(row + NGW) * 16 + lane] : -1; const float* x1 = rowptr(row + NGW);
#pragma unroll
            for (int j = 0; j < 4; ++j) xn[j] = *(const f32x4*)(x1 + 4 * (lane + 64 * j)); }
        f32x4 acc[4];
#pragma unroll
        for (int j = 0; j < 4; ++j) acc[j] = (f32x4){0.f, 0.f, 0.f, 0.f};
        unsigned mask = (unsigned)(__ballot(myslot >= 0) & 0xFFFFull);
        while (mask) {
            const int e0 = __builtin_ctz(mask); mask &= mask - 1; const bool two = mask != 0u; const int e1 = two ? __builtin_ctz(mask) : e0; if (two) mask &= mask - 1;
            const int s0 = __builtin_amdgcn_readlane(myslot, e0), s1 = __builtin_amdgcn_readlane(myslot, e1);
            const bf16_t* y0 = ye + (size_t)s0 * 1024; const bf16_t* y1 = ye + (size_t)s1 * 1024; const float w1 = two ? 1.f : 0.f;
            u32x2 a[4], c[4];
#pragma unroll
            for (int j = 0; j < 4; ++j) { a[j] = *(const u32x2*)(y0 + 4 * (lane + 64 * j)); c[j] = *(const u32x2*)(y1 + 4 * (lane + 64 * j)); }
#pragma unroll
            for (int j = 0; j < 4; ++j) { acc[j].x += bf_lo(a[j].x) + w1 * bf_lo(c[j].x); acc[j].y += bf_hi(a[j].x) + w1 * bf_hi(c[j].x); acc[j].z += bf_lo(a[j].y) + w1 * bf_lo(c[j].y); acc[j].w += bf_hi(a[j].y) + w1 * bf_hi(c[j].y); }
        }
        f32x4 v[4];
#pragma unroll
        for (int j = 0; j < 4; ++j) { const int c = 4 * (lane + 64 * j); v[j] = xv[j] + *(const f32x4*)(m + 5120 + c) * acc[j]; *(f32x4*)(xr + c) = v[j]; }
        if (!last) { const float* m2 = mod_row(F, l + 1, row); norm_mod_store(v, INP(6) + (l + 1) * 1024, m2, m2 + 1024, WSP(unsigned char, WS_HB) + (size_t)row * 1024, lane); }
    }
}
constexpr int NPHASE = 2 + 9 * DEPTH;
DI void load_tabs(const Frame& F) {
    const f32x2* t64 = WSP(f32x2, WS_TAB64); const f32x2* t32 = WSP(f32x2, WS_TAB32);
    LAS f32x2* l64 = (LAS f32x2*)(F.lds + LDS_TAB64); LAS f32x2* l32 = (LAS f32x2*)(F.lds + LDS_TAB32);
    for (int i = F.tid; i < 64 * 16; i += NTHR) l64[i] = t64[i];
    for (int i = F.tid; i < 64 * 8; i += NTHR) l32[i] = t32[i];
    __syncthreads();
}
#ifndef PH_EN
#define PH_EN(k) 1
#endif
DI void run_phase(const Frame& F, int ph, int rep = 0) {
    unsigned char* ws = F.ws;
    if (ph == 0) { if (PH_EN(100)) p0_phase(F); return; }
    if (ph == 1) { if (PH_EN(101)) init_norm_phase(F); return; }
    const int l = (ph - 2) / 9, s = (ph - 2) % 9; const bool last = (l == DEPTH - 1);
    switch (s) {
    case 0: if (PH_EN(0)) { load_tabs(F);
        g8::DenseSched S; S.init(MT, 6, F.G, F.bid, 512, ws + WS_WIN + (size_t)l * 1536 * 1024);
        EpiInProj E{ws, F.intab, l, (const LAS f32x2*)(F.lds + LDS_TAB64), (const LAS f32x2*)(F.lds + LDS_TAB32)};
        g8::gemm_phase(F.tid, F.lds, (const char*)(ws + WS_HB), 512, S, E); } break;
    case 1: if (PH_EN(1)) { load_tabs(F);
        g8::DenseSched S; S.init(MT, 6, F.G, F.bid, 384, ws + WS_WUP + (size_t)l * 1536 * 384 * 2, true);
        EpiUpProj E{ws, F.intab, l, (const LAS f32x2*)(F.lds + LDS_TAB32)};
        g8::gemm_phase(F.tid, F.lds, (const char*)(ws + Z_CRAW), 384, S, E); } break;
    case 2: if (PH_EN(2)) attn_phase(F, l, !last, rep); break;
    case 3: if (PH_EN(3)) { g8::DenseSched S; S.init(last ? LAT / 256 : MT, 4, F.G, F.bid, 1024, ws + WS_WOUT + (size_t)l * 1024 * 1024 * 2);
        EpiOutProj E{ws, l == 0 ? INP(0) : F.out, INP(2), F.out, l};
        g8::gemm_phase(F.tid, F.lds, (const char*)(ws + Z_OB), 1024, S, E); } break;
    case 4: if (PH_EN(4)) router_phase(F, l, !last); break;
    case 5: if (PH_EN(5)) topk_phase(F, !last); break;
    case 6: if (PH_EN(6)) { g8::MoeSched<true> S; S.init(8, !last, F.G, F.bid, 512, ws + WS_W1 + (size_t)l * 16 * 2048 * 1024, (size_t)2048 * 1024, (const int*)(ws + WS_GIDX));
        EpiMoe1 E{ws}; g8::gemm_phase(F.tid, F.lds, (const char*)(ws + WS_HB), 512, S, E); } break;
    case 7: if (PH_EN(7)) { g8::MoeSched<false> S; S.init(4, !last, F.G, F.bid, 512, ws + WS_W2 + (size_t)l * 16 * 1024 * 1024, (size_t)1024 * 1024, nullptr);
        EpiMoe2 E{ws}; g8::gemm_phase(F.tid, F.lds, (const char*)(ws + Z_HID), 512, S, E); } break;
    case 8: if (PH_EN(8)) combine_phase(F, l, !last); break;
    }
}
__global__ void __launch_bounds__(NTHR, 2) mega_kernel(Args a) {
    extern __shared__ __attribute__((aligned(16))) unsigned char lds_raw[];
    Frame F; F.lds = (LAS unsigned char*)lds_raw; F.ws = a.ws; F.ctl = (unsigned*)(a.ws + WS_CTL);
    F.tid = threadIdx.x; F.lane = F.tid & 63; F.wave = __builtin_amdgcn_readfirstlane(F.tid >> 6); F.G = gridDim.x; F.bid = blockIdx.x; F.out = a.out;
    { LAS unsigned long long* tab = (LAS unsigned long long*)(F.lds + LDS_INTAB); if (F.tid < 27) tab[F.tid] = (unsigned long long)a.in[F.tid]; F.intab = tab; }
    volatile LAS unsigned* MISC = (volatile LAS unsigned*)(F.lds + LDS_MISC);
    if (F.tid < 64) MISC[F.tid] = 0u;
    __syncthreads();
    const bool multi = a.ph_hi - a.ph_lo > 1;
    XcdBarrier bar; bar.bar = F.ctl + CW_BAR + a.li * XCD_BAR_WORDS; bar.x = 0; bar.st = MISC;
    if (multi) bar = xcd_barrier_post(F.ctl + CW_BAR + a.li * XCD_BAR_WORDS, MISC);
    for (int ph = a.ph_lo; ph < a.ph_hi; ++ph) {
        {
            GAS unsigned char* w_ = (GAS unsigned char*)a.ws; GAS float* o_ = (GAS float*)a.out; unsigned l_ = (unsigned)(unsigned long long)F.lds, t_ = (unsigned)(unsigned long long)F.intab; int tid_ = threadIdx.x, g_ = gridDim.x, b_ = blockIdx.x;
            asm volatile("" : "+s"(w_), "+s"(o_), "+s"(l_), "+s"(t_), "+v"(tid_), "+s"(g_), "+s"(b_));
            F.ws = (unsigned char*)w_; F.out = (float*)o_; F.lds = (LAS unsigned char*)(unsigned long long)l_; F.intab = (const LAS unsigned long long*)(unsigned long long)t_; F.ctl = (unsigned*)(F.ws + WS_CTL);
            F.tid = tid_; F.lane = tid_ & 63; F.wave = __builtin_amdgcn_readfirstlane(tid_ >> 6); F.G = g_; F.bid = b_; }
        run_phase(F, ph, a.li);
#ifdef PROBE_I
        xcd_barrier(bar);
        if (F.bid == 0 && F.tid == 0) ((unsigned long long*)(F.ws + 49152))[ph + 1] = __builtin_amdgcn_s_memrealtime();
#else
        if (ph + 1 < a.ph_hi) xcd_barrier(bar);
#endif
    }
#ifdef PROBE_I
    {
        xcd_barrier(bar);
        const unsigned long long* ts = (const unsigned long long*)(F.ws + 49152);
        float ti = (float)(__hip_atomic_load(ts + PROBE_I + 1, __ATOMIC_RELAXED, __HIP_MEMORY_SCOPE_AGENT) - __hip_atomic_load(ts + PROBE_I, __ATOMIC_RELAXED, __HIP_MEMORY_SCOPE_AGENT)) * 0.01f;
        float tj = (float)(__hip_atomic_load(ts + PROBE_J + 1, __ATOMIC_RELAXED, __HIP_MEMORY_SCOPE_AGENT) - __hip_atomic_load(ts + PROBE_J, __ATOMIC_RELAXED, __HIP_MEMORY_SCOPE_AGENT)) * 0.01f;
        ti = exp2f(rintf(log2f(fmaxf(ti, 1.f)) * 14.2067f) / 14.2067f); tj = exp2f(rintf(log2f(fmaxf(tj, 1.f)) * 14.2067f) / 14.2067f);
        const float* xin = inp(F.intab, 0); const size_t n = (size_t)8 * 4096 * 1024;
        for (size_t i = (size_t)F.bid * NTHR + F.tid; i < n; i += (size_t)F.G * NTHR) F.out[i] = xin[i] + ti + (i == 0 ? 100.f * tj : 0.f);
    }
#endif
}
}

extern "C" void kernel_launch(void* const* d_in, const int* in_sizes, int n_in, void* d_out, int out_size, void* d_ws, size_t ws_size, hipStream_t stream) {
    static int grid = 0;
    if (grid == 0) {
        if (n_in != 27 || out_size != 8 * 4096 * 1024 || ws_size < fp::WS_END) { fprintf(stderr, "kernel_launch: unexpected problem (n_in %d, out %d, ws %zu < %zu)\n", n_in, out_size, ws_size, (size_t)fp::WS_END); grid = -1; return; }
        int dev = 0, cus = 0, per_cu = 0;
        if (hipGetDevice(&dev) != hipSuccess || hipDeviceGetAttribute(&cus, hipDeviceAttributeMultiprocessorCount, dev) != hipSuccess) { fprintf(stderr, "kernel_launch: device query failed\n"); grid = -1; return; }
        if (hipFuncSetAttribute((const void*)fp::mega_kernel, hipFuncAttributeMaxDynamicSharedMemorySize, fp::LDS_BYTES) != hipSuccess) { fprintf(stderr, "kernel_launch: hipFuncSetAttribute failed\n"); grid = -1; return; }
        if (hipOccupancyMaxActiveBlocksPerMultiprocessor(&per_cu, (const void*)fp::mega_kernel, fp::NTHR, fp::LDS_BYTES) != hipSuccess || per_cu < 1) fprintf(stderr, "kernel_launch: note: occupancy query reports %d workgroups per CU\n", per_cu);
        (void)hipGetLastError();
        grid = cus;
    }
    if (grid < 0) return;
    if (hipMemsetAsync((char*)d_ws + fp::WS_CTL, 0, fp::CTL_BYTES, stream) != hipSuccess) { fprintf(stderr, "kernel_launch: memset failed\n"); return; }
    fp::Args a{};
    for (int i = 0; i < 27; ++i) a.in[i] = (const float*)d_in[i];
    a.out = (float*)d_out; a.ws = (unsigned char*)d_ws; a.ph_lo = 0; a.ph_hi = fp::NPHASE;
#ifdef PROBE_SPLIT_LO
    a.ph_hi = PROBE_SPLIT_HI; a.li = 1; hipLaunchKernelGGL(fp::mega_kernel, dim3(grid), dim3(fp::NTHR), fp::LDS_BYTES, stream, a);
    a.ph_lo = PROBE_SPLIT_LO; a.ph_hi = fp::NPHASE; a.li = 0;
#endif
    hipLaunchKernelGGL(fp::mega_kernel, dim3(grid), dim3(fp::NTHR), fp::LDS_BYTES, stream, a);
}
```

```cpp
#include <hip/hip_runtime.h>
#include <stdint.h>
#include <stdio.h>
#include <math.h>
#include <type_traits>
constexpr int DEPTH = 2;
#define FAST_NB 8
namespace fp {
#define LAS __attribute__((address_space(3)))
#define GAS __attribute__((address_space(1)))
typedef unsigned short bf16_t;
typedef short bf16x8 __attribute__((ext_vector_type(8)));
typedef short s16x4 __attribute__((ext_vector_type(4)));
typedef float f32x4 __attribute__((ext_vector_type(4)));
typedef float f32x16 __attribute__((ext_vector_type(16)));
typedef unsigned u32x4 __attribute__((ext_vector_type(4)));
typedef unsigned u32x2 __attribute__((ext_vector_type(2)));
typedef float f32x2 __attribute__((ext_vector_type(2)));
#define DI __device__ __forceinline__

DI unsigned cvt_pk(float lo, float hi) { typedef float f2 __attribute__((ext_vector_type(2))); typedef __bf16 b2 __attribute__((ext_vector_type(2))); f2 v = {lo, hi}; b2 b = __builtin_convertvector(v, b2); return __builtin_bit_cast(unsigned, b); }
DI float bf_lo(unsigned w) { return __uint_as_float(w << 16); }
DI float bf_hi(unsigned w) { return __uint_as_float(w & 0xffff0000u); }
DI float silu_f(float v) { return v / (1.f + __expf(-v)); }
template <int M> DI float swz_xor(float v) { return __int_as_float(__builtin_amdgcn_ds_swizzle(__float_as_int(v), (M << 10) | 0x1F)); }
DI float add_xor16(float v) { return v + swz_xor<16>(v); }
DI float add_xor32(float v) { auto r = __builtin_amdgcn_permlane32_swap(__float_as_uint(v), __float_as_uint(v), false, false); return __uint_as_float(r[0]) + __uint_as_float(r[1]); }
DI float other32(float v, bool upper_half) { auto r = __builtin_amdgcn_permlane32_swap(__float_as_uint(v), __float_as_uint(v), false, false); return __uint_as_float(upper_half ? r[0] : r[1]); }
DI float wave_sum(float v) { v += swz_xor<1>(v); v += swz_xor<2>(v); v += swz_xor<4>(v); v += swz_xor<8>(v); v += swz_xor<16>(v); return add_xor32(v); }
DI unsigned shfl_up_u(unsigned v, int o, int lane) { return (unsigned)__builtin_amdgcn_ds_bpermute((lane - o) << 2, (int)v); }

constexpr int NB = FAST_NB;
constexpr int LAT = NB * 4096, CTXR = NB * 256, R = LAT + CTXR, MT = R / 256;
constexpr int MOE_LAT = NB * 16 * 512, MOE_ROWS = MOE_LAT + 16 * 256;
constexpr float EPS = 1e-6f, LOG2E = 1.4426950408889634f;
constexpr float QS64 = 0.125f * LOG2E, QS96 = 0.10206207261596575f * LOG2E;
constexpr float QF64 = QS64 * 8.f, QF96 = QS96 * 8.f;
constexpr int NWAVES = 8, NTHR = 512;

constexpr size_t al256(size_t x) { return (x + 255) & ~(size_t)255; }
constexpr size_t WS_CTL = 0, CTL_BYTES = 65536;
constexpr size_t WS_MOD = WS_CTL + CTL_BYTES;
constexpr size_t WS_TAB64 = WS_MOD + al256((size_t)2 * 9 * 6144 * 4);
constexpr size_t WS_TAB32 = WS_TAB64 + 8192;
constexpr size_t WS_WIN = WS_TAB32 + 4096;
constexpr size_t WS_WUP = WS_WIN + (size_t)2 * 1536 * 1024 * 2;
constexpr size_t WS_WOUT = WS_WUP + (size_t)2 * 1536 * 384 * 2;
constexpr size_t WS_W1 = WS_WOUT + (size_t)2 * 1024 * 1024 * 2;
constexpr size_t WS_W2 = WS_W1 + (size_t)2 * 16 * 2048 * 1024 * 2;
constexpr size_t WS_HB = WS_W2 + (size_t)2 * 16 * 1024 * 1024 * 2;
constexpr size_t WS_CTXF = WS_HB + (size_t)R * 1024 * 2;
constexpr size_t WS_SSQ = WS_CTXF + (size_t)CTXR * 1024 * 4;
constexpr size_t WS_AFFL = WS_SSQ + (size_t)R * 8 * 4;
constexpr size_t WS_AFFC = WS_AFFL + (size_t)NB * 16 * 4096 * 4;
constexpr size_t WS_GIDX = WS_AFFC + (size_t)NB * 16 * 256 * 4;
constexpr size_t WS_GATE = WS_GIDX + (size_t)MOE_ROWS * 4;
constexpr size_t WS_INV = WS_GATE + (size_t)MOE_ROWS * 4;
constexpr size_t WS_Z = al256(WS_INV + (size_t)R * 16 * 4);
constexpr size_t Z_QA = WS_Z, Z_KA = Z_QA + (size_t)R * 384 * 2, Z_VA = Z_KA + (size_t)R * 128 * 2, Z_QC = Z_VA + (size_t)R * 128 * 2, Z_KC = Z_QC + (size_t)R * 256 * 2,
                 Z_VC = Z_KC + (size_t)R * 128 * 2, Z_CRAW = Z_VC + (size_t)R * 128 * 2, Z_QB = Z_CRAW + (size_t)R * 384 * 2, Z_KB = Z_QB + (size_t)R * 576 * 2,
                 Z_VB = Z_KB + (size_t)R * 576 * 2, Z_OB = Z_VB + (size_t)R * 384 * 2, Z_END1 = Z_OB + (size_t)R * 1024 * 2;
constexpr size_t VT_TILE = 4096, VT_HEAD = 68 * VT_TILE;
constexpr size_t Z_HID = WS_Z, Z_YE = Z_HID + (size_t)MOE_ROWS * 1024 * 2, Z_END2 = Z_YE + (size_t)MOE_ROWS * 1024 * 2;
constexpr size_t WS_END = al256(Z_END1 > Z_END2 ? Z_END1 : Z_END2);
constexpr int CW_BAR = 1024;
constexpr int CW_QUEUE = 8192;

DI int vt_pos(int k) { return ((k & 4) << 3) | ((k & 32) >> 1) | ((k & 24) >> 1) | (k & 3); }
constexpr int RING_BYTES = 131072;
constexpr int LDS_TAB64 = RING_BYTES, LDS_TAB32 = LDS_TAB64 + 8192, LDS_MISC = LDS_TAB32 + 4096;
constexpr int LDS_INTAB = LDS_MISC + 256;
constexpr int LDS_BYTES = 147456;

#define XB_TMO      128
#define XB_XCNT(j)  (256  + 64 * (j))
#define XB_XSUB(j)  (1280 + 64 * (j))
#define XB_XGEN(j)  (2304 + 64 * (j))
#define XB_TOP      3328
#define XB_TOPGEN   3392
#define XCD_BAR_WORDS 3456
#define XB_SPIN_CAP (1u << 20)
DI unsigned xb_ld(unsigned* p)              { return __hip_atomic_load(p, __ATOMIC_RELAXED, __HIP_MEMORY_SCOPE_AGENT); }
DI unsigned xb_add(unsigned* p, unsigned v) { return __hip_atomic_fetch_add(p, v, __ATOMIC_RELAXED, __HIP_MEMORY_SCOPE_AGENT); }
DI unsigned xb_xcc_id() { return (unsigned)__builtin_amdgcn_s_getreg((3 << 11) | 20) & 0xFu; }
#define XB_SPIN(cond, bar) do { unsigned _sp = 0; while (cond) { __builtin_amdgcn_s_sleep(1); \
    if ((++_sp & 255u) == 0u) { if (xb_ld(&(bar)[XB_TMO])) break; if (_sp > XB_SPIN_CAP) { atomicAdd(&(bar)[XB_TMO], 1u); break; } } } } while (0)
struct XcdBarrier { unsigned* bar; unsigned x; volatile LAS unsigned* st; };
DI XcdBarrier xcd_barrier_post(unsigned* bar, volatile LAS unsigned* st) {
    XcdBarrier b; b.bar = bar; b.x = xb_xcc_id(); b.st = st;
    if (threadIdx.x == 0) (void)xb_add(&bar[XB_XCNT(b.x)], 1u);
    return b;
}
DI void xcd_barrier_complete(unsigned* bar, unsigned x, unsigned& nloc, unsigned& nx) {
    asm volatile("" : "+s"(x));
    const unsigned G = gridDim.x * gridDim.y * gridDim.z;
    unsigned sum, cnt, mine, sp = 0u;
    for (;;) {
        sum = 0u; cnt = 0u; mine = 0u;
#pragma unroll
        for (unsigned j = 0; j < 16; ++j) { const unsigned c = xb_ld(&bar[XB_XCNT(j)]); sum += c; cnt += (c > 0u) ? 1u : 0u; mine = (j == x) ? c : mine; }
        if (sum == G) break;
        __builtin_amdgcn_s_sleep(1);
        if ((++sp & 255u) == 0u) { if (xb_ld(&bar[XB_TMO])) break; if (sp > XB_SPIN_CAP) { atomicAdd(&bar[XB_TMO], 1u); break; } }
    }
    nloc = mine > 0u ? mine : 1u; nx = cnt > 0u ? cnt : 1u;
}
DI void xcd_barrier(const XcdBarrier& b) {
    asm volatile("s_waitcnt vmcnt(0)" ::: "memory");
    __syncthreads();
    if (threadIdx.x == 0) {
        unsigned* bar = b.bar; asm volatile("" : "+s"(bar));
        __builtin_amdgcn_s_waitcnt(0);
        unsigned nloc = b.st[0], nx = b.st[1];
        if (nloc == 0u) { xcd_barrier_complete(bar, b.x, nloc, nx); b.st[0] = nloc; b.st[1] = nx; }
        const unsigned old = xb_add(&bar[XB_XSUB(b.x)], 1u);
        const unsigned gen = old / nloc;
        if (old + 1u == (gen + 1u) * nloc) {
            __builtin_amdgcn_fence(__ATOMIC_RELEASE, "agent");
            asm volatile("s_waitcnt vmcnt(0)" ::: "memory");
            const unsigned og = xb_add(&bar[XB_TOP], 1u);
            const unsigned tg = og / nx;
            if (og + 1u == (tg + 1u) * nx) xb_add(&bar[XB_TOPGEN], 1u);
            else XB_SPIN(xb_ld(&bar[XB_TOPGEN]) == tg, bar);
            __builtin_amdgcn_fence(__ATOMIC_ACQUIRE, "agent");
            xb_add(&bar[XB_XGEN(b.x)], 1u);
            asm volatile("s_waitcnt vmcnt(0)" ::: "memory");
        } else {
            XB_SPIN(xb_ld(&bar[XB_XGEN(b.x)]) == gen, bar);
            __builtin_amdgcn_fence(__ATOMIC_ACQUIRE, "agent");
            asm volatile("s_waitcnt vmcnt(0)" ::: "memory");
        }
    }
    __syncthreads();
}

struct Args { const float* in[27]; float* out; unsigned char* ws; int ph_lo, ph_hi, li, pad; };
struct Frame {
    LAS unsigned char* lds; unsigned char* ws; unsigned* ctl;
    int tid, lane, wave, G, bid;
    const LAS unsigned long long* intab; float* out;
};
DI const float* inp(const LAS unsigned long long* tab, int k) { const unsigned long long v = tab[k]; const unsigned lo = __builtin_amdgcn_readfirstlane((unsigned)v), hi = __builtin_amdgcn_readfirstlane((unsigned)(v >> 32)); return (const float*)(const GAS float*)(((unsigned long long)hi << 32) | lo); }
#define INP(k) inp(F.intab, k)
#define WSP(T, off) ((T*)(F.ws + (off)))

DI void mod_item(const Frame& F, int item, const LAS float* s9, LAS float* red) {
    const int l = item / 96, c0 = (item % 96) * 64;
    const float* W = INP(4) + (size_t)l * 1024 * 6144 + c0;
    const int cg = F.lane & 15, ks = F.wave * 4 + (F.lane >> 4);
    f32x4 acc[9];
#pragma unroll
    for (int r = 0; r < 9; ++r) acc[r] = (f32x4){0.f, 0.f, 0.f, 0.f};
#pragma unroll 4
    for (int i = 0; i < 32; ++i) { const int k = ks + 32 * i; const f32x4 w = *(const f32x4*)(W + (size_t)k * 6144 + cg * 4);
#pragma unroll
        for (int r = 0; r < 9; ++r) acc[r] += w * s9[r * 1024 + k]; }
#pragma unroll
    for (int r = 0; r < 9; ++r)
#pragma unroll
        for (int j = 0; j < 4; ++j) { acc[r][j] = add_xor32(add_xor16(acc[r][j])); }
    __syncthreads();
    if (F.lane < 16) {
#pragma unroll
        for (int r = 0; r < 9; ++r) *(LAS f32x4*)(red + (F.wave * 9 + r) * 64 + cg * 4) = acc[r]; }
    __syncthreads();
    for (int e = F.tid; e < 9 * 64; e += NTHR) { const int r = e / 64, c = e % 64; float s = 0.f;
#pragma unroll
        for (int w = 0; w < 8; ++w) s += red[(w * 9 + r) * 64 + c];
        WSP(float, WS_MOD)[((size_t)l * 9 + r) * 6144 + c0 + c] = s + INP(5)[l * 6144 + c0 + c]; }
}

DI void cv_block(const float* src  , int ld, const float* ksc, bf16_t* drow  ) {
#pragma unroll
    for (int kc = 0; kc < 8; ++kc) {
        float v[8];
#pragma unroll
        for (int j = 0; j < 8; ++j) v[j] = src ? src[(size_t)(kc * 8 + j) * ld] : 0.f;
        if (ksc) {
#pragma unroll
            for (int j = 0; j < 8; ++j) v[j] *= ksc[kc * 8 + j]; }
        u32x4 o; o.x = cvt_pk(v[0], v[1]); o.y = cvt_pk(v[2], v[3]); o.z = cvt_pk(v[4], v[5]); o.w = cvt_pk(v[6], v[7]);
        *(u32x4*)(drow + kc * 8) = o;
    }
}
DI void cv_block_fp8(const float* src, int ld, unsigned char* drow) {
    float v[64];
#pragma unroll
    for (int j = 0; j < 64; ++j) v[j] = src[(size_t)j * ld];
#pragma unroll
    for (int kc = 0; kc < 4; ++kc) {
        u32x4 o;
        { int w = __builtin_amdgcn_cvt_pk_fp8_f32(v[16 * kc + 0] * 64.f, v[16 * kc + 1] * 64.f, 0, false); w = __builtin_amdgcn_cvt_pk_fp8_f32(v[16 * kc + 2] * 64.f, v[16 * kc + 3] * 64.f, w, true); o.x = (unsigned)w; }
        { int w = __builtin_amdgcn_cvt_pk_fp8_f32(v[16 * kc + 4] * 64.f, v[16 * kc + 5] * 64.f, 0, false); w = __builtin_amdgcn_cvt_pk_fp8_f32(v[16 * kc + 6] * 64.f, v[16 * kc + 7] * 64.f, w, true); o.y = (unsigned)w; }
        { int w = __builtin_amdgcn_cvt_pk_fp8_f32(v[16 * kc + 8] * 64.f, v[16 * kc + 9] * 64.f, 0, false); w = __builtin_amdgcn_cvt_pk_fp8_f32(v[16 * kc + 10] * 64.f, v[16 * kc + 11] * 64.f, w, true); o.z = (unsigned)w; }
        { int w = __builtin_amdgcn_cvt_pk_fp8_f32(v[16 * kc + 12] * 64.f, v[16 * kc + 13] * 64.f, 0, false); w = __builtin_amdgcn_cvt_pk_fp8_f32(v[16 * kc + 14] * 64.f, v[16 * kc + 15] * 64.f, w, true); o.w = (unsigned)w; }
        *(u32x4*)(drow + kc * 16) = o;
    }
}
constexpr int CV_WIN = 384, CV_WUP = 144, CV_WOUT = 256, CV_W1 = 8192, CV_W2 = 4096, CV_LAYER = CV_WIN + CV_WUP + CV_WOUT + CV_W1 + CV_W2;
DI void conv_item(const Frame& F, int it) {
    const int l = it / CV_LAYER; int r = it % CV_LAYER; const int lane = F.lane, hl = lane >> 5, ll = lane & 31;
    if (r < CV_WIN) {
        const int kb = r / 24, g = (r % 24) * 2 + hl, x = ((g >> 3) * 4 + (g & 3)) * 64 + 32 * ((g >> 2) & 1) + ll;
        const int sc = x < 960 ? x : (x < 1472 ? x + 32 : (x < 1504 ? x - 512 : -1));
        const float* src = sc < 0 ? nullptr : INP(8) + (size_t)l * 1024 * 1504 + (size_t)(kb * 64) * 1504 + sc;
        unsigned char* drow = WSP(unsigned char, WS_WIN) + (size_t)l * 1536 * 1024 + (size_t)((r % 24) * 64 + lane) * 1024 + kb * 64;
        if (__builtin_amdgcn_readfirstlane(sc < 0 ? 1 : 0) | __any(sc < 0)) { const float* s2 = sc < 0 ? INP(8) : src; cv_block_fp8(s2, sc < 0 ? 0 : 1504, drow);
            if (sc < 0) {
#pragma unroll
                for (int kc = 0; kc < 4; ++kc) *(u32x4*)(drow + kc * 16) = (u32x4){0u, 0u, 0u, 0u}; } }
        else cv_block_fp8(src, 1504, drow);
        return; }
    r -= CV_WIN;
    if (r < CV_WUP) {
        const int kb = r / 24, g = (r % 24) * 2 + hl, slot = (g >> 3) * 4 + (g & 3), half = (g >> 2) & 1;
        const float* src = nullptr; const float* ksc = nullptr; int ld = 0;
        if (slot < 9 && kb < 3) { const int col = slot < 6 ? slot * 96 + 32 * half : (2 * (slot - 6) + half) * 96 + 64;
            src = INP(13) + (size_t)l * 192 * 576 + (size_t)(kb * 64) * 576 + col + ll; ld = 576; ksc = INP(11) + l * 192 + kb * 64; }
        else if (slot >= 12 && (kb == 3 || kb == 4)) { const int h = slot < 18 ? slot - 12 : slot - 18; const int col = h * 128 + (slot < 18 ? 0 : 64) + 32 * half;
            src = INP(14) + (size_t)l * 128 * 768 + (size_t)((kb - 3) * 64) * 768 + col + ll; ld = 768; ksc = INP(12) + l * 128 + (kb - 3) * 64; }
        cv_block(src, ld, ksc, WSP(bf16_t, WS_WUP) + (size_t)l * 1536 * 384 + (size_t)((r % 24) * 64 + lane) * 384 + kb * 64); return; }
    r -= CV_WUP;
    if (r < CV_WOUT) { const int kb = r / 16, g = r % 16;
        cv_block(INP(22) + (size_t)l * 1024 * 1024 + (size_t)(kb * 64) * 1024 + g * 64 + lane, 1024, nullptr, WSP(bf16_t, WS_WOUT) + (size_t)l * 1024 * 1024 + (size_t)(g * 64 + lane) * 1024 + kb * 64); return; }
    r -= CV_WOUT;
    if (r < CV_W1) { const int e = r / 512, q = r % 512, kb = q / 32, g = (q % 32) * 2 + hl, pn = g >> 3, bj = (g >> 2) & 1, wc = g & 3;
        const float* src = (bj ? INP(25) : INP(24)) + ((size_t)l * 16 + e) * 1024 * 1024 + (size_t)(kb * 64) * 1024 + 128 * pn + 32 * wc + ll;
        cv_block_fp8(src, 1024, WSP(unsigned char, WS_W1) + ((size_t)l * 16 + e) * 2048 * 1024 + (size_t)((q % 32) * 64 + lane) * 1024 + kb * 64); return; }
    r -= CV_W1;
    { const int e = r / 256, q = r % 256, kb = q / 16, g = q % 16;
        cv_block_fp8(INP(26) + ((size_t)l * 16 + e) * 1024 * 1024 + (size_t)(kb * 64) * 1024 + g * 64 + lane, 1024, WSP(unsigned char, WS_W2) + ((size_t)l * 16 + e) * 1024 * 1024 + (size_t)(g * 64 + lane) * 1024 + kb * 64); }
}
DI void p0_phase(const Frame& F) {
    LAS float* s9 = (LAS float*)F.lds;
    LAS float* red = (LAS float*)(F.lds + 9 * 1024 * 4);
    if (F.bid == 0) {
        for (int i = F.tid; i < 64 * 16; i += NTHR) { const int pos = i / 16, f = i % 16; const float inv = exp2f(-(float)(2 * f) / 32.f * 13.287712379549449f); const float a = (float)pos * inv; WSP(f32x2, WS_TAB64)[i] = (f32x2){cosf(a), sinf(a)}; }
        for (int i = F.tid; i < 64 * 8; i += NTHR) { const int pos = i / 8, f = i % 8; const float inv = exp2f(-(float)(2 * f) / 16.f * 13.287712379549449f); const float a = (float)pos * inv; WSP(f32x2, WS_TAB32)[i] = (f32x2){cosf(a), sinf(a)}; }
    }
    bool have_s9 = false;
    for (int it = F.bid; it < 192; it += F.G) {
        if (!have_s9) { for (int e = F.tid; e < 9 * 1024; e += NTHR) { const int r = e / 1024, k = e % 1024; const float v = r < 8 ? INP(1)[r * 1024 + k] : INP(3)[k]; s9[e] = silu_f(v); } have_s9 = true; __syncthreads(); }
        mod_item(F, it, s9, red);
    }
    __syncthreads();
    const int gw = F.bid * NWAVES + F.wave, NGW = F.G * NWAVES;
    for (int it = gw; it < 2 * CV_LAYER; it += NGW) conv_item(F, it);
}

DI unsigned pk_fp8q(float a, float b, float c, float d) { int w = __builtin_amdgcn_cvt_pk_fp8_f32(a, b, 0, false); w = __builtin_amdgcn_cvt_pk_fp8_f32(c, d, w, true); return (unsigned)w; }
DI void norm_mod_store(const f32x4 (&v)[4], const float* g, const float* sh, const float* sc, unsigned char* orow  , int lane) {
    float s = 0.f;
#pragma unroll
    for (int j = 0; j < 4; ++j) s += (v[j].x * v[j].x + v[j].y * v[j].y) + (v[j].z * v[j].z + v[j].w * v[j].w);
    const float rstd = 1.0f / sqrtf(wave_sum(s) * (1.f / 1024.f) + EPS);
#pragma unroll
    for (int j = 0; j < 4; ++j) { const int c = 4 * (lane + 64 * j); const f32x4 gv = *(const f32x4*)(g + c), sv = *(const f32x4*)(sh + c), cv = *(const f32x4*)(sc + c);
        const f32x4 o = v[j] * rstd * gv * (cv + 1.0f) + sv; *(unsigned*)(orow + c) = pk_fp8q(o.x, o.y, o.z, o.w); }
}
DI const float* mod_row(const Frame& F, int l, int row) { const int r = row < LAT ? row / 4096 : 8; return WSP(float, WS_MOD) + ((size_t)l * 9 + r) * 6144; }
DI void init_norm_phase(const Frame& F) {
    const int gw = F.bid * NWAVES + F.wave, NGW = F.G * NWAVES;
    auto rowptr = [&](int row) -> const float* { return row < LAT ? INP(0) + (size_t)row * 1024 : INP(2) + (size_t)(row - LAT) * 1024; };
    f32x4 vn[4];
    if (gw < R) { const float* x0 = rowptr(gw);
#pragma unroll
        for (int j = 0; j < 4; ++j) vn[j] = *(const f32x4*)(x0 + 4 * (F.lane + 64 * j)); }
    for (int row = gw; row < R; row += NGW) {
        f32x4 v[4];
#pragma unroll
        for (int j = 0; j < 4; ++j) v[j] = vn[j];
        if (row + NGW < R) { const float* x1 = rowptr(row + NGW);
#pragma unroll
            for (int j = 0; j < 4; ++j) vn[j] = *(const f32x4*)(x1 + 4 * (F.lane + 64 * j)); }
        const float* m = mod_row(F, 0, row);
        norm_mod_store(v, INP(6), m, m + 1024, WSP(unsigned char, WS_HB) + (size_t)row * 1024, F.lane);
    }
}
namespace g8 {
constexpr int BM = 256, BK = 64, HALF = 128, HTB = HALF * BK * 2, STAGE_BYTES = 8 * HTB;
DI int lds_byte(int r, int c) { const int st = (r >> 4) * 2 + (c >> 5), rr = r & 15, cc = c & 31, ob = rr * 64 + cc * 2; return st * 1024 + (ob ^ (((ob >> 9) & 1) << 5)); }
DI void stage_rc(int b, int& Rr, int& Cc) { const int st = b / 1024, sb = b % 1024, swz = sb ^ (((sb >> 9) & 1) << 5); Rr = (st >> 1) * 16 + swz / 64; Cc = (st & 1) * 32 + (swz % 64) / 2; }
DI int perm32(int rho) { const int n = rho >> 4, i = rho & 15; return 8 * (i >> 2) + 4 * n + (i & 3); }

typedef int i32x4 __attribute__((ext_vector_type(4)));
typedef int i32x8 __attribute__((ext_vector_type(8)));
struct Unit { int pm, pn, aux, kt0, nt; const char* Bp; };

template <class Epi, class Sched>
DI void gemm_phase(const int tid, LAS unsigned char* lds, const char* Abase, int K, const Sched& S, const Epi& E) {
    asm volatile("" : "+s"(K));
    const int wid = __builtin_amdgcn_readfirstlane(tid >> 6), lane = tid & 63, wr = wid >> 2, wc = wid & 3, fr = lane & 15, fq = lane >> 4;
    int Rr[2], Cc[2]; unsigned voffB[2];
#pragma unroll
    for (int i = 0; i < 2; ++i) { int r_, c_; stage_rc(tid * 16 + i * 8192, r_, c_); Rr[i] = r_; Cc[i] = c_; const int Rb = Epi::PERM ? ((r_ & ~31) + perm32(r_ & 31)) : r_; voffB[i] = (unsigned)(Rb * K + c_) * 2u; }
    const size_t hstepB = (size_t)HALF * K * 2;
    const unsigned ldsw = (unsigned)wid * 1024u;
    const int aoff = lds_byte(wr * 64 + fr, fq * 8), boff = lds_byte(wc * 32 + fr, fq * 8);
#define G8_SA(b, h) (((b) * 2 + (h)) * HTB)
#define G8_SB(b, h) ((4 + (b) * 2 + (h)) * HTB)
#define G8_STAGE_A(bufoff, ao2, kt) do { _Pragma("unroll") for (int _i = 0; _i < 2; ++_i) \
        __builtin_amdgcn_global_load_lds((const unsigned*)(Abase + (size_t)(ao2)[_i] + (size_t)(kt) * 128), (LAS unsigned*)(lds + (bufoff) + ldsw + _i * 8192), 16, 0, 0); } while (0)
#define G8_STAGE_B(bufoff, bp, h, kt) do { _Pragma("unroll") for (int _i = 0; _i < 2; ++_i) \
        __builtin_amdgcn_global_load_lds((const unsigned*)((bp) + (size_t)(h) * hstepB + voffB[_i] + (size_t)(kt) * 128), (LAS unsigned*)(lds + (bufoff) + ldsw + _i * 8192), 16, 0, 0); } while (0)
#define G8_LD16(off) (*(const LAS i32x4*)(lds + (off)))
#define G8_LDA(dst, b, h) do { _Pragma("unroll") for (int m = 0; m < 4; ++m) { const i32x4 lo_ = G8_LD16(G8_SA(b, h) + aoff + m * 2048), hi_ = G8_LD16(G8_SA(b, h) + aoff + m * 2048 + 1024); dst[m] = __builtin_shufflevector(lo_, hi_, 0, 1, 2, 3, 4, 5, 6, 7); } } while (0)
#define G8_LDB(dst, b, h) do { _Pragma("unroll") for (int n = 0; n < 2; ++n) { const i32x4 lo_ = G8_LD16(G8_SB(b, h) + boff + n * 2048), hi_ = G8_LD16(G8_SB(b, h) + boff + n * 2048 + 1024); dst[n] = __builtin_shufflevector(lo_, hi_, 0, 1, 2, 3, 4, 5, 6, 7); } } while (0)
#define G8_HALF(v, k) __builtin_bit_cast(bf16x8, __builtin_shufflevector((v), (v), 4 * (k), 4 * (k) + 1, 4 * (k) + 2, 4 * (k) + 3))
#define G8_MMA(ai, bj, At, Bt) do { __builtin_amdgcn_s_setprio(1); _Pragma("unroll") for (int m = 0; m < 4; ++m) _Pragma("unroll") for (int n = 0; n < 2; ++n) { \
        if constexpr (Epi::FP8) asm volatile("v_mfma_scale_f32_16x16x128_f8f6f4 %0, %1, %2, %0, %3, %3 op_sel_hi:[0,0,0]" : "+v"(acc[ai][bj][m][n]) : "v"(Bt[n]), "v"(At[m]), "v"(fp8_scale)); \
        else { acc[ai][bj][m][n] = __builtin_amdgcn_mfma_f32_16x16x32_bf16(G8_HALF(Bt[n], 0), G8_HALF(At[m], 0), acc[ai][bj][m][n], 0, 0, 0); \
               acc[ai][bj][m][n] = __builtin_amdgcn_mfma_f32_16x16x32_bf16(G8_HALF(Bt[n], 1), G8_HALF(At[m], 1), acc[ai][bj][m][n], 0, 0, 0); } } __builtin_amdgcn_s_setprio(0); } while (0)
#define G8_WAIT_V(n) asm volatile("s_waitcnt vmcnt(" #n ")" ::: "memory")
#define G8_WAIT_L(n) asm volatile("s_waitcnt lgkmcnt(" #n ")" ::: "memory")
#define G8_BAR __builtin_amdgcn_s_barrier()
#define G8_SCHED __builtin_amdgcn_sched_barrier(0)
    const int fp8_scale = 0x7F7F7F7F;
    Unit cur, nxt; int ui = 0;
    if (!S.next(0, cur)) return;
    unsigned aoc[2][2], aon[2][2];
    S.aoffs(cur, Rr, Cc, aoc);
    f32x4 acc[2][2][4][2];
#pragma unroll
    for (int a = 0; a < 2; ++a)
#pragma unroll
        for (int b = 0; b < 2; ++b)
#pragma unroll
            for (int m = 0; m < 4; ++m)
#pragma unroll
                for (int n = 0; n < 2; ++n) acc[a][b][m][n] = (f32x4){0.f, 0.f, 0.f, 0.f};
    i32x8 At[4], B0[2], B1[2];
    const char* cB = cur.Bp;
    G8_STAGE_B(G8_SB(0, 0), cB, 0, 0); G8_STAGE_B(G8_SB(0, 1), cB, 1, 0); G8_STAGE_A(G8_SA(0, 0), aoc[0], 0); G8_STAGE_A(G8_SA(0, 1), aoc[1], 0);
    if (wr == 1) G8_BAR;
    G8_WAIT_V(2); G8_BAR;
    G8_STAGE_B(G8_SB(1, 0), cB, 0, 1); G8_STAGE_A(G8_SA(1, 0), aoc[0], 1); G8_STAGE_B(G8_SB(1, 1), cB, 1, 1);
    G8_WAIT_V(6); G8_BAR;
    for (;;) {
        const bool has_next = S.next(ui + 1, nxt);
        if (has_next) S.aoffs(nxt, Rr, Cc, aon);
        else {
#pragma unroll
            for (int h = 0; h < 2; ++h)
#pragma unroll
                for (int i = 0; i < 2; ++i) aon[h][i] = aoc[h][i]; }
        const char* nB = has_next ? nxt.Bp : cB;
        const int nt = cur.nt;
        for (int t = 0; t < nt; t += 2) {
            const bool last = (t == nt - 2);
            unsigned a2[2][2];
#pragma unroll
            for (int h = 0; h < 2; ++h)
#pragma unroll
                for (int i = 0; i < 2; ++i) a2[h][i] = last ? aon[h][i] : aoc[h][i];
            const int kt2 = last ? 0 : t + 2; const char* b2 = last ? nB : cB;
            G8_LDB(B0, 0, 0); G8_LDB(B1, 0, 1); G8_SCHED; G8_LDA(At, 0, 0); G8_STAGE_A(G8_SA(1, 1), aoc[1], t + 1);
            G8_WAIT_V(8); G8_WAIT_L(0); G8_BAR; G8_MMA(0, 0, At, B0); G8_MMA(0, 1, At, B1); G8_BAR; G8_SCHED;
            G8_LDA(At, 0, 1); G8_STAGE_B(G8_SB(0, 0), b2, 0, kt2); G8_STAGE_B(G8_SB(0, 1), b2, 1, kt2); G8_STAGE_A(G8_SA(0, 0), a2[0], kt2);
            G8_WAIT_V(8); G8_WAIT_L(0); G8_BAR; G8_MMA(1, 0, At, B0); G8_MMA(1, 1, At, B1); G8_BAR; G8_SCHED;
            G8_LDB(B0, 1, 0); G8_LDB(B1, 1, 1); G8_SCHED; G8_LDA(At, 1, 0); G8_STAGE_A(G8_SA(0, 1), a2[1], kt2);
            G8_WAIT_V(8); G8_WAIT_L(0); G8_BAR; G8_MMA(0, 0, At, B0); G8_MMA(0, 1, At, B1); G8_BAR; G8_SCHED;
            G8_LDA(At, 1, 1); G8_STAGE_B(G8_SB(1, 0), b2, 0, kt2 + 1); G8_STAGE_B(G8_SB(1, 1), b2, 1, kt2 + 1); G8_STAGE_A(G8_SA(1, 0), a2[0], kt2 + 1);
            G8_WAIT_V(8); G8_WAIT_L(0); G8_BAR; G8_MMA(1, 0, At, B0); G8_MMA(1, 1, At, B1); G8_BAR; G8_SCHED;
        }
        if (wr == 0) G8_BAR;
        if constexpr (Epi::FP8) asm volatile("s_nop 15\n\ts_nop 15" ::: "memory");
        E(acc, cur, wr, wc, fr, fq);
        if (!has_next) break;
#pragma unroll
        for (int a = 0; a < 2; ++a)
#pragma unroll
            for (int b = 0; b < 2; ++b)
#pragma unroll
                for (int m = 0; m < 4; ++m)
#pragma unroll
                    for (int n = 0; n < 2; ++n) acc[a][b][m][n] = (f32x4){0.f, 0.f, 0.f, 0.f};
        cur = nxt; cB = nB;
#pragma unroll
        for (int h = 0; h < 2; ++h)
#pragma unroll
            for (int i = 0; i < 2; ++i) aoc[h][i] = aon[h][i];
        ++ui;
        if (wr == 1) G8_BAR;
    }
    G8_WAIT_V(0);
    G8_BAR;
#undef G8_SA
#undef G8_SB
#undef G8_STAGE_A
#undef G8_STAGE_B
#undef G8_LDA
#undef G8_LDB
#undef G8_MMA
#undef G8_HALF
#undef G8_LD16
#undef G8_WAIT_V
#undef G8_WAIT_L
#undef G8_BAR
#undef G8_SCHED
}

struct DenseSched {
    int nM, nN, nwg, G, c, K; const char* Bt; bool split3;
    DI void init(int nM_, int nN_, int G_, int c_, int K_, const void* Bt_, bool split3_ = false) { nM = nM_; nN = nN_; nwg = nM * nN; G = G_; c = c_; K = K_; Bt = (const char*)Bt_; split3 = split3_; }
    DI bool next(int i, Unit& u) const {
        const long L = (long)i * G + c; if (L >= nwg) return false;
        int wgid = (int)L; { const int q = nwg / 8, r = nwg % 8, xcd = wgid % 8, off = wgid / 8; wgid = (xcd < r ? xcd * (q + 1) : r * (q + 1) + (xcd - r) * q) + off; }
        const int WGM = 8, nig = WGM * nN, gid = wgid / nig, fm = gid * WGM, gsz = (nM - fm) < WGM ? (nM - fm) : WGM;
        u.pm = fm + ((wgid % nig) % gsz); u.pn = (wgid % nig) / gsz; u.aux = 0; u.kt0 = 0; u.nt = K / 64;
        if (split3) { if (u.pn < 3) { u.nt = 4; } else { u.kt0 = 3; u.nt = 2; } }
        u.Bp = Bt + (size_t)u.pn * 256 * K * 2 + u.kt0 * 128; return true;
    }
    DI void aoffs(const Unit& u, const int (&Rr)[2], const int (&Cc)[2], unsigned (&ao)[2][2]) const {
#pragma unroll
        for (int h = 0; h < 2; ++h)
#pragma unroll
            for (int i = 0; i < 2; ++i) ao[h][i] = (unsigned)(((size_t)(u.pm * 256 + h * 128 + Rr[i]) * K + Cc[i]) * 2 + u.kt0 * 128);
    }
};
template <bool GATHER>
struct MoeSched {
    int nN, tiles_per_e, nwg, G, c, K, NBt; const char* Bt; size_t estride; const int* gidx; bool with_ctx;
    DI void init(int nN_, bool with_ctx_, int G_, int c_, int K_, const void* Bt_, size_t estride_, const int* gidx_) {
        nN = nN_; with_ctx = with_ctx_; tiles_per_e = NB * 2 + (with_ctx_ ? 1 : 0); nwg = 16 * tiles_per_e * nN; G = G_; c = c_; K = K_; Bt = (const char*)Bt_; estride = estride_; gidx = gidx_; }
    DI bool next(int i, Unit& u) const {
        int mt;
        if (G % (8 * nN) == 0) {
            const int per = (G / 8) / nN, xcd = c & 7, j8 = c >> 3; mt = (i * 8 + xcd) * per + j8 / nN; u.pn = j8 % nN; if (mt >= 16 * tiles_per_e) return false;
        } else { const long L = (long)i * G + c; if (L >= nwg) return false; mt = (int)L / nN; u.pn = (int)L % nN; }
        const int e = mt / tiles_per_e, j = mt % tiles_per_e;
        const int rowbase = j < NB * 2 ? ((j >> 1) * 16 + e) * 512 + (j & 1) * 256 : MOE_LAT + e * 256;
        u.pm = rowbase / 256; u.aux = e; u.kt0 = 0; u.nt = K / 64; u.Bp = Bt + (size_t)e * estride + (size_t)u.pn * 256 * K * 2; return true;
    }
    DI void aoffs(const Unit& u, const int (&Rr)[2], const int (&Cc)[2], unsigned (&ao)[2][2]) const {
#pragma unroll
        for (int h = 0; h < 2; ++h)
#pragma unroll
            for (int i = 0; i < 2; ++i) { const int mrow = u.pm * 256 + h * 128 + Rr[i]; const int arow = GATHER ? gidx[mrow] : mrow; ao[h][i] = (unsigned)(((size_t)arow * K + Cc[i]) * 2); }
    }
};
}

typedef f32x4 Acc[2][2][4][2];
DI unsigned pk_fp8x4(float a, float b, float c, float d) { int w = __builtin_amdgcn_cvt_pk_fp8_f32(a, b, 0, false); w = __builtin_amdgcn_cvt_pk_fp8_f32(c, d, w, true); return (unsigned)w; }
DI unsigned pk_fp8v(const f32x4 v) { return pk_fp8x4(v.x, v.y, v.z, v.w); }
DI void st_bf16x4(bf16_t* p, const f32x4 v) { u32x2 w; w.x = cvt_pk(v.x, v.y); w.y = cvt_pk(v.z, v.w); *(u32x2*)p = w; }

DI void st_vt4(unsigned char* tile, int d0, int pos, const f32x4 v) { const unsigned w = pk_fp8v(v); unsigned char* p = tile + d0 * 64 + pos;
    p[0] = (unsigned char)w; p[64] = (unsigned char)(w >> 8); p[128] = (unsigned char)(w >> 16); p[192] = (unsigned char)(w >> 24); }
DI size_t vt_tile_of_rowgroup(int row64  ) {
    return row64 < LAT ? (size_t)(row64 / 4096) * 68 + 4 + (row64 % 4096) / 64 : (size_t)((row64 - LAT) / 256) * 68 + ((row64 - LAT) % 256) / 64; }
struct EpiInProj {
    static constexpr bool PERM = false, FP8 = true;
    unsigned char* ws; const LAS unsigned long long* in; int l; const LAS f32x2* tab64; const LAS f32x2* tab32;
    DI void operator()(const Acc& acc, const g8::Unit& u, int wr, int wc, int fr, int fq) const {
        asm volatile("" : "+v"(fr), "+v"(fq));
        constexpr float SC = 1.0f / 64.0f;
        const int slot = 4 * u.pn + wc; const int rowt = u.pm * 256 + wr * 64 + fr; const bool lat = (u.pm * 256) < LAT;
        int kind; bf16_t* dst; int ld, coff; const float* gain = nullptr; float qs = 1.f;
        if (slot < 6)       { kind = 0; dst = (bf16_t*)(ws + Z_QA); ld = 384; coff = slot * 64; gain = inp(in, 9) + l * 64; qs = QF64; }
        else if (slot < 8)  { kind = 0; dst = (bf16_t*)(ws + Z_KA); ld = 128; coff = (slot - 6) * 64; gain = inp(in, 10) + l * 64; }
        else if (slot < 10) { kind = 1; dst = (bf16_t*)(ws + Z_VA); ld = 128; coff = (slot - 8) * 64; }
        else if (slot < 15) { kind = 2; dst = (bf16_t*)(ws + Z_CRAW); ld = 384; coff = (slot - 10) * 64; }
        else if (slot < 19) { kind = 0; dst = (bf16_t*)(ws + Z_QC); ld = 256; coff = (slot - 15) * 64; gain = inp(in, 19) + l * 64; qs = QF64; }
        else if (slot < 21) { kind = 0; dst = (bf16_t*)(ws + Z_KC); ld = 128; coff = (slot - 19) * 64; gain = inp(in, 20) + l * 64; }
        else if (slot < 23) { kind = 1; dst = (bf16_t*)(ws + Z_VC); ld = 128; coff = (slot - 21) * 64; }
        else                { kind = 3; dst = (bf16_t*)(ws + Z_KB); ld = 576; coff = 64; gain = inp(in, 18) + l * 32; }
        if (kind == 0) {
            f32x4 g[2][2];
#pragma unroll
            for (int bj = 0; bj < 2; ++bj)
#pragma unroll
                for (int n = 0; n < 2; ++n) g[bj][n] = *(const f32x4*)(gain + 32 * bj + 16 * n + 4 * fq) * qs;
#pragma unroll
            for (int ai = 0; ai < 2; ++ai)
#pragma unroll
                for (int m = 0; m < 4; ++m) {
                    const int row = rowt + ai * 128 + m * 16; float s = 0.f;
#pragma unroll
                    for (int bj = 0; bj < 2; ++bj)
#pragma unroll
                        for (int n = 0; n < 2; ++n) { const f32x4 x = acc[ai][bj][m][n] * SC; s += (x.x * x.x + x.y * x.y) + (x.z * x.z + x.w * x.w); }
                    s = add_xor32(add_xor16(s));
                    const float rstd = SC / sqrtf(s * (1.f / 64.f) + EPS);
                    const int t = row & 4095, pr = t >> 6, pc = t & 63;
#pragma unroll
                    for (int bj = 0; bj < 2; ++bj) {
                        f32x4 x1 = acc[ai][bj][m][0] * rstd * g[bj][0], x2 = acc[ai][bj][m][1] * rstd * g[bj][1];
                        if (lat) { const LAS f32x2* tb = tab64 + (bj == 0 ? pr : pc) * 16 + 4 * fq; f32x4 o1, o2;
#pragma unroll
                            for (int i = 0; i < 4; ++i) { const f32x2 cs = tb[i]; o1[i] = x1[i] * cs.x - x2[i] * cs.y; o2[i] = x2[i] * cs.x + x1[i] * cs.y; }
                            x1 = o1; x2 = o2; }
                        unsigned char* p = (unsigned char*)dst + (size_t)row * ld + coff + 32 * bj + 4 * fq;
                        *(unsigned*)p = pk_fp8v(x1); *(unsigned*)(p + 16) = pk_fp8v(x2);
                    }
                    asm volatile("" ::: "memory");
                }
        } else if (kind == 1 || kind == 2) {
#pragma unroll
            for (int ai = 0; ai < 2; ++ai)
#pragma unroll
                for (int m = 0; m < 4; ++m) {
                    const int row = rowt + ai * 128 + m * 16; float s = 0.f;
#pragma unroll
                    for (int bj = 0; bj < 2; ++bj)
#pragma unroll
                        for (int n = 0; n < 2; ++n) { const f32x4 x = acc[ai][bj][m][n] * SC; s += (x.x * x.x + x.y * x.y) + (x.z * x.z + x.w * x.w);
                            if (kind == 2) st_bf16x4(dst + (size_t)row * ld + coff + 32 * bj + 16 * n + 4 * fq, x);
                            else { const int row64 = u.pm * 256 + ai * 128 + wr * 64;
                                const size_t bt = vt_tile_of_rowgroup(row64); unsigned char* tile = (unsigned char*)dst + ((bt / 68) * 2 + coff / 64) * VT_HEAD + (bt % 68) * VT_TILE;
                                st_vt4(tile, 32 * bj + 16 * n + 4 * fq, vt_pos(16 * m + fr), x); } }
                    if (kind == 2) { s = add_xor32(add_xor16(s)); if (fq == 0) ((float*)(ws + WS_SSQ))[(size_t)row * 8 + (slot - 10)] = s; }
                }
        } else {
            const f32x4 g0 = *(const f32x4*)(gain + 4 * fq), g1 = *(const f32x4*)(gain + 16 + 4 * fq);
            bf16_t* craw = (bf16_t*)(ws + Z_CRAW);
#pragma unroll
            for (int ai = 0; ai < 2; ++ai)
#pragma unroll
                for (int m = 0; m < 4; ++m) {
                    const int row = rowt + ai * 128 + m * 16;
                    const f32x4 a0 = acc[ai][0][m][0] * SC, a1 = acc[ai][0][m][1] * SC;
                    float s = (a0.x * a0.x + a0.y * a0.y) + (a0.z * a0.z + a0.w * a0.w) + (a1.x * a1.x + a1.y * a1.y) + (a1.z * a1.z + a1.w * a1.w);
                    s = add_xor32(add_xor16(s));
                    const float rstd = 1.0f / sqrtf(s * (1.f / 32.f) + EPS);
                    f32x4 v0 = a0 * rstd * g0, v1 = a1 * rstd * g1;
                    if (lat) { const int t = row & 4095, pr = t >> 6, pc = t & 63;
                        f32x4 p0, p1;
#pragma unroll
                        for (int i = 0; i < 4; ++i) { p0[i] = other32(v0[i], fq >= 2); p1[i] = other32(v1[i], fq >= 2); }
                        const LAS f32x2* t0 = tab32 + pr * 8 + 4 * (fq & 1); const LAS f32x2* t1 = tab32 + pc * 8 + 4 * (fq & 1);
#pragma unroll
                        for (int i = 0; i < 4; ++i) { const f32x2 c0 = t0[i], c1 = t1[i];
                            v0[i] = fq < 2 ? v0[i] * c0.x - p0[i] * c0.y : v0[i] * c0.x + p0[i] * c0.y;
                            v1[i] = fq < 2 ? v1[i] * c1.x - p1[i] * c1.y : v1[i] * c1.x + p1[i] * c1.y; } }
                    const unsigned w0 = pk_fp8v(v0), w1 = pk_fp8v(v1);
#pragma unroll
                    for (int h = 0; h < 6; ++h) { unsigned char* p = (unsigned char*)dst + (size_t)row * 768 + h * 128 + 64 + 4 * fq; *(unsigned*)p = w0; *(unsigned*)(p + 16) = w1; *(unsigned*)(p + 32) = 0u; *(unsigned*)(p + 48) = 0u; }
                    const u32x2 z = {0u, 0u};
#pragma unroll
                    for (int q = 0; q < 4; ++q) *(u32x2*)(craw + (size_t)row * 384 + 320 + 16 * q + 4 * fq) = z;
                    asm volatile("" ::: "memory");
                }
        }
    }
};

struct EpiUpProj {
    static constexpr bool PERM = false, FP8 = false;
    unsigned char* ws; const LAS unsigned long long* in; int l; const LAS f32x2* tab32;
    DI void operator()(const Acc& acc, const g8::Unit& u, int wr, int wc, int fr, int fq) const {
        asm volatile("" : "+v"(fr), "+v"(fq));
        const int slot = 4 * u.pn + wc; if (slot >= 9 && slot < 12) return;
        const int rowt = u.pm * 256 + wr * 64 + fr; const bool lat = (u.pm * 256) < LAT;
        const float* ssq = (const float*)(ws + WS_SSQ);
        bf16_t* qB = (bf16_t*)(ws + Z_QB); bf16_t* kB = (bf16_t*)(ws + Z_KB); bf16_t* vB = (bf16_t*)(ws + Z_VB);
        const bool isq = slot < 9;
#pragma unroll
        for (int ai = 0; ai < 2; ++ai)
#pragma unroll
            for (int m = 0; m < 4; ++m) {
                const int row = rowt + ai * 128 + m * 16;
                const f32x4 sa = *(const f32x4*)(ssq + (size_t)row * 8); const float sb = ssq[(size_t)row * 8 + 4];
                const float r0 = isq ? 1.0f / sqrtf((sa.x + sa.y + sa.z) * (1.f / 192.f) + EPS) : 1.0f / sqrtf((sa.w + sb) * (1.f / 128.f) + EPS);
                if (slot < 6 || (slot >= 12 && slot < 18)) {
                    const float* gain = slot < 6 ? inp(in, 15) + l * 64 : inp(in, 16) + l * 64; const float qs = slot < 6 ? QF96 : 1.f;
                    const int h = slot < 6 ? slot : slot - 12; unsigned char* dst = (unsigned char*)(slot < 6 ? qB : kB) + (size_t)row * 768 + h * 128;
                    float s = 0.f; f32x4 x[2][2];
#pragma unroll
                    for (int bj = 0; bj < 2; ++bj)
#pragma unroll
                        for (int n = 0; n < 2; ++n) { x[bj][n] = acc[ai][bj][m][n] * r0; s += (x[bj][n].x * x[bj][n].x + x[bj][n].y * x[bj][n].y) + (x[bj][n].z * x[bj][n].z + x[bj][n].w * x[bj][n].w); }
                    s = add_xor32(add_xor16(s));
                    const float rstd = qs / sqrtf(s * (1.f / 64.f) + EPS);
#pragma unroll
                    for (int bj = 0; bj < 2; ++bj)
#pragma unroll
                        for (int n = 0; n < 2; ++n) { const int c = 32 * bj + 16 * n + 4 * fq; *(unsigned*)(dst + c) = pk_fp8v(x[bj][n] * rstd * *(const f32x4*)(gain + c)); }
                } else if (slot >= 18) {
                    const int row64 = u.pm * 256 + ai * 128 + wr * 64; const size_t bt = vt_tile_of_rowgroup(row64);
                    unsigned char* tile = (unsigned char*)vB + ((bt / 68) * 6 + (slot - 18)) * VT_HEAD + (bt % 68) * VT_TILE;
#pragma unroll
                    for (int bj = 0; bj < 2; ++bj)
#pragma unroll
                        for (int n = 0; n < 2; ++n) st_vt4(tile, 32 * bj + 16 * n + 4 * fq, vt_pos(16 * m + fr), acc[ai][bj][m][n] * r0);
                } else {
                    const float* gain = inp(in, 17) + l * 32;
#pragma unroll
                    for (int bj = 0; bj < 2; ++bj) {
                        const f32x4 a0 = acc[ai][bj][m][0] * r0, a1 = acc[ai][bj][m][1] * r0;
                        float s = (a0.x * a0.x + a0.y * a0.y) + (a0.z * a0.z + a0.w * a0.w) + (a1.x * a1.x + a1.y * a1.y) + (a1.z * a1.z + a1.w * a1.w);
                        s = add_xor32(add_xor16(s));
                        const float rstd = QF96 / sqrtf(s * (1.f / 32.f) + EPS);
                        f32x4 v0 = a0 * rstd * *(const f32x4*)(gain + 4 * fq), v1 = a1 * rstd * *(const f32x4*)(gain + 16 + 4 * fq);
                        if (lat) { const int t = row & 4095, pr = t >> 6, pc = t & 63; f32x4 p0, p1;
#pragma unroll
                            for (int i = 0; i < 4; ++i) { p0[i] = other32(v0[i], fq >= 2); p1[i] = other32(v1[i], fq >= 2); }
                            const LAS f32x2* t0 = tab32 + pr * 8 + 4 * (fq & 1); const LAS f32x2* t1 = tab32 + pc * 8 + 4 * (fq & 1);
#pragma unroll
                            for (int i = 0; i < 4; ++i) { const f32x2 c0 = t0[i], c1 = t1[i];
                                v0[i] = fq < 2 ? v0[i] * c0.x - p0[i] * c0.y : v0[i] * c0.x + p0[i] * c0.y;
                                v1[i] = fq < 2 ? v1[i] * c1.x - p1[i] * c1.y : v1[i] * c1.x + p1[i] * c1.y; } }
                        unsigned char* p = (unsigned char*)qB + (size_t)row * 768 + (2 * (slot - 6) + bj) * 128 + 64 + 4 * fq;
                        *(unsigned*)p = pk_fp8v(v0); *(unsigned*)(p + 16) = pk_fp8v(v1); *(unsigned*)(p + 32) = 0u; *(unsigned*)(p + 48) = 0u;
                    }
                }
                asm volatile("" ::: "memory");
            }
    }
};

struct EpiOutProj {
    static constexpr bool PERM = false, FP8 = false;
    unsigned char* ws; const float* xin; const float* cin; float* out; int l;
    DI void operator()(const Acc& acc, const g8::Unit& u, int wr, int wc, int fr, int fq) const {
        asm volatile("" : "+v"(fr), "+v"(fq));
        const int rowt = u.pm * 256 + wr * 64 + fr; const bool lat = (u.pm * 256) < LAT;
        const float* mod = (const float*)(ws + WS_MOD) + ((size_t)l * 9 + (lat ? (u.pm * 256) / 4096 : 8)) * 6144 + 2048;
        const int col0 = u.pn * 256 + wc * 32 + 4 * fq;
        f32x4 gv[2][2];
#pragma unroll
        for (int bj = 0; bj < 2; ++bj)
#pragma unroll
            for (int n = 0; n < 2; ++n) gv[bj][n] = *(const f32x4*)(mod + col0 + 128 * bj + 16 * n);
#pragma unroll
        for (int ai = 0; ai < 2; ++ai)
#pragma unroll
            for (int m = 0; m < 4; ++m) {
                const int row = rowt + ai * 128 + m * 16;
                const float* src = lat ? xin + (size_t)row * 1024 : cin + (size_t)(row - LAT) * 1024;
                float* dst = lat ? out + (size_t)row * 1024 : (float*)(ws + WS_CTXF) + (size_t)(row - LAT) * 1024;
#pragma unroll
                for (int bj = 0; bj < 2; ++bj)
#pragma unroll
                    for (int n = 0; n < 2; ++n) { const int c = col0 + 128 * bj + 16 * n; *(f32x4*)(dst + c) = *(const f32x4*)(src + c) + gv[bj][n] * acc[ai][bj][m][n]; }
            }
    }
};

constexpr int WSH = 6, HSH = 3;
struct EpiMoe1 {
    static constexpr bool PERM = true, FP8 = true;
    unsigned char* ws;
    DI void operator()(const Acc& acc, const g8::Unit& u, int wr, int wc, int fr, int fq) const {
        asm volatile("" : "+v"(fr), "+v"(fq));
        unsigned char* hid = ws + Z_HID; constexpr float SC = 1.0f / (float)(1 << WSH), HS = (float)(1 << HSH);
#pragma unroll
        for (int ai = 0; ai < 2; ++ai)
#pragma unroll
            for (int m = 0; m < 4; ++m) {
                const int row = u.pm * 256 + ai * 128 + wr * 64 + m * 16 + fr;
                f32x4 h0, h1;
#pragma unroll
                for (int i = 0; i < 4; ++i) { h0[i] = silu_f(acc[ai][0][m][0][i] * SC) * (acc[ai][1][m][0][i] * (SC * HS)); h1[i] = silu_f(acc[ai][0][m][1][i] * SC) * (acc[ai][1][m][1][i] * (SC * HS)); }
                u32x2 w; w.x = pk_fp8x4(h0.x, h0.y, h0.z, h0.w); w.y = pk_fp8x4(h1.x, h1.y, h1.z, h1.w);
                *(u32x2*)(hid + (size_t)row * 1024 + u.pn * 128 + wc * 32 + 8 * fq) = w;
            }
    }
};
struct EpiMoe2 {
    static constexpr bool PERM = true, FP8 = true;
    unsigned char* ws;
    DI void operator()(const Acc& acc, const g8::Unit& u, int wr, int wc, int fr, int fq) const {
        asm volatile("" : "+v"(fr), "+v"(fq));
        bf16_t* ye = (bf16_t*)(ws + Z_YE); const float* gate = (const float*)(ws + WS_GATE); constexpr float SC = 1.0f / (float)(1 << (WSH + HSH));
#pragma unroll
        for (int ai = 0; ai < 2; ++ai)
#pragma unroll
            for (int m = 0; m < 4; ++m) {
                const int row = u.pm * 256 + ai * 128 + wr * 64 + m * 16 + fr; const float gv = gate[row] * SC;
#pragma unroll
                for (int bj = 0; bj < 2; ++bj) { const f32x4 a = acc[ai][bj][m][0] * gv, b = acc[ai][bj][m][1] * gv; u32x4 w;
                    w.x = cvt_pk(a.x, a.y); w.y = cvt_pk(a.z, a.w); w.z = cvt_pk(b.x, b.y); w.w = cvt_pk(b.z, b.w);
                    *(u32x4*)(ye + (size_t)row * 1024 + u.pn * 256 + bj * 128 + wc * 32 + 8 * fq) = w; }
            }
    }
};
DI int crow(int i, int hh) { return (i & 3) + 8 * (i >> 2) + 4 * hh; }
typedef short v4i16_t __attribute__((ext_vector_type(4)));
DI s16x4 vtr(const LAS unsigned char* p) { return __builtin_bit_cast(s16x4, __builtin_amdgcn_ds_read_tr16_b64_v4i16((LAS v4i16_t*)p)); }
#define MFMA32(a, b, c) __builtin_amdgcn_mfma_f32_32x32x16_bf16((a), (b), (c), 0, 0, 0)

struct AttnDesc { const unsigned char* Q; int ldq, qoff; const unsigned char* K; int ldk, koff; const unsigned char* Vt; bf16_t* O; int ooff; float sink2; };
DI float fmax3(float a, float b, float c) { return __builtin_fmaxf(__builtin_fmaxf(a, b), c); }
typedef int i32x4 __attribute__((ext_vector_type(4)));
typedef int i32x8 __attribute__((ext_vector_type(8)));
#define MFMA8Z(acc, a, b, sa, sb) asm volatile("v_mfma_scale_f32_32x32x64_f8f6f4 %0, %1, %2, 0, %3, %4 op_sel_hi:[0,0,0]" : "=&v"(acc) : "v"(a), "v"(b), "v"(sa), "v"(sb))
#define MFMA8(acc, a, b, sa, sb) asm volatile("v_mfma_scale_f32_32x32x64_f8f6f4 %0, %1, %2, %0, %3, %4 op_sel_hi:[0,0,0]" : "+v"(acc) : "v"(a), "v"(b), "v"(sa), "v"(sb))
template <int DQB  , int MODE, bool TRACK, int ABL = 0>
DI void attn_unit(const int tid, LAS unsigned char* lds, const AttnDesc& d, int b, int qb, bool has_sink) {
    constexpr int KSTR = DQB + 16, VSTR = 80, KBUF = 128 * KSTR, VTILE = 64 * VSTR, VBUF = 2 * VTILE, NS = DQB / 64, KCH = DQB / 16, KC1 = KCH + 1, VC1 = 5;
    const int lane = tid & 63, wid = __builtin_amdgcn_readfirstlane(tid >> 6), r = lane & 31, hh = lane >> 5;
    const int q0 = qb * 256;
    const int qrow = (MODE == 2 ? LAT + b * 256 : b * 4096) + q0 + wid * 32 + r;
    int lo = 0, ntl = 0;
    if (MODE == 0) { lo = 0; ntl = 64; }
    if (MODE == 1) { lo = q0 - 128 < 0 ? 0 : q0 - 128; const int hi = q0 + 384 > 4096 ? 4096 : q0 + 384; ntl = (hi - lo) / 64; }
    const int NSTEP = (4 + ntl) / 2;
    auto step_row = [&](int st) -> int { return st < 2 ? LAT + b * 256 + st * 128 : b * 4096 + lo + (st - 2) * 128; };
    auto step_T = [&](int st) -> int { return st < 2 ? 2 * st : 4 + lo / 64 + 2 * (st - 2); };
    i32x8 qf[NS];
#pragma unroll
    for (int s = 0; s < NS; ++s) { const unsigned char* qp = d.Q + (size_t)qrow * d.ldq + d.qoff + 64 * s + 32 * hh; const i32x4 lo4 = *(const i32x4*)qp, hi4 = *(const i32x4*)(qp + 16); qf[s] = __builtin_shufflevector(lo4, hi4, 0, 1, 2, 3, 4, 5, 6, 7); }
    const int sclK = 0x7F7F7F7F, sclQ = 0x7C7C7C7C;
    constexpr int NKC = 128 * KC1, NVC = 128 * VC1, NKI = (NKC + 511) / 512, NVI = (NVC + 511) / 512;
    auto dma_step = [&](int st, int buf) {
        const unsigned char* kb_ = d.K + (size_t)step_row(st) * d.ldk; const unsigned char* vb_ = d.Vt + (size_t)step_T(st) * VT_TILE;
#pragma unroll
        for (int i = 0; i < NKI; ++i) { if (i * 512 + wid * 64 < NKC) { const int c = i * 512 + tid, row = c / KC1, ch = c % KC1;
            __builtin_amdgcn_global_load_lds((const unsigned*)(kb_ + (unsigned)(row * d.ldk + d.koff + (ch < KCH ? ch : 0) * 16)), (LAS unsigned*)(lds + buf * KBUF + i * 8192 + wid * 1024), 16, 0, 0); } }
#pragma unroll
        for (int i = 0; i < NVI; ++i) { if (i * 512 + wid * 64 < NVC) { const int c = i * 512 + tid, row = c / VC1, ch = c % VC1;
            __builtin_amdgcn_global_load_lds((const unsigned*)(vb_ + (unsigned)(row * 64 + (ch < 4 ? ch : 0) * 16)), (LAS unsigned*)(lds + 2 * KBUF + buf * VBUF + i * 8192 + wid * 1024), 16, 0, 0); } } };
    constexpr float THR = 8.f, POFF = 6.f;
    static_assert(TRACK, "the fp8 P.V path needs the running row maximum");
    float m = 0.f, l = 0.f;
    if (has_sink) { m = d.sink2 - POFF; l = hh == 0 ? __builtin_amdgcn_exp2f(POFF) : 0.f; }
    f32x16 o0, o1, sc[4];
#pragma unroll
    for (int i = 0; i < 16; ++i) { o0[i] = 0.f; o1[i] = 0.f; }
    const int koffl = r * KSTR + hh * 32, voffl = r * VSTR + hh * 32, sclV = 0x7F7F7F7F;
    auto frag = [&](const LAS unsigned char* p) -> i32x8 { const i32x4 lo4 = *(const LAS i32x4*)p, hi4 = *(const LAS i32x4*)(p + 16); return __builtin_shufflevector(lo4, hi4, 0, 1, 2, 3, 4, 5, 6, 7); };
    __syncthreads();
    dma_step(0, 0); asm volatile("s_waitcnt vmcnt(0)" ::: "memory");
    __syncthreads();
    for (int st = 0; st < NSTEP; ++st) {
        const int buf = st & 1;
        if (st + 1 < NSTEP) dma_step(st + 1, buf ^ 1);
        { const LAS unsigned char* kb = lds + buf * KBUF + koffl; const float negm = -m;
#pragma unroll
          for (int j = 0; j < 4; ++j) {
#pragma unroll
              for (int i = 0; i < 16; ++i) sc[j][i] = negm; }
          asm volatile("s_nop 1" : "+v"(sc[0]), "+v"(sc[1]), "+v"(sc[2]), "+v"(sc[3]));
#pragma unroll
          for (int j = 0; j < 4; ++j) {
#pragma unroll
              for (int s = 0; s < NS; ++s) { const i32x8 x = frag(kb + (32 * j) * KSTR + s * 64); MFMA8(sc[j], x, qf[s], sclK, sclQ); } }
          asm volatile("s_nop 15\n\ts_nop 7" : "+v"(sc[0]), "+v"(sc[1]), "+v"(sc[2]), "+v"(sc[3])); }
        if (MODE == 1) { if (st >= 2) { const int kp0 = lo + (st - 2) * 128, qp = q0 + wid * 32 + r;
#pragma unroll
            for (int j = 0; j < 4; ++j)
#pragma unroll
                for (int i = 0; i < 16; ++i) { const int dk = kp0 + 32 * j + crow(i, hh) - qp; if (dk > 128 || dk < -128) sc[j][i] = -1e30f; } } }
        { float ma = fmax3(sc[0][0], sc[1][0], sc[2][0]), mb = fmax3(sc[3][0], sc[0][1], sc[1][1]);
#pragma unroll
          for (int i = 0; i < 16; ++i) { if (i >= 1) ma = fmax3(ma, sc[0][i], sc[1][i]); if (i >= 2) mb = fmax3(mb, sc[2][i], sc[3][i]); }
          mb = fmax3(mb, sc[2][1], sc[3][1]);
          float mx = __builtin_fmaxf(ma, mb);
          { auto rr = __builtin_amdgcn_permlane32_swap(__float_as_uint(mx), __float_as_uint(mx), false, false); mx = __builtin_fmaxf(__uint_as_float(rr[0]), __uint_as_float(rr[1])); }
          if (st == 0 && !has_sink) {
              const float dl = mx - POFF; m = dl;
#pragma unroll
              for (int j = 0; j < 4; ++j)
#pragma unroll
                  for (int i = 0; i < 16; ++i) sc[j][i] -= dl;
          } else if (__any(mx > THR)) {
              const float dl = __builtin_fmaxf(mx - POFF, 0.f), alpha = __builtin_amdgcn_exp2f(-dl);
              asm volatile("s_nop 15\n\ts_nop 7" : "+v"(o0), "+v"(o1));
              m += dl; l *= alpha;
#pragma unroll
              for (int i = 0; i < 16; ++i) { o0[i] *= alpha; o1[i] *= alpha; }
#pragma unroll
              for (int j = 0; j < 4; ++j)
#pragma unroll
                  for (int i = 0; i < 16; ++i) sc[j][i] -= dl; } }
        float ps0 = 0.f, ps1 = 0.f, ps2 = 0.f, ps3 = 0.f;
#pragma unroll
        for (int j = 0; j < 4; ++j)
#pragma unroll
            for (int i = 0; i < 16; i += 4) { sc[j][i] = __builtin_amdgcn_exp2f(sc[j][i]); sc[j][i + 1] = __builtin_amdgcn_exp2f(sc[j][i + 1]); sc[j][i + 2] = __builtin_amdgcn_exp2f(sc[j][i + 2]); sc[j][i + 3] = __builtin_amdgcn_exp2f(sc[j][i + 3]);
                ps0 += sc[j][i]; ps1 += sc[j][i + 1]; ps2 += sc[j][i + 2]; ps3 += sc[j][i + 3]; }
        l += (ps0 + ps1) + (ps2 + ps3);
        i32x8 pf[2];
#pragma unroll
        for (int t2 = 0; t2 < 2; ++t2) {
#pragma unroll
            for (int q4 = 0; q4 < 4; ++q4) { pf[t2][q4] = (int)pk_fp8x4(sc[2 * t2][4 * q4], sc[2 * t2][4 * q4 + 1], sc[2 * t2][4 * q4 + 2], sc[2 * t2][4 * q4 + 3]);
                                             pf[t2][4 + q4] = (int)pk_fp8x4(sc[2 * t2 + 1][4 * q4], sc[2 * t2 + 1][4 * q4 + 1], sc[2 * t2 + 1][4 * q4 + 2], sc[2 * t2 + 1][4 * q4 + 3]); } }
        asm volatile("s_nop 1" : "+v"(pf[0]), "+v"(pf[1]));
        { const LAS unsigned char* vb = lds + 2 * KBUF + buf * VBUF + voffl;
#pragma unroll
          for (int t2 = 0; t2 < 2; ++t2) { const i32x8 v0 = frag(vb + t2 * VTILE), v1 = frag(vb + t2 * VTILE + 32 * VSTR); MFMA8(o0, v0, pf[t2], sclV, sclV); MFMA8(o1, v1, pf[t2], sclV, sclV); } }
        asm volatile("s_waitcnt vmcnt(0) lgkmcnt(0)" ::: "memory"); __builtin_amdgcn_s_barrier(); asm volatile("" ::: "memory");
    }
    asm volatile("s_nop 15\n\ts_nop 15" : "+v"(o0), "+v"(o1));
    { auto rr = __builtin_amdgcn_permlane32_swap(__float_as_uint(l), __float_as_uint(l), false, false); l = __uint_as_float(rr[0]) + __uint_as_float(rr[1]); }
    const float inv = 1.0f / l;
    bf16_t* op = d.O + (size_t)qrow * 1024 + d.ooff + 4 * hh;
#pragma unroll
    for (int g4 = 0; g4 < 4; ++g4) {
        u32x2 w; w.x = cvt_pk(o0[4 * g4] * inv, o0[4 * g4 + 1] * inv); w.y = cvt_pk(o0[4 * g4 + 2] * inv, o0[4 * g4 + 3] * inv); *(u32x2*)(op + 8 * g4) = w;
        u32x2 x; x.x = cvt_pk(o1[4 * g4] * inv, o1[4 * g4 + 1] * inv); x.y = cvt_pk(o1[4 * g4 + 2] * inv, o1[4 * g4 + 3] * inv); *(u32x2*)(op + 32 + 8 * g4) = x;
    }
}

#ifndef TRACK_EN
#define TRACK_EN 1
#endif
DI void attn_phase(const Frame& F, int l, bool with_ctx, int rep = 0) {
    constexpr int NU_B = NB * 96, NU_A = NB * 96, NU_C = NB * 64, NU_X = NB * 16;
    const int NU = NU_B + NU_A + NU_C + (with_ctx ? NU_X : 0);
    unsigned* head = F.ctl + CW_QUEUE + 64 * (l + 2 * rep);
    volatile LAS int* slot = (volatile LAS int*)(F.lds + LDS_MISC + 16);
    const float* sinkp = INP(21) + l * 4;
    __syncthreads();
    if (F.tid == 0) slot[0] = (int)__hip_atomic_fetch_add(head, 1u, __ATOMIC_RELAXED, __HIP_MEMORY_SCOPE_AGENT);
    __syncthreads();
    for (int it = 0;; ++it) {
        int u = slot[it & 1]; if (u >= NU) break;
        int nxt_u = 0; if (F.tid == 0) nxt_u = (int)__hip_atomic_fetch_add(head, 1u, __ATOMIC_RELAXED, __HIP_MEMORY_SCOPE_AGENT);
        [&]() {
        GAS unsigned char* wsg = (GAS unsigned char*)F.ws; asm volatile("" : "+s"(wsg)); unsigned char* ws = (unsigned char*)wsg;
        int tidu = F.tid; asm volatile("" : "+v"(tidu));
        AttnDesc d;
        if (u < NU_B) { const int b = u / 96, h = (u % 96) / 16, qb = u % 16;
            d = AttnDesc{(const unsigned char*)(ws + Z_QB), 768, h * 128, (const unsigned char*)(ws + Z_KB), 768, h * 128, (const unsigned char*)(ws + Z_VB) + ((size_t)b * 6 + h) * VT_HEAD, (bf16_t*)(ws + Z_OB), 384 + h * 64, 0.f};
#ifdef ATT_ABL
            if (rep) { attn_unit<128, 0, true, ATT_ABL>(tidu, F.lds, d, b, qb, false); return; }
#endif
            attn_unit<128, 0, true>(tidu, F.lds, d, b, qb, false); return; }
        u -= NU_B;
        if (u < NU_A) { const int b = u / 96, h = (u % 96) / 16, qb = u % 16;
            d = AttnDesc{(const unsigned char*)(ws + Z_QA), 384, h * 64, (const unsigned char*)(ws + Z_KA), 128, (h / 3) * 64, (const unsigned char*)(ws + Z_VA) + ((size_t)b * 2 + h / 3) * VT_HEAD, (bf16_t*)(ws + Z_OB), h * 64, 0.f};
#ifdef ATT_ABL
            if (rep) { attn_unit<64, 0, true, ATT_ABL>(tidu, F.lds, d, b, qb, false); return; }
#endif
            attn_unit<64, 0, true>(tidu, F.lds, d, b, qb, false); return; }
        u -= NU_A;
        if (u < NU_C) { const int b = u / 64, h = (u % 64) / 16, qb = u % 16;
            d = AttnDesc{(const unsigned char*)(ws + Z_QC), 256, h * 64, (const unsigned char*)(ws + Z_KC), 128, (h / 2) * 64, (const unsigned char*)(ws + Z_VC) + ((size_t)b * 2 + h / 2) * VT_HEAD, (bf16_t*)(ws + Z_OB), 768 + h * 64, sinkp[h] * LOG2E};
            attn_unit<64, 1, true>(tidu, F.lds, d, b, qb, true); return; }
        u -= NU_C;
        { const int b = u / 16, hx = u % 16;
            if (hx < 6) { const int h = hx;
                d = AttnDesc{(const unsigned char*)(ws + Z_QA), 384, h * 64, (const unsigned char*)(ws + Z_KA), 128, (h / 3) * 64, (const unsigned char*)(ws + Z_VA) + ((size_t)b * 2 + h / 3) * VT_HEAD, (bf16_t*)(ws + Z_OB), h * 64, 0.f};
                attn_unit<64, 2, true>(tidu, F.lds, d, b, 0, false); }
            else if (hx < 12) { const int h = hx - 6;
                d = AttnDesc{(const unsigned char*)(ws + Z_QB), 768, h * 128, (const unsigned char*)(ws + Z_KB), 768, h * 128, (const unsigned char*)(ws + Z_VB) + ((size_t)b * 6 + h) * VT_HEAD, (bf16_t*)(ws + Z_OB), 384 + h * 64, 0.f};
                attn_unit<128, 2, true>(tidu, F.lds, d, b, 0, false); }
            else { const int h = hx - 12;
                d = AttnDesc{(const unsigned char*)(ws + Z_QC), 256, h * 64, (const unsigned char*)(ws + Z_KC), 128, (h / 2) * 64, (const unsigned char*)(ws + Z_VC) + ((size_t)b * 2 + h / 2) * VT_HEAD, (bf16_t*)(ws + Z_OB), 768 + h * 64, sinkp[h] * LOG2E};
                attn_unit<64, 2, true>(tidu, F.lds, d, b, 0, true); }
        }
        }();
        if (F.tid == 0) slot[(it & 1) ^ 1] = nxt_u;
        __syncthreads();
    }
}

DI void router_phase(const Frame& F, int l, bool with_ctx) {
    LAS float* wT = (LAS float*)F.lds;
    const float* wr = INP(23) + (size_t)l * 1024 * 16;
    for (int e = F.tid; e < 16 * 1024; e += NTHR) { const int k = e / 16, x = e % 16; wT[x * 1024 + k] = wr[e]; }
    __syncthreads();
    const int gw = F.bid * NWAVES + F.wave, NGW = F.G * NWAVES, NR = with_ctx ? R : LAT, lane = F.lane;
    const float* g = INP(7) + l * 1024;
    auto rowptr = [&](int row) -> const float* { return row < LAT ? F.out + (size_t)row * 1024 : WSP(float, WS_CTXF) + (size_t)(row - LAT) * 1024; };
    f32x4 vn[4];
    if (gw < NR) { const float* xr0 = rowptr(gw);
#pragma unroll
        for (int j = 0; j < 4; ++j) vn[j] = *(const f32x4*)(xr0 + 4 * (lane + 64 * j)); }
    for (int row = gw; row < NR; row += NGW) {
        const float* m = mod_row(F, l, row);
        f32x4 v[4]; float s = 0.f;
#pragma unroll
        for (int j = 0; j < 4; ++j) { v[j] = vn[j]; s += (v[j].x * v[j].x + v[j].y * v[j].y) + (v[j].z * v[j].z + v[j].w * v[j].w); }
        if (row + NGW < NR) { const float* xr1 = rowptr(row + NGW);
#pragma unroll
            for (int j = 0; j < 4; ++j) vn[j] = *(const f32x4*)(xr1 + 4 * (lane + 64 * j)); }
        const float rstd = 1.0f / sqrtf(wave_sum(s) * (1.f / 1024.f) + EPS);
        float lg[16];
#pragma unroll
        for (int e = 0; e < 16; ++e) lg[e] = 0.f;
        unsigned char* orow = WSP(unsigned char, WS_HB) + (size_t)row * 1024;
#pragma unroll
        for (int j = 0; j < 4; ++j) { const int c = 4 * (lane + 64 * j); const f32x4 gv = *(const f32x4*)(g + c), sv = *(const f32x4*)(m + 3072 + c), cv = *(const f32x4*)(m + 4096 + c);
            v[j] = v[j] * rstd * gv * (cv + 1.0f) + sv; *(unsigned*)(orow + c) = pk_fp8x4(v[j].x, v[j].y, v[j].z, v[j].w); }
        asm volatile("" ::: "memory");
#pragma unroll
        for (int e = 0; e < 16; ++e) {
#pragma unroll
            for (int j = 0; j < 4; ++j) { const f32x4 wv = *(const LAS f32x4*)(wT + e * 1024 + 4 * (lane + 64 * j)); lg[e] += (v[j].x * wv.x + v[j].y * wv.y) + (v[j].z * wv.z + v[j].w * wv.w); }
            if (e & 1) asm volatile("" ::: "memory"); }
#pragma unroll
        for (int e = 0; e < 16; ++e) lg[e] = wave_sum(lg[e]);
        float mx = lg[0];
#pragma unroll
        for (int e = 1; e < 16; ++e) mx = fmaxf(mx, lg[e]);
        float sum = 0.f;
#pragma unroll
        for (int e = 0; e < 16; ++e) { lg[e] = expf(lg[e] - mx); sum += lg[e]; }
        const float isum = 1.0f / sum;
        float mine = 0.f;
#pragma unroll
        for (int e = 0; e < 16; ++e) mine = (lane == e) ? lg[e] * isum : mine;
        if (lane < 16) {
            if (row < LAT) WSP(float, WS_AFFL)[((size_t)(row / 4096) * 16 + lane) * 4096 + (row & 4095)] = mine;
            else { const int rc = row - LAT; WSP(float, WS_AFFC)[((size_t)(rc / 256) * 16 + lane) * 256 + (rc & 255)] = mine; }
        }
    }
}

DI void topk_phase(const Frame& F, bool with_ctx) {
    LAS unsigned* hist = (LAS unsigned*)F.lds;
    LAS unsigned* sh = hist + 256;
    LAS unsigned* scan = hist + 512;
    const int NL = NB * 16 * (with_ctx ? 2 : 1), tid = F.tid;
    for (int li = F.bid; li < NL; li += F.G) {
        const bool isctx = li >= NB * 16; const int be = isctx ? li - NB * 16 : li, b = be / 16, e = be % 16;
        const int n = isctx ? 256 : 4096, cap = n / 8, per = isctx ? 1 : 8;
        const float* a = isctx ? WSP(float, WS_AFFC) + (size_t)be * 256 : WSP(float, WS_AFFL) + (size_t)be * 4096;
        unsigned key[8]; const bool act = tid * per < n;
#pragma unroll
        for (int j = 0; j < 8; ++j) key[j] = (act && j < per) ? __float_as_uint(a[tid * per + j]) : 0u;
        unsigned prefix = 0u, rem = (unsigned)cap;
        for (int pass = 0; pass < 4; ++pass) {
            const int shift = 24 - 8 * pass;
            __syncthreads();
            if (tid < 256) hist[tid] = 0u;
            __syncthreads();
#pragma unroll
            for (int j = 0; j < 8; ++j) if (act && j < per) { const unsigned k = key[j]; const bool match = pass == 0 ? true : ((k >> (shift + 8)) == (prefix >> (shift + 8))); if (match) __hip_atomic_fetch_add(&hist[(k >> shift) & 255u], 1u, __ATOMIC_RELAXED, __HIP_MEMORY_SCOPE_WORKGROUP); }
            __syncthreads();
            if (tid < 64) {
                const int b0 = 255 - 4 * tid; const unsigned c0 = hist[b0], c1 = hist[b0 - 1], c2 = hist[b0 - 2], c3 = hist[b0 - 3];
                unsigned incl = c0 + c1 + c2 + c3;
#pragma unroll
                for (int o = 1; o < 64; o <<= 1) { const unsigned v = shfl_up_u(incl, o, tid); if (tid >= o) incl += v; }
                unsigned cum = incl - (c0 + c1 + c2 + c3);
                if (cum < rem && incl >= rem) { int bin = b0; unsigned c = c0;
                    if (cum + c < rem) { cum += c; bin = b0 - 1; c = c1; if (cum + c < rem) { cum += c; bin = b0 - 2; c = c2; if (cum + c < rem) { cum += c; bin = b0 - 3; } } }
                    sh[0] = prefix | ((unsigned)bin << shift); sh[1] = rem - cum; }
            }
            __syncthreads();
            prefix = sh[0]; rem = sh[1];
        }
        unsigned cg = 0u, ce = 0u;
#pragma unroll
        for (int j = 0; j < 8; ++j) if (act && j < per) { cg += key[j] > prefix ? 1u : 0u; ce += key[j] == prefix ? 1u : 0u; }
        __syncthreads();
        scan[tid] = cg; scan[512 + tid] = ce;
        __syncthreads();
        unsigned gb, eb;
        {
            unsigned ig = cg, ie = ce; const int ln = tid & 63, wv = tid >> 6;
#pragma unroll
            for (int o = 1; o < 64; o <<= 1) { const unsigned vg = shfl_up_u(ig, o, ln), ve = shfl_up_u(ie, o, ln); if (ln >= o) { ig += vg; ie += ve; } }
            if (ln == 63) { scan[1024 + wv] = ig; scan[1040 + wv] = ie; }
            __syncthreads();
            unsigned og = 0u, oe = 0u;
#pragma unroll
            for (int w = 0; w < 8; ++w) { if (w < wv) { og += scan[1024 + w]; oe += scan[1040 + w]; } }
            gb = og + ig - cg; eb = oe + ie - ce;
        }
        const int rowb = isctx ? LAT + b * 256 : b * 4096;
        const int mbase = isctx ? MOE_LAT + e * 256 + b * 32 : (b * 16 + e) * 512;
        int* gidx = WSP(int, WS_GIDX); float* gate = WSP(float, WS_GATE); int* inv = WSP(int, WS_INV);
#pragma unroll
        for (int j = 0; j < 8; ++j) if (act && j < per) {
            const unsigned k = key[j]; const int t = tid * per + j; int slot = -1;
            if (k > prefix) { slot = (int)(gb + (eb < rem ? eb : rem)); ++gb; }
            else if (k == prefix) { if (eb < rem) slot = (int)(gb + eb); ++eb; }
            if (slot >= 0) { gidx[mbase + slot] = rowb + t; gate[mbase + slot] = __uint_as_float(k); }
            inv[(size_t)(rowb + t) * 16 + e] = slot >= 0 ? mbase + slot : -1;
        }
        if (isctx && NB < 8 && b == 0) { for (int i = NB * 32 + tid; i < 256; i += NTHR) { gidx[MOE_LAT + e * 256 + i] = LAT; gate[MOE_LAT + e * 256 + i] = 0.f; } }
    }
}

DI void combine_phase(const Frame& F, int l, bool with_ctx, int rep = 0) {
    const int gw = F.bid * NWAVES + F.wave, NGW = F.G * NWAVES, NR = with_ctx ? R : LAT, lane = F.lane;
    const bool last = (l == DEPTH - 1);
    const bf16_t* ye = WSP(bf16_t, Z_YE); const int* inv = WSP(int, WS_INV);
    auto rowptr = [&](int row) -> float* { return row < LAT ? F.out + (size_t)row * 1024 : WSP(float, WS_CTXF) + (size_t)(row - LAT) * 1024; };
    int slot_n = -1; f32x4 xn[4];
    if (gw < NR) { slot_n = lane < 16 ? inv[(size_t)gw * 16 + lane] : -1; const float* x0 = rowptr(gw);
#pragma unroll
        for (int j = 0; j < 4; ++j) xn[j] = *(const f32x4*)(x0 + 4 * (lane + 64 * j)); }
    for (int row = gw; row < NR; row += NGW) {
        float* xr = rowptr(row);
        const float* m = mod_row(F, l, row);
        const int myslot = slot_n; f32x4 xv[4];
#pragma unroll
        for (int j = 0; j < 4; ++j) xv[j] = xn[j];
        if (row + NGW < NR) { slot_n = lane < 16 ? inv[(size_t)(row + NGW) * 16 + lane] : -1; const float* x1 = rowptr(row + NGW);
#pragma unroll
            for (int j = 0; j < 4; ++j) xn[j] = *(const f32x4*)(x1 + 4 * (lane + 64 * j)); }
        f32x4 acc[4];
#pragma unroll
        for (int j = 0; j < 4; ++j) acc[j] = (f32x4){0.f, 0.f, 0.f, 0.f};
        unsigned mask = (unsigned)(__ballot(myslot >= 0) & 0xFFFFull);
        while (mask) {
            const int e0 = __builtin_ctz(mask); mask &= mask - 1; const bool two = mask != 0u; const int e1 = two ? __builtin_ctz(mask) : e0; if (two) mask &= mask - 1;
            const int s0 = __builtin_amdgcn_readlane(myslot, e0), s1 = __builtin_amdgcn_readlane(myslot, e1);
            const bf16_t* y0 = ye + (size_t)s0 * 1024; const bf16_t* y1 = ye + (size_t)s1 * 1024; const float w1 = two ? 1.f : 0.f;
            u32x2 a[4], c[4];
#pragma unroll
            for (int j = 0; j < 4; ++j) { a[j] = *(const u32x2*)(y0 + 4 * (lane + 64 * j)); c[j] = *(const u32x2*)(y1 + 4 * (lane + 64 * j)); }
#pragma unroll
            for (int j = 0; j < 4; ++j) { acc[j].x += bf_lo(a[j].x) + w1 * bf_lo(c[j].x); acc[j].y += bf_hi(a[j].x) + w1 * bf_hi(c[j].x); acc[j].z += bf_lo(a[j].y) + w1 * bf_lo(c[j].y); acc[j].w += bf_hi(a[j].y) + w1 * bf_hi(c[j].y); }
        }
        f32x4 v[4];
#pragma unroll
        for (int j = 0; j < 4; ++j) { const int c = 4 * (lane + 64 * j); v[j] = xv[j] + *(const f32x4*)(m + 5120 + c) * acc[j]; if (!rep) *(f32x4*)(xr + c) = v[j]; }
        if (!last) { const float* m2 = mod_row(F, l + 1, row); norm_mod_store(v, INP(6) + (l + 1) * 1024, m2, m2 + 1024, WSP(unsigned char, WS_HB) + (size_t)row * 1024, lane); }
    }
}
constexpr int NPHASE = 2 + 9 * DEPTH;
DI void load_tabs(const Frame& F) {
    const f32x2* t64 = WSP(f32x2, WS_TAB64); const f32x2* t32 = WSP(f32x2, WS_TAB32);
    LAS f32x2* l64 = (LAS f32x2*)(F.lds + LDS_TAB64); LAS f32x2* l32 = (LAS f32x2*)(F.lds + LDS_TAB32);
    for (int i = F.tid; i < 64 * 16; i += NTHR) l64[i] = t64[i];
    for (int i = F.tid; i < 64 * 8; i += NTHR) l32[i] = t32[i];
    __syncthreads();
}
#ifndef PH_EN
#define PH_EN(k) 1
#endif
DI void run_phase(const Frame& F, int ph, int rep = 0) {
    unsigned char* ws = F.ws;
    if (ph == 0) { if (PH_EN(100)) p0_phase(F); return; }
    if (ph == 1) { if (PH_EN(101)) init_norm_phase(F); return; }
    const int l = (ph - 2) / 9, s = (ph - 2) % 9; const bool last = (l == DEPTH - 1);
    switch (s) {
    case 0: if (PH_EN(0)) { load_tabs(F);
        g8::DenseSched S; S.init(MT, 6, F.G, F.bid, 512, ws + WS_WIN + (size_t)l * 1536 * 1024);
        EpiInProj E{ws, F.intab, l, (const LAS f32x2*)(F.lds + LDS_TAB64), (const LAS f32x2*)(F.lds + LDS_TAB32)};
        g8::gemm_phase(F.tid, F.lds, (const char*)(ws + WS_HB), 512, S, E); } break;
    case 1: if (PH_EN(1)) { load_tabs(F);
        g8::DenseSched S; S.init(MT, 6, F.G, F.bid, 384, ws + WS_WUP + (size_t)l * 1536 * 384 * 2, true);
        EpiUpProj E{ws, F.intab, l, (const LAS f32x2*)(F.lds + LDS_TAB32)};
        g8::gemm_phase(F.tid, F.lds, (const char*)(ws + Z_CRAW), 384, S, E); } break;
    case 2: if (PH_EN(2)) attn_phase(F, l, !last, rep); break;
    case 3: if (PH_EN(3)) { g8::DenseSched S; S.init(last ? LAT / 256 : MT, 4, F.G, F.bid, 1024, ws + WS_WOUT + (size_t)l * 1024 * 1024 * 2);
        EpiOutProj E{ws, l == 0 ? INP(0) : F.out, INP(2), F.out, l};
        g8::gemm_phase(F.tid, F.lds, (const char*)(ws + Z_OB), 1024, S, E); } break;
    case 4: if (PH_EN(4)) router_phase(F, l, !last); break;
    case 5: if (PH_EN(5)) topk_phase(F, !last); break;
    case 6: if (PH_EN(6)) { g8::MoeSched<true> S; S.init(8, !last, F.G, F.bid, 512, ws + WS_W1 + (size_t)l * 16 * 2048 * 1024, (size_t)2048 * 1024, (const int*)(ws + WS_GIDX));
        EpiMoe1 E{ws}; g8::gemm_phase(F.tid, F.lds, (const char*)(ws + WS_HB), 512, S, E); } break;
    case 7: if (PH_EN(7)) { g8::MoeSched<false> S; S.init(4, !last, F.G, F.bid, 512, ws + WS_W2 + (size_t)l * 16 * 1024 * 1024, (size_t)1024 * 1024, nullptr);
        EpiMoe2 E{ws}; g8::gemm_phase(F.tid, F.lds, (const char*)(ws + Z_HID), 512, S, E); } break;
    case 8: if (PH_EN(8)) combine_phase(F, l, !last, rep); break;
    }
}
__global__ void __launch_bounds__(NTHR, 2) mega_kernel(Args a) {
    extern __shared__ __attribute__((aligned(16))) unsigned char lds_raw[];
    Frame F; F.lds = (LAS unsigned char*)lds_raw; F.ws = a.ws; F.ctl = (unsigned*)(a.ws + WS_CTL);
    F.tid = threadIdx.x; F.lane = F.tid & 63; F.wave = __builtin_amdgcn_readfirstlane(F.tid >> 6); F.G = gridDim.x; F.bid = blockIdx.x; F.out = a.out;
    { LAS unsigned long long* tab = (LAS unsigned long long*)(F.lds + LDS_INTAB); if (F.tid < 27) tab[F.tid] = (unsigned long long)a.in[F.tid]; F.intab = tab; }
    volatile LAS unsigned* MISC = (volatile LAS unsigned*)(F.lds + LDS_MISC);
    if (F.tid < 64) MISC[F.tid] = 0u;
    __syncthreads();
    const bool multi = a.ph_hi - a.ph_lo > 1;
    XcdBarrier bar; bar.bar = F.ctl + CW_BAR + a.li * XCD_BAR_WORDS; bar.x = 0; bar.st = MISC;
    if (multi) bar = xcd_barrier_post(F.ctl + CW_BAR + a.li * XCD_BAR_WORDS, MISC);
    for (int ph = a.ph_lo; ph < a.ph_hi; ++ph) {
        {
            GAS unsigned char* w_ = (GAS unsigned char*)a.ws; GAS float* o_ = (GAS float*)a.out; unsigned l_ = (unsigned)(unsigned long long)F.lds, t_ = (unsigned)(unsigned long long)F.intab; int tid_ = threadIdx.x, g_ = gridDim.x, b_ = blockIdx.x;
            asm volatile("" : "+s"(w_), "+s"(o_), "+s"(l_), "+s"(t_), "+v"(tid_), "+s"(g_), "+s"(b_));
            F.ws = (unsigned char*)w_; F.out = (float*)o_; F.lds = (LAS unsigned char*)(unsigned long long)l_; F.intab = (const LAS unsigned long long*)(unsigned long long)t_; F.ctl = (unsigned*)(F.ws + WS_CTL);
            F.tid = tid_; F.lane = tid_ & 63; F.wave = __builtin_amdgcn_readfirstlane(tid_ >> 6); F.G = g_; F.bid = b_; }
        run_phase(F, ph, a.li);
#ifdef PROBE_I
        xcd_barrier(bar);
        if (F.bid == 0 && F.tid == 0) ((unsigned long long*)(F.ws + 49152))[ph + 1] = __builtin_amdgcn_s_memrealtime();
#else
        if (ph + 1 < a.ph_hi) xcd_barrier(bar);
#endif
    }
#ifdef PROBE_I
    {
        xcd_barrier(bar);
        const unsigned long long* ts = (const unsigned long long*)(F.ws + 49152);
        float ti = (float)(__hip_atomic_load(ts + PROBE_I + 1, __ATOMIC_RELAXED, __HIP_MEMORY_SCOPE_AGENT) - __hip_atomic_load(ts + PROBE_I, __ATOMIC_RELAXED, __HIP_MEMORY_SCOPE_AGENT)) * 0.01f;
        float tj = (float)(__hip_atomic_load(ts + PROBE_J + 1, __ATOMIC_RELAXED, __HIP_MEMORY_SCOPE_AGENT) - __hip_atomic_load(ts + PROBE_J, __ATOMIC_RELAXED, __HIP_MEMORY_SCOPE_AGENT)) * 0.01f;
        ti = exp2f(rintf(log2f(fmaxf(ti, 1.f)) * 14.2067f) / 14.2067f); tj = exp2f(rintf(log2f(fmaxf(tj, 1.f)) * 14.2067f) / 14.2067f);
        const float* xin = inp(F.intab, 0); const size_t n = (size_t)8 * 4096 * 1024;
        for (size_t i = (size_t)F.bid * NTHR + F.tid; i < n; i += (size_t)F.G * NTHR) F.out[i] = xin[i] + ti + (i == 0 ? 100.f * tj : 0.f);
    }
#endif
}
}

extern "C" void kernel_launch(void* const* d_in, const int* in_sizes, int n_in, void* d_out, int out_size, void* d_ws, size_t ws_size, hipStream_t stream) {
    static int grid = 0;
    if (grid == 0) {
        if (n_in != 27 || out_size != 8 * 4096 * 1024 || ws_size < fp::WS_END) { fprintf(stderr, "kernel_launch: unexpected problem (n_in %d, out %d, ws %zu < %zu)\n", n_in, out_size, ws_size, (size_t)fp::WS_END); grid = -1; return; }
        int dev = 0, cus = 0, per_cu = 0;
        if (hipGetDevice(&dev) != hipSuccess || hipDeviceGetAttribute(&cus, hipDeviceAttributeMultiprocessorCount, dev) != hipSuccess) { fprintf(stderr, "kernel_launch: device query failed\n"); grid = -1; return; }
        if (hipFuncSetAttribute((const void*)fp::mega_kernel, hipFuncAttributeMaxDynamicSharedMemorySize, fp::LDS_BYTES) != hipSuccess) { fprintf(stderr, "kernel_launch: hipFuncSetAttribute failed\n"); grid = -1; return; }
        if (hipOccupancyMaxActiveBlocksPerMultiprocessor(&per_cu, (const void*)fp::mega_kernel, fp::NTHR, fp::LDS_BYTES) != hipSuccess || per_cu < 1) fprintf(stderr, "kernel_launch: note: occupancy query reports %d workgroups per CU\n", per_cu);
        (void)hipGetLastError();
        grid = cus;
    }
    if (grid < 0) return;
    if (hipMemsetAsync((char*)d_ws + fp::WS_CTL, 0, fp::CTL_BYTES, stream) != hipSuccess) { fprintf(stderr, "kernel_launch: memset failed\n"); return; }
    fp::Args a{};
    for (int i = 0; i < 27; ++i) a.in[i] = (const float*)d_in[i];
    a.out = (float*)d_out; a.ws = (unsigned char*)d_ws; a.ph_lo = 0; a.ph_hi = fp::NPHASE;
#ifdef PROBE_SPLIT_LO
    a.ph_hi = PROBE_SPLIT_HI; a.li = 1; hipLaunchKernelGGL(fp::mega_kernel, dim3(grid), dim3(fp::NTHR), fp::LDS_BYTES, stream, a);
    a.ph_lo = PROBE_SPLIT_LO; a.ph_hi = fp::NPHASE; a.li = 0;
#endif
    hipLaunchKernelGGL(fp::mega_kernel, dim3(grid), dim3(fp::NTHR), fp::LDS_BYTES, stream, a);
}
```

```cpp
#include <hip/hip_runtime.h>
#include <stdint.h>
#include <stdio.h>
#include <math.h>
#include <type_traits>
constexpr int DEPTH = 2;
#define FAST_NB 8
namespace fp {
#define LAS __attribute__((address_space(3)))
#define GAS __attribute__((address_space(1)))
typedef unsigned short bf16_t;
typedef short bf16x8 __attribute__((ext_vector_type(8)));
typedef short s16x4 __attribute__((ext_vector_type(4)));
typedef float f32x4 __attribute__((ext_vector_type(4)));
typedef float f32x16 __attribute__((ext_vector_type(16)));
typedef unsigned u32x4 __attribute__((ext_vector_type(4)));
typedef unsigned u32x2 __attribute__((ext_vector_type(2)));
typedef float f32x2 __attribute__((ext_vector_type(2)));
#define DI __device__ __forceinline__

DI unsigned cvt_pk(float lo, float hi) { typedef float f2 __attribute__((ext_vector_type(2))); typedef __bf16 b2 __attribute__((ext_vector_type(2))); f2 v = {lo, hi}; b2 b = __builtin_convertvector(v, b2); return __builtin_bit_cast(unsigned, b); }
DI float bf_lo(unsigned w) { return __uint_as_float(w << 16); }
DI float bf_hi(unsigned w) { return __uint_as_float(w & 0xffff0000u); }
DI float silu_f(float v) { return v / (1.f + __expf(-v)); }
template <int M> DI float swz_xor(float v) { return __int_as_float(__builtin_amdgcn_ds_swizzle(__float_as_int(v), (M << 10) | 0x1F)); }
DI float add_xor16(float v) { return v + swz_xor<16>(v); }
DI float add_xor32(float v) { auto r = __builtin_amdgcn_permlane32_swap(__float_as_uint(v), __float_as_uint(v), false, false); return __uint_as_float(r[0]) + __uint_as_float(r[1]); }
DI float other32(float v, bool upper_half) { auto r = __builtin_amdgcn_permlane32_swap(__float_as_uint(v), __float_as_uint(v), false, false); return __uint_as_float(upper_half ? r[0] : r[1]); }
DI float wave_sum(float v) { v += swz_xor<1>(v); v += swz_xor<2>(v); v += swz_xor<4>(v); v += swz_xor<8>(v); v += swz_xor<16>(v); return add_xor32(v); }
DI unsigned shfl_up_u(unsigned v, int o, int lane) { return (unsigned)__builtin_amdgcn_ds_bpermute((lane - o) << 2, (int)v); }

constexpr int NB = FAST_NB;
constexpr int LAT = NB * 4096, CTXR = NB * 256, R = LAT + CTXR, MT = R / 256;
constexpr int MOE_LAT = NB * 16 * 512, MOE_ROWS = MOE_LAT + 16 * 256;
constexpr float EPS = 1e-6f, LOG2E = 1.4426950408889634f;
constexpr float QS64 = 0.125f * LOG2E, QS96 = 0.10206207261596575f * LOG2E;
constexpr float QF64 = QS64 * 8.f, QF96 = QS96 * 8.f;
constexpr int NWAVES = 8, NTHR = 512;

constexpr size_t al256(size_t x) { return (x + 255) & ~(size_t)255; }
constexpr size_t WS_CTL = 0, CTL_BYTES = 65536;
constexpr size_t WS_MOD = WS_CTL + CTL_BYTES;
constexpr size_t WS_TAB64 = WS_MOD + al256((size_t)2 * 9 * 6144 * 4);
constexpr size_t WS_TAB32 = WS_TAB64 + 8192;
constexpr size_t WS_WIN = WS_TAB32 + 4096;
constexpr size_t WS_WUP = WS_WIN + (size_t)2 * 1536 * 1024 * 2;
constexpr size_t WS_WOUT = WS_WUP + (size_t)2 * 1536 * 384 * 2;
constexpr size_t WS_W1 = WS_WOUT + (size_t)2 * 1024 * 1024 * 2;
constexpr size_t WS_W2 = WS_W1 + (size_t)2 * 16 * 2048 * 1024 * 2;
constexpr size_t WS_HB = WS_W2 + (size_t)2 * 16 * 1024 * 1024 * 2;
constexpr size_t WS_CTXF = WS_HB + (size_t)R * 1024 * 2;
constexpr size_t WS_SSQ = WS_CTXF + (size_t)CTXR * 1024 * 4;
constexpr size_t WS_AFFL = WS_SSQ + (size_t)R * 8 * 4;
constexpr size_t WS_AFFC = WS_AFFL + (size_t)NB * 16 * 4096 * 4;
constexpr size_t WS_GIDX = WS_AFFC + (size_t)NB * 16 * 256 * 4;
constexpr size_t WS_GATE = WS_GIDX + (size_t)MOE_ROWS * 4;
constexpr size_t WS_INV = WS_GATE + (size_t)MOE_ROWS * 4;
constexpr size_t WS_Z = al256(WS_INV + (size_t)R * 16 * 4);
constexpr size_t Z_QA = WS_Z, Z_KA = Z_QA + (size_t)R * 384 * 2, Z_VA = Z_KA + (size_t)R * 128 * 2, Z_QC = Z_VA + (size_t)R * 128 * 2, Z_KC = Z_QC + (size_t)R * 256 * 2,
                 Z_VC = Z_KC + (size_t)R * 128 * 2, Z_CRAW = Z_VC + (size_t)R * 128 * 2, Z_QB = Z_CRAW + (size_t)R * 384 * 2, Z_KB = Z_QB + (size_t)R * 576 * 2,
                 Z_VB = Z_KB + (size_t)R * 576 * 2, Z_OB = Z_VB + (size_t)R * 384 * 2, Z_END1 = Z_OB + (size_t)R * 1024 * 2;
constexpr size_t VT_TILE = 4096, VT_HEAD = 68 * VT_TILE;
constexpr size_t Z_HID = WS_Z, Z_YE = Z_HID + (size_t)MOE_ROWS * 1024 * 2, Z_END2 = Z_YE + (size_t)MOE_ROWS * 1024 * 2;
constexpr size_t WS_END = al256(Z_END1 > Z_END2 ? Z_END1 : Z_END2);
constexpr int CW_BAR = 1024;
constexpr int CW_QUEUE = 8192;

DI int vt_pos(int k) { return ((k & 4) << 3) | ((k & 32) >> 1) | ((k & 24) >> 1) | (k & 3); }
constexpr int RING_BYTES = 131072;
constexpr int LDS_TAB64 = RING_BYTES, LDS_TAB32 = LDS_TAB64 + 8192, LDS_MISC = LDS_TAB32 + 4096;
constexpr int LDS_INTAB = LDS_MISC + 256;
constexpr int LDS_BYTES = 147456;

#define XB_TMO      128
#define XB_XCNT(j)  (256  + 64 * (j))
#define XB_XSUB(j)  (1280 + 64 * (j))
#define XB_XGEN(j)  (2304 + 64 * (j))
#define XB_TOP      3328
#define XB_TOPGEN   3392
#define XCD_BAR_WORDS 3456
#define XB_SPIN_CAP (1u << 20)
DI unsigned xb_ld(unsigned* p)              { return __hip_atomic_load(p, __ATOMIC_RELAXED, __HIP_MEMORY_SCOPE_AGENT); }
DI unsigned xb_add(unsigned* p, unsigned v) { return __hip_atomic_fetch_add(p, v, __ATOMIC_RELAXED, __HIP_MEMORY_SCOPE_AGENT); }
DI unsigned xb_xcc_id() { return (unsigned)__builtin_amdgcn_s_getreg((3 << 11) | 20) & 0xFu; }
#define XB_SPIN(cond, bar) do { unsigned _sp = 0; while (cond) { __builtin_amdgcn_s_sleep(1); \
    if ((++_sp & 255u) == 0u) { if (xb_ld(&(bar)[XB_TMO])) break; if (_sp > XB_SPIN_CAP) { atomicAdd(&(bar)[XB_TMO], 1u); break; } } } } while (0)
struct XcdBarrier { unsigned* bar; unsigned x; volatile LAS unsigned* st; };
DI XcdBarrier xcd_barrier_post(unsigned* bar, volatile LAS unsigned* st) {
    XcdBarrier b; b.bar = bar; b.x = xb_xcc_id(); b.st = st;
    if (threadIdx.x == 0) (void)xb_add(&bar[XB_XCNT(b.x)], 1u);
    return b;
}
DI void xcd_barrier_complete(unsigned* bar, unsigned x, unsigned& nloc, unsigned& nx) {
    asm volatile("" : "+s"(x));
    const unsigned G = gridDim.x * gridDim.y * gridDim.z;
    unsigned sum, cnt, mine, sp = 0u;
    for (;;) {
        sum = 0u; cnt = 0u; mine = 0u;
#pragma unroll
        for (unsigned j = 0; j < 16; ++j) { const unsigned c = xb_ld(&bar[XB_XCNT(j)]); sum += c; cnt += (c > 0u) ? 1u : 0u; mine = (j == x) ? c : mine; }
        if (sum == G) break;
        __builtin_amdgcn_s_sleep(1);
        if ((++sp & 255u) == 0u) { if (xb_ld(&bar[XB_TMO])) break; if (sp > XB_SPIN_CAP) { atomicAdd(&bar[XB_TMO], 1u); break; } }
    }
    nloc = mine > 0u ? mine : 1u; nx = cnt > 0u ? cnt : 1u;
}
DI void xcd_barrier(const XcdBarrier& b) {
    asm volatile("s_waitcnt vmcnt(0)" ::: "memory");
    __syncthreads();
    if (threadIdx.x == 0) {
        unsigned* bar = b.bar; asm volatile("" : "+s"(bar));
        __builtin_amdgcn_s_waitcnt(0);
        unsigned nloc = b.st[0], nx = b.st[1];
        if (nloc == 0u) { xcd_barrier_complete(bar, b.x, nloc, nx); b.st[0] = nloc; b.st[1] = nx; }
        const unsigned old = xb_add(&bar[XB_XSUB(b.x)], 1u);
        const unsigned gen = old / nloc;
        if (old + 1u == (gen + 1u) * nloc) {
            __builtin_amdgcn_fence(__ATOMIC_RELEASE, "agent");
            asm volatile("s_waitcnt vmcnt(0)" ::: "memory");
            const unsigned og = xb_add(&bar[XB_TOP], 1u);
            const unsigned tg = og / nx;
            if (og + 1u == (tg + 1u) * nx) xb_add(&bar[XB_TOPGEN], 1u);
            else XB_SPIN(xb_ld(&bar[XB_TOPGEN]) == tg, bar);
            __builtin_amdgcn_fence(__ATOMIC_ACQUIRE, "agent");
            xb_add(&bar[XB_XGEN(b.x)], 1u);
            asm volatile("s_waitcnt vmcnt(0)" ::: "memory");
        } else {
            XB_SPIN(xb_ld(&bar[XB_XGEN(b.x)]) == gen, bar);
            __builtin_amdgcn_fence(__ATOMIC_ACQUIRE, "agent");
            asm volatile("s_waitcnt vmcnt(0)" ::: "memory");
        }
    }
    __syncthreads();
}

struct Args { const float* in[27]; float* out; unsigned char* ws; int ph_lo, ph_hi, li, pad; };
struct Frame {
    LAS unsigned char* lds; unsigned char* ws; unsigned* ctl;
    int tid, lane, wave, G, bid;
    const LAS unsigned long long* intab; float* out;
};
DI const float* inp(const LAS unsigned long long* tab, int k) { const unsigned long long v = tab[k]; const unsigned lo = __builtin_amdgcn_readfirstlane((unsigned)v), hi = __builtin_amdgcn_readfirstlane((unsigned)(v >> 32)); return (const float*)(const GAS float*)(((unsigned long long)hi << 32) | lo); }
#define INP(k) inp(F.intab, k)
#define WSP(T, off) ((T*)(F.ws + (off)))

DI void mod_item(const Frame& F, int item, const LAS float* s9, LAS float* red) {
    const int l = item / 96, c0 = (item % 96) * 64;
    const float* W = INP(4) + (size_t)l * 1024 * 6144 + c0;
    const int cg = F.lane & 15, ks = F.wave * 4 + (F.lane >> 4);
    f32x4 acc[9];
#pragma unroll
    for (int r = 0; r < 9; ++r) acc[r] = (f32x4){0.f, 0.f, 0.f, 0.f};
#pragma unroll 4
    for (int i = 0; i < 32; ++i) { const int k = ks + 32 * i; const f32x4 w = *(const f32x4*)(W + (size_t)k * 6144 + cg * 4);
#pragma unroll
        for (int r = 0; r < 9; ++r) acc[r] += w * s9[r * 1024 + k]; }
#pragma unroll
    for (int r = 0; r < 9; ++r)
#pragma unroll
        for (int j = 0; j < 4; ++j) { acc[r][j] = add_xor32(add_xor16(acc[r][j])); }
    __syncthreads();
    if (F.lane < 16) {
#pragma unroll
        for (int r = 0; r < 9; ++r) *(LAS f32x4*)(red + (F.wave * 9 + r) * 64 + cg * 4) = acc[r]; }
    __syncthreads();
    for (int e = F.tid; e < 9 * 64; e += NTHR) { const int r = e / 64, c = e % 64; float s = 0.f;
#pragma unroll
        for (int w = 0; w < 8; ++w) s += red[(w * 9 + r) * 64 + c];
        WSP(float, WS_MOD)[((size_t)l * 9 + r) * 6144 + c0 + c] = s + INP(5)[l * 6144 + c0 + c]; }
}

DI void cv_block(const float* src  , int ld, const float* ksc, bf16_t* drow  ) {
#pragma unroll
    for (int kc = 0; kc < 8; ++kc) {
        float v[8];
#pragma unroll
        for (int j = 0; j < 8; ++j) v[j] = src ? src[(size_t)(kc * 8 + j) * ld] : 0.f;
        if (ksc) {
#pragma unroll
            for (int j = 0; j < 8; ++j) v[j] *= ksc[kc * 8 + j]; }
        u32x4 o; o.x = cvt_pk(v[0], v[1]); o.y = cvt_pk(v[2], v[3]); o.z = cvt_pk(v[4], v[5]); o.w = cvt_pk(v[6], v[7]);
        *(u32x4*)(drow + kc * 8) = o;
    }
}
DI void cv_block_fp8(const float* src, int ld, unsigned char* drow) {
    float v[64];
#pragma unroll
    for (int j = 0; j < 64; ++j) v[j] = src[(size_t)j * ld];
#pragma unroll
    for (int kc = 0; kc < 4; ++kc) {
        u32x4 o;
        { int w = __builtin_amdgcn_cvt_pk_fp8_f32(v[16 * kc + 0] * 64.f, v[16 * kc + 1] * 64.f, 0, false); w = __builtin_amdgcn_cvt_pk_fp8_f32(v[16 * kc + 2] * 64.f, v[16 * kc + 3] * 64.f, w, true); o.x = (unsigned)w; }
        { int w = __builtin_amdgcn_cvt_pk_fp8_f32(v[16 * kc + 4] * 64.f, v[16 * kc + 5] * 64.f, 0, false); w = __builtin_amdgcn_cvt_pk_fp8_f32(v[16 * kc + 6] * 64.f, v[16 * kc + 7] * 64.f, w, true); o.y = (unsigned)w; }
        { int w = __builtin_amdgcn_cvt_pk_fp8_f32(v[16 * kc + 8] * 64.f, v[16 * kc + 9] * 64.f, 0, false); w = __builtin_amdgcn_cvt_pk_fp8_f32(v[16 * kc + 10] * 64.f, v[16 * kc + 11] * 64.f, w, true); o.z = (unsigned)w; }
        { int w = __builtin_amdgcn_cvt_pk_fp8_f32(v[16 * kc + 12] * 64.f, v[16 * kc + 13] * 64.f, 0, false); w = __builtin_amdgcn_cvt_pk_fp8_f32(v[16 * kc + 14] * 64.f, v[16 * kc + 15] * 64.f, w, true); o.w = (unsigned)w; }
        *(u32x4*)(drow + kc * 16) = o;
    }
}
constexpr int CV_WIN = 384, CV_WUP = 144, CV_WOUT = 256, CV_W1 = 8192, CV_W2 = 4096, CV_LAYER = CV_WIN + CV_WUP + CV_WOUT + CV_W1 + CV_W2;
DI void conv_item(const Frame& F, int it) {
    const int l = it / CV_LAYER; int r = it % CV_LAYER; const int lane = F.lane, hl = lane >> 5, ll = lane & 31;
    if (r < CV_WIN) {
        const int kb = r / 24, g = (r % 24) * 2 + hl, x = ((g >> 3) * 4 + (g & 3)) * 64 + 32 * ((g >> 2) & 1) + ll;
        const int sc = x < 960 ? x : (x < 1472 ? x + 32 : (x < 1504 ? x - 512 : -1));
        const float* src = sc < 0 ? nullptr : INP(8) + (size_t)l * 1024 * 1504 + (size_t)(kb * 64) * 1504 + sc;
        unsigned char* drow = WSP(unsigned char, WS_WIN) + (size_t)l * 1536 * 1024 + (size_t)((r % 24) * 64 + lane) * 1024 + kb * 64;
        if (__builtin_amdgcn_readfirstlane(sc < 0 ? 1 : 0) | __any(sc < 0)) { const float* s2 = sc < 0 ? INP(8) : src; cv_block_fp8(s2, sc < 0 ? 0 : 1504, drow);
            if (sc < 0) {
#pragma unroll
                for (int kc = 0; kc < 4; ++kc) *(u32x4*)(drow + kc * 16) = (u32x4){0u, 0u, 0u, 0u}; } }
        else cv_block_fp8(src, 1504, drow);
        return; }
    r -= CV_WIN;
    if (r < CV_WUP) {
        const int kb = r / 24, g = (r % 24) * 2 + hl, slot = (g >> 3) * 4 + (g & 3), half = (g >> 2) & 1;
        const float* src = nullptr; const float* ksc = nullptr; int ld = 0;
        if (slot < 9 && kb < 3) { const int col = slot < 6 ? slot * 96 + 32 * half : (2 * (slot - 6) + half) * 96 + 64;
            src = INP(13) + (size_t)l * 192 * 576 + (size_t)(kb * 64) * 576 + col + ll; ld = 576; ksc = INP(11) + l * 192 + kb * 64; }
        else if (slot >= 12 && (kb == 3 || kb == 4)) { const int h = slot < 18 ? slot - 12 : slot - 18; const int col = h * 128 + (slot < 18 ? 0 : 64) + 32 * half;
            src = INP(14) + (size_t)l * 128 * 768 + (size_t)((kb - 3) * 64) * 768 + col + ll; ld = 768; ksc = INP(12) + l * 128 + (kb - 3) * 64; }
        cv_block(src, ld, ksc, WSP(bf16_t, WS_WUP) + (size_t)l * 1536 * 384 + (size_t)((r % 24) * 64 + lane) * 384 + kb * 64); return; }
    r -= CV_WUP;
    if (r < CV_WOUT) { const int kb = r / 16, g = r % 16;
        cv_block(INP(22) + (size_t)l * 1024 * 1024 + (size_t)(kb * 64) * 1024 + g * 64 + lane, 1024, nullptr, WSP(bf16_t, WS_WOUT) + (size_t)l * 1024 * 1024 + (size_t)(g * 64 + lane) * 1024 + kb * 64); return; }
    r -= CV_WOUT;
    if (r < CV_W1) { const int e = r / 512, q = r % 512, kb = q / 32, g = (q % 32) * 2 + hl, pn = g >> 3, bj = (g >> 2) & 1, wc = g & 3;
        const float* src = (bj ? INP(25) : INP(24)) + ((size_t)l * 16 + e) * 1024 * 1024 + (size_t)(kb * 64) * 1024 + 128 * pn + 32 * wc + ll;
        cv_block_fp8(src, 1024, WSP(unsigned char, WS_W1) + ((size_t)l * 16 + e) * 2048 * 1024 + (size_t)((q % 32) * 64 + lane) * 1024 + kb * 64); return; }
    r -= CV_W1;
    { const int e = r / 256, q = r % 256, kb = q / 16, g = q % 16;
        cv_block_fp8(INP(26) + ((size_t)l * 16 + e) * 1024 * 1024 + (size_t)(kb * 64) * 1024 + g * 64 + lane, 1024, WSP(unsigned char, WS_W2) + ((size_t)l * 16 + e) * 1024 * 1024 + (size_t)(g * 64 + lane) * 1024 + kb * 64); }
}
DI void p0_phase(const Frame& F) {
    LAS float* s9 = (LAS float*)F.lds;
    LAS float* red = (LAS float*)(F.lds + 9 * 1024 * 4);
    if (F.bid == 0) {
        for (int i = F.tid; i < 64 * 16; i += NTHR) { const int pos = i / 16, f = i % 16; const float inv = exp2f(-(float)(2 * f) / 32.f * 13.287712379549449f); const float a = (float)pos * inv; WSP(f32x2, WS_TAB64)[i] = (f32x2){cosf(a), sinf(a)}; }
        for (int i = F.tid; i < 64 * 8; i += NTHR) { const int pos = i / 8, f = i % 8; const float inv = exp2f(-(float)(2 * f) / 16.f * 13.287712379549449f); const float a = (float)pos * inv; WSP(f32x2, WS_TAB32)[i] = (f32x2){cosf(a), sinf(a)}; }
    }
    bool have_s9 = false;
    for (int it = F.bid; it < 192; it += F.G) {
        if (!have_s9) { for (int e = F.tid; e < 9 * 1024; e += NTHR) { const int r = e / 1024, k = e % 1024; const float v = r < 8 ? INP(1)[r * 1024 + k] : INP(3)[k]; s9[e] = silu_f(v); } have_s9 = true; __syncthreads(); }
        mod_item(F, it, s9, red);
    }
    __syncthreads();
    const int gw = F.bid * NWAVES + F.wave, NGW = F.G * NWAVES;
    for (int it = gw; it < 2 * CV_LAYER; it += NGW) conv_item(F, it);
}

DI unsigned pk_fp8q(float a, float b, float c, float d) { int w = __builtin_amdgcn_cvt_pk_fp8_f32(a, b, 0, false); w = __builtin_amdgcn_cvt_pk_fp8_f32(c, d, w, true); return (unsigned)w; }
DI void norm_mod_store(const f32x4 (&v)[4], const float* g, const float* sh, const float* sc, unsigned char* orow  , int lane) {
    float s = 0.f;
#pragma unroll
    for (int j = 0; j < 4; ++j) s += (v[j].x * v[j].x + v[j].y * v[j].y) + (v[j].z * v[j].z + v[j].w * v[j].w);
    const float rstd = 1.0f / sqrtf(wave_sum(s) * (1.f / 1024.f) + EPS);
#pragma unroll
    for (int j = 0; j < 4; ++j) { const int c = 4 * (lane + 64 * j); const f32x4 gv = *(const f32x4*)(g + c), sv = *(const f32x4*)(sh + c), cv = *(const f32x4*)(sc + c);
        const f32x4 o = v[j] * rstd * gv * (cv + 1.0f) + sv; *(unsigned*)(orow + c) = pk_fp8q(o.x, o.y, o.z, o.w); }
}
DI const float* mod_row(const Frame& F, int l, int row) { const int r = row < LAT ? row / 4096 : 8; return WSP(float, WS_MOD) + ((size_t)l * 9 + r) * 6144; }
DI void init_norm_phase(const Frame& F) {
    const int gw = F.bid * NWAVES + F.wave, NGW = F.G * NWAVES;
    auto rowptr = [&](int row) -> const float* { return row < LAT ? INP(0) + (size_t)row * 1024 : INP(2) + (size_t)(row - LAT) * 1024; };
    f32x4 vn[4];
    if (gw < R) { const float* x0 = rowptr(gw);
#pragma unroll
        for (int j = 0; j < 4; ++j) vn[j] = *(const f32x4*)(x0 + 4 * (F.lane + 64 * j)); }
    for (int row = gw; row < R; row += NGW) {
        f32x4 v[4];
#pragma unroll
        for (int j = 0; j < 4; ++j) v[j] = vn[j];
        if (row + NGW < R) { const float* x1 = rowptr(row + NGW);
#pragma unroll
            for (int j = 0; j < 4; ++j) vn[j] = *(const f32x4*)(x1 + 4 * (F.lane + 64 * j)); }
        const float* m = mod_row(F, 0, row);
        norm_mod_store(v, INP(6), m, m + 1024, WSP(unsigned char, WS_HB) + (size_t)row * 1024, F.lane);
    }
}
namespace g8 {
constexpr int BM = 256, BK = 64, HALF = 128, HTB = HALF * BK * 2, STAGE_BYTES = 8 * HTB;
DI int lds_byte(int r, int c) { const int st = (r >> 4) * 2 + (c >> 5), rr = r & 15, cc = c & 31, ob = rr * 64 + cc * 2; return st * 1024 + (ob ^ (((ob >> 9) & 1) << 5)); }
DI void stage_rc(int b, int& Rr, int& Cc) { const int st = b / 1024, sb = b % 1024, swz = sb ^ (((sb >> 9) & 1) << 5); Rr = (st >> 1) * 16 + swz / 64; Cc = (st & 1) * 32 + (swz % 64) / 2; }
DI int perm32(int rho) { const int n = rho >> 4, i = rho & 15; return 8 * (i >> 2) + 4 * n + (i & 3); }

typedef int i32x4 __attribute__((ext_vector_type(4)));
typedef int i32x8 __attribute__((ext_vector_type(8)));
struct Unit { int pm, pn, aux, kt0, nt; const char* Bp; };

template <class Epi, class Sched>
DI void gemm_phase(const int tid, LAS unsigned char* lds, const char* Abase, int K, const Sched& S, const Epi& E) {
    asm volatile("" : "+s"(K));
    const int wid = __builtin_amdgcn_readfirstlane(tid >> 6), lane = tid & 63, wr = wid >> 2, wc = wid & 3, fr = lane & 15, fq = lane >> 4;
    int Rr[2], Cc[2]; unsigned voffB[2];
#pragma unroll
    for (int i = 0; i < 2; ++i) { int r_, c_; stage_rc(tid * 16 + i * 8192, r_, c_); Rr[i] = r_; Cc[i] = c_; const int Rb = Epi::PERM ? ((r_ & ~31) + perm32(r_ & 31)) : r_; voffB[i] = (unsigned)(Rb * K + c_) * 2u; }
    const size_t hstepB = (size_t)HALF * K * 2;
    const unsigned ldsw = (unsigned)wid * 1024u;
    const int aoff = lds_byte(wr * 64 + fr, fq * 8), boff = lds_byte(wc * 32 + fr, fq * 8);
#define G8_SA(b, h) (((b) * 2 + (h)) * HTB)
#define G8_SB(b, h) ((4 + (b) * 2 + (h)) * HTB)
#define G8_STAGE_A(bufoff, ao2, kt) do { _Pragma("unroll") for (int _i = 0; _i < 2; ++_i) \
        __builtin_amdgcn_global_load_lds((const unsigned*)(Abase + (size_t)(ao2)[_i] + (size_t)(kt) * 128), (LAS unsigned*)(lds + (bufoff) + ldsw + _i * 8192), 16, 0, 0); } while (0)
#define G8_STAGE_B(bufoff, bp, h, kt) do { _Pragma("unroll") for (int _i = 0; _i < 2; ++_i) \
        __builtin_amdgcn_global_load_lds((const unsigned*)((bp) + (size_t)(h) * hstepB + voffB[_i] + (size_t)(kt) * 128), (LAS unsigned*)(lds + (bufoff) + ldsw + _i * 8192), 16, 0, 0); } while (0)
#define G8_LD16(off) (*(const LAS i32x4*)(lds + (off)))
#define G8_LDA(dst, b, h) do { _Pragma("unroll") for (int m = 0; m < 4; ++m) { const i32x4 lo_ = G8_LD16(G8_SA(b, h) + aoff + m * 2048), hi_ = G8_LD16(G8_SA(b, h) + aoff + m * 2048 + 1024); dst[m] = __builtin_shufflevector(lo_, hi_, 0, 1, 2, 3, 4, 5, 6, 7); } } while (0)
#define G8_LDB(dst, b, h) do { _Pragma("unroll") for (int n = 0; n < 2; ++n) { const i32x4 lo_ = G8_LD16(G8_SB(b, h) + boff + n * 2048), hi_ = G8_LD16(G8_SB(b, h) + boff + n * 2048 + 1024); dst[n] = __builtin_shufflevector(lo_, hi_, 0, 1, 2, 3, 4, 5, 6, 7); } } while (0)
#define G8_HALF(v, k) __builtin_bit_cast(bf16x8, __builtin_shufflevector((v), (v), 4 * (k), 4 * (k) + 1, 4 * (k) + 2, 4 * (k) + 3))
#define G8_MMA(ai, bj, At, Bt) do { __builtin_amdgcn_s_setprio(1); _Pragma("unroll") for (int m = 0; m < 4; ++m) _Pragma("unroll") for (int n = 0; n < 2; ++n) { \
        if constexpr (Epi::FP8) asm volatile("v_mfma_scale_f32_16x16x128_f8f6f4 %0, %1, %2, %0, %3, %3 op_sel_hi:[0,0,0]" : "+v"(acc[ai][bj][m][n]) : "v"(Bt[n]), "v"(At[m]), "v"(fp8_scale)); \
        else { acc[ai][bj][m][n] = __builtin_amdgcn_mfma_f32_16x16x32_bf16(G8_HALF(Bt[n], 0), G8_HALF(At[m], 0), acc[ai][bj][m][n], 0, 0, 0); \
               acc[ai][bj][m][n] = __builtin_amdgcn_mfma_f32_16x16x32_bf16(G8_HALF(Bt[n], 1), G8_HALF(At[m], 1), acc[ai][bj][m][n], 0, 0, 0); } } __builtin_amdgcn_s_setprio(0); } while (0)
#define G8_WAIT_V(n) asm volatile("s_waitcnt vmcnt(" #n ")" ::: "memory")
#define G8_WAIT_L(n) asm volatile("s_waitcnt lgkmcnt(" #n ")" ::: "memory")
#define G8_BAR __builtin_amdgcn_s_barrier()
#define G8_SCHED __builtin_amdgcn_sched_barrier(0)
    const int fp8_scale = 0x7F7F7F7F;
    Unit cur, nxt; int ui = 0;
    if (!S.next(0, cur)) return;
    unsigned aoc[2][2], aon[2][2];
    S.aoffs(cur, Rr, Cc, aoc);
    f32x4 acc[2][2][4][2];
#pragma unroll
    for (int a = 0; a < 2; ++a)
#pragma unroll
        for (int b = 0; b < 2; ++b)
#pragma unroll
            for (int m = 0; m < 4; ++m)
#pragma unroll
                for (int n = 0; n < 2; ++n) acc[a][b][m][n] = (f32x4){0.f, 0.f, 0.f, 0.f};
    i32x8 At[4], B0[2], B1[2];
    const char* cB = cur.Bp;
    G8_STAGE_B(G8_SB(0, 0), cB, 0, 0); G8_STAGE_B(G8_SB(0, 1), cB, 1, 0); G8_STAGE_A(G8_SA(0, 0), aoc[0], 0); G8_STAGE_A(G8_SA(0, 1), aoc[1], 0);
    if (wr == 1) G8_BAR;
    G8_WAIT_V(2); G8_BAR;
    G8_STAGE_B(G8_SB(1, 0), cB, 0, 1); G8_STAGE_A(G8_SA(1, 0), aoc[0], 1); G8_STAGE_B(G8_SB(1, 1), cB, 1, 1);
    G8_WAIT_V(6); G8_BAR;
    for (;;) {
        const bool has_next = S.next(ui + 1, nxt);
        if (has_next) S.aoffs(nxt, Rr, Cc, aon);
        else {
#pragma unroll
            for (int h = 0; h < 2; ++h)
#pragma unroll
                for (int i = 0; i < 2; ++i) aon[h][i] = aoc[h][i]; }
        const char* nB = has_next ? nxt.Bp : cB;
        const int nt = cur.nt;
        for (int t = 0; t < nt; t += 2) {
            const bool last = (t == nt - 2);
            unsigned a2[2][2];
#pragma unroll
            for (int h = 0; h < 2; ++h)
#pragma unroll
                for (int i = 0; i < 2; ++i) a2[h][i] = last ? aon[h][i] : aoc[h][i];
            const int kt2 = last ? 0 : t + 2; const char* b2 = last ? nB : cB;
            G8_LDB(B0, 0, 0); G8_LDB(B1, 0, 1); G8_SCHED; G8_LDA(At, 0, 0); G8_STAGE_A(G8_SA(1, 1), aoc[1], t + 1);
            G8_WAIT_V(8); G8_WAIT_L(0); G8_BAR; G8_MMA(0, 0, At, B0); G8_MMA(0, 1, At, B1); G8_BAR; G8_SCHED;
            G8_LDA(At, 0, 1); G8_STAGE_B(G8_SB(0, 0), b2, 0, kt2); G8_STAGE_B(G8_SB(0, 1), b2, 1, kt2); G8_STAGE_A(G8_SA(0, 0), a2[0], kt2);
            G8_WAIT_V(8); G8_WAIT_L(0); G8_BAR; G8_MMA(1, 0, At, B0); G8_MMA(1, 1, At, B1); G8_BAR; G8_SCHED;
            G8_LDB(B0, 1, 0); G8_LDB(B1, 1, 1); G8_SCHED; G8_LDA(At, 1, 0); G8_STAGE_A(G8_SA(0, 1), a2[1], kt2);
            G8_WAIT_V(8); G8_WAIT_L(0); G8_BAR; G8_MMA(0, 0, At, B0); G8_MMA(0, 1, At, B1); G8_BAR; G8_SCHED;
            G8_LDA(At, 1, 1); G8_STAGE_B(G8_SB(1, 0), b2, 0, kt2 + 1); G8_STAGE_B(G8_SB(1, 1), b2, 1, kt2 + 1); G8_STAGE_A(G8_SA(1, 0), a2[0], kt2 + 1);
            G8_WAIT_V(8); G8_WAIT_L(0); G8_BAR; G8_MMA(1, 0, At, B0); G8_MMA(1, 1, At, B1); G8_BAR; G8_SCHED;
        }
        if (wr == 0) G8_BAR;
        if constexpr (Epi::FP8) asm volatile("s_nop 15\n\ts_nop 15" ::: "memory");
        E(acc, cur, wr, wc, fr, fq);
        if (!has_next) break;
#pragma unroll
        for (int a = 0; a < 2; ++a)
#pragma unroll
            for (int b = 0; b < 2; ++b)
#pragma unroll
                for (int m = 0; m < 4; ++m)
#pragma unroll
                    for (int n = 0; n < 2; ++n) acc[a][b][m][n] = (f32x4){0.f, 0.f, 0.f, 0.f};
        cur = nxt; cB = nB;
#pragma unroll
        for (int h = 0; h < 2; ++h)
#pragma unroll
            for (int i = 0; i < 2; ++i) aoc[h][i] = aon[h][i];
        ++ui;
        if (wr == 1) G8_BAR;
    }
    G8_WAIT_V(0);
    G8_BAR;
#undef G8_SA
#undef G8_SB
#undef G8_STAGE_A
#undef G8_STAGE_B
#undef G8_LDA
#undef G8_LDB
#undef G8_MMA
#undef G8_HALF
#undef G8_LD16
#undef G8_WAIT_V
#undef G8_WAIT_L
#undef G8_BAR
#undef G8_SCHED
}

struct DenseSched {
    int nM, nN, nwg, G, c, K; const char* Bt; bool split3;
    DI void init(int nM_, int nN_, int G_, int c_, int K_, const void* Bt_, bool split3_ = false) { nM = nM_; nN = nN_; nwg = nM * nN; G = G_; c = c_; K = K_; Bt = (const char*)Bt_; split3 = split3_; }
    DI bool next(int i, Unit& u) const {
        const long L = (long)i * G + c; if (L >= nwg) return false;
        int wgid = (int)L; { const int q = nwg / 8, r = nwg % 8, xcd = wgid % 8, off = wgid / 8; wgid = (xcd < r ? xcd * (q + 1) : r * (q + 1) + (xcd - r) * q) + off; }
        const int WGM = 8, nig = WGM * nN, gid = wgid / nig, fm = gid * WGM, gsz = (nM - fm) < WGM ? (nM - fm) : WGM;
        u.pm = fm + ((wgid % nig) % gsz); u.pn = (wgid % nig) / gsz; u.aux = 0; u.kt0 = 0; u.nt = K / 64;
        if (split3) { if (u.pn < 3) { u.nt = 4; } else { u.kt0 = 3; u.nt = 2; } }
        u.Bp = Bt + (size_t)u.pn * 256 * K * 2 + u.kt0 * 128; return true;
    }
    DI void aoffs(const Unit& u, const int (&Rr)[2], const int (&Cc)[2], unsigned (&ao)[2][2]) const {
#pragma unroll
        for (int h = 0; h < 2; ++h)
#pragma unroll
            for (int i = 0; i < 2; ++i) ao[h][i] = (unsigned)(((size_t)(u.pm * 256 + h * 128 + Rr[i]) * K + Cc[i]) * 2 + u.kt0 * 128);
    }
};
template <bool GATHER>
struct MoeSched {
    int nN, tiles_per_e, nwg, G, c, K, NBt; const char* Bt; size_t estride; const int* gidx; bool with_ctx;
    DI void init(int nN_, bool with_ctx_, int G_, int c_, int K_, const void* Bt_, size_t estride_, const int* gidx_) {
        nN = nN_; with_ctx = with_ctx_; tiles_per_e = NB * 2 + (with_ctx_ ? 1 : 0); nwg = 16 * tiles_per_e * nN; G = G_; c = c_; K = K_; Bt = (const char*)Bt_; estride = estride_; gidx = gidx_; }
    DI bool next(int i, Unit& u) const {
        int mt;
        if (G % (8 * nN) == 0) {
            const int per = (G / 8) / nN, xcd = c & 7, j8 = c >> 3; mt = (i * 8 + xcd) * per + j8 / nN; u.pn = j8 % nN; if (mt >= 16 * tiles_per_e) return false;
        } else { const long L = (long)i * G + c; if (L >= nwg) return false; mt = (int)L / nN; u.pn = (int)L % nN; }
        const int e = mt / tiles_per_e, j = mt % tiles_per_e;
        const int rowbase = j < NB * 2 ? ((j >> 1) * 16 + e) * 512 + (j & 1) * 256 : MOE_LAT + e * 256;
        u.pm = rowbase / 256; u.aux = e; u.kt0 = 0; u.nt = K / 64; u.Bp = Bt + (size_t)e * estride + (size_t)u.pn * 256 * K * 2; return true;
    }
    DI void aoffs(const Unit& u, const int (&Rr)[2], const int (&Cc)[2], unsigned (&ao)[2][2]) const {
#pragma unroll
        for (int h = 0; h < 2; ++h)
#pragma unroll
            for (int i = 0; i < 2; ++i) { const int mrow = u.pm * 256 + h * 128 + Rr[i]; const int arow = GATHER ? gidx[mrow] : mrow; ao[h][i] = (unsigned)(((size_t)arow * K + Cc[i]) * 2); }
    }
};
}

typedef f32x4 Acc[2][2][4][2];
DI unsigned pk_fp8x4(float a, float b, float c, float d) { int w = __builtin_amdgcn_cvt_pk_fp8_f32(a, b, 0, false); w = __builtin_amdgcn_cvt_pk_fp8_f32(c, d, w, true); return (unsigned)w; }
DI unsigned pk_fp8v(const f32x4 v) { return pk_fp8x4(v.x, v.y, v.z, v.w); }
DI void st_bf16x4(bf16_t* p, const f32x4 v) { u32x2 w; w.x = cvt_pk(v.x, v.y); w.y = cvt_pk(v.z, v.w); *(u32x2*)p = w; }

DI void st_vt4(unsigned char* tile, int d0, int pos, const f32x4 v) { const unsigned w = pk_fp8v(v); unsigned char* p = tile + d0 * 64 + pos;
    p[0] = (unsigned char)w; p[64] = (unsigned char)(w >> 8); p[128] = (unsigned char)(w >> 16); p[192] = (unsigned char)(w >> 24); }
DI size_t vt_tile_of_rowgroup(int row64  ) {
    return row64 < LAT ? (size_t)(row64 / 4096) * 68 + 4 + (row64 % 4096) / 64 : (size_t)((row64 - LAT) / 256) * 68 + ((row64 - LAT) % 256) / 64; }
struct EpiInProj {
    static constexpr bool PERM = false, FP8 = true;
    unsigned char* ws; const LAS unsigned long long* in; int l; const LAS f32x2* tab64; const LAS f32x2* tab32;
    DI void operator()(const Acc& acc, const g8::Unit& u, int wr, int wc, int fr, int fq) const {
        asm volatile("" : "+v"(fr), "+v"(fq));
        constexpr float SC = 1.0f / 64.0f;
        const int slot = 4 * u.pn + wc; const int rowt = u.pm * 256 + wr * 64 + fr; const bool lat = (u.pm * 256) < LAT;
        int kind; bf16_t* dst; int ld, coff; const float* gain = nullptr; float qs = 1.f;
        if (slot < 6)       { kind = 0; dst = (bf16_t*)(ws + Z_QA); ld = 384; coff = slot * 64; gain = inp(in, 9) + l * 64; qs = QF64; }
        else if (slot < 8)  { kind = 0; dst = (bf16_t*)(ws + Z_KA); ld = 128; coff = (slot - 6) * 64; gain = inp(in, 10) + l * 64; }
        else if (slot < 10) { kind = 1; dst = (bf16_t*)(ws + Z_VA); ld = 128; coff = (slot - 8) * 64; }
        else if (slot < 15) { kind = 2; dst = (bf16_t*)(ws + Z_CRAW); ld = 384; coff = (slot - 10) * 64; }
        else if (slot < 19) { kind = 0; dst = (bf16_t*)(ws + Z_QC); ld = 256; coff = (slot - 15) * 64; gain = inp(in, 19) + l * 64; qs = QF64; }
        else if (slot < 21) { kind = 0; dst = (bf16_t*)(ws + Z_KC); ld = 128; coff = (slot - 19) * 64; gain = inp(in, 20) + l * 64; }
        else if (slot < 23) { kind = 1; dst = (bf16_t*)(ws + Z_VC); ld = 128; coff = (slot - 21) * 64; }
        else                { kind = 3; dst = (bf16_t*)(ws + Z_KB); ld = 576; coff = 64; gain = inp(in, 18) + l * 32; }
        if (kind == 0) {
            f32x4 g[2][2];
#pragma unroll
            for (int bj = 0; bj < 2; ++bj)
#pragma unroll
                for (int n = 0; n < 2; ++n) g[bj][n] = *(const f32x4*)(gain + 32 * bj + 16 * n + 4 * fq) * qs;
#pragma unroll
            for (int ai = 0; ai < 2; ++ai)
#pragma unroll
                for (int m = 0; m < 4; ++m) {
                    const int row = rowt + ai * 128 + m * 16; float s = 0.f;
#pragma unroll
                    for (int bj = 0; bj < 2; ++bj)
#pragma unroll
                        for (int n = 0; n < 2; ++n) { const f32x4 x = acc[ai][bj][m][n] * SC; s += (x.x * x.x + x.y * x.y) + (x.z * x.z + x.w * x.w); }
                    s = add_xor32(add_xor16(s));
                    const float rstd = SC / sqrtf(s * (1.f / 64.f) + EPS);
                    const int t = row & 4095, pr = t >> 6, pc = t & 63;
#pragma unroll
                    for (int bj = 0; bj < 2; ++bj) {
                        f32x4 x1 = acc[ai][bj][m][0] * rstd * g[bj][0], x2 = acc[ai][bj][m][1] * rstd * g[bj][1];
                        if (lat) { const LAS f32x2* tb = tab64 + (bj == 0 ? pr : pc) * 16 + 4 * fq; f32x4 o1, o2;
#pragma unroll
                            for (int i = 0; i < 4; ++i) { const f32x2 cs = tb[i]; o1[i] = x1[i] * cs.x - x2[i] * cs.y; o2[i] = x2[i] * cs.x + x1[i] * cs.y; }
                            x1 = o1; x2 = o2; }
                        unsigned char* p = (unsigned char*)dst + (size_t)row * ld + coff + 32 * bj + 4 * fq;
                        *(unsigned*)p = pk_fp8v(x1); *(unsigned*)(p + 16) = pk_fp8v(x2);
                    }
                    asm volatile("" ::: "memory");
                }
        } else if (kind == 1 || kind == 2) {
#pragma unroll
            for (int ai = 0; ai < 2; ++ai)
#pragma unroll
                for (int m = 0; m < 4; ++m) {
                    const int row = rowt + ai * 128 + m * 16; float s = 0.f;
#pragma unroll
                    for (int bj = 0; bj < 2; ++bj)
#pragma unroll
                        for (int n = 0; n < 2; ++n) { const f32x4 x = acc[ai][bj][m][n] * SC; s += (x.x * x.x + x.y * x.y) + (x.z * x.z + x.w * x.w);
                            if (kind == 2) st_bf16x4(dst + (size_t)row * ld + coff + 32 * bj + 16 * n + 4 * fq, x);
                            else { const int row64 = u.pm * 256 + ai * 128 + wr * 64;
                                const size_t bt = vt_tile_of_rowgroup(row64); unsigned char* tile = (unsigned char*)dst + ((bt / 68) * 2 + coff / 64) * VT_HEAD + (bt % 68) * VT_TILE;
                                st_vt4(tile, 32 * bj + 16 * n + 4 * fq, vt_pos(16 * m + fr), x); } }
                    if (kind == 2) { s = add_xor32(add_xor16(s)); if (fq == 0) ((float*)(ws + WS_SSQ))[(size_t)row * 8 + (slot - 10)] = s; }
                }
        } else {
            const f32x4 g0 = *(const f32x4*)(gain + 4 * fq), g1 = *(const f32x4*)(gain + 16 + 4 * fq);
            bf16_t* craw = (bf16_t*)(ws + Z_CRAW);
#pragma unroll
            for (int ai = 0; ai < 2; ++ai)
#pragma unroll
                for (int m = 0; m < 4; ++m) {
                    const int row = rowt + ai * 128 + m * 16;
                    const f32x4 a0 = acc[ai][0][m][0] * SC, a1 = acc[ai][0][m][1] * SC;
                    float s = (a0.x * a0.x + a0.y * a0.y) + (a0.z * a0.z + a0.w * a0.w) + (a1.x * a1.x + a1.y * a1.y) + (a1.z * a1.z + a1.w * a1.w);
                    s = add_xor32(add_xor16(s));
                    const float rstd = 1.0f / sqrtf(s * (1.f / 32.f) + EPS);
                    f32x4 v0 = a0 * rstd * g0, v1 = a1 * rstd * g1;
                    if (lat) { const int t = row & 4095, pr = t >> 6, pc = t & 63;
                        f32x4 p0, p1;
#pragma unroll
                        for (int i = 0; i < 4; ++i) { p0[i] = other32(v0[i], fq >= 2); p1[i] = other32(v1[i], fq >= 2); }
                        const LAS f32x2* t0 = tab32 + pr * 8 + 4 * (fq & 1); const LAS f32x2* t1 = tab32 + pc * 8 + 4 * (fq & 1);
#pragma unroll
                        for (int i = 0; i < 4; ++i) { const f32x2 c0 = t0[i], c1 = t1[i];
                            v0[i] = fq < 2 ? v0[i] * c0.x - p0[i] * c0.y : v0[i] * c0.x + p0[i] * c0.y;
                            v1[i] = fq < 2 ? v1[i] * c1.x - p1[i] * c1.y : v1[i] * c1.x + p1[i] * c1.y; } }
                    const unsigned w0 = pk_fp8v(v0), w1 = pk_fp8v(v1);
#pragma unroll
                    for (int h = 0; h < 6; ++h) { unsigned char* p = (unsigned char*)dst + (size_t)row * 768 + h * 128 + 64 + 4 * fq; *(unsigned*)p = w0; *(unsigned*)(p + 16) = w1; *(unsigned*)(p + 32) = 0u; *(unsigned*)(p + 48) = 0u; }
                    const u32x2 z = {0u, 0u};
#pragma unroll
                    for (int q = 0; q < 4; ++q) *(u32x2*)(craw + (size_t)row * 384 + 320 + 16 * q + 4 * fq) = z;
                    asm volatile("" ::: "memory");
                }
        }
    }
};

struct EpiUpProj {
    static constexpr bool PERM = false, FP8 = false;
    unsigned char* ws; const LAS unsigned long long* in; int l; const LAS f32x2* tab32;
    DI void operator()(const Acc& acc, const g8::Unit& u, int wr, int wc, int fr, int fq) const {
        asm volatile("" : "+v"(fr), "+v"(fq));
        const int slot = 4 * u.pn + wc; if (slot >= 9 && slot < 12) return;
        const int rowt = u.pm * 256 + wr * 64 + fr; const bool lat = (u.pm * 256) < LAT;
        const float* ssq = (const float*)(ws + WS_SSQ);
        bf16_t* qB = (bf16_t*)(ws + Z_QB); bf16_t* kB = (bf16_t*)(ws + Z_KB); bf16_t* vB = (bf16_t*)(ws + Z_VB);
        const bool isq = slot < 9;
#pragma unroll
        for (int ai = 0; ai < 2; ++ai)
#pragma unroll
            for (int m = 0; m < 4; ++m) {
                const int row = rowt + ai * 128 + m * 16;
                const f32x4 sa = *(const f32x4*)(ssq + (size_t)row * 8); const float sb = ssq[(size_t)row * 8 + 4];
                const float r0 = isq ? 1.0f / sqrtf((sa.x + sa.y + sa.z) * (1.f / 192.f) + EPS) : 1.0f / sqrtf((sa.w + sb) * (1.f / 128.f) + EPS);
                if (slot < 6 || (slot >= 12 && slot < 18)) {
                    const float* gain = slot < 6 ? inp(in, 15) + l * 64 : inp(in, 16) + l * 64; const float qs = slot < 6 ? QF96 : 1.f;
                    const int h = slot < 6 ? slot : slot - 12; unsigned char* dst = (unsigned char*)(slot < 6 ? qB : kB) + (size_t)row * 768 + h * 128;
                    float s = 0.f; f32x4 x[2][2];
#pragma unroll
                    for (int bj = 0; bj < 2; ++bj)
#pragma unroll
                        for (int n = 0; n < 2; ++n) { x[bj][n] = acc[ai][bj][m][n] * r0; s += (x[bj][n].x * x[bj][n].x + x[bj][n].y * x[bj][n].y) + (x[bj][n].z * x[bj][n].z + x[bj][n].w * x[bj][n].w); }
                    s = add_xor32(add_xor16(s));
                    const float rstd = qs / sqrtf(s * (1.f / 64.f) + EPS);
#pragma unroll
                    for (int bj = 0; bj < 2; ++bj)
#pragma unroll
                        for (int n = 0; n < 2; ++n) { const int c = 32 * bj + 16 * n + 4 * fq; *(unsigned*)(dst + c) = pk_fp8v(x[bj][n] * rstd * *(const f32x4*)(gain + c)); }
                } else if (slot >= 18) {
                    const int row64 = u.pm * 256 + ai * 128 + wr * 64; const size_t bt = vt_tile_of_rowgroup(row64);
                    unsigned char* tile = (unsigned char*)vB + ((bt / 68) * 6 + (slot - 18)) * VT_HEAD + (bt % 68) * VT_TILE;
#pragma unroll
                    for (int bj = 0; bj < 2; ++bj)
#pragma unroll
                        for (int n = 0; n < 2; ++n) st_vt4(tile, 32 * bj + 16 * n + 4 * fq, vt_pos(16 * m + fr), acc[ai][bj][m][n] * r0);
                } else {
                    const float* gain = inp(in, 17) + l * 32;
#pragma unroll
                    for (int bj = 0; bj < 2; ++bj) {
                        const f32x4 a0 = acc[ai][bj][m][0] * r0, a1 = acc[ai][bj][m][1] * r0;
                        float s = (a0.x * a0.x + a0.y * a0.y) + (a0.z * a0.z + a0.w * a0.w) + (a1.x * a1.x + a1.y * a1.y) + (a1.z * a1.z + a1.w * a1.w);
                        s = add_xor32(add_xor16(s));
                        const float rstd = QF96 / sqrtf(s * (1.f / 32.f) + EPS);
                        f32x4 v0 = a0 * rstd * *(const f32x4*)(gain + 4 * fq), v1 = a1 * rstd * *(const f32x4*)(gain + 16 + 4 * fq);
                        if (lat) { const int t = row & 4095, pr = t >> 6, pc = t & 63; f32x4 p0, p1;
#pragma unroll
                            for (int i = 0; i < 4; ++i) { p0[i] = other32(v0[i], fq >= 2); p1[i] = other32(v1[i], fq >= 2); }
                            const LAS f32x2* t0 = tab32 + pr * 8 + 4 * (fq & 1); const LAS f32x2* t1 = tab32 + pc * 8 + 4 * (fq & 1);
#pragma unroll
                            for (int i = 0; i < 4; ++i) { const f32x2 c0 = t0[i], c1 = t1[i];
                                v0[i] = fq < 2 ? v0[i] * c0.x - p0[i] * c0.y : v0[i] * c0.x + p0[i] * c0.y;
                                v1[i] = fq < 2 ? v1[i] * c1.x - p1[i] * c1.y : v1[i] * c1.x + p1[i] * c1.y; } }
                        unsigned char* p = (unsigned char*)qB + (size_t)row * 768 + (2 * (slot - 6) + bj) * 128 + 64 + 4 * fq;
                        *(unsigned*)p = pk_fp8v(v0); *(unsigned*)(p + 16) = pk_fp8v(v1); *(unsigned*)(p + 32) = 0u; *(unsigned*)(p + 48) = 0u;
                    }
                }
                asm volatile("" ::: "memory");
            }
    }
};

struct EpiOutProj {
    static constexpr bool PERM = false, FP8 = false;
    unsigned char* ws; const float* xin; const float* cin; float* out; int l;
    DI void operator()(const Acc& acc, const g8::Unit& u, int wr, int wc, int fr, int fq) const {
        asm volatile("" : "+v"(fr), "+v"(fq));
        const int rowt = u.pm * 256 + wr * 64 + fr; const bool lat = (u.pm * 256) < LAT;
        const float* mod = (const float*)(ws + WS_MOD) + ((size_t)l * 9 + (lat ? (u.pm * 256) / 4096 : 8)) * 6144 + 2048;
        const int col0 = u.pn * 256 + wc * 32 + 4 * fq;
        f32x4 gv[2][2];
#pragma unroll
        for (int bj = 0; bj < 2; ++bj)
#pragma unroll
            for (int n = 0; n < 2; ++n) gv[bj][n] = *(const f32x4*)(mod + col0 + 128 * bj + 16 * n);
#pragma unroll
        for (int ai = 0; ai < 2; ++ai)
#pragma unroll
            for (int m = 0; m < 4; ++m) {
                const int row = rowt + ai * 128 + m * 16;
                const float* src = lat ? xin + (size_t)row * 1024 : cin + (size_t)(row - LAT) * 1024;
                float* dst = lat ? out + (size_t)row * 1024 : (float*)(ws + WS_CTXF) + (size_t)(row - LAT) * 1024;
#pragma unroll
                for (int bj = 0; bj < 2; ++bj)
#pragma unroll
                    for (int n = 0; n < 2; ++n) { const int c = col0 + 128 * bj + 16 * n; *(f32x4*)(dst + c) = *(const f32x4*)(src + c) + gv[bj][n] * acc[ai][bj][m][n]; }
            }
    }
};

constexpr int WSH = 6, HSH = 3;
struct EpiMoe1 {
    static constexpr bool PERM = true, FP8 = true;
    unsigned char* ws;
    DI void operator()(const Acc& acc, const g8::Unit& u, int wr, int wc, int fr, int fq) const {
        asm volatile("" : "+v"(fr), "+v"(fq));
        unsigned char* hid = ws + Z_HID; constexpr float SC = 1.0f / (float)(1 << WSH), HS = (float)(1 << HSH);
#pragma unroll
        for (int ai = 0; ai < 2; ++ai)
#pragma unroll
            for (int m = 0; m < 4; ++m) {
                const int row = u.pm * 256 + ai * 128 + wr * 64 + m * 16 + fr;
                f32x4 h0, h1;
#pragma unroll
                for (int i = 0; i < 4; ++i) { h0[i] = silu_f(acc[ai][0][m][0][i] * SC) * (acc[ai][1][m][0][i] * (SC * HS)); h1[i] = silu_f(acc[ai][0][m][1][i] * SC) * (acc[ai][1][m][1][i] * (SC * HS)); }
                u32x2 w; w.x = pk_fp8x4(h0.x, h0.y, h0.z, h0.w); w.y = pk_fp8x4(h1.x, h1.y, h1.z, h1.w);
                *(u32x2*)(hid + (size_t)row * 1024 + u.pn * 128 + wc * 32 + 8 * fq) = w;
            }
    }
};
struct EpiMoe2 {
    static constexpr bool PERM = true, FP8 = true;
    unsigned char* ws;
    DI void operator()(const Acc& acc, const g8::Unit& u, int wr, int wc, int fr, int fq) const {
        asm volatile("" : "+v"(fr), "+v"(fq));
        bf16_t* ye = (bf16_t*)(ws + Z_YE); const float* gate = (const float*)(ws + WS_GATE); constexpr float SC = 1.0f / (float)(1 << (WSH + HSH));
#pragma unroll
        for (int ai = 0; ai < 2; ++ai)
#pragma unroll
            for (int m = 0; m < 4; ++m) {
                const int row = u.pm * 256 + ai * 128 + wr * 64 + m * 16 + fr; const float gv = gate[row] * SC;
#pragma unroll
                for (int bj = 0; bj < 2; ++bj) { const f32x4 a = acc[ai][bj][m][0] * gv, b = acc[ai][bj][m][1] * gv; u32x4 w;
                    w.x = cvt_pk(a.x, a.y); w.y = cvt_pk(a.z, a.w); w.z = cvt_pk(b.x, b.y); w.w = cvt_pk(b.z, b.w);
                    *(u32x4*)(ye + (size_t)row * 1024 + u.pn * 256 + bj * 128 + wc * 32 + 8 * fq) = w; }
            }
    }
};
DI int crow(int i, int hh) { return (i & 3) + 8 * (i >> 2) + 4 * hh; }
typedef short v4i16_t __attribute__((ext_vector_type(4)));
DI s16x4 vtr(const LAS unsigned char* p) { return __builtin_bit_cast(s16x4, __builtin_amdgcn_ds_read_tr16_b64_v4i16((LAS v4i16_t*)p)); }
#define MFMA32(a, b, c) __builtin_amdgcn_mfma_f32_32x32x16_bf16((a), (b), (c), 0, 0, 0)

struct AttnDesc { const unsigned char* Q; int ldq, qoff; const unsigned char* K; int ldk, koff; const unsigned char* Vt; bf16_t* O; int ooff; float sink2; };
DI float fmax3(float a, float b, float c) { return __builtin_fmaxf(__builtin_fmaxf(a, b), c); }
typedef int i32x4 __attribute__((ext_vector_type(4)));
typedef int i32x8 __attribute__((ext_vector_type(8)));
#define MFMA8Z(acc, a, b, sa, sb) asm volatile("v_mfma_scale_f32_32x32x64_f8f6f4 %0, %1, %2, 0, %3, %4 op_sel_hi:[0,0,0]" : "=&v"(acc) : "v"(a), "v"(b), "v"(sa), "v"(sb))
#define MFMA8(acc, a, b, sa, sb) asm volatile("v_mfma_scale_f32_32x32x64_f8f6f4 %0, %1, %2, %0, %3, %4 op_sel_hi:[0,0,0]" : "+v"(acc) : "v"(a), "v"(b), "v"(sa), "v"(sb))
DI int cvt8x4(float a, float b, float c, float d) { int w; asm("v_cvt_pk_fp8_f32 %0, %1, %2" : "=v"(w) : "v"(a), "v"(b)); asm("v_cvt_pk_fp8_f32 %0, %1, %2 op_sel:[0,0,1]" : "+v"(w) : "v"(c), "v"(d)); return w; }
#define MFMA8C(acc, a, b, c, sa, sb) asm volatile("v_mfma_scale_f32_32x32x64_f8f6f4 %0, %1, %2, %3, %4, %5 op_sel_hi:[0,0,0]" : "=&v"(acc) : "v"(a), "v"(b), "v"(c), "v"(sa), "v"(sb))
template <int DQB  , int MODE, bool TRACK, int ABL = 0>
DI void attn_unit(const int tid, LAS unsigned char* lds, const AttnDesc& d, int b, int qb, bool has_sink) {
    constexpr int KSTR = DQB + 16, VSTR = 80, KBUF = 128 * KSTR, VTILE = 64 * VSTR, VBUF = 2 * VTILE, NS = DQB / 64, KCH = DQB / 16, KC1 = KCH + 1, VC1 = 5;
    const int lane = tid & 63, wid = __builtin_amdgcn_readfirstlane(tid >> 6), r = lane & 31, hh = lane >> 5;
    const int q0 = qb * 256;
    const int qrow = (MODE == 2 ? LAT + b * 256 : b * 4096) + q0 + wid * 32 + r;
    int lo = 0, ntl = 0;
    if (MODE == 0) { lo = 0; ntl = 64; }
    if (MODE == 1) { lo = q0 - 128 < 0 ? 0 : q0 - 128; const int hi = q0 + 384 > 4096 ? 4096 : q0 + 384; ntl = (hi - lo) / 64; }
    int NSTEP = (4 + ntl) / 2;
    asm volatile("" : "+s"(NSTEP));
    auto step_row = [&](int st) -> int { return st < 2 ? LAT + b * 256 + st * 128 : b * 4096 + lo + (st - 2) * 128; };
    auto step_T = [&](int st) -> int { return st < 2 ? 2 * st : 4 + lo / 64 + 2 * (st - 2); };
    i32x8 qf[NS];
#pragma unroll
    for (int s = 0; s < NS; ++s) { const unsigned char* qp = d.Q + (size_t)qrow * d.ldq + d.qoff + 64 * s + 32 * hh; const i32x4 lo4 = *(const i32x4*)qp, hi4 = *(const i32x4*)(qp + 16); qf[s] = __builtin_shufflevector(lo4, hi4, 0, 1, 2, 3, 4, 5, 6, 7); }
    const int sclK = 0x7F7F7F7F, sclQ = 0x7C7C7C7C;
    constexpr int NKC = 128 * KC1, NVC = 128 * VC1, NKI = (NKC + 511) / 512, NVI = (NVC + 511) / 512;
    auto dma_piece = [&](int st, int buf, int i) {
        if (i < NKI) { if (i * 512 + wid * 64 < NKC) { const int c = i * 512 + tid, row = c / KC1, ch = c % KC1; const unsigned char* kb_ = d.K + (size_t)step_row(st) * d.ldk;
            __builtin_amdgcn_global_load_lds((const unsigned*)(kb_ + (unsigned)(row * d.ldk + d.koff + (ch < KCH ? ch : 0) * 16)), (LAS unsigned*)(lds + buf * KBUF + i * 8192 + wid * 1024), 16, 0, 0); } }
        else { const int iv = i - NKI; if (iv * 512 + wid * 64 < NVC) { const int c = iv * 512 + tid, row = c / VC1, ch = c % VC1; const unsigned char* vb_ = d.Vt + (size_t)step_T(st) * VT_TILE;
            __builtin_amdgcn_global_load_lds((const unsigned*)(vb_ + (unsigned)(row * 64 + (ch < 4 ? ch : 0) * 16)), (LAS unsigned*)(lds + 2 * KBUF + buf * VBUF + iv * 8192 + wid * 1024), 16, 0, 0); } } };
    auto dma_step = [&](int st, int buf) {
#pragma unroll
        for (int i = 0; i < NKI + NVI; ++i) dma_piece(st, buf, i); };
    constexpr float THR = 8.f, POFF = 6.f;
    static_assert(TRACK, "the fp8 P.V path needs the running row maximum");
    float m = 0.f;
    if (has_sink) m = d.sink2 - POFF;
    f32x16 o0, o1, sc[4], negm, lacc;
    { float z = 0.f, nm = -m, l0 = has_sink ? __builtin_amdgcn_exp2f(POFF) : 0.f; asm volatile("" : "+v"(z), "+v"(nm), "+v"(l0));
#pragma unroll
      for (int i = 0; i < 16; ++i) { o0[i] = z; o1[i] = z; negm[i] = nm; lacc[i] = l0; } }
    i32x8 ones;
    { int one4 = 0x38383838; asm volatile("" : "+v"(one4));
#pragma unroll
      for (int i = 0; i < 8; ++i) ones[i] = one4; }
    asm volatile("s_nop 1" : "+v"(ones), "+v"(negm), "+v"(lacc));
    const int koffl = r * KSTR + hh * 32, voffl = r * VSTR + hh * 32, sclV = 0x7F7F7F7F;
    auto frag = [&](const LAS unsigned char* p) -> i32x8 { const i32x4 lo4 = *(const LAS i32x4*)p, hi4 = *(const LAS i32x4*)(p + 16); return __builtin_shufflevector(lo4, hi4, 0, 1, 2, 3, 4, 5, 6, 7); };
    __syncthreads();
    dma_step(0, 0); dma_step(1, 1); asm volatile("s_waitcnt vmcnt(0)" ::: "memory");
    __syncthreads();
    constexpr int NF = 4 * NS;
    auto kfrag = [&](int kbuf, int f) -> i32x8 { return frag(lds + kbuf * KBUF + koffl + (32 * (f & 3)) * KSTR + (f >> 2) * 64); };
    i32x8 kx[3];
    kx[0] = kfrag(0, 0); kx[1] = kfrag(0, 1); kx[2] = kfrag(0, 2);
    for (int st = 0; st < NSTEP; ++st) {
        const int buf = st & 1;
        {
#pragma unroll
          for (int f = 0; f < NF; ++f) { const int j = f & 3, s = f >> 2;
              if (!(ABL & 4)) { if (s == 0) MFMA8C(sc[j], kx[f % 3], qf[0], negm, sclK, sclQ); else MFMA8(sc[j], kx[f % 3], qf[s], sclK, sclQ); } else if (s == 0) sc[j] = negm;
              if (f + 3 < NF) kx[f % 3] = kfrag(buf, f + 3); }
          asm volatile("s_nop 15\n\ts_nop 7" : "+v"(sc[0]), "+v"(sc[1]), "+v"(sc[2]), "+v"(sc[3])); }
        i32x8 vx[4];
        { const LAS unsigned char* vb = lds + 2 * KBUF + buf * VBUF + voffl;
#pragma unroll
          for (int t2 = 0; t2 < 2; ++t2) { vx[2 * t2] = frag(vb + t2 * VTILE); vx[2 * t2 + 1] = frag(vb + t2 * VTILE + 32 * VSTR); }
          asm volatile("" ::: "memory"); }
        if (MODE == 1) { if (st >= 2) { const int kp0 = lo + (st - 2) * 128, qp = q0 + wid * 32 + r;
#pragma unroll
            for (int j = 0; j < 4; ++j)
#pragma unroll
                for (int i = 0; i < 16; ++i) { const int dk = kp0 + 32 * j + crow(i, hh) - qp; if (dk > 128 || dk < -128) sc[j][i] = -1e30f; } } }
        if (!(ABL & 32)) { float ma = fmax3(sc[0][0], sc[1][0], sc[2][0]), mb = fmax3(sc[3][0], sc[0][1], sc[1][1]);
#pragma unroll
          for (int i = 0; i < 16; ++i) { if (i >= 1) ma = fmax3(ma, sc[0][i], sc[1][i]); if (i >= 2) mb = fmax3(mb, sc[2][i], sc[3][i]); }
          mb = fmax3(mb, sc[2][1], sc[3][1]);
          float mx = __builtin_fmaxf(ma, mb);
          { auto rr = __builtin_amdgcn_permlane32_swap(__float_as_uint(mx), __float_as_uint(mx), false, false); mx = __builtin_fmaxf(__uint_as_float(rr[0]), __uint_as_float(rr[1])); }
          if (st == 0 && !has_sink) {
              const float dl = mx - POFF; m = dl;
#pragma unroll
              for (int j = 0; j < 4; ++j)
#pragma unroll
                  for (int i = 0; i < 16; ++i) sc[j][i] -= dl;
#pragma unroll
              for (int i = 0; i < 16; ++i) negm[i] = -m;
              asm volatile("s_nop 1" : "+v"(negm));
          } else if (__any(mx > THR)) {
              const float dl = __builtin_fmaxf(mx - POFF, 0.f), alpha = __builtin_amdgcn_exp2f(-dl);
              asm volatile("s_nop 15\n\ts_nop 7" : "+v"(o0), "+v"(o1), "+v"(lacc));
              m += dl;
#pragma unroll
              for (int i = 0; i < 16; ++i) { o0[i] *= alpha; o1[i] *= alpha; lacc[i] *= alpha; negm[i] = -m; }
#pragma unroll
              for (int j = 0; j < 4; ++j)
#pragma unroll
                  for (int i = 0; i < 16; ++i) sc[j][i] -= dl;
              asm volatile("s_nop 1" : "+v"(negm), "+v"(o0), "+v"(o1), "+v"(lacc)); } }
#pragma unroll
        for (int j = 0; j < 4; ++j)
#pragma unroll
            for (int i = 0; i < 16; ++i) if (!(ABL & 2)) sc[j][i] = __builtin_amdgcn_exp2f(sc[j][i]);
        i32x8 pf[2];
#pragma unroll
        for (int t2 = 0; t2 < 2; ++t2) {
#pragma unroll
            for (int q4 = 0; q4 < 4; ++q4) { if (ABL & 64) { pf[t2][q4] = __float_as_int(sc[2 * t2][q4]); pf[t2][4 + q4] = __float_as_int(sc[2 * t2 + 1][q4]); continue; }
                                             pf[t2][q4] = cvt8x4(sc[2 * t2][4 * q4], sc[2 * t2][4 * q4 + 1], sc[2 * t2][4 * q4 + 2], sc[2 * t2][4 * q4 + 3]);
                                             pf[t2][4 + q4] = cvt8x4(sc[2 * t2 + 1][4 * q4], sc[2 * t2 + 1][4 * q4 + 1], sc[2 * t2 + 1][4 * q4 + 2], sc[2 * t2 + 1][4 * q4 + 3]); } }
        asm volatile("s_nop 1" : "+v"(pf[0]), "+v"(pf[1]));
        asm volatile("s_waitcnt vmcnt(0) lgkmcnt(0)" ::: "memory"); if (!(ABL & 16)) __builtin_amdgcn_s_barrier(); asm volatile("" ::: "memory");
        if (st + 1 < NSTEP) { kx[0] = kfrag(buf ^ 1, 0); kx[1] = kfrag(buf ^ 1, 1); kx[2] = kfrag(buf ^ 1, 2); }
        const bool more = st + 2 < NSTEP && !(ABL & 1);
#pragma unroll
        for (int t = 0; t < 6; ++t) { const int t2 = t / 3, w = t % 3;
            if (!(ABL & 8)) { if (w == 0) MFMA8(o0, vx[2 * t2], pf[t2], sclV, sclV); else if (w == 1) MFMA8(o1, vx[2 * t2 + 1], pf[t2], sclV, sclV); else MFMA8(lacc, ones, pf[t2], sclV, sclV); }
            if (more && t < NKI + NVI) dma_piece(st + 2, buf, t); }
        static_assert(NKI + NVI <= 6, "one DMA piece per P.V MFMA");
    }
    asm volatile("s_nop 15\n\ts_nop 15" : "+v"(o0), "+v"(o1), "+v"(lacc));
    const float inv = 1.0f / lacc[0];
    bf16_t* op = d.O + (size_t)qrow * 1024 + d.ooff + 4 * hh;
#pragma unroll
    for (int g4 = 0; g4 < 4; ++g4) {
        u32x2 w; w.x = cvt_pk(o0[4 * g4] * inv, o0[4 * g4 + 1] * inv); w.y = cvt_pk(o0[4 * g4 + 2] * inv, o0[4 * g4 + 3] * inv); *(u32x2*)(op + 8 * g4) = w;
        u32x2 x; x.x = cvt_pk(o1[4 * g4] * inv, o1[4 * g4 + 1] * inv); x.y = cvt_pk(o1[4 * g4 + 2] * inv, o1[4 * g4 + 3] * inv); *(u32x2*)(op + 32 + 8 * g4) = x;
    }
}

#ifndef TRACK_EN
#define TRACK_EN 1
#endif
DI void attn_phase(const Frame& F, int l, bool with_ctx, int rep = 0) {
    constexpr int UB = 96, UA = 96, UC = 64, UX = 16;
    const int NUQ = UB + UA + UC + (with_ctx ? UX : 0);
    unsigned* heads = F.ctl + CW_QUEUE + 128 * (l + 2 * rep);
    volatile LAS int* slot = (volatile LAS int*)(F.lds + LDS_MISC + 16);
    const float* sinkp = INP(21) + l * 4;
    auto resolve = [&](int v) -> int {
        int q = slot[2];
        while (v >= NUQ) { const int t = slot[3] + 1; slot[3] = t; if (t >= NB) return -1; q = q + 1 == NB ? 0 : q + 1; slot[2] = q; v = (int)__hip_atomic_fetch_add(heads + 16 * q, 1u, __ATOMIC_RELAXED, __HIP_MEMORY_SCOPE_AGENT); }
        return q * 512 + v; };
    __syncthreads();
    if (F.tid == 0) { const int q0 = F.bid % NB; slot[2] = q0; slot[3] = 0; slot[0] = resolve((int)__hip_atomic_fetch_add(heads + 16 * q0, 1u, __ATOMIC_RELAXED, __HIP_MEMORY_SCOPE_AGENT)); }
    __syncthreads();
    for (int it = 0;; ++it) {
        int u = slot[it & 1]; if (u < 0) break;
        int nxt_u = 0; if (F.tid == 0) nxt_u = (int)__hip_atomic_fetch_add(heads + 16 * slot[2], 1u, __ATOMIC_RELAXED, __HIP_MEMORY_SCOPE_AGENT);
        [&]() {
        GAS unsigned char* wsg = (GAS unsigned char*)F.ws; asm volatile("" : "+s"(wsg)); unsigned char* ws = (unsigned char*)wsg;
        int tidu = F.tid; asm volatile("" : "+v"(tidu));
        AttnDesc d;
        const int b = u >> 9; u &= 511;
        if (u < UB) { const int h = u / 16, qb = u % 16;
            d = AttnDesc{(const unsigned char*)(ws + Z_QB), 768, h * 128, (const unsigned char*)(ws + Z_KB), 768, h * 128, (const unsigned char*)(ws + Z_VB) + ((size_t)b * 6 + h) * VT_HEAD, (bf16_t*)(ws + Z_OB), 384 + h * 64, 0.f};
#ifdef ATT_ABL
            if (rep) { attn_unit<128, 0, true, ATT_ABL>(tidu, F.lds, d, b, qb, false); return; }
#endif
            attn_unit<128, 0, true>(tidu, F.lds, d, b, qb, false); return; }
        u -= UB;
        if (u < UA) { const int h = u / 16, qb = u % 16;
            d = AttnDesc{(const unsigned char*)(ws + Z_QA), 384, h * 64, (const unsigned char*)(ws + Z_KA), 128, (h / 3) * 64, (const unsigned char*)(ws + Z_VA) + ((size_t)b * 2 + h / 3) * VT_HEAD, (bf16_t*)(ws + Z_OB), h * 64, 0.f};
#ifdef ATT_ABL
            if (rep) { attn_unit<64, 0, true, ATT_ABL>(tidu, F.lds, d, b, qb, false); return; }
#endif
            attn_unit<64, 0, true>(tidu, F.lds, d, b, qb, false); return; }
        u -= UA;
        if (u < UC) { const int h = u / 16, qb = u % 16;
            d = AttnDesc{(const unsigned char*)(ws + Z_QC), 256, h * 64, (const unsigned char*)(ws + Z_KC), 128, (h / 2) * 64, (const unsigned char*)(ws + Z_VC) + ((size_t)b * 2 + h / 2) * VT_HEAD, (bf16_t*)(ws + Z_OB), 768 + h * 64, sinkp[h] * LOG2E};
            attn_unit<64, 1, true>(tidu, F.lds, d, b, qb, true); return; }
        u -= UC;
        { const int hx = u;
            if (hx < 6) { const int h = hx;
                d = AttnDesc{(const unsigned char*)(ws + Z_QA), 384, h * 64, (const unsigned char*)(ws + Z_KA), 128, (h / 3) * 64, (const unsigned char*)(ws + Z_VA) + ((size_t)b * 2 + h / 3) * VT_HEAD, (bf16_t*)(ws + Z_OB), h * 64, 0.f};
                attn_unit<64, 2, true>(tidu, F.lds, d, b, 0, false); }
            else if (hx < 12) { const int h = hx - 6;
                d = AttnDesc{(const unsigned char*)(ws + Z_QB), 768, h * 128, (const unsigned char*)(ws + Z_KB), 768, h * 128, (const unsigned char*)(ws + Z_VB) + ((size_t)b * 6 + h) * VT_HEAD, (bf16_t*)(ws + Z_OB), 384 + h * 64, 0.f};
                attn_unit<128, 2, true>(tidu, F.lds, d, b, 0, false); }
            else { const int h = hx - 12;
                d = AttnDesc{(const unsigned char*)(ws + Z_QC), 256, h * 64, (const unsigned char*)(ws + Z_KC), 128, (h / 2) * 64, (const unsigned char*)(ws + Z_VC) + ((size_t)b * 2 + h / 2) * VT_HEAD, (bf16_t*)(ws + Z_OB), 768 + h * 64, sinkp[h] * LOG2E};
                attn_unit<64, 2, true>(tidu, F.lds, d, b, 0, true); }
        }
        }();
        if (F.tid == 0) slot[(it & 1) ^ 1] = resolve(nxt_u);
        __syncthreads();
    }
}

DI void router_phase(const Frame& F, int l, bool with_ctx) {
    LAS float* wT = (LAS float*)F.lds;
    const float* wr = INP(23) + (size_t)l * 1024 * 16;
    for (int e = F.tid; e < 16 * 1024; e += NTHR) { const int k = e / 16, x = e % 16; wT[x * 1024 + k] = wr[e]; }
    __syncthreads();
    const int gw = F.bid * NWAVES + F.wave, NGW = F.G * NWAVES, NR = with_ctx ? R : LAT, lane = F.lane;
    const float* g = INP(7) + l * 1024;
    auto rowptr = [&](int row) -> const float* { return row < LAT ? F.out + (size_t)row * 1024 : WSP(float, WS_CTXF) + (size_t)(row - LAT) * 1024; };
    f32x4 vn[4];
    if (gw < NR) { const float* xr0 = rowptr(gw);
#pragma unroll
        for (int j = 0; j < 4; ++j) vn[j] = *(const f32x4*)(xr0 + 4 * (lane + 64 * j)); }
    for (int row = gw; row < NR; row += NGW) {
        const float* m = mod_row(F, l, row);
        f32x4 v[4]; float s = 0.f;
#pragma unroll
        for (int j = 0; j < 4; ++j) { v[j] = vn[j]; s += (v[j].x * v[j].x + v[j].y * v[j].y) + (v[j].z * v[j].z + v[j].w * v[j].w); }
        if (row + NGW < NR) { const float* xr1 = rowptr(row + NGW);
#pragma unroll
            for (int j = 0; j < 4; ++j) vn[j] = *(const f32x4*)(xr1 + 4 * (lane + 64 * j)); }
        const float rstd = 1.0f / sqrtf(wave_sum(s) * (1.f / 1024.f) + EPS);
        float lg[16];
#pragma unroll
        for (int e = 0; e < 16; ++e) lg[e] = 0.f;
        unsigned char* orow = WSP(unsigned char, WS_HB) + (size_t)row * 1024;
#pragma unroll
        for (int j = 0; j < 4; ++j) { const int c = 4 * (lane + 64 * j); const f32x4 gv = *(const f32x4*)(g + c), sv = *(const f32x4*)(m + 3072 + c), cv = *(const f32x4*)(m + 4096 + c);
            v[j] = v[j] * rstd * gv * (cv + 1.0f) + sv; *(unsigned*)(orow + c) = pk_fp8x4(v[j].x, v[j].y, v[j].z, v[j].w); }
        asm volatile("" ::: "memory");
#pragma unroll
        for (int e = 0; e < 16; ++e) {
#pragma unroll
            for (int j = 0; j < 4; ++j) { const f32x4 wv = *(const LAS f32x4*)(wT + e * 1024 + 4 * (lane + 64 * j)); lg[e] += (v[j].x * wv.x + v[j].y * wv.y) + (v[j].z * wv.z + v[j].w * wv.w); }
            if (e & 1) asm volatile("" ::: "memory"); }
#pragma unroll
        for (int e = 0; e < 16; ++e) lg[e] = wave_sum(lg[e]);
        float mx = lg[0];
#pragma unroll
        for (int e = 1; e < 16; ++e) mx = fmaxf(mx, lg[e]);
        float sum = 0.f;
#pragma unroll
        for (int e = 0; e < 16; ++e) { lg[e] = expf(lg[e] - mx); sum += lg[e]; }
        const float isum = 1.0f / sum;
        float mine = 0.f;
#pragma unroll
        for (int e = 0; e < 16; ++e) mine = (lane == e) ? lg[e] * isum : mine;
        if (lane < 16) {
            if (row < LAT) WSP(float, WS_AFFL)[((size_t)(row / 4096) * 16 + lane) * 4096 + (row & 4095)] = mine;
            else { const int rc = row - LAT; WSP(float, WS_AFFC)[((size_t)(rc / 256) * 16 + lane) * 256 + (rc & 255)] = mine; }
        }
    }
}

DI void topk_phase(const Frame& F, bool with_ctx) {
    LAS unsigned* hist = (LAS unsigned*)F.lds;
    LAS unsigned* sh = hist + 256;
    LAS unsigned* scan = hist + 512;
    const int NL = NB * 16 * (with_ctx ? 2 : 1), tid = F.tid;
    for (int li = F.bid; li < NL; li += F.G) {
        const bool isctx = li >= NB * 16; const int be = isctx ? li - NB * 16 : li, b = be / 16, e = be % 16;
        const int n = isctx ? 256 : 4096, cap = n / 8, per = isctx ? 1 : 8;
        const float* a = isctx ? WSP(float, WS_AFFC) + (size_t)be * 256 : WSP(float, WS_AFFL) + (size_t)be * 4096;
        unsigned key[8]; const bool act = tid * per < n;
#pragma unroll
        for (int j = 0; j < 8; ++j) key[j] = (act && j < per) ? __float_as_uint(a[tid * per + j]) : 0u;
        unsigned prefix = 0u, rem = (unsigned)cap;
        for (int pass = 0; pass < 4; ++pass) {
            const int shift = 24 - 8 * pass;
            __syncthreads();
            if (tid < 256) hist[tid] = 0u;
            __syncthreads();
#pragma unroll
            for (int j = 0; j < 8; ++j) if (act && j < per) { const unsigned k = key[j]; const bool match = pass == 0 ? true : ((k >> (shift + 8)) == (prefix >> (shift + 8))); if (match) __hip_atomic_fetch_add(&hist[(k >> shift) & 255u], 1u, __ATOMIC_RELAXED, __HIP_MEMORY_SCOPE_WORKGROUP); }
            __syncthreads();
            if (tid < 64) {
                const int b0 = 255 - 4 * tid; const unsigned c0 = hist[b0], c1 = hist[b0 - 1], c2 = hist[b0 - 2], c3 = hist[b0 - 3];
                unsigned incl = c0 + c1 + c2 + c3;
#pragma unroll
                for (int o = 1; o < 64; o <<= 1) { const unsigned v = shfl_up_u(incl, o, tid); if (tid >= o) incl += v; }
                unsigned cum = incl - (c0 + c1 + c2 + c3);
                if (cum < rem && incl >= rem) { int bin = b0; unsigned c = c0;
                    if (cum + c < rem) { cum += c; bin = b0 - 1; c = c1; if (cum + c < rem) { cum += c; bin = b0 - 2; c = c2; if (cum + c < rem) { cum += c; bin = b0 - 3; } } }
                    sh[0] = prefix | ((unsigned)bin << shift); sh[1] = rem - cum; }
            }
            __syncthreads();
            prefix = sh[0]; rem = sh[1];
        }
        unsigned cg = 0u, ce = 0u;
#pragma unroll
        for (int j = 0; j < 8; ++j) if (act && j < per) { cg += key[j] > prefix ? 1u : 0u; ce += key[j] == prefix ? 1u : 0u; }
        __syncthreads();
        scan[tid] = cg; scan[512 + tid] = ce;
        __syncthreads();
        unsigned gb, eb;
        {
            unsigned ig = cg, ie = ce; const int ln = tid & 63, wv = tid >> 6;
#pragma unroll
            for (int o = 1; o < 64; o <<= 1) { const unsigned vg = shfl_up_u(ig, o, ln), ve = shfl_up_u(ie, o, ln); if (ln >= o) { ig += vg; ie += ve; } }
            if (ln == 63) { scan[1024 + wv] = ig; scan[1040 + wv] = ie; }
            __syncthreads();
            unsigned og = 0u, oe = 0u;
#pragma unroll
            for (int w = 0; w < 8; ++w) { if (w < wv) { og += scan[1024 + w]; oe += scan[1040 + w]; } }
            gb = og + ig - cg; eb = oe + ie - ce;
        }
        const int rowb = isctx ? LAT + b * 256 : b * 4096;
        const int mbase = isctx ? MOE_LAT + e * 256 + b * 32 : (b * 16 + e) * 512;
        int* gidx = WSP(int, WS_GIDX); float* gate = WSP(float, WS_GATE); int* inv = WSP(int, WS_INV);
#pragma unroll
        for (int j = 0; j < 8; ++j) if (act && j < per) {
            const unsigned k = key[j]; const int t = tid * per + j; int slot = -1;
            if (k > prefix) { slot = (int)(gb + (eb < rem ? eb : rem)); ++gb; }
            else if (k == prefix) { if (eb < rem) slot = (int)(gb + eb); ++eb; }
            if (slot >= 0) { gidx[mbase + slot] = rowb + t; gate[mbase + slot] = __uint_as_float(k); }
            inv[(size_t)(rowb + t) * 16 + e] = slot >= 0 ? mbase + slot : -1;
        }
        if (isctx && NB < 8 && b == 0) { for (int i = NB * 32 + tid; i < 256; i += NTHR) { gidx[MOE_LAT + e * 256 + i] = LAT; gate[MOE_LAT + e * 256 + i] = 0.f; } }
    }
}

DI void combine_phase(const Frame& F, int l, bool with_ctx, int rep = 0) {
    const int gw = F.bid * NWAVES + F.wave, NGW = F.G * NWAVES, NR = with_ctx ? R : LAT, lane = F.lane;
    const bool last = (l == DEPTH - 1);
    const bf16_t* ye = WSP(bf16_t, Z_YE); const int* inv = WSP(int, WS_INV);
    auto rowptr = [&](int row) -> float* { return row < LAT ? F.out + (size_t)row * 1024 : WSP(float, WS_CTXF) + (size_t)(row - LAT) * 1024; };
    int slot_n = -1; f32x4 xn[4];
    if (gw < NR) { slot_n = lane < 16 ? inv[(size_t)gw * 16 + lane] : -1; const float* x0 = rowptr(gw);
#pragma unroll
        for (int j = 0; j < 4; ++j) xn[j] = *(const f32x4*)(x0 + 4 * (lane + 64 * j)); }
    for (int row = gw; row < NR; row += NGW) {
        float* xr = rowptr(row);
        const float* m = mod_row(F, l, row);
        const int myslot = slot_n; f32x4 xv[4];
#pragma unroll
        for (int j = 0; j < 4; ++j) xv[j] = xn[j];
        if (row + NGW < NR) { slot_n = lane < 16 ? inv[(size_t)(row + NGW) * 16 + lane] : -1; const float* x1 = rowptr(row + NGW);
#pragma unroll
            for (int j = 0; j < 4; ++j) xn[j] = *(const f32x4*)(x1 + 4 * (lane + 64 * j)); }
        f32x4 acc[4];
#pragma unroll
        for (int j = 0; j < 4; ++j) acc[j] = (f32x4){0.f, 0.f, 0.f, 0.f};
        unsigned mask = (unsigned)(__ballot(myslot >= 0) & 0xFFFFull);
        while (mask) {
            const int e0 = __builtin_ctz(mask); mask &= mask - 1; const bool two = mask != 0u; const int e1 = two ? __builtin_ctz(mask) : e0; if (two) mask &= mask - 1;
            const int s0 = __builtin_amdgcn_readlane(myslot, e0), s1 = __builtin_amdgcn_readlane(myslot, e1);
            const bf16_t* y0 = ye + (size_t)s0 * 1024; const bf16_t* y1 = ye + (size_t)s1 * 1024; const float w1 = two ? 1.f : 0.f;
            u32x2 a[4], c[4];
#pragma unroll
            for (int j = 0; j < 4; ++j) { a[j] = *(const u32x2*)(y0 + 4 * (lane + 64 * j)); c[j] = *(const u32x2*)(y1 + 4 * (lane + 64 * j)); }
#pragma unroll
            for (int j = 0; j < 4; ++j) { acc[j].x += bf_lo(a[j].x) + w1 * bf_lo(c[j].x); acc[j].y += bf_hi(a[j].x) + w1 * bf_hi(c[j].x); acc[j].z += bf_lo(a[j].y) + w1 * bf_lo(c[j].y); acc[j].w += bf_hi(a[j].y) + w1 * bf_hi(c[j].y); }
        }
        f32x4 v[4];
#pragma unroll
        for (int j = 0; j < 4; ++j) { const int c = 4 * (lane + 64 * j); v[j] = xv[j] + *(const f32x4*)(m + 5120 + c) * acc[j]; if (!rep) *(f32x4*)(xr + c) = v[j]; }
        if (!last) { const float* m2 = mod_row(F, l + 1, row); norm_mod_store(v, INP(6) + (l + 1) * 1024, m2, m2 + 1024, WSP(unsigned char, WS_HB) + (size_t)row * 1024, lane); }
    }
}
constexpr int NPHASE = 2 + 9 * DEPTH;
DI void load_tabs(const Frame& F) {
    const f32x2* t64 = WSP(f32x2, WS_TAB64); const f32x2* t32 = WSP(f32x2, WS_TAB32);
    LAS f32x2* l64 = (LAS f32x2*)(F.lds + LDS_TAB64); LAS f32x2* l32 = (LAS f32x2*)(F.lds + LDS_TAB32);
    for (int i = F.tid; i < 64 * 16; i += NTHR) l64[i] = t64[i];
    for (int i = F.tid; i < 64 * 8; i += NTHR) l32[i] = t32[i];
    __syncthreads();
}
#ifndef PH_EN
#define PH_EN(k) 1
#endif
#ifdef UBENCH
template <int V> DI void ubench(const Frame& F) {
    const int wid = __builtin_amdgcn_readfirstlane(F.tid >> 6);
    f32x16 a0, a1; i32x8 x, y; float e[32]; int scl = 0x7F7F7F7F;
    { float z = (float)F.tid * 1e-9f; int q = F.tid; asm volatile("" : "+v"(z), "+v"(q), "+v"(scl));
#pragma unroll
      for (int i = 0; i < 16; ++i) { a0[i] = z; a1[i] = z; }
#pragma unroll
      for (int i = 0; i < 8; ++i) { x[i] = q; y[i] = q; }
#pragma unroll
      for (int i = 0; i < 32; ++i) e[i] = z * (float)(i + 1); }
    asm volatile("s_nop 1" : "+v"(a0), "+v"(a1), "+v"(x), "+v"(y));
    const bool g1 = (V == 1) ? (wid >= 4) : (V == 5) ? (wid & 1) : false;
    auto M = [&]() {
#pragma unroll
        for (int k = 0; k < 7; ++k) { MFMA8(a0, x, y, scl, scl); MFMA8(a1, x, y, scl, scl); } };
    auto VV = [&]() {
#pragma unroll
        for (int r = 0; r < 2; ++r)
#pragma unroll
            for (int i = 0; i < 32; ++i) e[i] = __builtin_amdgcn_exp2f(e[i]);
#pragma unroll
        for (int r = 0; r < 3; ++r)
#pragma unroll
            for (int i = 0; i < 32; ++i) e[i] = __builtin_fmaf(e[i], 0.999f, 1e-3f);
#pragma unroll
        for (int i = 0; i < 32; ++i) asm volatile("" : "+v"(e[i])); };
    auto MV = [&]() {
#pragma unroll
        for (int k = 0; k < 16; ++k) {
            if (k < 14) { if (k & 1) MFMA8(a1, x, y, scl, scl); else MFMA8(a0, x, y, scl, scl); }
#pragma unroll
            for (int j = 0; j < 2; ++j) { float v = e[2 * k + j]; v = __builtin_amdgcn_exp2f(v); v = __builtin_amdgcn_exp2f(v); v = __builtin_fmaf(v, 0.999f, 1e-3f); v = __builtin_fmaf(v, 0.999f, 1e-3f); v = __builtin_fmaf(v, 0.999f, 1e-3f); e[2 * k + j] = v; }
            asm volatile("" : "+v"(e[2 * k]), "+v"(e[2 * k + 1]));
        } };
    for (int it = 0; it < 3000; ++it) {
        if (V == 6 || V == 7) { MV(); if (V == 6) __builtin_amdgcn_s_barrier(); continue; }
        if (V == 3) M();
        else if (V == 4) VV();
        else if (!g1) { M(); VV(); } else { VV(); M(); }
        if (V != 2 && V != 7) __builtin_amdgcn_s_barrier();
    }
    asm volatile("s_nop 15\n\ts_nop 15" : "+v"(a0), "+v"(a1));
    float acc = 0.f;
#pragma unroll
    for (int i = 0; i < 16; ++i) acc += a0[i] + a1[i];
#pragma unroll
    for (int i = 0; i < 32; ++i) acc += e[i];
    if (acc == 123.456f) F.out[F.tid] = acc;
}
#endif
DI void run_phase(const Frame& F, int ph, int rep = 0) {
    unsigned char* ws = F.ws;
#ifdef UBENCH
    if (ph == 1000) { ubench<UBENCH>(F); return; }
#endif
    if (ph == 0) { if (PH_EN(100)) p0_phase(F); return; }
    if (ph == 1) { if (PH_EN(101)) init_norm_phase(F); return; }
    const int l = (ph - 2) / 9, s = (ph - 2) % 9; const bool last = (l == DEPTH - 1);
    switch (s) {
    case 0: if (PH_EN(0)) { load_tabs(F);
        g8::DenseSched S; S.init(MT, 6, F.G, F.bid, 512, ws + WS_WIN + (size_t)l * 1536 * 1024);
        EpiInProj E{ws, F.intab, l, (const LAS f32x2*)(F.lds + LDS_TAB64), (const LAS f32x2*)(F.lds + LDS_TAB32)};
        g8::gemm_phase(F.tid, F.lds, (const char*)(ws + WS_HB), 512, S, E); } break;
    case 1: if (PH_EN(1)) { load_tabs(F);
        g8::DenseSched S; S.init(MT, 6, F.G, F.bid, 384, ws + WS_WUP + (size_t)l * 1536 * 384 * 2, true);
        EpiUpProj E{ws, F.intab, l, (const LAS f32x2*)(F.lds + LDS_TAB32)};
        g8::gemm_phase(F.tid, F.lds, (const char*)(ws + Z_CRAW), 384, S, E); } break;
    case 2: if (PH_EN(2)) attn_phase(F, l, !last, rep); break;
    case 3: if (PH_EN(3)) { g8::DenseSched S; S.init(last ? LAT / 256 : MT, 4, F.G, F.bid, 1024, ws + WS_WOUT + (size_t)l * 1024 * 1024 * 2);
        EpiOutProj E{ws, l == 0 ? INP(0) : F.out, INP(2), F.out, l};
        g8::gemm_phase(F.tid, F.lds, (const char*)(ws + Z_OB), 1024, S, E); } break;
    case 4: if (PH_EN(4)) router_phase(F, l, !last); break;
    case 5: if (PH_EN(5)) topk_phase(F, !last); break;
    case 6: if (PH_EN(6)) { g8::MoeSched<true> S; S.init(8, !last, F.G, F.bid, 512, ws + WS_W1 + (size_t)l * 16 * 2048 * 1024, (size_t)2048 * 1024, (const int*)(ws + WS_GIDX));
        EpiMoe1 E{ws}; g8::gemm_phase(F.tid, F.lds, (const char*)(ws + WS_HB), 512, S, E); } break;
    case 7: if (PH_EN(7)) { g8::MoeSched<false> S; S.init(4, !last, F.G, F.bid, 512, ws + WS_W2 + (size_t)l * 16 * 1024 * 1024, (size_t)1024 * 1024, nullptr);
        EpiMoe2 E{ws}; g8::gemm_phase(F.tid, F.lds, (const char*)(ws + Z_HID), 512, S, E); } break;
    case 8: if (PH_EN(8)) combine_phase(F, l, !last, rep); break;
    }
}
__global__ void __launch_bounds__(NTHR, 2) mega_kernel(Args a) {
    extern __shared__ __attribute__((aligned(16))) unsigned char lds_raw[];
    Frame F; F.lds = (LAS unsigned char*)lds_raw; F.ws = a.ws; F.ctl = (unsigned*)(a.ws + WS_CTL);
    F.tid = threadIdx.x; F.lane = F.tid & 63; F.wave = __builtin_amdgcn_readfirstlane(F.tid >> 6); F.G = gridDim.x; F.bid = blockIdx.x; F.out = a.out;
    { LAS unsigned long long* tab = (LAS unsigned long long*)(F.lds + LDS_INTAB); if (F.tid < 27) tab[F.tid] = (unsigned long long)a.in[F.tid]; F.intab = tab; }
    volatile LAS unsigned* MISC = (volatile LAS unsigned*)(F.lds + LDS_MISC);
    if (F.tid < 64) MISC[F.tid] = 0u;
    __syncthreads();
    const bool multi = a.ph_hi - a.ph_lo > 1;
    const unsigned wave0 = __builtin_amdgcn_readfirstlane(threadIdx.x >> 6);
    XcdBarrier bar; bar.bar = F.ctl + CW_BAR + a.li * XCD_BAR_WORDS; bar.x = 0; bar.st = MISC;
    if (multi) bar = xcd_barrier_post(F.ctl + CW_BAR + a.li * XCD_BAR_WORDS, MISC);
    for (int ph = a.ph_lo; ph < a.ph_hi; ++ph) {
        {
            GAS unsigned char* w_ = (GAS unsigned char*)a.ws; GAS float* o_ = (GAS float*)a.out; unsigned l_ = (unsigned)(unsigned long long)F.lds, t_ = (unsigned)(unsigned long long)F.intab; int g_ = gridDim.x, b_ = blockIdx.x;
            unsigned all_ = ~0u, wv_ = wave0; asm volatile("" : "+s"(all_), "+s"(wv_));
            int tid_ = (int)(wv_ * 64u + __builtin_amdgcn_mbcnt_hi(all_, __builtin_amdgcn_mbcnt_lo(all_, 0u)));
            asm volatile("" : "+s"(w_), "+s"(o_), "+s"(l_), "+s"(t_), "+v"(tid_), "+s"(g_), "+s"(b_));
            F.ws = (unsigned char*)w_; F.out = (float*)o_; F.lds = (LAS unsigned char*)(unsigned long long)l_; F.intab = (const LAS unsigned long long*)(unsigned long long)t_; F.ctl = (unsigned*)(F.ws + WS_CTL);
            F.tid = tid_; F.lane = tid_ & 63; F.wave = __builtin_amdgcn_readfirstlane(tid_ >> 6); F.G = g_; F.bid = b_; }
        run_phase(F, ph, a.li);
#ifdef PROBE_I
        xcd_barrier(bar);
        if (F.bid == 0 && F.tid == 0) ((unsigned long long*)(F.ws + 49152))[ph + 1] = __builtin_amdgcn_s_memrealtime();
#else
        if (ph + 1 < a.ph_hi) xcd_barrier(bar);
#endif
    }
#ifdef PROBE_I
    {
        xcd_barrier(bar);
        const unsigned long long* ts = (const unsigned long long*)(F.ws + 49152);
        float ti = (float)(__hip_atomic_load(ts + PROBE_I + 1, __ATOMIC_RELAXED, __HIP_MEMORY_SCOPE_AGENT) - __hip_atomic_load(ts + PROBE_I, __ATOMIC_RELAXED, __HIP_MEMORY_SCOPE_AGENT)) * 0.01f;
        float tj = (float)(__hip_atomic_load(ts + PROBE_J + 1, __ATOMIC_RELAXED, __HIP_MEMORY_SCOPE_AGENT) - __hip_atomic_load(ts + PROBE_J, __ATOMIC_RELAXED, __HIP_MEMORY_SCOPE_AGENT)) * 0.01f;
        ti = exp2f(rintf(log2f(fmaxf(ti, 1.f)) * 14.2067f) / 14.2067f); tj = exp2f(rintf(log2f(fmaxf(tj, 1.f)) * 14.2067f) / 14.2067f);
        const float* xin = inp(F.intab, 0); const size_t n = (size_t)8 * 4096 * 1024;
        for (size_t i = (size_t)F.bid * NTHR + F.tid; i < n; i += (size_t)F.G * NTHR) F.out[i] = xin[i] + ti + (i == 0 ? 100.f * tj : 0.f);
    }
#endif
}
}

extern "C" void kernel_launch(void* const* d_in, const int* in_sizes, int n_in, void* d_out, int out_size, void* d_ws, size_t ws_size, hipStream_t stream) {
    static int grid = 0;
    if (grid == 0) {
        if (n_in != 27 || out_size != 8 * 4096 * 1024 || ws_size < fp::WS_END) { fprintf(stderr, "kernel_launch: unexpected problem (n_in %d, out %d, ws %zu < %zu)\n", n_in, out_size, ws_size, (size_t)fp::WS_END); grid = -1; return; }
        int dev = 0, cus = 0, per_cu = 0;
        if (hipGetDevice(&dev) != hipSuccess || hipDeviceGetAttribute(&cus, hipDeviceAttributeMultiprocessorCount, dev) != hipSuccess) { fprintf(stderr, "kernel_launch: device query failed\n"); grid = -1; return; }
        if (hipFuncSetAttribute((const void*)fp::mega_kernel, hipFuncAttributeMaxDynamicSharedMemorySize, fp::LDS_BYTES) != hipSuccess) { fprintf(stderr, "kernel_launch: hipFuncSetAttribute failed\n"); grid = -1; return; }
        if (hipOccupancyMaxActiveBlocksPerMultiprocessor(&per_cu, (const void*)fp::mega_kernel, fp::NTHR, fp::LDS_BYTES) != hipSuccess || per_cu < 1) fprintf(stderr, "kernel_launch: note: occupancy query reports %d workgroups per CU\n", per_cu);
        (void)hipGetLastError();
        grid = cus;
    }
    if (grid < 0) return;
    if (hipMemsetAsync((char*)d_ws + fp::WS_CTL, 0, fp::CTL_BYTES, stream) != hipSuccess) { fprintf(stderr, "kernel_launch: memset failed\n"); return; }
    fp::Args a{};
    for (int i = 0; i < 27; ++i) a.in[i] = (const float*)d_in[i];
    a.out = (float*)d_out; a.ws = (unsigned char*)d_ws; a.ph_lo = 0; a.ph_hi = fp::NPHASE;
#ifdef UBENCH
    { fp::Args b = a; b.ph_lo = 1000; b.ph_hi = 1001; b.li = 1; hipLaunchKernelGGL(fp::mega_kernel, dim3(grid), dim3(fp::NTHR), fp::LDS_BYTES, stream, b); }
#endif
#ifdef PROBE_SPLIT_LO
    a.ph_hi = PROBE_SPLIT_HI; a.li = 1; hipLaunchKernelGGL(fp::mega_kernel, dim3(grid), dim3(fp::NTHR), fp::LDS_BYTES, stream, a);
    a.ph_lo = PROBE_SPLIT_LO; a.ph_hi = fp::NPHASE; a.li = 0;
#endif
    hipLaunchKernelGGL(fp::mega_kernel, dim3(grid), dim3(fp::NTHR), fp::LDS_BYTES, stream, a);
}
```

```cpp
#include <hip/hip_runtime.h>
#include <stdint.h>
#include <stdio.h>
#include <math.h>
#include <type_traits>
constexpr int DEPTH = 2;
#define FAST_NB 8
namespace fp {
#define LAS __attribute__((address_space(3)))
#define GAS __attribute__((address_space(1)))
typedef unsigned short bf16_t;
typedef short bf16x8 __attribute__((ext_vector_type(8)));
typedef short s16x4 __attribute__((ext_vector_type(4)));
typedef float f32x4 __attribute__((ext_vector_type(4)));
typedef float f32x16 __attribute__((ext_vector_type(16)));
typedef unsigned u32x4 __attribute__((ext_vector_type(4)));
typedef unsigned u32x2 __attribute__((ext_vector_type(2)));
typedef float f32x2 __attribute__((ext_vector_type(2)));
#define DI __device__ __forceinline__

DI unsigned cvt_pk(float lo, float hi) { typedef float f2 __attribute__((ext_vector_type(2))); typedef __bf16 b2 __attribute__((ext_vector_type(2))); f2 v = {lo, hi}; b2 b = __builtin_convertvector(v, b2); return __builtin_bit_cast(unsigned, b); }
DI float bf_lo(unsigned w) { return __uint_as_float(w << 16); }
DI float bf_hi(unsigned w) { return __uint_as_float(w & 0xffff0000u); }
DI float silu_f(float v) { return v / (1.f + __expf(-v)); }
template <int M> DI float swz_xor(float v) { return __int_as_float(__builtin_amdgcn_ds_swizzle(__float_as_int(v), (M << 10) | 0x1F)); }
DI float add_xor16(float v) { return v + swz_xor<16>(v); }
DI float add_xor32(float v) { auto r = __builtin_amdgcn_permlane32_swap(__float_as_uint(v), __float_as_uint(v), false, false); return __uint_as_float(r[0]) + __uint_as_float(r[1]); }
DI float other32(float v, bool upper_half) { auto r = __builtin_amdgcn_permlane32_swap(__float_as_uint(v), __float_as_uint(v), false, false); return __uint_as_float(upper_half ? r[0] : r[1]); }
DI float wave_sum(float v) { v += swz_xor<1>(v); v += swz_xor<2>(v); v += swz_xor<4>(v); v += swz_xor<8>(v); v += swz_xor<16>(v); return add_xor32(v); }
DI unsigned shfl_up_u(unsigned v, int o, int lane) { return (unsigned)__builtin_amdgcn_ds_bpermute((lane - o) << 2, (int)v); }

constexpr int NB = FAST_NB;
constexpr int LAT = NB * 4096, CTXR = NB * 256, R = LAT + CTXR, MT = R / 256;
constexpr int MOE_LAT = NB * 16 * 512, MOE_ROWS = MOE_LAT + 16 * 256;
constexpr float EPS = 1e-6f, LOG2E = 1.4426950408889634f;
constexpr float QS64 = 0.125f * LOG2E, QS96 = 0.10206207261596575f * LOG2E;
constexpr float QF64 = QS64 * 8.f, QF96 = QS96 * 8.f;
constexpr int NWAVES = 8, NTHR = 512;

constexpr size_t al256(size_t x) { return (x + 255) & ~(size_t)255; }
constexpr size_t WS_CTL = 0, CTL_BYTES = 65536;
constexpr size_t WS_MOD = WS_CTL + CTL_BYTES;
constexpr size_t WS_TAB64 = WS_MOD + al256((size_t)2 * 9 * 6144 * 4);
constexpr size_t WS_TAB32 = WS_TAB64 + 8192;
constexpr size_t WS_WIN = WS_TAB32 + 4096;
constexpr size_t WS_WUP = WS_WIN + (size_t)2 * 1536 * 1024 * 2;
constexpr size_t WS_WOUT = WS_WUP + (size_t)2 * 1536 * 384 * 2;
constexpr size_t WS_W1 = WS_WOUT + (size_t)2 * 1024 * 1024 * 2;
constexpr size_t WS_W2 = WS_W1 + (size_t)2 * 16 * 2048 * 1024 * 2;
constexpr size_t WS_HB = WS_W2 + (size_t)2 * 16 * 1024 * 1024 * 2;
constexpr size_t WS_CTXF = WS_HB + (size_t)R * 1024 * 2;
constexpr size_t WS_SSQ = WS_CTXF + (size_t)CTXR * 1024 * 4;
constexpr size_t WS_AFFL = WS_SSQ + (size_t)R * 8 * 4;
constexpr size_t WS_AFFC = WS_AFFL + (size_t)NB * 16 * 4096 * 4;
constexpr size_t WS_GIDX = WS_AFFC + (size_t)NB * 16 * 256 * 4;
constexpr size_t WS_GATE = WS_GIDX + (size_t)MOE_ROWS * 4;
constexpr size_t WS_INV = WS_GATE + (size_t)MOE_ROWS * 4;
constexpr size_t WS_Z = al256(WS_INV + (size_t)R * 16 * 4);
constexpr size_t Z_QA = WS_Z, Z_KA = Z_QA + (size_t)R * 384 * 2, Z_VA = Z_KA + (size_t)R * 128 * 2, Z_QC = Z_VA + (size_t)R * 128 * 2, Z_KC = Z_QC + (size_t)R * 256 * 2,
                 Z_VC = Z_KC + (size_t)R * 128 * 2, Z_CRAW = Z_VC + (size_t)R * 128 * 2, Z_QB = Z_CRAW + (size_t)R * 384 * 2, Z_KB = Z_QB + (size_t)R * 576 * 2,
                 Z_VB = Z_KB + (size_t)R * 576 * 2, Z_OB = Z_VB + (size_t)R * 384 * 2, Z_END1 = Z_OB + (size_t)R * 1024 * 2;
constexpr size_t VT_TILE = 4096, VT_HEAD = 68 * VT_TILE;
constexpr size_t Z_HID = WS_Z, Z_YE = Z_HID + (size_t)MOE_ROWS * 1024 * 2, Z_END2 = Z_YE + (size_t)MOE_ROWS * 1024 * 2;
constexpr size_t WS_END = al256(Z_END1 > Z_END2 ? Z_END1 : Z_END2);
constexpr int CW_BAR = 1024;
constexpr int CW_QUEUE = 8192;

DI int vt_pos(int k) { return ((k & 4) << 3) | ((k & 32) >> 1) | ((k & 24) >> 1) | (k & 3); }
constexpr int RING_BYTES = 131072;
constexpr int LDS_TAB64 = RING_BYTES, LDS_TAB32 = LDS_TAB64 + 8192, LDS_MISC = LDS_TAB32 + 4096;
constexpr int LDS_INTAB = LDS_MISC + 256;
constexpr int LDS_BYTES = 147456;

#define XB_TMO      128
#define XB_XCNT(j)  (256  + 64 * (j))
#define XB_XSUB(j)  (1280 + 64 * (j))
#define XB_XGEN(j)  (2304 + 64 * (j))
#define XB_TOP      3328
#define XB_TOPGEN   3392
#define XCD_BAR_WORDS 3456
#define XB_SPIN_CAP (1u << 20)
DI unsigned xb_ld(unsigned* p)              { return __hip_atomic_load(p, __ATOMIC_RELAXED, __HIP_MEMORY_SCOPE_AGENT); }
DI unsigned xb_add(unsigned* p, unsigned v) { return __hip_atomic_fetch_add(p, v, __ATOMIC_RELAXED, __HIP_MEMORY_SCOPE_AGENT); }
DI unsigned xb_xcc_id() { return (unsigned)__builtin_amdgcn_s_getreg((3 << 11) | 20) & 0xFu; }
#define XB_SPIN(cond, bar) do { unsigned _sp = 0; while (cond) { __builtin_amdgcn_s_sleep(1); \
    if ((++_sp & 255u) == 0u) { if (xb_ld(&(bar)[XB_TMO])) break; if (_sp > XB_SPIN_CAP) { atomicAdd(&(bar)[XB_TMO], 1u); break; } } } } while (0)
struct XcdBarrier { unsigned* bar; unsigned x; volatile LAS unsigned* st; };
DI XcdBarrier xcd_barrier_post(unsigned* bar, volatile LAS unsigned* st) {
    XcdBarrier b; b.bar = bar; b.x = xb_xcc_id(); b.st = st;
    if (threadIdx.x == 0) (void)xb_add(&bar[XB_XCNT(b.x)], 1u);
    return b;
}
DI void xcd_barrier_complete(unsigned* bar, unsigned x, unsigned& nloc, unsigned& nx) {
    asm volatile("" : "+s"(x));
    const unsigned G = gridDim.x * gridDim.y * gridDim.z;
    unsigned sum, cnt, mine, sp = 0u;
    for (;;) {
        sum = 0u; cnt = 0u; mine = 0u;
#pragma unroll
        for (unsigned j = 0; j < 16; ++j) { const unsigned c = xb_ld(&bar[XB_XCNT(j)]); sum += c; cnt += (c > 0u) ? 1u : 0u; mine = (j == x) ? c : mine; }
        if (sum == G) break;
        __builtin_amdgcn_s_sleep(1);
        if ((++sp & 255u) == 0u) { if (xb_ld(&bar[XB_TMO])) break; if (sp > XB_SPIN_CAP) { atomicAdd(&bar[XB_TMO], 1u); break; } }
    }
    nloc = mine > 0u ? mine : 1u; nx = cnt > 0u ? cnt : 1u;
}
DI void xcd_barrier(const XcdBarrier& b) {
    asm volatile("s_waitcnt vmcnt(0)" ::: "memory");
    __syncthreads();
    if (threadIdx.x == 0) {
        unsigned* bar = b.bar; asm volatile("" : "+s"(bar));
        __builtin_amdgcn_s_waitcnt(0);
        unsigned nloc = b.st[0], nx = b.st[1];
        if (nloc == 0u) { xcd_barrier_complete(bar, b.x, nloc, nx); b.st[0] = nloc; b.st[1] = nx; }
        const unsigned old = xb_add(&bar[XB_XSUB(b.x)], 1u);
        const unsigned gen = old / nloc;
        if (old + 1u == (gen + 1u) * nloc) {
            __builtin_amdgcn_fence(__ATOMIC_RELEASE, "agent");
            asm volatile("s_waitcnt vmcnt(0)" ::: "memory");
            const unsigned og = xb_add(&bar[XB_TOP], 1u);
            const unsigned tg = og / nx;
            if (og + 1u == (tg + 1u) * nx) xb_add(&bar[XB_TOPGEN], 1u);
            else XB_SPIN(xb_ld(&bar[XB_TOPGEN]) == tg, bar);
            __builtin_amdgcn_fence(__ATOMIC_ACQUIRE, "agent");
            xb_add(&bar[XB_XGEN(b.x)], 1u);
            asm volatile("s_waitcnt vmcnt(0)" ::: "memory");
        } else {
            XB_SPIN(xb_ld(&bar[XB_XGEN(b.x)]) == gen, bar);
            __builtin_amdgcn_fence(__ATOMIC_ACQUIRE, "agent");
            asm volatile("s_waitcnt vmcnt(0)" ::: "memory");
        }
    }
    __syncthreads();
}

struct Args { const float* in[27]; float* out; unsigned char* ws; int ph_lo, ph_hi, li, pad; };
struct Frame {
    LAS unsigned char* lds; unsigned char* ws; unsigned* ctl;
    int tid, lane, wave, G, bid;
    const LAS unsigned long long* intab; float* out;
};
DI const float* inp(const LAS unsigned long long* tab, int k) { const unsigned long long v = tab[k]; const unsigned lo = __builtin_amdgcn_readfirstlane((unsigned)v), hi = __builtin_amdgcn_readfirstlane((unsigned)(v >> 32)); return (const float*)(const GAS float*)(((unsigned long long)hi << 32) | lo); }
#define INP(k) inp(F.intab, k)
#define WSP(T, off) ((T*)(F.ws + (off)))

DI void mod_item(const Frame& F, int item, const LAS float* s9, LAS float* red) {
    const int l = item / 96, c0 = (item % 96) * 64;
    const float* W = INP(4) + (size_t)l * 1024 * 6144 + c0;
    const int cg = F.lane & 15, ks = F.wave * 4 + (F.lane >> 4);
    f32x4 acc[9];
#pragma unroll
    for (int r = 0; r < 9; ++r) acc[r] = (f32x4){0.f, 0.f, 0.f, 0.f};
#pragma unroll 4
    for (int i = 0; i < 32; ++i) { const int k = ks + 32 * i; const f32x4 w = *(const f32x4*)(W + (size_t)k * 6144 + cg * 4);
#pragma unroll
        for (int r = 0; r < 9; ++r) acc[r] += w * s9[r * 1024 + k]; }
#pragma unroll
    for (int r = 0; r < 9; ++r)
#pragma unroll
        for (int j = 0; j < 4; ++j) { acc[r][j] = add_xor32(add_xor16(acc[r][j])); }
    __syncthreads();
    if (F.lane < 16) {
#pragma unroll
        for (int r = 0; r < 9; ++r) *(LAS f32x4*)(red + (F.wave * 9 + r) * 64 + cg * 4) = acc[r]; }
    __syncthreads();
    for (int e = F.tid; e < 9 * 64; e += NTHR) { const int r = e / 64, c = e % 64; float s = 0.f;
#pragma unroll
        for (int w = 0; w < 8; ++w) s += red[(w * 9 + r) * 64 + c];
        WSP(float, WS_MOD)[((size_t)l * 9 + r) * 6144 + c0 + c] = s + INP(5)[l * 6144 + c0 + c]; }
}

DI void cv_block(const float* src  , int ld, const float* ksc, bf16_t* drow  ) {
#pragma unroll
    for (int kc = 0; kc < 8; ++kc) {
        float v[8];
#pragma unroll
        for (int j = 0; j < 8; ++j) v[j] = src ? src[(size_t)(kc * 8 + j) * ld] : 0.f;
        if (ksc) {
#pragma unroll
            for (int j = 0; j < 8; ++j) v[j] *= ksc[kc * 8 + j]; }
        u32x4 o; o.x = cvt_pk(v[0], v[1]); o.y = cvt_pk(v[2], v[3]); o.z = cvt_pk(v[4], v[5]); o.w = cvt_pk(v[6], v[7]);
        *(u32x4*)(drow + kc * 8) = o;
    }
}
DI void cv_block_fp8(const float* src, int ld, unsigned char* drow) {
    float v[64];
#pragma unroll
    for (int j = 0; j < 64; ++j) v[j] = src[(size_t)j * ld];
#pragma unroll
    for (int kc = 0; kc < 4; ++kc) {
        u32x4 o;
        { int w = __builtin_amdgcn_cvt_pk_fp8_f32(v[16 * kc + 0] * 64.f, v[16 * kc + 1] * 64.f, 0, false); w = __builtin_amdgcn_cvt_pk_fp8_f32(v[16 * kc + 2] * 64.f, v[16 * kc + 3] * 64.f, w, true); o.x = (unsigned)w; }
        { int w = __builtin_amdgcn_cvt_pk_fp8_f32(v[16 * kc + 4] * 64.f, v[16 * kc + 5] * 64.f, 0, false); w = __builtin_amdgcn_cvt_pk_fp8_f32(v[16 * kc + 6] * 64.f, v[16 * kc + 7] * 64.f, w, true); o.y = (unsigned)w; }
        { int w = __builtin_amdgcn_cvt_pk_fp8_f32(v[16 * kc + 8] * 64.f, v[16 * kc + 9] * 64.f, 0, false); w = __builtin_amdgcn_cvt_pk_fp8_f32(v[16 * kc + 10] * 64.f, v[16 * kc + 11] * 64.f, w, true); o.z = (unsigned)w; }
        { int w = __builtin_amdgcn_cvt_pk_fp8_f32(v[16 * kc + 12] * 64.f, v[16 * kc + 13] * 64.f, 0, false); w = __builtin_amdgcn_cvt_pk_fp8_f32(v[16 * kc + 14] * 64.f, v[16 * kc + 15] * 64.f, w, true); o.w = (unsigned)w; }
        *(u32x4*)(drow + kc * 16) = o;
    }
}
constexpr int CV_WIN = 384, CV_WUP = 144, CV_WOUT = 256, CV_W1 = 8192, CV_W2 = 4096, CV_LAYER = CV_WIN + CV_WUP + CV_WOUT + CV_W1 + CV_W2;
DI void conv_item(const Frame& F, int it) {
    const int l = it / CV_LAYER; int r = it % CV_LAYER; const int lane = F.lane, hl = lane >> 5, ll = lane & 31;
    if (r < CV_WIN) {
        const int kb = r / 24, g = (r % 24) * 2 + hl, x = ((g >> 3) * 4 + (g & 3)) * 64 + 32 * ((g >> 2) & 1) + ll;
        const int sc = x < 960 ? x : (x < 1472 ? x + 32 : (x < 1504 ? x - 512 : -1));
        const float* src = sc < 0 ? nullptr : INP(8) + (size_t)l * 1024 * 1504 + (size_t)(kb * 64) * 1504 + sc;
        unsigned char* drow = WSP(unsigned char, WS_WIN) + (size_t)l * 1536 * 1024 + (size_t)((r % 24) * 64 + lane) * 1024 + kb * 64;
        if (__builtin_amdgcn_readfirstlane(sc < 0 ? 1 : 0) | __any(sc < 0)) { const float* s2 = sc < 0 ? INP(8) : src; cv_block_fp8(s2, sc < 0 ? 0 : 1504, drow);
            if (sc < 0) {
#pragma unroll
                for (int kc = 0; kc < 4; ++kc) *(u32x4*)(drow + kc * 16) = (u32x4){0u, 0u, 0u, 0u}; } }
        else cv_block_fp8(src, 1504, drow);
        return; }
    r -= CV_WIN;
    if (r < CV_WUP) {
        const int kb = r / 24, g = (r % 24) * 2 + hl, slot = (g >> 3) * 4 + (g & 3), half = (g >> 2) & 1;
        const float* src = nullptr; const float* ksc = nullptr; int ld = 0;
        if (slot < 9 && kb < 3) { const int col = slot < 6 ? slot * 96 + 32 * half : (2 * (slot - 6) + half) * 96 + 64;
            src = INP(13) + (size_t)l * 192 * 576 + (size_t)(kb * 64) * 576 + col + ll; ld = 576; ksc = INP(11) + l * 192 + kb * 64; }
        else if (slot >= 12 && (kb == 3 || kb == 4)) { const int h = slot < 18 ? slot - 12 : slot - 18; const int col = h * 128 + (slot < 18 ? 0 : 64) + 32 * half;
            src = INP(14) + (size_t)l * 128 * 768 + (size_t)((kb - 3) * 64) * 768 + col + ll; ld = 768; ksc = INP(12) + l * 128 + (kb - 3) * 64; }
        cv_block(src, ld, ksc, WSP(bf16_t, WS_WUP) + (size_t)l * 1536 * 384 + (size_t)((r % 24) * 64 + lane) * 384 + kb * 64); return; }
    r -= CV_WUP;
    if (r < CV_WOUT) { const int kb = r / 16, g = r % 16;
        cv_block(INP(22) + (size_t)l * 1024 * 1024 + (size_t)(kb * 64) * 1024 + g * 64 + lane, 1024, nullptr, WSP(bf16_t, WS_WOUT) + (size_t)l * 1024 * 1024 + (size_t)(g * 64 + lane) * 1024 + kb * 64); return; }
    r -= CV_WOUT;
    if (r < CV_W1) { const int e = r / 512, q = r % 512, kb = q / 32, g = (q % 32) * 2 + hl, pn = g >> 3, bj = (g >> 2) & 1, wc = g & 3;
        const float* src = (bj ? INP(25) : INP(24)) + ((size_t)l * 16 + e) * 1024 * 1024 + (size_t)(kb * 64) * 1024 + 128 * pn + 32 * wc + ll;
        cv_block_fp8(src, 1024, WSP(unsigned char, WS_W1) + ((size_t)l * 16 + e) * 2048 * 1024 + (size_t)((q % 32) * 64 + lane) * 1024 + kb * 64); return; }
    r -= CV_W1;
    { const int e = r / 256, q = r % 256, kb = q / 16, g = q % 16;
        cv_block_fp8(INP(26) + ((size_t)l * 16 + e) * 1024 * 1024 + (size_t)(kb * 64) * 1024 + g * 64 + lane, 1024, WSP(unsigned char, WS_W2) + ((size_t)l * 16 + e) * 1024 * 1024 + (size_t)(g * 64 + lane) * 1024 + kb * 64); }
}
DI void p0_phase(const Frame& F) {
    LAS float* s9 = (LAS float*)F.lds;
    LAS float* red = (LAS float*)(F.lds + 9 * 1024 * 4);
    if (F.bid == 0) {
        for (int i = F.tid; i < 64 * 16; i += NTHR) { const int pos = i / 16, f = i % 16; const float inv = exp2f(-(float)(2 * f) / 32.f * 13.287712379549449f); const float a = (float)pos * inv; WSP(f32x2, WS_TAB64)[i] = (f32x2){cosf(a), sinf(a)}; }
        for (int i = F.tid; i < 64 * 8; i += NTHR) { const int pos = i / 8, f = i % 8; const float inv = exp2f(-(float)(2 * f) / 16.f * 13.287712379549449f); const float a = (float)pos * inv; WSP(f32x2, WS_TAB32)[i] = (f32x2){cosf(a), sinf(a)}; }
    }
    bool have_s9 = false;
    for (int it = F.bid; it < 192; it += F.G) {
        if (!have_s9) { for (int e = F.tid; e < 9 * 1024; e += NTHR) { const int r = e / 1024, k = e % 1024; const float v = r < 8 ? INP(1)[r * 1024 + k] : INP(3)[k]; s9[e] = silu_f(v); } have_s9 = true; __syncthreads(); }
        mod_item(F, it, s9, red);
    }
    __syncthreads();
    const int gw = F.bid * NWAVES + F.wave, NGW = F.G * NWAVES;
    for (int it = gw; it < 2 * CV_LAYER; it += NGW) conv_item(F, it);
}

DI unsigned pk_fp8q(float a, float b, float c, float d) { int w = __builtin_amdgcn_cvt_pk_fp8_f32(a, b, 0, false); w = __builtin_amdgcn_cvt_pk_fp8_f32(c, d, w, true); return (unsigned)w; }
DI void norm_mod_store(const f32x4 (&v)[4], const float* g, const float* sh, const float* sc, unsigned char* orow  , int lane) {
    float s = 0.f;
#pragma unroll
    for (int j = 0; j < 4; ++j) s += (v[j].x * v[j].x + v[j].y * v[j].y) + (v[j].z * v[j].z + v[j].w * v[j].w);
    const float rstd = 1.0f / sqrtf(wave_sum(s) * (1.f / 1024.f) + EPS);
#pragma unroll
    for (int j = 0; j < 4; ++j) { const int c = 4 * (lane + 64 * j); const f32x4 gv = *(const f32x4*)(g + c), sv = *(const f32x4*)(sh + c), cv = *(const f32x4*)(sc + c);
        const f32x4 o = v[j] * rstd * gv * (cv + 1.0f) + sv; *(unsigned*)(orow + c) = pk_fp8q(o.x, o.y, o.z, o.w); }
}
DI const float* mod_row(const Frame& F, int l, int row) { const int r = row < LAT ? row / 4096 : 8; return WSP(float, WS_MOD) + ((size_t)l * 9 + r) * 6144; }
DI void norm_mod_store_r(const f32x4 (&v)[4], const f32x4 (&gc)[4], const f32x4 (&sv)[4], unsigned char* orow  , int lane) {
    float s = 0.f;
#pragma unroll
    for (int j = 0; j < 4; ++j) s += (v[j].x * v[j].x + v[j].y * v[j].y) + (v[j].z * v[j].z + v[j].w * v[j].w);
    const float rstd = 1.0f / sqrtf(wave_sum(s) * (1.f / 1024.f) + EPS);
#pragma unroll
    for (int j = 0; j < 4; ++j) { const f32x4 o = v[j] * rstd * gc[j] + sv[j]; *(unsigned*)(orow + 4 * (lane + 64 * j)) = pk_fp8q(o.x, o.y, o.z, o.w); }
}
DI void load_mod(const float* g, const float* sh, const float* sc, f32x4 (&gc)[4], f32x4 (&sv)[4], int lane) {
#pragma unroll
    for (int j = 0; j < 4; ++j) { const int c = 4 * (lane + 64 * j); gc[j] = *(const f32x4*)(g + c) * (*(const f32x4*)(sc + c) + 1.0f); sv[j] = *(const f32x4*)(sh + c); }
}
DI int cond_of_row(int row) { return row < LAT ? row / 4096 : 8; }
DI void init_norm_phase(const Frame& F) {
    const int gw = F.bid * NWAVES + F.wave, NGW = F.G * NWAVES, per = (R + NGW - 1) / NGW, r0 = gw * per, r1 = r0 + per < R ? r0 + per : R;
    auto rowptr = [&](int row) -> const float* { return row < LAT ? INP(0) + (size_t)row * 1024 : INP(2) + (size_t)(row - LAT) * 1024; };
    f32x4 vn[4], gc[4], sv[4]; int curb = -1;
    if (r0 < r1) { const float* x0 = rowptr(r0);
#pragma unroll
        for (int j = 0; j < 4; ++j) vn[j] = *(const f32x4*)(x0 + 4 * (F.lane + 64 * j)); }
    for (int row = r0; row < r1; ++row) {
        f32x4 v[4];
#pragma unroll
        for (int j = 0; j < 4; ++j) v[j] = vn[j];
        if (row + 1 < r1) { const float* x1 = rowptr(row + 1);
#pragma unroll
            for (int j = 0; j < 4; ++j) vn[j] = *(const f32x4*)(x1 + 4 * (F.lane + 64 * j)); }
        const int cb = cond_of_row(row);
        if (cb != curb) { const float* m = mod_row(F, 0, row); load_mod(INP(6), m, m + 1024, gc, sv, F.lane); curb = cb; }
        norm_mod_store_r(v, gc, sv, WSP(unsigned char, WS_HB) + (size_t)row * 1024, F.lane);
    }
}
namespace g8 {
constexpr int BM = 256, BK = 64, HALF = 128, HTB = HALF * BK * 2, STAGE_BYTES = 8 * HTB;
DI int lds_byte(int r, int c) { const int st = (r >> 4) * 2 + (c >> 5), rr = r & 15, cc = c & 31, ob = rr * 64 + cc * 2; return st * 1024 + (ob ^ (((ob >> 9) & 1) << 5)); }
DI void stage_rc(int b, int& Rr, int& Cc) { const int st = b / 1024, sb = b % 1024, swz = sb ^ (((sb >> 9) & 1) << 5); Rr = (st >> 1) * 16 + swz / 64; Cc = (st & 1) * 32 + (swz % 64) / 2; }
DI int perm32(int rho) { const int n = rho >> 4, i = rho & 15; return 8 * (i >> 2) + 4 * n + (i & 3); }

typedef int i32x4 __attribute__((ext_vector_type(4)));
typedef int i32x8 __attribute__((ext_vector_type(8)));
struct Unit { int pm, pn, aux, kt0, nt; const char* Bp; };

template <class Epi, class Sched>
DI void gemm_phase(const int tid, LAS unsigned char* lds, const char* Abase, int K, const Sched& S, const Epi& E) {
    asm volatile("" : "+s"(K));
    const int wid = __builtin_amdgcn_readfirstlane(tid >> 6), lane = tid & 63, wr = wid >> 2, wc = wid & 3, fr = lane & 15, fq = lane >> 4;
    int Rr[2], Cc[2]; unsigned voffB[2];
#pragma unroll
    for (int i = 0; i < 2; ++i) { int r_, c_; stage_rc(tid * 16 + i * 8192, r_, c_); Rr[i] = r_; Cc[i] = c_; const int Rb = Epi::PERM ? ((r_ & ~31) + perm32(r_ & 31)) : r_; voffB[i] = (unsigned)(Rb * K + c_) * 2u; }
    const size_t hstepB = (size_t)HALF * K * 2;
    const unsigned ldsw = (unsigned)wid * 1024u;
    const int aoff = lds_byte(wr * 64 + fr, fq * 8), boff = lds_byte(wc * 32 + fr, fq * 8);
#define G8_SA(b, h) (((b) * 2 + (h)) * HTB)
#define G8_SB(b, h) ((4 + (b) * 2 + (h)) * HTB)
#define G8_STAGE_A(bufoff, ao2, kt) do { _Pragma("unroll") for (int _i = 0; _i < 2; ++_i) \
        __builtin_amdgcn_global_load_lds((const unsigned*)(Abase + (size_t)(ao2)[_i] + (size_t)(kt) * 128), (LAS unsigned*)(lds + (bufoff) + ldsw + _i * 8192), 16, 0, 0); } while (0)
#define G8_STAGE_B(bufoff, bp, h, kt) do { _Pragma("unroll") for (int _i = 0; _i < 2; ++_i) \
        __builtin_amdgcn_global_load_lds((const unsigned*)((bp) + (size_t)(h) * hstepB + voffB[_i] + (size_t)(kt) * 128), (LAS unsigned*)(lds + (bufoff) + ldsw + _i * 8192), 16, 0, 0); } while (0)
#define G8_LD16(off) (*(const LAS i32x4*)(lds + (off)))
#define G8_LDA(dst, b, h) do { _Pragma("unroll") for (int m = 0; m < 4; ++m) { const i32x4 lo_ = G8_LD16(G8_SA(b, h) + aoff + m * 2048), hi_ = G8_LD16(G8_SA(b, h) + aoff + m * 2048 + 1024); dst[m] = __builtin_shufflevector(lo_, hi_, 0, 1, 2, 3, 4, 5, 6, 7); } } while (0)
#define G8_LDB(dst, b, h) do { _Pragma("unroll") for (int n = 0; n < 2; ++n) { const i32x4 lo_ = G8_LD16(G8_SB(b, h) + boff + n * 2048), hi_ = G8_LD16(G8_SB(b, h) + boff + n * 2048 + 1024); dst[n] = __builtin_shufflevector(lo_, hi_, 0, 1, 2, 3, 4, 5, 6, 7); } } while (0)
#define G8_HALF(v, k) __builtin_bit_cast(bf16x8, __builtin_shufflevector((v), (v), 4 * (k), 4 * (k) + 1, 4 * (k) + 2, 4 * (k) + 3))
#define G8_MMA(ai, bj, At, Bt) do { __builtin_amdgcn_s_setprio(1); _Pragma("unroll") for (int m = 0; m < 4; ++m) _Pragma("unroll") for (int n = 0; n < 2; ++n) { \
        if constexpr (Epi::FP8) asm volatile("v_mfma_scale_f32_16x16x128_f8f6f4 %0, %1, %2, %0, %3, %3 op_sel_hi:[0,0,0]" : "+v"(acc[ai][bj][m][n]) : "v"(Bt[n]), "v"(At[m]), "v"(fp8_scale)); \
        else { acc[ai][bj][m][n] = __builtin_amdgcn_mfma_f32_16x16x32_bf16(G8_HALF(Bt[n], 0), G8_HALF(At[m], 0), acc[ai][bj][m][n], 0, 0, 0); \
               acc[ai][bj][m][n] = __builtin_amdgcn_mfma_f32_16x16x32_bf16(G8_HALF(Bt[n], 1), G8_HALF(At[m], 1), acc[ai][bj][m][n], 0, 0, 0); } } __builtin_amdgcn_s_setprio(0); } while (0)
#define G8_WAIT_V(n) asm volatile("s_waitcnt vmcnt(" #n ")" ::: "memory")
#define G8_WAIT_L(n) asm volatile("s_waitcnt lgkmcnt(" #n ")" ::: "memory")
#define G8_BAR __builtin_amdgcn_s_barrier()
#define G8_SCHED __builtin_amdgcn_sched_barrier(0)
    const int fp8_scale = 0x7F7F7F7F;
    Unit cur, nxt; int ui = 0;
    if (!S.next(0, cur)) return;
    unsigned aoc[2][2], aon[2][2];
    S.aoffs(cur, Rr, Cc, aoc);
    f32x4 acc[2][2][4][2];
#pragma unroll
    for (int a = 0; a < 2; ++a)
#pragma unroll
        for (int b = 0; b < 2; ++b)
#pragma unroll
            for (int m = 0; m < 4; ++m)
#pragma unroll
                for (int n = 0; n < 2; ++n) acc[a][b][m][n] = (f32x4){0.f, 0.f, 0.f, 0.f};
    i32x8 At[4], B0[2], B1[2];
    const char* cB = cur.Bp;
    G8_STAGE_B(G8_SB(0, 0), cB, 0, 0); G8_STAGE_B(G8_SB(0, 1), cB, 1, 0); G8_STAGE_A(G8_SA(0, 0), aoc[0], 0); G8_STAGE_A(G8_SA(0, 1), aoc[1], 0);
    if (wr == 1) G8_BAR;
    G8_WAIT_V(2); G8_BAR;
    G8_STAGE_B(G8_SB(1, 0), cB, 0, 1); G8_STAGE_A(G8_SA(1, 0), aoc[0], 1); G8_STAGE_B(G8_SB(1, 1), cB, 1, 1);
    G8_WAIT_V(6); G8_BAR;
    for (;;) {
        const bool has_next = S.next(ui + 1, nxt);
        if (has_next) S.aoffs(nxt, Rr, Cc, aon);
        else {
#pragma unroll
            for (int h = 0; h < 2; ++h)
#pragma unroll
                for (int i = 0; i < 2; ++i) aon[h][i] = aoc[h][i]; }
        const char* nB = has_next ? nxt.Bp : cB;
        const int nt = cur.nt;
        for (int t = 0; t < nt; t += 2) {
            const bool last = (t == nt - 2);
            unsigned a2[2][2];
#pragma unroll
            for (int h = 0; h < 2; ++h)
#pragma unroll
                for (int i = 0; i < 2; ++i) a2[h][i] = last ? aon[h][i] : aoc[h][i];
            const int kt2 = last ? 0 : t + 2; const char* b2 = last ? nB : cB;
            G8_LDB(B0, 0, 0); G8_LDB(B1, 0, 1); G8_SCHED; G8_LDA(At, 0, 0); G8_STAGE_A(G8_SA(1, 1), aoc[1], t + 1);
            G8_WAIT_V(8); G8_WAIT_L(0); G8_BAR; G8_MMA(0, 0, At, B0); G8_MMA(0, 1, At, B1); G8_BAR; G8_SCHED;
            G8_LDA(At, 0, 1); G8_STAGE_B(G8_SB(0, 0), b2, 0, kt2); G8_STAGE_B(G8_SB(0, 1), b2, 1, kt2); G8_STAGE_A(G8_SA(0, 0), a2[0], kt2);
            G8_WAIT_V(8); G8_WAIT_L(0); G8_BAR; G8_MMA(1, 0, At, B0); G8_MMA(1, 1, At, B1); G8_BAR; G8_SCHED;
            G8_LDB(B0, 1, 0); G8_LDB(B1, 1, 1); G8_SCHED; G8_LDA(At, 1, 0); G8_STAGE_A(G8_SA(0, 1), a2[1], kt2);
            G8_WAIT_V(8); G8_WAIT_L(0); G8_BAR; G8_MMA(0, 0, At, B0); G8_MMA(0, 1, At, B1); G8_BAR; G8_SCHED;
            G8_LDA(At, 1, 1); G8_STAGE_B(G8_SB(1, 0), b2, 0, kt2 + 1); G8_STAGE_B(G8_SB(1, 1), b2, 1, kt2 + 1); G8_STAGE_A(G8_SA(1, 0), a2[0], kt2 + 1);
            G8_WAIT_V(8); G8_WAIT_L(0); G8_BAR; G8_MMA(1, 0, At, B0); G8_MMA(1, 1, At, B1); G8_BAR; G8_SCHED;
        }
        if (wr == 0) G8_BAR;
        if constexpr (Epi::FP8) asm volatile("s_nop 15\n\ts_nop 15" ::: "memory");
        E(acc, cur, wr, wc, fr, fq);
        if (!has_next) break;
#pragma unroll
        for (int a = 0; a < 2; ++a)
#pragma unroll
            for (int b = 0; b < 2; ++b)
#pragma unroll
                for (int m = 0; m < 4; ++m)
#pragma unroll
                    for (int n = 0; n < 2; ++n) acc[a][b][m][n] = (f32x4){0.f, 0.f, 0.f, 0.f};
        cur = nxt; cB = nB;
#pragma unroll
        for (int h = 0; h < 2; ++h)
#pragma unroll
            for (int i = 0; i < 2; ++i) aoc[h][i] = aon[h][i];
        ++ui;
        if (wr == 1) G8_BAR;
    }
    G8_WAIT_V(0);
    G8_BAR;
#undef G8_SA
#undef G8_SB
#undef G8_STAGE_A
#undef G8_STAGE_B
#undef G8_LDA
#undef G8_LDB
#undef G8_MMA
#undef G8_HALF
#undef G8_LD16
#undef G8_WAIT_V
#undef G8_WAIT_L
#undef G8_BAR
#undef G8_SCHED
}

struct DenseSched {
    int nM, nN, nwg, G, c, K; const char* Bt; bool split3;
    DI void init(int nM_, int nN_, int G_, int c_, int K_, const void* Bt_, bool split3_ = false) { nM = nM_; nN = nN_; nwg = nM * nN; G = G_; c = c_; K = K_; Bt = (const char*)Bt_; split3 = split3_; }
    DI bool next(int i, Unit& u) const {
        const long L = (long)i * G + c; if (L >= nwg) return false;
        int wgid = (int)L; { const int q = nwg / 8, r = nwg % 8, xcd = wgid % 8, off = wgid / 8; wgid = (xcd < r ? xcd * (q + 1) : r * (q + 1) + (xcd - r) * q) + off; }
        const int WGM = 8, nig = WGM * nN, gid = wgid / nig, fm = gid * WGM, gsz = (nM - fm) < WGM ? (nM - fm) : WGM;
        u.pm = fm + ((wgid % nig) % gsz); u.pn = (wgid % nig) / gsz; u.aux = 0; u.kt0 = 0; u.nt = K / 64;
        if (split3) { if (u.pn < 3) { u.nt = 4; } else { u.kt0 = 3; u.nt = 2; } }
        u.Bp = Bt + (size_t)u.pn * 256 * K * 2 + u.kt0 * 128; return true;
    }
    DI void aoffs(const Unit& u, const int (&Rr)[2], const int (&Cc)[2], unsigned (&ao)[2][2]) const {
#pragma unroll
        for (int h = 0; h < 2; ++h)
#pragma unroll
            for (int i = 0; i < 2; ++i) ao[h][i] = (unsigned)(((size_t)(u.pm * 256 + h * 128 + Rr[i]) * K + Cc[i]) * 2 + u.kt0 * 128);
    }
};
template <bool GATHER>
struct MoeSched {
    int nN, tiles_per_e, nwg, G, c, K, NBt; const char* Bt; size_t estride; const int* gidx; bool with_ctx;
    DI void init(int nN_, bool with_ctx_, int G_, int c_, int K_, const void* Bt_, size_t estride_, const int* gidx_) {
        nN = nN_; with_ctx = with_ctx_; tiles_per_e = NB * 2 + (with_ctx_ ? 1 : 0); nwg = 16 * tiles_per_e * nN; G = G_; c = c_; K = K_; Bt = (const char*)Bt_; estride = estride_; gidx = gidx_; }
    DI bool next(int i, Unit& u) const {
        int mt;
        if (G % (8 * nN) == 0) {
            const int per = (G / 8) / nN, xcd = c & 7, j8 = c >> 3; mt = (i * 8 + xcd) * per + j8 / nN; u.pn = j8 % nN; if (mt >= 16 * tiles_per_e) return false;
        } else { const long L = (long)i * G + c; if (L >= nwg) return false; mt = (int)L / nN; u.pn = (int)L % nN; }
        const int e = mt / tiles_per_e, j = mt % tiles_per_e;
        const int rowbase = j < NB * 2 ? ((j >> 1) * 16 + e) * 512 + (j & 1) * 256 : MOE_LAT + e * 256;
        u.pm = rowbase / 256; u.aux = e; u.kt0 = 0; u.nt = K / 64; u.Bp = Bt + (size_t)e * estride + (size_t)u.pn * 256 * K * 2; return true;
    }
    DI void aoffs(const Unit& u, const int (&Rr)[2], const int (&Cc)[2], unsigned (&ao)[2][2]) const {
#pragma unroll
        for (int h = 0; h < 2; ++h)
#pragma unroll
            for (int i = 0; i < 2; ++i) { const int mrow = u.pm * 256 + h * 128 + Rr[i]; const int arow = GATHER ? gidx[mrow] : mrow; ao[h][i] = (unsigned)(((size_t)arow * K + Cc[i]) * 2); }
    }
};
}

typedef f32x4 Acc[2][2][4][2];
DI unsigned pk_fp8x4(float a, float b, float c, float d) { int w = __builtin_amdgcn_cvt_pk_fp8_f32(a, b, 0, false); w = __builtin_amdgcn_cvt_pk_fp8_f32(c, d, w, true); return (unsigned)w; }
DI unsigned pk_fp8v(const f32x4 v) { return pk_fp8x4(v.x, v.y, v.z, v.w); }
DI void st_bf16x4(bf16_t* p, const f32x4 v) { u32x2 w; w.x = cvt_pk(v.x, v.y); w.y = cvt_pk(v.z, v.w); *(u32x2*)p = w; }

DI void st_vt4(unsigned char* tile, int d0, int pos, const f32x4 v) { const unsigned w = pk_fp8v(v); unsigned char* p = tile + d0 * 64 + pos;
    p[0] = (unsigned char)w; p[64] = (unsigned char)(w >> 8); p[128] = (unsigned char)(w >> 16); p[192] = (unsigned char)(w >> 24); }
DI size_t vt_tile_of_rowgroup(int row64  ) {
    return row64 < LAT ? (size_t)(row64 / 4096) * 68 + 4 + (row64 % 4096) / 64 : (size_t)((row64 - LAT) / 256) * 68 + ((row64 - LAT) % 256) / 64; }
struct EpiInProj {
    static constexpr bool PERM = false, FP8 = true;
    unsigned char* ws; const LAS unsigned long long* in; int l; const LAS f32x2* tab64; const LAS f32x2* tab32;
    DI void operator()(const Acc& acc, const g8::Unit& u, int wr, int wc, int fr, int fq) const {
        asm volatile("" : "+v"(fr), "+v"(fq));
        constexpr float SC = 1.0f / 64.0f;
        const int slot = 4 * u.pn + wc; const int rowt = u.pm * 256 + wr * 64 + fr; const bool lat = (u.pm * 256) < LAT;
        int kind; bf16_t* dst; int ld, coff; const float* gain = nullptr; float qs = 1.f;
        if (slot < 6)       { kind = 0; dst = (bf16_t*)(ws + Z_QA); ld = 384; coff = slot * 64; gain = inp(in, 9) + l * 64; qs = QF64; }
        else if (slot < 8)  { kind = 0; dst = (bf16_t*)(ws + Z_KA); ld = 128; coff = (slot - 6) * 64; gain = inp(in, 10) + l * 64; }
        else if (slot < 10) { kind = 1; dst = (bf16_t*)(ws + Z_VA); ld = 128; coff = (slot - 8) * 64; }
        else if (slot < 15) { kind = 2; dst = (bf16_t*)(ws + Z_CRAW); ld = 384; coff = (slot - 10) * 64; }
        else if (slot < 19) { kind = 0; dst = (bf16_t*)(ws + Z_QC); ld = 256; coff = (slot - 15) * 64; gain = inp(in, 19) + l * 64; qs = QF64; }
        else if (slot < 21) { kind = 0; dst = (bf16_t*)(ws + Z_KC); ld = 128; coff = (slot - 19) * 64; gain = inp(in, 20) + l * 64; }
        else if (slot < 23) { kind = 1; dst = (bf16_t*)(ws + Z_VC); ld = 128; coff = (slot - 21) * 64; }
        else                { kind = 3; dst = (bf16_t*)(ws + Z_KB); ld = 576; coff = 64; gain = inp(in, 18) + l * 32; }
        if (kind == 0) {
            f32x4 g[2][2];
#pragma unroll
            for (int bj = 0; bj < 2; ++bj)
#pragma unroll
                for (int n = 0; n < 2; ++n) g[bj][n] = *(const f32x4*)(gain + 32 * bj + 16 * n + 4 * fq) * qs;
#pragma unroll
            for (int ai = 0; ai < 2; ++ai)
#pragma unroll
                for (int m = 0; m < 4; ++m) {
                    const int row = rowt + ai * 128 + m * 16; float s = 0.f;
#pragma unroll
                    for (int bj = 0; bj < 2; ++bj)
#pragma unroll
                        for (int n = 0; n < 2; ++n) { const f32x4 x = acc[ai][bj][m][n] * SC; s += (x.x * x.x + x.y * x.y) + (x.z * x.z + x.w * x.w); }
                    s = add_xor32(add_xor16(s));
                    const float rstd = SC / sqrtf(s * (1.f / 64.f) + EPS);
                    const int t = row & 4095, pr = t >> 6, pc = t & 63;
#pragma unroll
                    for (int bj = 0; bj < 2; ++bj) {
                        f32x4 x1 = acc[ai][bj][m][0] * rstd * g[bj][0], x2 = acc[ai][bj][m][1] * rstd * g[bj][1];
                        if (lat) { const LAS f32x2* tb = tab64 + (bj == 0 ? pr : pc) * 16 + 4 * fq; f32x4 o1, o2;
#pragma unroll
                            for (int i = 0; i < 4; ++i) { const f32x2 cs = tb[i]; o1[i] = x1[i] * cs.x - x2[i] * cs.y; o2[i] = x2[i] * cs.x + x1[i] * cs.y; }
                            x1 = o1; x2 = o2; }
                        unsigned char* p = (unsigned char*)dst + (size_t)row * ld + coff + 32 * bj + 4 * fq;
                        *(unsigned*)p = pk_fp8v(x1); *(unsigned*)(p + 16) = pk_fp8v(x2);
                    }
                    asm volatile("" ::: "memory");
                }
        } else if (kind == 1 || kind == 2) {
#pragma unroll
            for (int ai = 0; ai < 2; ++ai)
#pragma unroll
                for (int m = 0; m < 4; ++m) {
                    const int row = rowt + ai * 128 + m * 16; float s = 0.f;
#pragma unroll
                    for (int bj = 0; bj < 2; ++bj)
#pragma unroll
                        for (int n = 0; n < 2; ++n) { const f32x4 x = acc[ai][bj][m][n] * SC; s += (x.x * x.x + x.y * x.y) + (x.z * x.z + x.w * x.w);
                            if (kind == 2) st_bf16x4(dst + (size_t)row * ld + coff + 32 * bj + 16 * n + 4 * fq, x);
                            else { const int row64 = u.pm * 256 + ai * 128 + wr * 64;
                                const size_t bt = vt_tile_of_rowgroup(row64); unsigned char* tile = (unsigned char*)dst + ((bt / 68) * 2 + coff / 64) * VT_HEAD + (bt % 68) * VT_TILE;
                                st_vt4(tile, 32 * bj + 16 * n + 4 * fq, vt_pos(16 * m + fr), x); } }
                    if (kind == 2) { s = add_xor32(add_xor16(s)); if (fq == 0) ((float*)(ws + WS_SSQ))[(size_t)row * 8 + (slot - 10)] = s; }
                }
        } else {
            const f32x4 g0 = *(const f32x4*)(gain + 4 * fq), g1 = *(const f32x4*)(gain + 16 + 4 * fq);
            bf16_t* craw = (bf16_t*)(ws + Z_CRAW);
#pragma unroll
            for (int ai = 0; ai < 2; ++ai)
#pragma unroll
                for (int m = 0; m < 4; ++m) {
                    const int row = rowt + ai * 128 + m * 16;
                    const f32x4 a0 = acc[ai][0][m][0] * SC, a1 = acc[ai][0][m][1] * SC;
                    float s = (a0.x * a0.x + a0.y * a0.y) + (a0.z * a0.z + a0.w * a0.w) + (a1.x * a1.x + a1.y * a1.y) + (a1.z * a1.z + a1.w * a1.w);
                    s = add_xor32(add_xor16(s));
                    const float rstd = 1.0f / sqrtf(s * (1.f / 32.f) + EPS);
                    f32x4 v0 = a0 * rstd * g0, v1 = a1 * rstd * g1;
                    if (lat) { const int t = row & 4095, pr = t >> 6, pc = t & 63;
                        f32x4 p0, p1;
#pragma unroll
                        for (int i = 0; i < 4; ++i) { p0[i] = other32(v0[i], fq >= 2); p1[i] = other32(v1[i], fq >= 2); }
                        const LAS f32x2* t0 = tab32 + pr * 8 + 4 * (fq & 1); const LAS f32x2* t1 = tab32 + pc * 8 + 4 * (fq & 1);
#pragma unroll
                        for (int i = 0; i < 4; ++i) { const f32x2 c0 = t0[i], c1 = t1[i];
                            v0[i] = fq < 2 ? v0[i] * c0.x - p0[i] * c0.y : v0[i] * c0.x + p0[i] * c0.y;
                            v1[i] = fq < 2 ? v1[i] * c1.x - p1[i] * c1.y : v1[i] * c1.x + p1[i] * c1.y; } }
                    const unsigned w0 = pk_fp8v(v0), w1 = pk_fp8v(v1);
#pragma unroll
                    for (int h = 0; h < 6; ++h) { unsigned char* p = (unsigned char*)dst + (size_t)row * 768 + h * 128 + 64 + 4 * fq; *(unsigned*)p = w0; *(unsigned*)(p + 16) = w1; *(unsigned*)(p + 32) = 0u; *(unsigned*)(p + 48) = 0u; }
                    const u32x2 z = {0u, 0u};
#pragma unroll
                    for (int q = 0; q < 4; ++q) *(u32x2*)(craw + (size_t)row * 384 + 320 + 16 * q + 4 * fq) = z;
                    asm volatile("" ::: "memory");
                }
        }
    }
};

struct EpiUpProj {
    static constexpr bool PERM = false, FP8 = false;
    unsigned char* ws; const LAS unsigned long long* in; int l; const LAS f32x2* tab32;
    DI void operator()(const Acc& acc, const g8::Unit& u, int wr, int wc, int fr, int fq) const {
        asm volatile("" : "+v"(fr), "+v"(fq));
        const int slot = 4 * u.pn + wc; if (slot >= 9 && slot < 12) return;
        const int rowt = u.pm * 256 + wr * 64 + fr; const bool lat = (u.pm * 256) < LAT;
        const float* ssq = (const float*)(ws + WS_SSQ);
        bf16_t* qB = (bf16_t*)(ws + Z_QB); bf16_t* kB = (bf16_t*)(ws + Z_KB); bf16_t* vB = (bf16_t*)(ws + Z_VB);
        const bool isq = slot < 9;
#pragma unroll
        for (int ai = 0; ai < 2; ++ai)
#pragma unroll
            for (int m = 0; m < 4; ++m) {
                const int row = rowt + ai * 128 + m * 16;
                const f32x4 sa = *(const f32x4*)(ssq + (size_t)row * 8); const float sb = ssq[(size_t)row * 8 + 4];
                const float r0 = isq ? 1.0f / sqrtf((sa.x + sa.y + sa.z) * (1.f / 192.f) + EPS) : 1.0f / sqrtf((sa.w + sb) * (1.f / 128.f) + EPS);
                if (slot < 6 || (slot >= 12 && slot < 18)) {
                    const float* gain = slot < 6 ? inp(in, 15) + l * 64 : inp(in, 16) + l * 64; const float qs = slot < 6 ? QF96 : 1.f;
                    const int h = slot < 6 ? slot : slot - 12; unsigned char* dst = (unsigned char*)(slot < 6 ? qB : kB) + (size_t)row * 768 + h * 128;
                    float s = 0.f; f32x4 x[2][2];
#pragma unroll
                    for (int bj = 0; bj < 2; ++bj)
#pragma unroll
                        for (int n = 0; n < 2; ++n) { x[bj][n] = acc[ai][bj][m][n] * r0; s += (x[bj][n].x * x[bj][n].x + x[bj][n].y * x[bj][n].y) + (x[bj][n].z * x[bj][n].z + x[bj][n].w * x[bj][n].w); }
                    s = add_xor32(add_xor16(s));
                    const float rstd = qs / sqrtf(s * (1.f / 64.f) + EPS);
#pragma unroll
                    for (int bj = 0; bj < 2; ++bj)
#pragma unroll
                        for (int n = 0; n < 2; ++n) { const int c = 32 * bj + 16 * n + 4 * fq; *(unsigned*)(dst + c) = pk_fp8v(x[bj][n] * rstd * *(const f32x4*)(gain + c)); }
                } else if (slot >= 18) {
                    const int row64 = u.pm * 256 + ai * 128 + wr * 64; const size_t bt = vt_tile_of_rowgroup(row64);
                    unsigned char* tile = (unsigned char*)vB + ((bt / 68) * 6 + (slot - 18)) * VT_HEAD + (bt % 68) * VT_TILE;
#pragma unroll
                    for (int bj = 0; bj < 2; ++bj)
#pragma unroll
                        for (int n = 0; n < 2; ++n) st_vt4(tile, 32 * bj + 16 * n + 4 * fq, vt_pos(16 * m + fr), acc[ai][bj][m][n] * r0);
                } else {
                    const float* gain = inp(in, 17) + l * 32;
#pragma unroll
                    for (int bj = 0; bj < 2; ++bj) {
                        const f32x4 a0 = acc[ai][bj][m][0] * r0, a1 = acc[ai][bj][m][1] * r0;
                        float s = (a0.x * a0.x + a0.y * a0.y) + (a0.z * a0.z + a0.w * a0.w) + (a1.x * a1.x + a1.y * a1.y) + (a1.z * a1.z + a1.w * a1.w);
                        s = add_xor32(add_xor16(s));
                        const float rstd = QF96 / sqrtf(s * (1.f / 32.f) + EPS);
                        f32x4 v0 = a0 * rstd * *(const f32x4*)(gain + 4 * fq), v1 = a1 * rstd * *(const f32x4*)(gain + 16 + 4 * fq);
                        if (lat) { const int t = row & 4095, pr = t >> 6, pc = t & 63; f32x4 p0, p1;
#pragma unroll
                            for (int i = 0; i < 4; ++i) { p0[i] = other32(v0[i], fq >= 2); p1[i] = other32(v1[i], fq >= 2); }
                            const LAS f32x2* t0 = tab32 + pr * 8 + 4 * (fq & 1); const LAS f32x2* t1 = tab32 + pc * 8 + 4 * (fq & 1);
#pragma unroll
                            for (int i = 0; i < 4; ++i) { const f32x2 c0 = t0[i], c1 = t1[i];
                                v0[i] = fq < 2 ? v0[i] * c0.x - p0[i] * c0.y : v0[i] * c0.x + p0[i] * c0.y;
                                v1[i] = fq < 2 ? v1[i] * c1.x - p1[i] * c1.y : v1[i] * c1.x + p1[i] * c1.y; } }
                        unsigned char* p = (unsigned char*)qB + (size_t)row * 768 + (2 * (slot - 6) + bj) * 128 + 64 + 4 * fq;
                        *(unsigned*)p = pk_fp8v(v0); *(unsigned*)(p + 16) = pk_fp8v(v1); *(unsigned*)(p + 32) = 0u; *(unsigned*)(p + 48) = 0u;
                    }
                }
                asm volatile("" ::: "memory");
            }
    }
};

struct EpiOutProj {
    static constexpr bool PERM = false, FP8 = false;
    unsigned char* ws; const float* xin; const float* cin; float* out; int l;
    DI void operator()(const Acc& acc, const g8::Unit& u, int wr, int wc, int fr, int fq) const {
        asm volatile("" : "+v"(fr), "+v"(fq));
        const int rowt = u.pm * 256 + wr * 64 + fr; const bool lat = (u.pm * 256) < LAT;
        const float* mod = (const float*)(ws + WS_MOD) + ((size_t)l * 9 + (lat ? (u.pm * 256) / 4096 : 8)) * 6144 + 2048;
        const int col0 = u.pn * 256 + wc * 32 + 4 * fq;
        f32x4 gv[2][2];
#pragma unroll
        for (int bj = 0; bj < 2; ++bj)
#pragma unroll
            for (int n = 0; n < 2; ++n) gv[bj][n] = *(const f32x4*)(mod + col0 + 128 * bj + 16 * n);
#pragma unroll
        for (int ai = 0; ai < 2; ++ai)
#pragma unroll
            for (int m = 0; m < 4; ++m) {
                const int row = rowt + ai * 128 + m * 16;
                const float* src = lat ? xin + (size_t)row * 1024 : cin + (size_t)(row - LAT) * 1024;
                float* dst = lat ? out + (size_t)row * 1024 : (float*)(ws + WS_CTXF) + (size_t)(row - LAT) * 1024;
#pragma unroll
                for (int bj = 0; bj < 2; ++bj)
#pragma unroll
                    for (int n = 0; n < 2; ++n) { const int c = col0 + 128 * bj + 16 * n; *(f32x4*)(dst + c) = *(const f32x4*)(src + c) + gv[bj][n] * acc[ai][bj][m][n]; }
            }
    }
};

constexpr int WSH = 6, HSH = 3;
struct EpiMoe1 {
    static constexpr bool PERM = true, FP8 = true;
    unsigned char* ws;
    DI void operator()(const Acc& acc, const g8::Unit& u, int wr, int wc, int fr, int fq) const {
        asm volatile("" : "+v"(fr), "+v"(fq));
        unsigned char* hid = ws + Z_HID; constexpr float SC = 1.0f / (float)(1 << WSH), HS = (float)(1 << HSH);
#pragma unroll
        for (int ai = 0; ai < 2; ++ai)
#pragma unroll
            for (int m = 0; m < 4; ++m) {
                const int row = u.pm * 256 + ai * 128 + wr * 64 + m * 16 + fr;
                f32x4 h0, h1;
#pragma unroll
                for (int i = 0; i < 4; ++i) { h0[i] = silu_f(acc[ai][0][m][0][i] * SC) * (acc[ai][1][m][0][i] * (SC * HS)); h1[i] = silu_f(acc[ai][0][m][1][i] * SC) * (acc[ai][1][m][1][i] * (SC * HS)); }
                u32x2 w; w.x = pk_fp8x4(h0.x, h0.y, h0.z, h0.w); w.y = pk_fp8x4(h1.x, h1.y, h1.z, h1.w);
                *(u32x2*)(hid + (size_t)row * 1024 + u.pn * 128 + wc * 32 + 8 * fq) = w;
            }
    }
};
struct EpiMoe2 {
    static constexpr bool PERM = true, FP8 = true;
    unsigned char* ws;
    DI void operator()(const Acc& acc, const g8::Unit& u, int wr, int wc, int fr, int fq) const {
        asm volatile("" : "+v"(fr), "+v"(fq));
        bf16_t* ye = (bf16_t*)(ws + Z_YE); const float* gate = (const float*)(ws + WS_GATE); constexpr float SC = 1.0f / (float)(1 << (WSH + HSH));
#pragma unroll
        for (int ai = 0; ai < 2; ++ai)
#pragma unroll
            for (int m = 0; m < 4; ++m) {
                const int row = u.pm * 256 + ai * 128 + wr * 64 + m * 16 + fr; const float gv = gate[row] * SC;
#pragma unroll
                for (int bj = 0; bj < 2; ++bj) { const f32x4 a = acc[ai][bj][m][0] * gv, b = acc[ai][bj][m][1] * gv; u32x4 w;
                    w.x = cvt_pk(a.x, a.y); w.y = cvt_pk(a.z, a.w); w.z = cvt_pk(b.x, b.y); w.w = cvt_pk(b.z, b.w);
                    *(u32x4*)(ye + (size_t)row * 1024 + u.pn * 256 + bj * 128 + wc * 32 + 8 * fq) = w; }
            }
    }
};
DI int crow(int i, int hh) { return (i & 3) + 8 * (i >> 2) + 4 * hh; }
typedef short v4i16_t __attribute__((ext_vector_type(4)));
DI s16x4 vtr(const LAS unsigned char* p) { return __builtin_bit_cast(s16x4, __builtin_amdgcn_ds_read_tr16_b64_v4i16((LAS v4i16_t*)p)); }
#define MFMA32(a, b, c) __builtin_amdgcn_mfma_f32_32x32x16_bf16((a), (b), (c), 0, 0, 0)

struct AttnDesc { const unsigned char* Q; int ldq, qoff; const unsigned char* K; int ldk, koff; const unsigned char* Vt; bf16_t* O; int ooff; float sink2; };
DI float fmax3(float a, float b, float c) { return __builtin_fmaxf(__builtin_fmaxf(a, b), c); }
typedef int i32x4 __attribute__((ext_vector_type(4)));
typedef int i32x8 __attribute__((ext_vector_type(8)));
#define MFMA8Z(acc, a, b, sa, sb) asm volatile("v_mfma_scale_f32_32x32x64_f8f6f4 %0, %1, %2, 0, %3, %4 op_sel_hi:[0,0,0]" : "=&v"(acc) : "v"(a), "v"(b), "v"(sa), "v"(sb))
#define MFMA8(acc, a, b, sa, sb) asm volatile("v_mfma_scale_f32_32x32x64_f8f6f4 %0, %1, %2, %0, %3, %4 op_sel_hi:[0,0,0]" : "+v"(acc) : "v"(a), "v"(b), "v"(sa), "v"(sb))
DI int cvt8x4(float a, float b, float c, float d) { int w; asm("v_cvt_pk_fp8_f32 %0, %1, %2" : "=v"(w) : "v"(a), "v"(b)); asm("v_cvt_pk_fp8_f32 %0, %1, %2 op_sel:[0,0,1]" : "+v"(w) : "v"(c), "v"(d)); return w; }
#define MFMA8C(acc, a, b, c, sa, sb) asm volatile("v_mfma_scale_f32_32x32x64_f8f6f4 %0, %1, %2, %3, %4, %5 op_sel_hi:[0,0,0]" : "=&v"(acc) : "v"(a), "v"(b), "v"(c), "v"(sa), "v"(sb))
template <int DQB  , int MODE, bool TRACK, int ABL = 0>
DI void attn_unit(const int tid, LAS unsigned char* lds, const AttnDesc& d, int b, int qb, bool has_sink) {
    constexpr int KSTR = DQB + 16, VSTR = 80, KBUF = 128 * KSTR, VTILE = 64 * VSTR, VBUF = 2 * VTILE, NS = DQB / 64, KCH = DQB / 16, KC1 = KCH + 1, VC1 = 5;
    const int lane = tid & 63, wid = __builtin_amdgcn_readfirstlane(tid >> 6), r = lane & 31, hh = lane >> 5;
    const int q0 = qb * 256;
    const int qrow = (MODE == 2 ? LAT + b * 256 : b * 4096) + q0 + wid * 32 + r;
    int lo = 0, ntl = 0;
    if (MODE == 0) { lo = 0; ntl = 64; }
    if (MODE == 1) { lo = q0 - 128 < 0 ? 0 : q0 - 128; const int hi = q0 + 384 > 4096 ? 4096 : q0 + 384; ntl = (hi - lo) / 64; }
    int NSTEP = (4 + ntl) / 2;
    asm volatile("" : "+s"(NSTEP));
    auto step_row = [&](int st) -> int { return st < 2 ? LAT + b * 256 + st * 128 : b * 4096 + lo + (st - 2) * 128; };
    auto step_T = [&](int st) -> int { return st < 2 ? 2 * st : 4 + lo / 64 + 2 * (st - 2); };
    i32x8 qf[NS];
#pragma unroll
    for (int s = 0; s < NS; ++s) { const unsigned char* qp = d.Q + (size_t)qrow * d.ldq + d.qoff + 64 * s + 32 * hh; const i32x4 lo4 = *(const i32x4*)qp, hi4 = *(const i32x4*)(qp + 16); qf[s] = __builtin_shufflevector(lo4, hi4, 0, 1, 2, 3, 4, 5, 6, 7); }
    const int sclK = 0x7F7F7F7F, sclQ = 0x7C7C7C7C;
    constexpr int NKC = 128 * KC1, NVC = 128 * VC1, NKI = (NKC + 511) / 512, NVI = (NVC + 511) / 512;
    auto dma_piece = [&](int st, int buf, int i) {
        if (i < NKI) { if (i * 512 + wid * 64 < NKC) { const int c = i * 512 + tid, row = c / KC1, ch = c % KC1; const unsigned char* kb_ = d.K + (size_t)step_row(st) * d.ldk;
            __builtin_amdgcn_global_load_lds((const unsigned*)(kb_ + (unsigned)(row * d.ldk + d.koff + (ch < KCH ? ch : 0) * 16)), (LAS unsigned*)(lds + buf * KBUF + i * 8192 + wid * 1024), 16, 0, 0); } }
        else { const int iv = i - NKI; if (iv * 512 + wid * 64 < NVC) { const int c = iv * 512 + tid, row = c / VC1, ch = c % VC1; const unsigned char* vb_ = d.Vt + (size_t)step_T(st) * VT_TILE;
            __builtin_amdgcn_global_load_lds((const unsigned*)(vb_ + (unsigned)(row * 64 + (ch < 4 ? ch : 0) * 16)), (LAS unsigned*)(lds + 2 * KBUF + buf * VBUF + iv * 8192 + wid * 1024), 16, 0, 0); } } };
    auto dma_step = [&](int st, int buf) {
#pragma unroll
        for (int i = 0; i < NKI + NVI; ++i) dma_piece(st, buf, i); };
    constexpr float THR = 8.f, POFF = 6.f;
    static_assert(TRACK, "the fp8 P.V path needs the running row maximum");
    float m = 0.f;
    if (has_sink) m = d.sink2 - POFF;
    f32x16 o0, o1, sc[4], negm, lacc;
    { float z = 0.f, nm = -m, l0 = has_sink ? __builtin_amdgcn_exp2f(POFF) : 0.f; asm volatile("" : "+v"(z), "+v"(nm), "+v"(l0));
#pragma unroll
      for (int i = 0; i < 16; ++i) { o0[i] = z; o1[i] = z; negm[i] = nm; lacc[i] = l0; } }
    i32x8 ones;
    { int one4 = 0x38383838; asm volatile("" : "+v"(one4));
#pragma unroll
      for (int i = 0; i < 8; ++i) ones[i] = one4; }
    asm volatile("s_nop 1" : "+v"(ones), "+v"(negm), "+v"(lacc));
    const int koffl = r * KSTR + hh * 32, voffl = r * VSTR + hh * 32, sclV = 0x7F7F7F7F;
    auto frag = [&](const LAS unsigned char* p) -> i32x8 { const i32x4 lo4 = *(const LAS i32x4*)p, hi4 = *(const LAS i32x4*)(p + 16); return __builtin_shufflevector(lo4, hi4, 0, 1, 2, 3, 4, 5, 6, 7); };
    __syncthreads();
    dma_step(0, 0); dma_step(1, 1); asm volatile("s_waitcnt vmcnt(0)" ::: "memory");
    __syncthreads();
    constexpr int NF = 4 * NS;
    auto kfrag = [&](int kbuf, int f) -> i32x8 { return frag(lds + kbuf * KBUF + koffl + (32 * (f & 3)) * KSTR + (f >> 2) * 64); };
    i32x8 kx[3];
    kx[0] = kfrag(0, 0); kx[1] = kfrag(0, 1); kx[2] = kfrag(0, 2);
    for (int st = 0; st < NSTEP; ++st) {
        const int buf = st & 1;
        {
#pragma unroll
          for (int f = 0; f < NF; ++f) { const int j = f & 3, s = f >> 2;
              if (!(ABL & 4)) { if (s == 0) MFMA8C(sc[j], kx[f % 3], qf[0], negm, sclK, sclQ); else MFMA8(sc[j], kx[f % 3], qf[s], sclK, sclQ); } else if (s == 0) sc[j] = negm;
              if (f + 3 < NF) kx[f % 3] = kfrag(buf, f + 3); }
          asm volatile("s_nop 15\n\ts_nop 7" : "+v"(sc[0]), "+v"(sc[1]), "+v"(sc[2]), "+v"(sc[3])); }
        i32x8 vx[4];
        { const LAS unsigned char* vb = lds + 2 * KBUF + buf * VBUF + voffl;
#pragma unroll
          for (int t2 = 0; t2 < 2; ++t2) { vx[2 * t2] = frag(vb + t2 * VTILE); vx[2 * t2 + 1] = frag(vb + t2 * VTILE + 32 * VSTR); }
          asm volatile("" ::: "memory"); }
        if (MODE == 1) { if (st >= 2) { const int kp0 = lo + (st - 2) * 128, qp = q0 + wid * 32 + r;
#pragma unroll
            for (int j = 0; j < 4; ++j)
#pragma unroll
                for (int i = 0; i < 16; ++i) { const int dk = kp0 + 32 * j + crow(i, hh) - qp; if (dk > 128 || dk < -128) sc[j][i] = -1e30f; } } }
        if (!(ABL & 32)) { float ma = fmax3(sc[0][0], sc[1][0], sc[2][0]), mb = fmax3(sc[3][0], sc[0][1], sc[1][1]);
#pragma unroll
          for (int i = 0; i < 16; ++i) { if (i >= 1) ma = fmax3(ma, sc[0][i], sc[1][i]); if (i >= 2) mb = fmax3(mb, sc[2][i], sc[3][i]); }
          mb = fmax3(mb, sc[2][1], sc[3][1]);
          float mx = __builtin_fmaxf(ma, mb);
          { auto rr = __builtin_amdgcn_permlane32_swap(__float_as_uint(mx), __float_as_uint(mx), false, false); mx = __builtin_fmaxf(__uint_as_float(rr[0]), __uint_as_float(rr[1])); }
          if (st == 0 && !has_sink) {
              const float dl = mx - POFF; m = dl;
#pragma unroll
              for (int j = 0; j < 4; ++j)
#pragma unroll
                  for (int i = 0; i < 16; ++i) sc[j][i] -= dl;
#pragma unroll
              for (int i = 0; i < 16; ++i) negm[i] = -m;
              asm volatile("s_nop 1" : "+v"(negm));
          } else if (__any(mx > THR)) {
              const float dl = __builtin_fmaxf(mx - POFF, 0.f), alpha = __builtin_amdgcn_exp2f(-dl);
              asm volatile("s_nop 15\n\ts_nop 7" : "+v"(o0), "+v"(o1), "+v"(lacc));
              m += dl;
#pragma unroll
              for (int i = 0; i < 16; ++i) { o0[i] *= alpha; o1[i] *= alpha; lacc[i] *= alpha; negm[i] = -m; }
#pragma unroll
              for (int j = 0; j < 4; ++j)
#pragma unroll
                  for (int i = 0; i < 16; ++i) sc[j][i] -= dl;
              asm volatile("s_nop 1" : "+v"(negm), "+v"(o0), "+v"(o1), "+v"(lacc)); } }
#pragma unroll
        for (int j = 0; j < 4; ++j)
#pragma unroll
            for (int i = 0; i < 16; ++i) if (!(ABL & 2)) sc[j][i] = __builtin_amdgcn_exp2f(sc[j][i]);
        i32x8 pf[2];
#pragma unroll
        for (int t2 = 0; t2 < 2; ++t2) {
#pragma unroll
            for (int q4 = 0; q4 < 4; ++q4) { if (ABL & 64) { pf[t2][q4] = __float_as_int(sc[2 * t2][q4]); pf[t2][4 + q4] = __float_as_int(sc[2 * t2 + 1][q4]); continue; }
                                             pf[t2][q4] = cvt8x4(sc[2 * t2][4 * q4], sc[2 * t2][4 * q4 + 1], sc[2 * t2][4 * q4 + 2], sc[2 * t2][4 * q4 + 3]);
                                             pf[t2][4 + q4] = cvt8x4(sc[2 * t2 + 1][4 * q4], sc[2 * t2 + 1][4 * q4 + 1], sc[2 * t2 + 1][4 * q4 + 2], sc[2 * t2 + 1][4 * q4 + 3]); } }
        asm volatile("s_nop 1" : "+v"(pf[0]), "+v"(pf[1]));
        asm volatile("s_waitcnt vmcnt(0) lgkmcnt(0)" ::: "memory"); if (!(ABL & 16)) __builtin_amdgcn_s_barrier(); asm volatile("" ::: "memory");
        if (st + 1 < NSTEP) { kx[0] = kfrag(buf ^ 1, 0); kx[1] = kfrag(buf ^ 1, 1); kx[2] = kfrag(buf ^ 1, 2); }
        const bool more = st + 2 < NSTEP && !(ABL & 1);
#pragma unroll
        for (int t = 0; t < 6; ++t) { const int t2 = t / 3, w = t % 3;
            if (!(ABL & 8)) { if (w == 0) MFMA8(o0, vx[2 * t2], pf[t2], sclV, sclV); else if (w == 1) MFMA8(o1, vx[2 * t2 + 1], pf[t2], sclV, sclV); else MFMA8(lacc, ones, pf[t2], sclV, sclV); }
            if (more && t < NKI + NVI) dma_piece(st + 2, buf, t); }
        static_assert(NKI + NVI <= 6, "one DMA piece per P.V MFMA");
    }
    asm volatile("s_nop 15\n\ts_nop 15" : "+v"(o0), "+v"(o1), "+v"(lacc));
    const float inv = 1.0f / lacc[0];
    bf16_t* op = d.O + (size_t)qrow * 1024 + d.ooff + 4 * hh;
#pragma unroll
    for (int g4 = 0; g4 < 4; ++g4) {
        u32x2 w; w.x = cvt_pk(o0[4 * g4] * inv, o0[4 * g4 + 1] * inv); w.y = cvt_pk(o0[4 * g4 + 2] * inv, o0[4 * g4 + 3] * inv); *(u32x2*)(op + 8 * g4) = w;
        u32x2 x; x.x = cvt_pk(o1[4 * g4] * inv, o1[4 * g4 + 1] * inv); x.y = cvt_pk(o1[4 * g4 + 2] * inv, o1[4 * g4 + 3] * inv); *(u32x2*)(op + 32 + 8 * g4) = x;
    }
}

#ifndef TRACK_EN
#define TRACK_EN 1
#endif
DI void attn_phase(const Frame& F, int l, bool with_ctx, int rep = 0) {
    constexpr int UB = 96, UA = 96, UC = 64, UX = 16;
    const int NUQ = UB + UA + UC + (with_ctx ? UX : 0);
    unsigned* heads = F.ctl + CW_QUEUE + 128 * (l + 2 * rep);
    volatile LAS int* slot = (volatile LAS int*)(F.lds + LDS_MISC + 16);
    const float* sinkp = INP(21) + l * 4;
    auto resolve = [&](int v) -> int {
        int q = slot[2];
        while (v >= NUQ) { const int t = slot[3] + 1; slot[3] = t; if (t >= NB) return -1; q = q + 1 == NB ? 0 : q + 1; slot[2] = q; v = (int)__hip_atomic_fetch_add(heads + 16 * q, 1u, __ATOMIC_RELAXED, __HIP_MEMORY_SCOPE_AGENT); }
        return q * 512 + v; };
    __syncthreads();
    if (F.tid == 0) { const int q0 = F.bid % NB; slot[2] = q0; slot[3] = 0; slot[0] = resolve((int)__hip_atomic_fetch_add(heads + 16 * q0, 1u, __ATOMIC_RELAXED, __HIP_MEMORY_SCOPE_AGENT)); }
    __syncthreads();
    for (int it = 0;; ++it) {
        int u = slot[it & 1]; if (u < 0) break;
        int nxt_u = 0; if (F.tid == 0) nxt_u = (int)__hip_atomic_fetch_add(heads + 16 * slot[2], 1u, __ATOMIC_RELAXED, __HIP_MEMORY_SCOPE_AGENT);
        [&]() {
        GAS unsigned char* wsg = (GAS unsigned char*)F.ws; asm volatile("" : "+s"(wsg)); unsigned char* ws = (unsigned char*)wsg;
        int tidu = F.tid; asm volatile("" : "+v"(tidu));
        AttnDesc d;
        const int b = u >> 9; u &= 511;
        if (u < UB) { const int h = u / 16, qb = u % 16;
            d = AttnDesc{(const unsigned char*)(ws + Z_QB), 768, h * 128, (const unsigned char*)(ws + Z_KB), 768, h * 128, (const unsigned char*)(ws + Z_VB) + ((size_t)b * 6 + h) * VT_HEAD, (bf16_t*)(ws + Z_OB), 384 + h * 64, 0.f};
#ifdef ATT_ABL
            if (rep) { attn_unit<128, 0, true, ATT_ABL>(tidu, F.lds, d, b, qb, false); return; }
#endif
            attn_unit<128, 0, true>(tidu, F.lds, d, b, qb, false); return; }
        u -= UB;
        if (u < UA) { const int h = u / 16, qb = u % 16;
            d = AttnDesc{(const unsigned char*)(ws + Z_QA), 384, h * 64, (const unsigned char*)(ws + Z_KA), 128, (h / 3) * 64, (const unsigned char*)(ws + Z_VA) + ((size_t)b * 2 + h / 3) * VT_HEAD, (bf16_t*)(ws + Z_OB), h * 64, 0.f};
#ifdef ATT_ABL
            if (rep) { attn_unit<64, 0, true, ATT_ABL>(tidu, F.lds, d, b, qb, false); return; }
#endif
            attn_unit<64, 0, true>(tidu, F.lds, d, b, qb, false); return; }
        u -= UA;
        if (u < UC) { const int h = u / 16, qb = u % 16;
            d = AttnDesc{(const unsigned char*)(ws + Z_QC), 256, h * 64, (const unsigned char*)(ws + Z_KC), 128, (h / 2) * 64, (const unsigned char*)(ws + Z_VC) + ((size_t)b * 2 + h / 2) * VT_HEAD, (bf16_t*)(ws + Z_OB), 768 + h * 64, sinkp[h] * LOG2E};
            attn_unit<64, 1, true>(tidu, F.lds, d, b, qb, true); return; }
        u -= UC;
        { const int hx = u;
            if (hx < 6) { const int h = hx;
                d = AttnDesc{(const unsigned char*)(ws + Z_QA), 384, h * 64, (const unsigned char*)(ws + Z_KA), 128, (h / 3) * 64, (const unsigned char*)(ws + Z_VA) + ((size_t)b * 2 + h / 3) * VT_HEAD, (bf16_t*)(ws + Z_OB), h * 64, 0.f};
                attn_unit<64, 2, true>(tidu, F.lds, d, b, 0, false); }
            else if (hx < 12) { const int h = hx - 6;
                d = AttnDesc{(const unsigned char*)(ws + Z_QB), 768, h * 128, (const unsigned char*)(ws + Z_KB), 768, h * 128, (const unsigned char*)(ws + Z_VB) + ((size_t)b * 6 + h) * VT_HEAD, (bf16_t*)(ws + Z_OB), 384 + h * 64, 0.f};
                attn_unit<128, 2, true>(tidu, F.lds, d, b, 0, false); }
            else { const int h = hx - 12;
                d = AttnDesc{(const unsigned char*)(ws + Z_QC), 256, h * 64, (const unsigned char*)(ws + Z_KC), 128, (h / 2) * 64, (const unsigned char*)(ws + Z_VC) + ((size_t)b * 2 + h / 2) * VT_HEAD, (bf16_t*)(ws + Z_OB), 768 + h * 64, sinkp[h] * LOG2E};
                attn_unit<64, 2, true>(tidu, F.lds, d, b, 0, true); }
        }
        }();
        if (F.tid == 0) slot[(it & 1) ^ 1] = resolve(nxt_u);
        __syncthreads();
    }
}

DI void router_phase(const Frame& F, int l, bool with_ctx) {
    LAS float* wT = (LAS float*)F.lds;
    const float* wr = INP(23) + (size_t)l * 1024 * 16;
    for (int e = F.tid; e < 16 * 1024; e += NTHR) { const int k = e / 16, x = e % 16; wT[x * 1024 + k] = wr[e]; }
    __syncthreads();
    const int gw = F.bid * NWAVES + F.wave, NGW = F.G * NWAVES, NR = with_ctx ? R : LAT, lane = F.lane;
    const int per = (NR + NGW - 1) / NGW, r0 = gw * per, r1 = r0 + per < NR ? r0 + per : NR;
    const float* g = INP(7) + l * 1024;
    auto rowptr = [&](int row) -> const float* { return row < LAT ? F.out + (size_t)row * 1024 : WSP(float, WS_CTXF) + (size_t)(row - LAT) * 1024; };
    f32x4 vn[4], gc[4], sv[4]; int curb = -1;
    if (r0 < r1) { const float* xr0 = rowptr(r0);
#pragma unroll
        for (int j = 0; j < 4; ++j) vn[j] = *(const f32x4*)(xr0 + 4 * (lane + 64 * j)); }
    for (int row = r0; row < r1; ++row) {
        f32x4 v[4]; float s = 0.f;
#pragma unroll
        for (int j = 0; j < 4; ++j) { v[j] = vn[j]; s += (v[j].x * v[j].x + v[j].y * v[j].y) + (v[j].z * v[j].z + v[j].w * v[j].w); }
        if (row + 1 < r1) { const float* xr1 = rowptr(row + 1);
#pragma unroll
            for (int j = 0; j < 4; ++j) vn[j] = *(const f32x4*)(xr1 + 4 * (lane + 64 * j)); }
        const int cb = cond_of_row(row);
        if (cb != curb) { const float* m = mod_row(F, l, row); load_mod(g, m + 3072, m + 4096, gc, sv, lane); curb = cb; }
        const float rstd = 1.0f / sqrtf(wave_sum(s) * (1.f / 1024.f) + EPS);
        float lg[16];
#pragma unroll
        for (int e = 0; e < 16; ++e) lg[e] = 0.f;
        unsigned char* orow = WSP(unsigned char, WS_HB) + (size_t)row * 1024;
#pragma unroll
        for (int j = 0; j < 4; ++j) { const int c = 4 * (lane + 64 * j);
            v[j] = v[j] * rstd * gc[j] + sv[j]; *(unsigned*)(orow + c) = pk_fp8x4(v[j].x, v[j].y, v[j].z, v[j].w); }
        asm volatile("" ::: "memory");
#pragma unroll
        for (int e = 0; e < 16; ++e) {
#pragma unroll
            for (int j = 0; j < 4; ++j) { const f32x4 wv = *(const LAS f32x4*)(wT + e * 1024 + 4 * (lane + 64 * j)); lg[e] += (v[j].x * wv.x + v[j].y * wv.y) + (v[j].z * wv.z + v[j].w * wv.w); }
            if (e & 1) asm volatile("" ::: "memory"); }
#pragma unroll
        for (int e = 0; e < 16; ++e) lg[e] = wave_sum(lg[e]);
        float mx = lg[0];
#pragma unroll
        for (int e = 1; e < 16; ++e) mx = fmaxf(mx, lg[e]);
        float sum = 0.f;
#pragma unroll
        for (int e = 0; e < 16; ++e) { lg[e] = expf(lg[e] - mx); sum += lg[e]; }
        const float isum = 1.0f / sum;
        float mine = 0.f;
#pragma unroll
        for (int e = 0; e < 16; ++e) mine = (lane == e) ? lg[e] * isum : mine;
        if (lane < 16) {
            if (row < LAT) WSP(float, WS_AFFL)[((size_t)(row / 4096) * 16 + lane) * 4096 + (row & 4095)] = mine;
            else { const int rc = row - LAT; WSP(float, WS_AFFC)[((size_t)(rc / 256) * 16 + lane) * 256 + (rc & 255)] = mine; }
        }
    }
}

DI void topk_phase(const Frame& F, bool with_ctx) {
    LAS unsigned* hist = (LAS unsigned*)F.lds;
    LAS unsigned* sh = hist + 256;
    LAS unsigned* scan = hist + 512;
    const int NL = NB * 16 * (with_ctx ? 2 : 1), tid = F.tid;
    for (int li = F.bid; li < NL; li += F.G) {
        const bool isctx = li >= NB * 16; const int be = isctx ? li - NB * 16 : li, b = be / 16, e = be % 16;
        const int n = isctx ? 256 : 4096, cap = n / 8, per = isctx ? 1 : 8;
        const float* a = isctx ? WSP(float, WS_AFFC) + (size_t)be * 256 : WSP(float, WS_AFFL) + (size_t)be * 4096;
        unsigned key[8]; const bool act = tid * per < n;
#pragma unroll
        for (int j = 0; j < 8; ++j) key[j] = (act && j < per) ? __float_as_uint(a[tid * per + j]) : 0u;
        unsigned prefix = 0u, rem = (unsigned)cap;
        for (int pass = 0; pass < 4; ++pass) {
            const int shift = 24 - 8 * pass;
            __syncthreads();
            if (tid < 256) hist[tid] = 0u;
            __syncthreads();
#pragma unroll
            for (int j = 0; j < 8; ++j) if (act && j < per) { const unsigned k = key[j]; const bool match = pass == 0 ? true : ((k >> (shift + 8)) == (prefix >> (shift + 8))); if (match) __hip_atomic_fetch_add(&hist[(k >> shift) & 255u], 1u, __ATOMIC_RELAXED, __HIP_MEMORY_SCOPE_WORKGROUP); }
            __syncthreads();
            if (tid < 64) {
                const int b0 = 255 - 4 * tid; const unsigned c0 = hist[b0], c1 = hist[b0 - 1], c2 = hist[b0 - 2], c3 = hist[b0 - 3];
                unsigned incl = c0 + c1 + c2 + c3;
#pragma unroll
                for (int o = 1; o < 64; o <<= 1) { const unsigned v = shfl_up_u(incl, o, tid); if (tid >= o) incl += v; }
                unsigned cum = incl - (c0 + c1 + c2 + c3);
                if (cum < rem && incl >= rem) { int bin = b0; unsigned c = c0;
                    if (cum + c < rem) { cum += c; bin = b0 - 1; c = c1; if (cum + c < rem) { cum += c; bin = b0 - 2; c = c2; if (cum + c < rem) { cum += c; bin = b0 - 3; } } }
                    sh[0] = prefix | ((unsigned)bin << shift); sh[1] = rem - cum; }
            }
            __syncthreads();
            prefix = sh[0]; rem = sh[1];
        }
        unsigned cg = 0u, ce = 0u;
#pragma unroll
        for (int j = 0; j < 8; ++j) if (act && j < per) { cg += key[j] > prefix ? 1u : 0u; ce += key[j] == prefix ? 1u : 0u; }
        __syncthreads();
        scan[tid] = cg; scan[512 + tid] = ce;
        __syncthreads();
        unsigned gb, eb;
        {
            unsigned ig = cg, ie = ce; const int ln = tid & 63, wv = tid >> 6;
#pragma unroll
            for (int o = 1; o < 64; o <<= 1) { const unsigned vg = shfl_up_u(ig, o, ln), ve = shfl_up_u(ie, o, ln); if (ln >= o) { ig += vg; ie += ve; } }
            if (ln == 63) { scan[1024 + wv] = ig; scan[1040 + wv] = ie; }
            __syncthreads();
            unsigned og = 0u, oe = 0u;
#pragma unroll
            for (int w = 0; w < 8; ++w) { if (w < wv) { og += scan[1024 + w]; oe += scan[1040 + w]; } }
            gb = og + ig - cg; eb = oe + ie - ce;
        }
        const int rowb = isctx ? LAT + b * 256 : b * 4096;
        const int mbase = isctx ? MOE_LAT + e * 256 + b * 32 : (b * 16 + e) * 512;
        int* gidx = WSP(int, WS_GIDX); float* gate = WSP(float, WS_GATE); int* inv = WSP(int, WS_INV);
#pragma unroll
        for (int j = 0; j < 8; ++j) if (act && j < per) {
            const unsigned k = key[j]; const int t = tid * per + j; int slot = -1;
            if (k > prefix) { slot = (int)(gb + (eb < rem ? eb : rem)); ++gb; }
            else if (k == prefix) { if (eb < rem) slot = (int)(gb + eb); ++eb; }
            if (slot >= 0) { gidx[mbase + slot] = rowb + t; gate[mbase + slot] = __uint_as_float(k); }
            inv[(size_t)(rowb + t) * 16 + e] = slot >= 0 ? mbase + slot : -1;
        }
        if (isctx && NB < 8 && b == 0) { for (int i = NB * 32 + tid; i < 256; i += NTHR) { gidx[MOE_LAT + e * 256 + i] = LAT; gate[MOE_LAT + e * 256 + i] = 0.f; } }
    }
}

DI void combine_phase(const Frame& F, int l, bool with_ctx, int rep = 0) {
    const int gw = F.bid * NWAVES + F.wave, NGW = F.G * NWAVES, NR = with_ctx ? R : LAT, lane = F.lane;
    const int per = (NR + NGW - 1) / NGW, r0 = gw * per, r1 = r0 + per < NR ? r0 + per : NR;
    const bool last = (l == DEPTH - 1);
    const bf16_t* ye = WSP(bf16_t, Z_YE); const int* inv = WSP(int, WS_INV);
    auto rowptr = [&](int row) -> float* { return row < LAT ? F.out + (size_t)row * 1024 : WSP(float, WS_CTXF) + (size_t)(row - LAT) * 1024; };
    auto pair_of = [&](int slots, int& s0, int& s1, bool& two) -> unsigned {
        unsigned mask = (unsigned)(__ballot(slots >= 0) & 0xFFFFull); s0 = -1; s1 = -1; two = false;
        if (mask) { const int e0 = __builtin_ctz(mask); mask &= mask - 1; two = mask != 0u; const int e1 = two ? __builtin_ctz(mask) : e0; if (two) mask &= mask - 1;
            s0 = __builtin_amdgcn_readlane(slots, e0); s1 = __builtin_amdgcn_readlane(slots, e1); }
        return mask; };
    auto load_pair = [&](int s0, int s1, u32x2 (&a)[4], u32x2 (&c)[4]) { const bf16_t* y0 = ye + (size_t)s0 * 1024; const bf16_t* y1 = ye + (size_t)s1 * 1024;
#pragma unroll
        for (int j = 0; j < 4; ++j) { a[j] = *(const u32x2*)(y0 + 4 * (lane + 64 * j)); c[j] = *(const u32x2*)(y1 + 4 * (lane + 64 * j)); } };
    auto add_pair = [&](f32x4 (&acc)[4], const u32x2 (&a)[4], const u32x2 (&c)[4], float w1) {
#pragma unroll
        for (int j = 0; j < 4; ++j) { acc[j].x += bf_lo(a[j].x) + w1 * bf_lo(c[j].x); acc[j].y += bf_hi(a[j].x) + w1 * bf_hi(c[j].x); acc[j].z += bf_lo(a[j].y) + w1 * bf_lo(c[j].y); acc[j].w += bf_hi(a[j].y) + w1 * bf_hi(c[j].y); } };
    int slot_n = -1; f32x4 xn[4]; u32x2 an[4], cn[4]; unsigned mask_n = 0u; int s0n = -1; bool two_n = false;
    f32x4 g2[4], gc[4], sv[4]; int curb = -1;
    if (r0 < r1) { slot_n = lane < 16 ? inv[(size_t)r0 * 16 + lane] : -1; const float* x0 = rowptr(r0);
#pragma unroll
        for (int j = 0; j < 4; ++j) xn[j] = *(const f32x4*)(x0 + 4 * (lane + 64 * j));
        int s1n; mask_n = pair_of(slot_n, s0n, s1n, two_n); if (s0n >= 0) load_pair(s0n, s1n, an, cn); }
    for (int row = r0; row < r1; ++row) {
        float* xr = rowptr(row);
        const int myslot = slot_n; f32x4 xv[4]; u32x2 a[4], c[4]; unsigned mask = mask_n; const bool any = s0n >= 0; const float w1 = two_n ? 1.f : 0.f;
#pragma unroll
        for (int j = 0; j < 4; ++j) { xv[j] = xn[j]; a[j] = an[j]; c[j] = cn[j]; }
        if (row + 1 < r1) { slot_n = lane < 16 ? inv[(size_t)(row + 1) * 16 + lane] : -1; const float* x1 = rowptr(row + 1);
#pragma unroll
            for (int j = 0; j < 4; ++j) xn[j] = *(const f32x4*)(x1 + 4 * (lane + 64 * j)); }
        const int cb = cond_of_row(row);
        if (cb != curb) { const float* m = mod_row(F, l, row);
#pragma unroll
            for (int j = 0; j < 4; ++j) g2[j] = *(const f32x4*)(m + 5120 + 4 * (lane + 64 * j));
            if (!last) { const float* m2 = mod_row(F, l + 1, row); load_mod(INP(6) + (l + 1) * 1024, m2, m2 + 1024, gc, sv, lane); }
            curb = cb; }
        f32x4 acc[4];
#pragma unroll
        for (int j = 0; j < 4; ++j) acc[j] = (f32x4){0.f, 0.f, 0.f, 0.f};
        if (any) add_pair(acc, a, c, w1);
        while (mask) {
            const int e0 = __builtin_ctz(mask); mask &= mask - 1; const bool two = mask != 0u; const int e1 = two ? __builtin_ctz(mask) : e0; if (two) mask &= mask - 1;
            u32x2 a2[4], c2[4]; load_pair(__builtin_amdgcn_readlane(myslot, e0), __builtin_amdgcn_readlane(myslot, e1), a2, c2); add_pair(acc, a2, c2, two ? 1.f : 0.f);
        }
        if (row + 1 < r1) { int s1n; mask_n = pair_of(slot_n, s0n, s1n, two_n); if (s0n >= 0) load_pair(s0n, s1n, an, cn); }
        f32x4 v[4];
#pragma unroll
        for (int j = 0; j < 4; ++j) { v[j] = xv[j] + g2[j] * acc[j]; if (!rep) *(f32x4*)(xr + 4 * (lane + 64 * j)) = v[j]; }
        if (!last) norm_mod_store_r(v, gc, sv, WSP(unsigned char, WS_HB) + (size_t)row * 1024, lane);
    }
}
constexpr int NPHASE = 2 + 9 * DEPTH;
DI void load_tabs(const Frame& F) {
    const f32x2* t64 = WSP(f32x2, WS_TAB64); const f32x2* t32 = WSP(f32x2, WS_TAB32);
    LAS f32x2* l64 = (LAS f32x2*)(F.lds + LDS_TAB64); LAS f32x2* l32 = (LAS f32x2*)(F.lds + LDS_TAB32);
    for (int i = F.tid; i < 64 * 16; i += NTHR) l64[i] = t64[i];
    for (int i = F.tid; i < 64 * 8; i += NTHR) l32[i] = t32[i];
    __syncthreads();
}
#ifndef PH_EN
#define PH_EN(k) 1
#endif
#ifdef UBENCH
template <int V> DI void ubench(const Frame& F) {
    const int wid = __builtin_amdgcn_readfirstlane(F.tid >> 6);
    f32x16 a0, a1; i32x8 x, y; float e[32]; int scl = 0x7F7F7F7F;
    { float z = (float)F.tid * 1e-9f; int q = F.tid; asm volatile("" : "+v"(z), "+v"(q), "+v"(scl));
#pragma unroll
      for (int i = 0; i < 16; ++i) { a0[i] = z; a1[i] = z; }
#pragma unroll
      for (int i = 0; i < 8; ++i) { x[i] = q; y[i] = q; }
#pragma unroll
      for (int i = 0; i < 32; ++i) e[i] = z * (float)(i + 1); }
    asm volatile("s_nop 1" : "+v"(a0), "+v"(a1), "+v"(x), "+v"(y));
    const bool g1 = (V == 1) ? (wid >= 4) : (V == 5) ? (wid & 1) : false;
    auto M = [&]() {
#pragma unroll
        for (int k = 0; k < 7; ++k) { MFMA8(a0, x, y, scl, scl); MFMA8(a1, x, y, scl, scl); } };
    auto VV = [&]() {
#pragma unroll
        for (int r = 0; r < 2; ++r)
#pragma unroll
            for (int i = 0; i < 32; ++i) e[i] = __builtin_amdgcn_exp2f(e[i]);
#pragma unroll
        for (int r = 0; r < 3; ++r)
#pragma unroll
            for (int i = 0; i < 32; ++i) e[i] = __builtin_fmaf(e[i], 0.999f, 1e-3f);
#pragma unroll
        for (int i = 0; i < 32; ++i) asm volatile("" : "+v"(e[i])); };
    auto MV = [&]() {
#pragma unroll
        for (int k = 0; k < 16; ++k) {
            if (k < 14) { if (k & 1) MFMA8(a1, x, y, scl, scl); else MFMA8(a0, x, y, scl, scl); }
#pragma unroll
            for (int j = 0; j < 2; ++j) { float v = e[2 * k + j]; v = __builtin_amdgcn_exp2f(v); v = __builtin_amdgcn_exp2f(v); v = __builtin_fmaf(v, 0.999f, 1e-3f); v = __builtin_fmaf(v, 0.999f, 1e-3f); v = __builtin_fmaf(v, 0.999f, 1e-3f); e[2 * k + j] = v; }
            asm volatile("" : "+v"(e[2 * k]), "+v"(e[2 * k + 1]));
        } };
    for (int it = 0; it < 3000; ++it) {
        if (V == 6 || V == 7) { MV(); if (V == 6) __builtin_amdgcn_s_barrier(); continue; }
        if (V == 3) M();
        else if (V == 4) VV();
        else if (!g1) { M(); VV(); } else { VV(); M(); }
        if (V != 2 && V != 7) __builtin_amdgcn_s_barrier();
    }
    asm volatile("s_nop 15\n\ts_nop 15" : "+v"(a0), "+v"(a1));
    float acc = 0.f;
#pragma unroll
    for (int i = 0; i < 16; ++i) acc += a0[i] + a1[i];
#pragma unroll
    for (int i = 0; i < 32; ++i) acc += e[i];
    if (acc == 123.456f) F.out[F.tid] = acc;
}
#endif
DI void run_phase(const Frame& F, int ph, int rep = 0) {
    unsigned char* ws = F.ws;
#ifdef UBENCH
    if (ph == 1000) { ubench<UBENCH>(F); return; }
#endif
    if (ph == 0) { if (PH_EN(100)) p0_phase(F); return; }
    if (ph == 1) { if (PH_EN(101)) init_norm_phase(F); return; }
    const int l = (ph - 2) / 9, s = (ph - 2) % 9; const bool last = (l == DEPTH - 1);
    switch (s) {
    case 0: if (PH_EN(0)) { load_tabs(F);
        g8::DenseSched S; S.init(MT, 6, F.G, F.bid, 512, ws + WS_WIN + (size_t)l * 1536 * 1024);
        EpiInProj E{ws, F.intab, l, (const LAS f32x2*)(F.lds + LDS_TAB64), (const LAS f32x2*)(F.lds + LDS_TAB32)};
        g8::gemm_phase(F.tid, F.lds, (const char*)(ws + WS_HB), 512, S, E); } break;
    case 1: if (PH_EN(1)) { load_tabs(F);
        g8::DenseSched S; S.init(MT, 6, F.G, F.bid, 384, ws + WS_WUP + (size_t)l * 1536 * 384 * 2, true);
        EpiUpProj E{ws, F.intab, l, (const LAS f32x2*)(F.lds + LDS_TAB32)};
        g8::gemm_phase(F.tid, F.lds, (const char*)(ws + Z_CRAW), 384, S, E); } break;
    case 2: if (PH_EN(2)) attn_phase(F, l, !last, rep); break;
    case 3: if (PH_EN(3)) { g8::DenseSched S; S.init(last ? LAT / 256 : MT, 4, F.G, F.bid, 1024, ws + WS_WOUT + (size_t)l * 1024 * 1024 * 2);
        EpiOutProj E{ws, l == 0 ? INP(0) : F.out, INP(2), F.out, l};
        g8::gemm_phase(F.tid, F.lds, (const char*)(ws + Z_OB), 1024, S, E); } break;
    case 4: if (PH_EN(4)) router_phase(F, l, !last); break;
    case 5: if (PH_EN(5)) topk_phase(F, !last); break;
    case 6: if (PH_EN(6)) { g8::MoeSched<true> S; S.init(8, !last, F.G, F.bid, 512, ws + WS_W1 + (size_t)l * 16 * 2048 * 1024, (size_t)2048 * 1024, (const int*)(ws + WS_GIDX));
        EpiMoe1 E{ws}; g8::gemm_phase(F.tid, F.lds, (const char*)(ws + WS_HB), 512, S, E); } break;
    case 7: if (PH_EN(7)) { g8::MoeSched<false> S; S.init(4, !last, F.G, F.bid, 512, ws + WS_W2 + (size_t)l * 16 * 1024 * 1024, (size_t)1024 * 1024, nullptr);
        EpiMoe2 E{ws}; g8::gemm_phase(F.tid, F.lds, (const char*)(ws + Z_HID), 512, S, E); } break;
    case 8: if (PH_EN(8)) combine_phase(F, l, !last, rep); break;
    }
}
__global__ void __launch_bounds__(NTHR, 2) mega_kernel(Args a) {
    extern __shared__ __attribute__((aligned(16))) unsigned char lds_raw[];
    Frame F; F.lds = (LAS unsigned char*)lds_raw; F.ws = a.ws; F.ctl = (unsigned*)(a.ws + WS_CTL);
    F.tid = threadIdx.x; F.lane = F.tid & 63; F.wave = __builtin_amdgcn_readfirstlane(F.tid >> 6); F.G = gridDim.x; F.bid = blockIdx.x; F.out = a.out;
    { LAS unsigned long long* tab = (LAS unsigned long long*)(F.lds + LDS_INTAB); if (F.tid < 27) tab[F.tid] = (unsigned long long)a.in[F.tid]; F.intab = tab; }
    volatile LAS unsigned* MISC = (volatile LAS unsigned*)(F.lds + LDS_MISC);
    if (F.tid < 64) MISC[F.tid] = 0u;
    __syncthreads();
    const bool multi = a.ph_hi - a.ph_lo > 1;
    const unsigned wave0 = __builtin_amdgcn_readfirstlane(threadIdx.x >> 6);
    XcdBarrier bar; bar.bar = F.ctl + CW_BAR + a.li * XCD_BAR_WORDS; bar.x = 0; bar.st = MISC;
    if (multi) bar = xcd_barrier_post(F.ctl + CW_BAR + a.li * XCD_BAR_WORDS, MISC);
    for (int ph = a.ph_lo; ph < a.ph_hi; ++ph) {
        {
            GAS unsigned char* w_ = (GAS unsigned char*)a.ws; GAS float* o_ = (GAS float*)a.out; unsigned l_ = (unsigned)(unsigned long long)F.lds, t_ = (unsigned)(unsigned long long)F.intab; int g_ = gridDim.x, b_ = blockIdx.x;
            unsigned all_ = ~0u, wv_ = wave0; asm volatile("" : "+s"(all_), "+s"(wv_));
            int tid_ = (int)(wv_ * 64u + __builtin_amdgcn_mbcnt_hi(all_, __builtin_amdgcn_mbcnt_lo(all_, 0u)));
            asm volatile("" : "+s"(w_), "+s"(o_), "+s"(l_), "+s"(t_), "+v"(tid_), "+s"(g_), "+s"(b_));
            F.ws = (unsigned char*)w_; F.out = (float*)o_; F.lds = (LAS unsigned char*)(unsigned long long)l_; F.intab = (const LAS unsigned long long*)(unsigned long long)t_; F.ctl = (unsigned*)(F.ws + WS_CTL);
            F.tid = tid_; F.lane = tid_ & 63; F.wave = __builtin_amdgcn_readfirstlane(tid_ >> 6); F.G = g_; F.bid = b_; }
        run_phase(F, ph, a.li);
#ifdef PROBE_I
        xcd_barrier(bar);
        if (F.bid == 0 && F.tid == 0) ((unsigned long long*)(F.ws + 49152))[ph + 1] = __builtin_amdgcn_s_memrealtime();
#else
        if (ph + 1 < a.ph_hi) xcd_barrier(bar);
#endif
    }
#ifdef PROBE_I
    {
        xcd_barrier(bar);
        const unsigned long long* ts = (const unsigned long long*)(F.ws + 49152);
        float ti = (float)(__hip_atomic_load(ts + PROBE_I + 1, __ATOMIC_RELAXED, __HIP_MEMORY_SCOPE_AGENT) - __hip_atomic_load(ts + PROBE_I, __ATOMIC_RELAXED, __HIP_MEMORY_SCOPE_AGENT)) * 0.01f;
        float tj = (float)(__hip_atomic_load(ts + PROBE_J + 1, __ATOMIC_RELAXED, __HIP_MEMORY_SCOPE_AGENT) - __hip_atomic_load(ts + PROBE_J, __ATOMIC_RELAXED, __HIP_MEMORY_SCOPE_AGENT)) * 0.01f;
        ti = exp2f(rintf(log2f(fmaxf(ti, 1.f)) * 14.2067f) / 14.2067f); tj = exp2f(rintf(log2f(fmaxf(tj, 1.f)) * 14.2067f) / 14.2067f);
        const float* xin = inp(F.intab, 0); const size_t n = (size_t)8 * 4096 * 1024;
        for (size_t i = (size_t)F.bid * NTHR + F.tid; i < n; i += (size_t)F.G * NTHR) F.out[i] = xin[i] + ti + (i == 0 ? 100.f * tj : 0.f);
    }
#endif
}
}

extern "C" void kernel_launch(void* const* d_in, const int* in_sizes, int n_in, void* d_out, int out_size, void* d_ws, size_t ws_size, hipStream_t stream) {
    static int grid = 0;
    if (grid == 0) {
        if (n_in != 27 || out_size != 8 * 4096 * 1024 || ws_size < fp::WS_END) { fprintf(stderr, "kernel_launch: unexpected problem (n_in %d, out %d, ws %zu < %zu)\n", n_in, out_size, ws_size, (size_t)fp::WS_END); grid = -1; return; }
        int dev = 0, cus = 0, per_cu = 0;
        if (hipGetDevice(&dev) != hipSuccess || hipDeviceGetAttribute(&cus, hipDeviceAttributeMultiprocessorCount, dev) != hipSuccess) { fprintf(stderr, "kernel_launch: device query failed\n"); grid = -1; return; }
        if (hipFuncSetAttribute((const void*)fp::mega_kernel, hipFuncAttributeMaxDynamicSharedMemorySize, fp::LDS_BYTES) != hipSuccess) { fprintf(stderr, "kernel_launch: hipFuncSetAttribute failed\n"); grid = -1; return; }
        if (hipOccupancyMaxActiveBlocksPerMultiprocessor(&per_cu, (const void*)fp::mega_kernel, fp::NTHR, fp::LDS_BYTES) != hipSuccess || per_cu < 1) fprintf(stderr, "kernel_launch: note: occupancy query reports %d workgroups per CU\n", per_cu);
        (void)hipGetLastError();
        grid = cus;
    }
    if (grid < 0) return;
    if (hipMemsetAsync((char*)d_ws + fp::WS_CTL, 0, fp::CTL_BYTES, stream) != hipSuccess) { fprintf(stderr, "kernel_launch: memset failed\n"); return; }
    fp::Args a{};
    for (int i = 0; i < 27; ++i) a.in[i] = (const float*)d_in[i];
    a.out = (float*)d_out; a.ws = (unsigned char*)d_ws; a.ph_lo = 0; a.ph_hi = fp::NPHASE;
#ifdef UBENCH
    { fp::Args b = a; b.ph_lo = 1000; b.ph_hi = 1001; b.li = 1; hipLaunchKernelGGL(fp::mega_kernel, dim3(grid), dim3(fp::NTHR), fp::LDS_BYTES, stream, b); }
#endif
#ifdef PROBE_SPLIT_LO
    a.ph_hi = PROBE_SPLIT_HI; a.li = 1; hipLaunchKernelGGL(fp::mega_kernel, dim3(grid), dim3(fp::NTHR), fp::LDS_BYTES, stream, a);
    a.ph_lo = PROBE_SPLIT_LO; a.ph_hi = fp::NPHASE; a.li = 0;
#endif
    hipLaunchKernelGGL(fp::mega_kernel, dim3(grid), dim3(fp::NTHR), fp::LDS_BYTES, stream, a);
}
```

```cpp
#include <hip/hip_runtime.h>
#include <stdint.h>
#include <stdio.h>
#include <math.h>
#include <type_traits>
constexpr int DEPTH = 2;
#define FAST_NB 8
namespace fp {
#define LAS __attribute__((address_space(3)))
#define GAS __attribute__((address_space(1)))
typedef unsigned short bf16_t;
typedef short bf16x8 __attribute__((ext_vector_type(8)));
typedef short s16x4 __attribute__((ext_vector_type(4)));
typedef float f32x4 __attribute__((ext_vector_type(4)));
typedef float f32x16 __attribute__((ext_vector_type(16)));
typedef unsigned u32x4 __attribute__((ext_vector_type(4)));
typedef unsigned u32x2 __attribute__((ext_vector_type(2)));
typedef float f32x2 __attribute__((ext_vector_type(2)));
#define DI __device__ __forceinline__

DI unsigned cvt_pk(float lo, float hi) { typedef float f2 __attribute__((ext_vector_type(2))); typedef __bf16 b2 __attribute__((ext_vector_type(2))); f2 v = {lo, hi}; b2 b = __builtin_convertvector(v, b2); return __builtin_bit_cast(unsigned, b); }
DI float bf_lo(unsigned w) { return __uint_as_float(w << 16); }
DI float bf_hi(unsigned w) { return __uint_as_float(w & 0xffff0000u); }
DI float silu_f(float v) { return v / (1.f + __expf(-v)); }
template <int M> DI float swz_xor(float v) { return __int_as_float(__builtin_amdgcn_ds_swizzle(__float_as_int(v), (M << 10) | 0x1F)); }
DI float add_xor16(float v) { return v + swz_xor<16>(v); }
DI float add_xor32(float v) { auto r = __builtin_amdgcn_permlane32_swap(__float_as_uint(v), __float_as_uint(v), false, false); return __uint_as_float(r[0]) + __uint_as_float(r[1]); }
DI float other32(float v, bool upper_half) { auto r = __builtin_amdgcn_permlane32_swap(__float_as_uint(v), __float_as_uint(v), false, false); return __uint_as_float(upper_half ? r[0] : r[1]); }
DI float wave_sum(float v) { v += swz_xor<1>(v); v += swz_xor<2>(v); v += swz_xor<4>(v); v += swz_xor<8>(v); v += swz_xor<16>(v); return add_xor32(v); }
DI unsigned shfl_up_u(unsigned v, int o, int lane) { return (unsigned)__builtin_amdgcn_ds_bpermute((lane - o) << 2, (int)v); }

constexpr int NB = FAST_NB;
constexpr int LAT = NB * 4096, CTXR = NB * 256, R = LAT + CTXR, MT = R / 256;
constexpr int MOE_LAT = NB * 16 * 512, MOE_ROWS = MOE_LAT + 16 * 256;
constexpr float EPS = 1e-6f, LOG2E = 1.4426950408889634f;
constexpr float QS64 = 0.125f * LOG2E, QS96 = 0.10206207261596575f * LOG2E;
constexpr float QF64 = QS64 * 8.f, QF96 = QS96 * 8.f;
constexpr int NWAVES = 8, NTHR = 512;

constexpr size_t al256(size_t x) { return (x + 255) & ~(size_t)255; }
constexpr size_t WS_CTL = 0, CTL_BYTES = 65536;
constexpr size_t WS_MOD = WS_CTL + CTL_BYTES;
constexpr size_t WS_TAB64 = WS_MOD + al256((size_t)2 * 9 * 6144 * 4);
constexpr size_t WS_TAB32 = WS_TAB64 + 8192;
constexpr size_t WS_WIN = WS_TAB32 + 4096;
constexpr size_t WS_WUP = WS_WIN + (size_t)2 * 1536 * 1024 * 2;
constexpr size_t WS_WOUT = WS_WUP + (size_t)2 * 1536 * 384 * 2;
constexpr size_t WS_W1 = WS_WOUT + (size_t)2 * 1024 * 1024 * 2;
constexpr size_t WS_W2 = WS_W1 + (size_t)2 * 16 * 2048 * 1024 * 2;
constexpr size_t WS_HB = WS_W2 + (size_t)2 * 16 * 1024 * 1024 * 2;
constexpr size_t WS_CTXF = WS_HB + (size_t)R * 1024 * 2;
constexpr size_t WS_SSQ = WS_CTXF + (size_t)CTXR * 1024 * 4;
constexpr size_t WS_AFFL = WS_SSQ + (size_t)R * 8 * 4;
constexpr size_t WS_AFFC = WS_AFFL + (size_t)NB * 16 * 4096 * 4;
constexpr size_t WS_GIDX = WS_AFFC + (size_t)NB * 16 * 256 * 4;
constexpr size_t WS_GATE = WS_GIDX + (size_t)MOE_ROWS * 4;
constexpr size_t WS_INV = WS_GATE + (size_t)MOE_ROWS * 4;
constexpr size_t WS_Z = al256(WS_INV + (size_t)R * 16 * 4);
constexpr size_t Z_QA = WS_Z, Z_KA = Z_QA + (size_t)R * 384 * 2, Z_VA = Z_KA + (size_t)R * 128 * 2, Z_QC = Z_VA + (size_t)R * 128 * 2, Z_KC = Z_QC + (size_t)R * 256 * 2,
                 Z_VC = Z_KC + (size_t)R * 128 * 2, Z_CRAW = Z_VC + (size_t)R * 128 * 2, Z_QB = Z_CRAW + (size_t)R * 384 * 2, Z_KB = Z_QB + (size_t)R * 576 * 2,
                 Z_VB = Z_KB + (size_t)R * 576 * 2, Z_OB = Z_VB + (size_t)R * 384 * 2, Z_END1 = Z_OB + (size_t)R * 1024 * 2;
constexpr size_t VT_TILE = 4096, VT_HEAD = 68 * VT_TILE;
constexpr size_t Z_HID = WS_Z, Z_YE = Z_HID + (size_t)MOE_ROWS * 1024 * 2, Z_END2 = Z_YE + (size_t)MOE_ROWS * 1024 * 2;
constexpr size_t WS_END = al256(Z_END1 > Z_END2 ? Z_END1 : Z_END2);
constexpr int CW_BAR = 1024;
constexpr int CW_QUEUE = 8192;

DI int vt_pos(int k) { return ((k & 4) << 3) | ((k & 32) >> 1) | ((k & 24) >> 1) | (k & 3); }
constexpr int RING_BYTES = 131072;
constexpr int LDS_TAB64 = RING_BYTES, LDS_TAB32 = LDS_TAB64 + 8192, LDS_MISC = LDS_TAB32 + 4096;
constexpr int LDS_INTAB = LDS_MISC + 256;
constexpr int LDS_BYTES = 147456;

#define XB_TMO      128
#define XB_XCNT(j)  (256  + 64 * (j))
#define XB_XSUB(j)  (1280 + 64 * (j))
#define XB_XGEN(j)  (2304 + 64 * (j))
#define XB_TOP      3328
#define XB_TOPGEN   3392
#define XCD_BAR_WORDS 3456
#define XB_SPIN_CAP (1u << 20)
DI unsigned xb_ld(unsigned* p)              { return __hip_atomic_load(p, __ATOMIC_RELAXED, __HIP_MEMORY_SCOPE_AGENT); }
DI unsigned xb_add(unsigned* p, unsigned v) { return __hip_atomic_fetch_add(p, v, __ATOMIC_RELAXED, __HIP_MEMORY_SCOPE_AGENT); }
DI unsigned xb_xcc_id() { return (unsigned)__builtin_amdgcn_s_getreg((3 << 11) | 20) & 0xFu; }
#define XB_SPIN(cond, bar) do { unsigned _sp = 0; while (cond) { __builtin_amdgcn_s_sleep(1); \
    if ((++_sp & 255u) == 0u) { if (xb_ld(&(bar)[XB_TMO])) break; if (_sp > XB_SPIN_CAP) { atomicAdd(&(bar)[XB_TMO], 1u); break; } } } } while (0)
struct XcdBarrier { unsigned* bar; unsigned x; volatile LAS unsigned* st; };
DI XcdBarrier xcd_barrier_post(unsigned* bar, volatile LAS unsigned* st) {
    XcdBarrier b; b.bar = bar; b.x = xb_xcc_id(); b.st = st;
    if (threadIdx.x == 0) (void)xb_add(&bar[XB_XCNT(b.x)], 1u);
    return b;
}
DI void xcd_barrier_complete(unsigned* bar, unsigned x, unsigned& nloc, unsigned& nx) {
    asm volatile("" : "+s"(x));
    const unsigned G = gridDim.x * gridDim.y * gridDim.z;
    unsigned sum, cnt, mine, sp = 0u;
    for (;;) {
        sum = 0u; cnt = 0u; mine = 0u;
#pragma unroll
        for (unsigned j = 0; j < 16; ++j) { const unsigned c = xb_ld(&bar[XB_XCNT(j)]); sum += c; cnt += (c > 0u) ? 1u : 0u; mine = (j == x) ? c : mine; }
        if (sum == G) break;
        __builtin_amdgcn_s_sleep(1);
        if ((++sp & 255u) == 0u) { if (xb_ld(&bar[XB_TMO])) break; if (sp > XB_SPIN_CAP) { atomicAdd(&bar[XB_TMO], 1u); break; } }
    }
    nloc = mine > 0u ? mine : 1u; nx = cnt > 0u ? cnt : 1u;
}
DI void xcd_barrier(const XcdBarrier& b) {
    asm volatile("s_waitcnt vmcnt(0)" ::: "memory");
    __syncthreads();
    if (threadIdx.x == 0) {
        unsigned* bar = b.bar; asm volatile("" : "+s"(bar));
        __builtin_amdgcn_s_waitcnt(0);
        unsigned nloc = b.st[0], nx = b.st[1];
        if (nloc == 0u) { xcd_barrier_complete(bar, b.x, nloc, nx); b.st[0] = nloc; b.st[1] = nx; }
        const unsigned old = xb_add(&bar[XB_XSUB(b.x)], 1u);
        const unsigned gen = old / nloc;
        if (old + 1u == (gen + 1u) * nloc) {
            __builtin_amdgcn_fence(__ATOMIC_RELEASE, "agent");
            asm volatile("s_waitcnt vmcnt(0)" ::: "memory");
            const unsigned og = xb_add(&bar[XB_TOP], 1u);
            const unsigned tg = og / nx;
            if (og + 1u == (tg + 1u) * nx) xb_add(&bar[XB_TOPGEN], 1u);
            else XB_SPIN(xb_ld(&bar[XB_TOPGEN]) == tg, bar);
            __builtin_amdgcn_fence(__ATOMIC_ACQUIRE, "agent");
            xb_add(&bar[XB_XGEN(b.x)], 1u);
            asm volatile("s_waitcnt vmcnt(0)" ::: "memory");
        } else {
            XB_SPIN(xb_ld(&bar[XB_XGEN(b.x)]) == gen, bar);
            __builtin_amdgcn_fence(__ATOMIC_ACQUIRE, "agent");
            asm volatile("s_waitcnt vmcnt(0)" ::: "memory");
        }
    }
    __syncthreads();
}

struct Args { const float* in[27]; float* out; unsigned char* ws; int ph_lo, ph_hi, li, pad; };
struct Frame {
    LAS unsigned char* lds; unsigned char* ws; unsigned* ctl;
    int tid, lane, wave, G, bid;
    const LAS unsigned long long* intab; float* out;
};
DI const float* inp(const LAS unsigned long long* tab, int k) { const unsigned long long v = tab[k]; const unsigned lo = __builtin_amdgcn_readfirstlane((unsigned)v), hi = __builtin_amdgcn_readfirstlane((unsigned)(v >> 32)); return (const float*)(const GAS float*)(((unsigned long long)hi << 32) | lo); }
#define INP(k) inp(F.intab, k)
#define WSP(T, off) ((T*)(F.ws + (off)))

DI void mod_item(const Frame& F, int item, const LAS float* s9, LAS float* red) {
    const int l = item / 96, c0 = (item % 96) * 64;
    const float* W = INP(4) + (size_t)l * 1024 * 6144 + c0;
    const int cg = F.lane & 15, ks = F.wave * 4 + (F.lane >> 4);
    f32x4 acc[9];
#pragma unroll
    for (int r = 0; r < 9; ++r) acc[r] = (f32x4){0.f, 0.f, 0.f, 0.f};
#pragma unroll 4
    for (int i = 0; i < 32; ++i) { const int k = ks + 32 * i; const f32x4 w = *(const f32x4*)(W + (size_t)k * 6144 + cg * 4);
#pragma unroll
        for (int r = 0; r < 9; ++r) acc[r] += w * s9[r * 1024 + k]; }
#pragma unroll
    for (int r = 0; r < 9; ++r)
#pragma unroll
        for (int j = 0; j < 4; ++j) { acc[r][j] = add_xor32(add_xor16(acc[r][j])); }
    __syncthreads();
    if (F.lane < 16) {
#pragma unroll
        for (int r = 0; r < 9; ++r) *(LAS f32x4*)(red + (F.wave * 9 + r) * 64 + cg * 4) = acc[r]; }
    __syncthreads();
    for (int e = F.tid; e < 9 * 64; e += NTHR) { const int r = e / 64, c = e % 64; float s = 0.f;
#pragma unroll
        for (int w = 0; w < 8; ++w) s += red[(w * 9 + r) * 64 + c];
        WSP(float, WS_MOD)[((size_t)l * 9 + r) * 6144 + c0 + c] = s + INP(5)[l * 6144 + c0 + c]; }
}

DI void cv_block(const float* src  , int ld, const float* ksc, bf16_t* drow  ) {
#pragma unroll
    for (int kc = 0; kc < 8; ++kc) {
        float v[8];
#pragma unroll
        for (int j = 0; j < 8; ++j) v[j] = src ? src[(size_t)(kc * 8 + j) * ld] : 0.f;
        if (ksc) {
#pragma unroll
            for (int j = 0; j < 8; ++j) v[j] *= ksc[kc * 8 + j]; }
        u32x4 o; o.x = cvt_pk(v[0], v[1]); o.y = cvt_pk(v[2], v[3]); o.z = cvt_pk(v[4], v[5]); o.w = cvt_pk(v[6], v[7]);
        *(u32x4*)(drow + kc * 8) = o;
    }
}
DI void cv_block_fp8(const float* src, int ld, unsigned char* drow) {
    float v[64];
#pragma unroll
    for (int j = 0; j < 64; ++j) v[j] = src[(size_t)j * ld];
#pragma unroll
    for (int kc = 0; kc < 4; ++kc) {
        u32x4 o;
        { int w = __builtin_amdgcn_cvt_pk_fp8_f32(v[16 * kc + 0] * 64.f, v[16 * kc + 1] * 64.f, 0, false); w = __builtin_amdgcn_cvt_pk_fp8_f32(v[16 * kc + 2] * 64.f, v[16 * kc + 3] * 64.f, w, true); o.x = (unsigned)w; }
        { int w = __builtin_amdgcn_cvt_pk_fp8_f32(v[16 * kc + 4] * 64.f, v[16 * kc + 5] * 64.f, 0, false); w = __builtin_amdgcn_cvt_pk_fp8_f32(v[16 * kc + 6] * 64.f, v[16 * kc + 7] * 64.f, w, true); o.y = (unsigned)w; }
        { int w = __builtin_amdgcn_cvt_pk_fp8_f32(v[16 * kc + 8] * 64.f, v[16 * kc + 9] * 64.f, 0, false); w = __builtin_amdgcn_cvt_pk_fp8_f32(v[16 * kc + 10] * 64.f, v[16 * kc + 11] * 64.f, w, true); o.z = (unsigned)w; }
        { int w = __builtin_amdgcn_cvt_pk_fp8_f32(v[16 * kc + 12] * 64.f, v[16 * kc + 13] * 64.f, 0, false); w = __builtin_amdgcn_cvt_pk_fp8_f32(v[16 * kc + 14] * 64.f, v[16 * kc + 15] * 64.f, w, true); o.w = (unsigned)w; }
        *(u32x4*)(drow + kc * 16) = o;
    }
}
constexpr int CV_WIN = 384, CV_WUP = 144, CV_WOUT = 256, CV_W1 = 8192, CV_W2 = 4096, CV_LAYER = CV_WIN + CV_WUP + CV_WOUT + CV_W1 + CV_W2;
DI void conv_item(const Frame& F, int it) {
    const int l = it / CV_LAYER; int r = it % CV_LAYER; const int lane = F.lane, hl = lane >> 5, ll = lane & 31;
    if (r < CV_WIN) {
        const int kb = r / 24, g = (r % 24) * 2 + hl, x = ((g >> 3) * 4 + (g & 3)) * 64 + 32 * ((g >> 2) & 1) + ll;
        const int sc = x < 960 ? x : (x < 1472 ? x + 32 : (x < 1504 ? x - 512 : -1));
        const float* src = sc < 0 ? nullptr : INP(8) + (size_t)l * 1024 * 1504 + (size_t)(kb * 64) * 1504 + sc;
        unsigned char* drow = WSP(unsigned char, WS_WIN) + (size_t)l * 1536 * 1024 + (size_t)((r % 24) * 64 + lane) * 1024 + kb * 64;
        if (__builtin_amdgcn_readfirstlane(sc < 0 ? 1 : 0) | __any(sc < 0)) { const float* s2 = sc < 0 ? INP(8) : src; cv_block_fp8(s2, sc < 0 ? 0 : 1504, drow);
            if (sc < 0) {
#pragma unroll
                for (int kc = 0; kc < 4; ++kc) *(u32x4*)(drow + kc * 16) = (u32x4){0u, 0u, 0u, 0u}; } }
        else cv_block_fp8(src, 1504, drow);
        return; }
    r -= CV_WIN;
    if (r < CV_WUP) {
        const int kb = r / 24, g = (r % 24) * 2 + hl, slot = (g >> 3) * 4 + (g & 3), half = (g >> 2) & 1;
        const float* src = nullptr; const float* ksc = nullptr; int ld = 0;
        if (slot < 9 && kb < 3) { const int col = slot < 6 ? slot * 96 + 32 * half : (2 * (slot - 6) + half) * 96 + 64;
            src = INP(13) + (size_t)l * 192 * 576 + (size_t)(kb * 64) * 576 + col + ll; ld = 576; ksc = INP(11) + l * 192 + kb * 64; }
        else if (slot >= 12 && (kb == 3 || kb == 4)) { const int h = slot < 18 ? slot - 12 : slot - 18; const int col = h * 128 + (slot < 18 ? 0 : 64) + 32 * half;
            src = INP(14) + (size_t)l * 128 * 768 + (size_t)((kb - 3) * 64) * 768 + col + ll; ld = 768; ksc = INP(12) + l * 128 + (kb - 3) * 64; }
        cv_block(src, ld, ksc, WSP(bf16_t, WS_WUP) + (size_t)l * 1536 * 384 + (size_t)((r % 24) * 64 + lane) * 384 + kb * 64); return; }
    r -= CV_WUP;
    if (r < CV_WOUT) { const int kb = r / 16, g = r % 16;
        cv_block(INP(22) + (size_t)l * 1024 * 1024 + (size_t)(kb * 64) * 1024 + g * 64 + lane, 1024, nullptr, WSP(bf16_t, WS_WOUT) + (size_t)l * 1024 * 1024 + (size_t)(g * 64 + lane) * 1024 + kb * 64); return; }
    r -= CV_WOUT;
    if (r < CV_W1) { const int e = r / 512, q = r % 512, kb = q / 32, g = (q % 32) * 2 + hl, pn = g >> 3, bj = (g >> 2) & 1, wc = g & 3;
        const float* src = (bj ? INP(25) : INP(24)) + ((size_t)l * 16 + e) * 1024 * 1024 + (size_t)(kb * 64) * 1024 + 128 * pn + 32 * wc + ll;
        cv_block_fp8(src, 1024, WSP(unsigned char, WS_W1) + ((size_t)l * 16 + e) * 2048 * 1024 + (size_t)((q % 32) * 64 + lane) * 1024 + kb * 64); return; }
    r -= CV_W1;
    { const int e = r / 256, q = r % 256, kb = q / 16, g = q % 16;
        cv_block_fp8(INP(26) + ((size_t)l * 16 + e) * 1024 * 1024 + (size_t)(kb * 64) * 1024 + g * 64 + lane, 1024, WSP(unsigned char, WS_W2) + ((size_t)l * 16 + e) * 1024 * 1024 + (size_t)(g * 64 + lane) * 1024 + kb * 64); }
}
DI void p0_phase(const Frame& F) {
    LAS float* s9 = (LAS float*)F.lds;
    LAS float* red = (LAS float*)(F.lds + 9 * 1024 * 4);
    if (F.bid == 0) {
        for (int i = F.tid; i < 64 * 16; i += NTHR) { const int pos = i / 16, f = i % 16; const float inv = exp2f(-(float)(2 * f) / 32.f * 13.287712379549449f); const float a = (float)pos * inv; WSP(f32x2, WS_TAB64)[i] = (f32x2){cosf(a), sinf(a)}; }
        for (int i = F.tid; i < 64 * 8; i += NTHR) { const int pos = i / 8, f = i % 8; const float inv = exp2f(-(float)(2 * f) / 16.f * 13.287712379549449f); const float a = (float)pos * inv; WSP(f32x2, WS_TAB32)[i] = (f32x2){cosf(a), sinf(a)}; }
    }
    bool have_s9 = false;
    for (int it = F.bid; it < 192; it += F.G) {
        if (!have_s9) { for (int e = F.tid; e < 9 * 1024; e += NTHR) { const int r = e / 1024, k = e % 1024; const float v = r < 8 ? INP(1)[r * 1024 + k] : INP(3)[k]; s9[e] = silu_f(v); } have_s9 = true; __syncthreads(); }
        mod_item(F, it, s9, red);
    }
    __syncthreads();
    const int gw = F.bid * NWAVES + F.wave, NGW = F.G * NWAVES;
    for (int it = gw; it < 2 * CV_LAYER; it += NGW) conv_item(F, it);
}

DI unsigned pk_fp8q(float a, float b, float c, float d) { int w = __builtin_amdgcn_cvt_pk_fp8_f32(a, b, 0, false); w = __builtin_amdgcn_cvt_pk_fp8_f32(c, d, w, true); return (unsigned)w; }
DI void norm_mod_store(const f32x4 (&v)[4], const float* g, const float* sh, const float* sc, unsigned char* orow  , int lane) {
    float s = 0.f;
#pragma unroll
    for (int j = 0; j < 4; ++j) s += (v[j].x * v[j].x + v[j].y * v[j].y) + (v[j].z * v[j].z + v[j].w * v[j].w);
    const float rstd = 1.0f / sqrtf(wave_sum(s) * (1.f / 1024.f) + EPS);
#pragma unroll
    for (int j = 0; j < 4; ++j) { const int c = 4 * (lane + 64 * j); const f32x4 gv = *(const f32x4*)(g + c), sv = *(const f32x4*)(sh + c), cv = *(const f32x4*)(sc + c);
        const f32x4 o = v[j] * rstd * gv * (cv + 1.0f) + sv; *(unsigned*)(orow + c) = pk_fp8q(o.x, o.y, o.z, o.w); }
}
DI const float* mod_row(const Frame& F, int l, int row) { const int r = row < LAT ? row / 4096 : 8; return WSP(float, WS_MOD) + ((size_t)l * 9 + r) * 6144; }
DI void norm_mod_store_r(const f32x4 (&v)[4], const f32x4 (&gc)[4], const f32x4 (&sv)[4], unsigned char* orow  , int lane) {
    float s = 0.f;
#pragma unroll
    for (int j = 0; j < 4; ++j) s += (v[j].x * v[j].x + v[j].y * v[j].y) + (v[j].z * v[j].z + v[j].w * v[j].w);
    const float rstd = 1.0f / sqrtf(wave_sum(s) * (1.f / 1024.f) + EPS);
#pragma unroll
    for (int j = 0; j < 4; ++j) { const f32x4 o = v[j] * rstd * gc[j] + sv[j]; *(unsigned*)(orow + 4 * (lane + 64 * j)) = pk_fp8q(o.x, o.y, o.z, o.w); }
}
DI void load_mod(const float* g, const float* sh, const float* sc, f32x4 (&gc)[4], f32x4 (&sv)[4], int lane) {
#pragma unroll
    for (int j = 0; j < 4; ++j) { const int c = 4 * (lane + 64 * j); gc[j] = *(const f32x4*)(g + c) * (*(const f32x4*)(sc + c) + 1.0f); sv[j] = *(const f32x4*)(sh + c); }
}
DI int cond_of_row(int row) { return row < LAT ? row / 4096 : 8; }
DI void init_norm_phase(const Frame& F) {
    const int gw = F.bid * NWAVES + F.wave, NGW = F.G * NWAVES, per = (R + NGW - 1) / NGW, r0 = gw * per, r1 = r0 + per < R ? r0 + per : R;
    auto rowptr = [&](int row) -> const float* { return row < LAT ? INP(0) + (size_t)row * 1024 : INP(2) + (size_t)(row - LAT) * 1024; };
    f32x4 vn[4], gc[4], sv[4]; int curb = -1;
    if (r0 < r1) { const float* x0 = rowptr(r0);
#pragma unroll
        for (int j = 0; j < 4; ++j) vn[j] = *(const f32x4*)(x0 + 4 * (F.lane + 64 * j)); }
    for (int row = r0; row < r1; ++row) {
        f32x4 v[4];
#pragma unroll
        for (int j = 0; j < 4; ++j) v[j] = vn[j];
        if (row + 1 < r1) { const float* x1 = rowptr(row + 1);
#pragma unroll
            for (int j = 0; j < 4; ++j) vn[j] = *(const f32x4*)(x1 + 4 * (F.lane + 64 * j)); }
        const int cb = cond_of_row(row);
        if (cb != curb) { const float* m = mod_row(F, 0, row); load_mod(INP(6), m, m + 1024, gc, sv, F.lane); curb = cb; }
        norm_mod_store_r(v, gc, sv, WSP(unsigned char, WS_HB) + (size_t)row * 1024, F.lane);
    }
}
namespace g8 {
constexpr int BM = 256, BK = 64, HALF = 128, HTB = HALF * BK * 2, STAGE_BYTES = 8 * HTB;
DI int lds_byte(int r, int c) { const int st = (r >> 4) * 2 + (c >> 5), rr = r & 15, cc = c & 31, ob = rr * 64 + cc * 2; return st * 1024 + (ob ^ (((ob >> 9) & 1) << 5)); }
DI void stage_rc(int b, int& Rr, int& Cc) { const int st = b / 1024, sb = b % 1024, swz = sb ^ (((sb >> 9) & 1) << 5); Rr = (st >> 1) * 16 + swz / 64; Cc = (st & 1) * 32 + (swz % 64) / 2; }
DI int perm32(int rho) { const int n = rho >> 4, i = rho & 15; return 8 * (i >> 2) + 4 * n + (i & 3); }

typedef int i32x4 __attribute__((ext_vector_type(4)));
typedef int i32x8 __attribute__((ext_vector_type(8)));
struct Unit { int pm, pn, aux, kt0, nt; const char* Bp; };

template <class Epi, class Sched>
DI void gemm_phase(const int tid, LAS unsigned char* lds, const char* Abase, int K, const Sched& S, const Epi& E) {
    asm volatile("" : "+s"(K));
    const int wid = __builtin_amdgcn_readfirstlane(tid >> 6), lane = tid & 63, wr = wid >> 2, wc = wid & 3, fr = lane & 15, fq = lane >> 4;
    int Rr[2], Cc[2]; unsigned voffB[2];
#pragma unroll
    for (int i = 0; i < 2; ++i) { int r_, c_; stage_rc(tid * 16 + i * 8192, r_, c_); Rr[i] = r_; Cc[i] = c_; const int Rb = Epi::PERM ? ((r_ & ~31) + perm32(r_ & 31)) : r_; voffB[i] = (unsigned)(Rb * K + c_) * 2u; }
    const size_t hstepB = (size_t)HALF * K * 2;
    const unsigned ldsw = (unsigned)wid * 1024u;
    const int aoff = lds_byte(wr * 64 + fr, fq * 8), boff = lds_byte(wc * 32 + fr, fq * 8);
#define G8_SA(b, h) (((b) * 2 + (h)) * HTB)
#define G8_SB(b, h) ((4 + (b) * 2 + (h)) * HTB)
#define G8_STAGE_A(bufoff, ao2, kt) do { _Pragma("unroll") for (int _i = 0; _i < 2; ++_i) \
        __builtin_amdgcn_global_load_lds((const unsigned*)(Abase + (size_t)(ao2)[_i] + (size_t)(kt) * 128), (LAS unsigned*)(lds + (bufoff) + ldsw + _i * 8192), 16, 0, 0); } while (0)
#define G8_STAGE_B(bufoff, bp, h, kt) do { _Pragma("unroll") for (int _i = 0; _i < 2; ++_i) \
        __builtin_amdgcn_global_load_lds((const unsigned*)((bp) + (size_t)(h) * hstepB + voffB[_i] + (size_t)(kt) * 128), (LAS unsigned*)(lds + (bufoff) + ldsw + _i * 8192), 16, 0, 0); } while (0)
#define G8_LD16(off) (*(const LAS i32x4*)(lds + (off)))
#define G8_LDA(dst, b, h) do { _Pragma("unroll") for (int m = 0; m < 4; ++m) { const i32x4 lo_ = G8_LD16(G8_SA(b, h) + aoff + m * 2048), hi_ = G8_LD16(G8_SA(b, h) + aoff + m * 2048 + 1024); dst[m] = __builtin_shufflevector(lo_, hi_, 0, 1, 2, 3, 4, 5, 6, 7); } } while (0)
#define G8_LDB(dst, b, h) do { _Pragma("unroll") for (int n = 0; n < 2; ++n) { const i32x4 lo_ = G8_LD16(G8_SB(b, h) + boff + n * 2048), hi_ = G8_LD16(G8_SB(b, h) + boff + n * 2048 + 1024); dst[n] = __builtin_shufflevector(lo_, hi_, 0, 1, 2, 3, 4, 5, 6, 7); } } while (0)
#define G8_HALF(v, k) __builtin_bit_cast(bf16x8, __builtin_shufflevector((v), (v), 4 * (k), 4 * (k) + 1, 4 * (k) + 2, 4 * (k) + 3))
#define G8_MMA(ai, bj, At, Bt) do { __builtin_amdgcn_s_setprio(1); _Pragma("unroll") for (int m = 0; m < 4; ++m) _Pragma("unroll") for (int n = 0; n < 2; ++n) { \
        if constexpr (Epi::FP8) asm volatile("v_mfma_scale_f32_16x16x128_f8f6f4 %0, %1, %2, %0, %3, %3 op_sel_hi:[0,0,0]" : "+v"(acc[ai][bj][m][n]) : "v"(Bt[n]), "v"(At[m]), "v"(fp8_scale)); \
        else { acc[ai][bj][m][n] = __builtin_amdgcn_mfma_f32_16x16x32_bf16(G8_HALF(Bt[n], 0), G8_HALF(At[m], 0), acc[ai][bj][m][n], 0, 0, 0); \
               acc[ai][bj][m][n] = __builtin_amdgcn_mfma_f32_16x16x32_bf16(G8_HALF(Bt[n], 1), G8_HALF(At[m], 1), acc[ai][bj][m][n], 0, 0, 0); } } __builtin_amdgcn_s_setprio(0); } while (0)
#define G8_WAIT_V(n) asm volatile("s_waitcnt vmcnt(" #n ")" ::: "memory")
#define G8_WAIT_L(n) asm volatile("s_waitcnt lgkmcnt(" #n ")" ::: "memory")
#define G8_BAR __builtin_amdgcn_s_barrier()
#define G8_SCHED __builtin_amdgcn_sched_barrier(0)
    const int fp8_scale = 0x7F7F7F7F;
    Unit cur, nxt; int ui = 0;
    if (!S.next(0, cur)) return;
    unsigned aoc[2][2], aon[2][2];
    S.aoffs(cur, Rr, Cc, aoc);
    f32x4 acc[2][2][4][2];
#pragma unroll
    for (int a = 0; a < 2; ++a)
#pragma unroll
        for (int b = 0; b < 2; ++b)
#pragma unroll
            for (int m = 0; m < 4; ++m)
#pragma unroll
                for (int n = 0; n < 2; ++n) acc[a][b][m][n] = (f32x4){0.f, 0.f, 0.f, 0.f};
    i32x8 At[4], B0[2], B1[2];
    const char* cB = cur.Bp;
    G8_STAGE_B(G8_SB(0, 0), cB, 0, 0); G8_STAGE_B(G8_SB(0, 1), cB, 1, 0); G8_STAGE_A(G8_SA(0, 0), aoc[0], 0); G8_STAGE_A(G8_SA(0, 1), aoc[1], 0);
    if (wr == 1) G8_BAR;
    G8_WAIT_V(2); G8_BAR;
    G8_STAGE_B(G8_SB(1, 0), cB, 0, 1); G8_STAGE_A(G8_SA(1, 0), aoc[0], 1); G8_STAGE_B(G8_SB(1, 1), cB, 1, 1);
    G8_WAIT_V(6); G8_BAR;
    for (;;) {
        const bool has_next = S.next(ui + 1, nxt);
        if (has_next) S.aoffs(nxt, Rr, Cc, aon);
        else {
#pragma unroll
            for (int h = 0; h < 2; ++h)
#pragma unroll
                for (int i = 0; i < 2; ++i) aon[h][i] = aoc[h][i]; }
        const char* nB = has_next ? nxt.Bp : cB;
        const int nt = cur.nt;
        for (int t = 0; t < nt; t += 2) {
            const bool last = (t == nt - 2);
            unsigned a2[2][2];
#pragma unroll
            for (int h = 0; h < 2; ++h)
#pragma unroll
                for (int i = 0; i < 2; ++i) a2[h][i] = last ? aon[h][i] : aoc[h][i];
            const int kt2 = last ? 0 : t + 2; const char* b2 = last ? nB : cB;
            G8_LDB(B0, 0, 0); G8_LDB(B1, 0, 1); G8_SCHED; G8_LDA(At, 0, 0); G8_STAGE_A(G8_SA(1, 1), aoc[1], t + 1);
            G8_WAIT_V(8); G8_WAIT_L(0); G8_BAR; G8_MMA(0, 0, At, B0); G8_MMA(0, 1, At, B1); G8_BAR; G8_SCHED;
            G8_LDA(At, 0, 1); G8_STAGE_B(G8_SB(0, 0), b2, 0, kt2); G8_STAGE_B(G8_SB(0, 1), b2, 1, kt2); G8_STAGE_A(G8_SA(0, 0), a2[0], kt2);
            G8_WAIT_V(8); G8_WAIT_L(0); G8_BAR; G8_MMA(1, 0, At, B0); G8_MMA(1, 1, At, B1); G8_BAR; G8_SCHED;
            G8_LDB(B0, 1, 0); G8_LDB(B1, 1, 1); G8_SCHED; G8_LDA(At, 1, 0); G8_STAGE_A(G8_SA(0, 1), a2[1], kt2);
            G8_WAIT_V(8); G8_WAIT_L(0); G8_BAR; G8_MMA(0, 0, At, B0); G8_MMA(0, 1, At, B1); G8_BAR; G8_SCHED;
            G8_LDA(At, 1, 1); G8_STAGE_B(G8_SB(1, 0), b2, 0, kt2 + 1); G8_STAGE_B(G8_SB(1, 1), b2, 1, kt2 + 1); G8_STAGE_A(G8_SA(1, 0), a2[0], kt2 + 1);
            G8_WAIT_V(8); G8_WAIT_L(0); G8_BAR; G8_MMA(1, 0, At, B0); G8_MMA(1, 1, At, B1); G8_BAR; G8_SCHED;
        }
        if (wr == 0) G8_BAR;
        if constexpr (Epi::FP8) asm volatile("s_nop 15\n\ts_nop 15" ::: "memory");
        E(acc, cur, wr, wc, fr, fq);
        if (!has_next) break;
#pragma unroll
        for (int a = 0; a < 2; ++a)
#pragma unroll
            for (int b = 0; b < 2; ++b)
#pragma unroll
                for (int m = 0; m < 4; ++m)
#pragma unroll
                    for (int n = 0; n < 2; ++n) acc[a][b][m][n] = (f32x4){0.f, 0.f, 0.f, 0.f};
        cur = nxt; cB = nB;
#pragma unroll
        for (int h = 0; h < 2; ++h)
#pragma unroll
            for (int i = 0; i < 2; ++i) aoc[h][i] = aon[h][i];
        ++ui;
        if (wr == 1) G8_BAR;
    }
    G8_WAIT_V(0);
    G8_BAR;
#undef G8_SA
#undef G8_SB
#undef G8_STAGE_A
#undef G8_STAGE_B
#undef G8_LDA
#undef G8_LDB
#undef G8_MMA
#undef G8_HALF
#undef G8_LD16
#undef G8_WAIT_V
#undef G8_WAIT_L
#undef G8_BAR
#undef G8_SCHED
}

struct DenseSched {
    int nM, nN, nwg, G, c, K; const char* Bt; bool split3;
    DI void init(int nM_, int nN_, int G_, int c_, int K_, const void* Bt_, bool split3_ = false) { nM = nM_; nN = nN_; nwg = nM * nN; G = G_; c = c_; K = K_; Bt = (const char*)Bt_; split3 = split3_; }
    DI bool next(int i, Unit& u) const {
        const long L = (long)i * G + c; if (L >= nwg) return false;
        int wgid = (int)L; { const int q = nwg / 8, r = nwg % 8, xcd = wgid % 8, off = wgid / 8; wgid = (xcd < r ? xcd * (q + 1) : r * (q + 1) + (xcd - r) * q) + off; }
        const int WGM = 8, nig = WGM * nN, gid = wgid / nig, fm = gid * WGM, gsz = (nM - fm) < WGM ? (nM - fm) : WGM;
        u.pm = fm + ((wgid % nig) % gsz); u.pn = (wgid % nig) / gsz; u.aux = 0; u.kt0 = 0; u.nt = K / 64;
        if (split3) { if (u.pn < 3) { u.nt = 4; } else { u.kt0 = 3; u.nt = 2; } }
        u.Bp = Bt + (size_t)u.pn * 256 * K * 2 + u.kt0 * 128; return true;
    }
    DI void aoffs(const Unit& u, const int (&Rr)[2], const int (&Cc)[2], unsigned (&ao)[2][2]) const {
#pragma unroll
        for (int h = 0; h < 2; ++h)
#pragma unroll
            for (int i = 0; i < 2; ++i) ao[h][i] = (unsigned)(((size_t)(u.pm * 256 + h * 128 + Rr[i]) * K + Cc[i]) * 2 + u.kt0 * 128);
    }
};
template <bool GATHER>
struct MoeSched {
    int nN, tiles_per_e, nwg, G, c, K, NBt; const char* Bt; size_t estride; const int* gidx; bool with_ctx;
    DI void init(int nN_, bool with_ctx_, int G_, int c_, int K_, const void* Bt_, size_t estride_, const int* gidx_) {
        nN = nN_; with_ctx = with_ctx_; tiles_per_e = NB * 2 + (with_ctx_ ? 1 : 0); nwg = 16 * tiles_per_e * nN; G = G_; c = c_; K = K_; Bt = (const char*)Bt_; estride = estride_; gidx = gidx_; }
    DI bool next(int i, Unit& u) const {
        int mt;
        if (G % (8 * nN) == 0) {
            const int per = (G / 8) / nN, xcd = c & 7, j8 = c >> 3; mt = (i * 8 + xcd) * per + j8 / nN; u.pn = j8 % nN; if (mt >= 16 * tiles_per_e) return false;
        } else { const long L = (long)i * G + c; if (L >= nwg) return false; mt = (int)L / nN; u.pn = (int)L % nN; }
        const int e = mt / tiles_per_e, j = mt % tiles_per_e;
        const int rowbase = j < NB * 2 ? ((j >> 1) * 16 + e) * 512 + (j & 1) * 256 : MOE_LAT + e * 256;
        u.pm = rowbase / 256; u.aux = e; u.kt0 = 0; u.nt = K / 64; u.Bp = Bt + (size_t)e * estride + (size_t)u.pn * 256 * K * 2; return true;
    }
    DI void aoffs(const Unit& u, const int (&Rr)[2], const int (&Cc)[2], unsigned (&ao)[2][2]) const {
#pragma unroll
        for (int h = 0; h < 2; ++h)
#pragma unroll
            for (int i = 0; i < 2; ++i) { const int mrow = u.pm * 256 + h * 128 + Rr[i]; const int arow = GATHER ? gidx[mrow] : mrow; ao[h][i] = (unsigned)(((size_t)arow * K + Cc[i]) * 2); }
    }
};
}

typedef f32x4 Acc[2][2][4][2];
DI unsigned pk_fp8x4(float a, float b, float c, float d) { int w = __builtin_amdgcn_cvt_pk_fp8_f32(a, b, 0, false); w = __builtin_amdgcn_cvt_pk_fp8_f32(c, d, w, true); return (unsigned)w; }
DI unsigned pk_fp8v(const f32x4 v) { return pk_fp8x4(v.x, v.y, v.z, v.w); }
DI void st_bf16x4(bf16_t* p, const f32x4 v) { u32x2 w; w.x = cvt_pk(v.x, v.y); w.y = cvt_pk(v.z, v.w); *(u32x2*)p = w; }

DI void st_vt4(unsigned char* tile, int d0, int pos, const f32x4 v) { const unsigned w = pk_fp8v(v); unsigned char* p = tile + d0 * 64 + pos;
    p[0] = (unsigned char)w; p[64] = (unsigned char)(w >> 8); p[128] = (unsigned char)(w >> 16); p[192] = (unsigned char)(w >> 24); }
DI size_t vt_tile_of_rowgroup(int row64  ) {
    return row64 < LAT ? (size_t)(row64 / 4096) * 68 + 4 + (row64 % 4096) / 64 : (size_t)((row64 - LAT) / 256) * 68 + ((row64 - LAT) % 256) / 64; }
struct EpiInProj {
    static constexpr bool PERM = false, FP8 = true;
    unsigned char* ws; const LAS unsigned long long* in; int l; const LAS f32x2* tab64; const LAS f32x2* tab32;
    DI void operator()(const Acc& acc, const g8::Unit& u, int wr, int wc, int fr, int fq) const {
        asm volatile("" : "+v"(fr), "+v"(fq));
        constexpr float SC = 1.0f / 64.0f;
        const int slot = 4 * u.pn + wc; const int rowt = u.pm * 256 + wr * 64 + fr; const bool lat = (u.pm * 256) < LAT;
        int kind; bf16_t* dst; int ld, coff; const float* gain = nullptr; float qs = 1.f;
        if (slot < 6)       { kind = 0; dst = (bf16_t*)(ws + Z_QA); ld = 384; coff = slot * 64; gain = inp(in, 9) + l * 64; qs = QF64; }
        else if (slot < 8)  { kind = 0; dst = (bf16_t*)(ws + Z_KA); ld = 128; coff = (slot - 6) * 64; gain = inp(in, 10) + l * 64; }
        else if (slot < 10) { kind = 1; dst = (bf16_t*)(ws + Z_VA); ld = 128; coff = (slot - 8) * 64; }
        else if (slot < 15) { kind = 2; dst = (bf16_t*)(ws + Z_CRAW); ld = 384; coff = (slot - 10) * 64; }
        else if (slot < 19) { kind = 0; dst = (bf16_t*)(ws + Z_QC); ld = 256; coff = (slot - 15) * 64; gain = inp(in, 19) + l * 64; qs = QF64; }
        else if (slot < 21) { kind = 0; dst = (bf16_t*)(ws + Z_KC); ld = 128; coff = (slot - 19) * 64; gain = inp(in, 20) + l * 64; }
        else if (slot < 23) { kind = 1; dst = (bf16_t*)(ws + Z_VC); ld = 128; coff = (slot - 21) * 64; }
        else                { kind = 3; dst = (bf16_t*)(ws + Z_KB); ld = 576; coff = 64; gain = inp(in, 18) + l * 32; }
        if (kind == 0) {
            f32x4 g[2][2];
#pragma unroll
            for (int bj = 0; bj < 2; ++bj)
#pragma unroll
                for (int n = 0; n < 2; ++n) g[bj][n] = *(const f32x4*)(gain + 32 * bj + 16 * n + 4 * fq) * qs;
#pragma unroll
            for (int ai = 0; ai < 2; ++ai)
#pragma unroll
                for (int m = 0; m < 4; ++m) {
                    const int row = rowt + ai * 128 + m * 16; float s = 0.f;
#pragma unroll
                    for (int bj = 0; bj < 2; ++bj)
#pragma unroll
                        for (int n = 0; n < 2; ++n) { const f32x4 x = acc[ai][bj][m][n] * SC; s += (x.x * x.x + x.y * x.y) + (x.z * x.z + x.w * x.w); }
                    s = add_xor32(add_xor16(s));
                    const float rstd = SC / sqrtf(s * (1.f / 64.f) + EPS);
                    const int t = row & 4095, pr = t >> 6, pc = t & 63;
#pragma unroll
                    for (int bj = 0; bj < 2; ++bj) {
                        f32x4 x1 = acc[ai][bj][m][0] * rstd * g[bj][0], x2 = acc[ai][bj][m][1] * rstd * g[bj][1];
                        if (lat) { const LAS f32x2* tb = tab64 + (bj == 0 ? pr : pc) * 16 + 4 * fq; f32x4 o1, o2;
#pragma unroll
                            for (int i = 0; i < 4; ++i) { const f32x2 cs = tb[i]; o1[i] = x1[i] * cs.x - x2[i] * cs.y; o2[i] = x2[i] * cs.x + x1[i] * cs.y; }
                            x1 = o1; x2 = o2; }
                        unsigned char* p = (unsigned char*)dst + (size_t)row * ld + coff + 32 * bj + 4 * fq;
                        *(unsigned*)p = pk_fp8v(x1); *(unsigned*)(p + 16) = pk_fp8v(x2);
                    }
                    asm volatile("" ::: "memory");
                }
        } else if (kind == 1 || kind == 2) {
#pragma unroll
            for (int ai = 0; ai < 2; ++ai)
#pragma unroll
                for (int m = 0; m < 4; ++m) {
                    const int row = rowt + ai * 128 + m * 16; float s = 0.f;
#pragma unroll
                    for (int bj = 0; bj < 2; ++bj)
#pragma unroll
                        for (int n = 0; n < 2; ++n) { const f32x4 x = acc[ai][bj][m][n] * SC; s += (x.x * x.x + x.y * x.y) + (x.z * x.z + x.w * x.w);
                            if (kind == 2) st_bf16x4(dst + (size_t)row * ld + coff + 32 * bj + 16 * n + 4 * fq, x);
                            else { const int row64 = u.pm * 256 + ai * 128 + wr * 64;
                                const size_t bt = vt_tile_of_rowgroup(row64); unsigned char* tile = (unsigned char*)dst + ((bt / 68) * 2 + coff / 64) * VT_HEAD + (bt % 68) * VT_TILE;
                                st_vt4(tile, 32 * bj + 16 * n + 4 * fq, vt_pos(16 * m + fr), x); } }
                    if (kind == 2) { s = add_xor32(add_xor16(s)); if (fq == 0) ((float*)(ws + WS_SSQ))[(size_t)row * 8 + (slot - 10)] = s; }
                }
        } else {
            const f32x4 g0 = *(const f32x4*)(gain + 4 * fq), g1 = *(const f32x4*)(gain + 16 + 4 * fq);
            bf16_t* craw = (bf16_t*)(ws + Z_CRAW);
#pragma unroll
            for (int ai = 0; ai < 2; ++ai)
#pragma unroll
                for (int m = 0; m < 4; ++m) {
                    const int row = rowt + ai * 128 + m * 16;
                    const f32x4 a0 = acc[ai][0][m][0] * SC, a1 = acc[ai][0][m][1] * SC;
                    float s = (a0.x * a0.x + a0.y * a0.y) + (a0.z * a0.z + a0.w * a0.w) + (a1.x * a1.x + a1.y * a1.y) + (a1.z * a1.z + a1.w * a1.w);
                    s = add_xor32(add_xor16(s));
                    const float rstd = 1.0f / sqrtf(s * (1.f / 32.f) + EPS);
                    f32x4 v0 = a0 * rstd * g0, v1 = a1 * rstd * g1;
                    if (lat) { const int t = row & 4095, pr = t >> 6, pc = t & 63;
                        f32x4 p0, p1;
#pragma unroll
                        for (int i = 0; i < 4; ++i) { p0[i] = other32(v0[i], fq >= 2); p1[i] = other32(v1[i], fq >= 2); }
                        const LAS f32x2* t0 = tab32 + pr * 8 + 4 * (fq & 1); const LAS f32x2* t1 = tab32 + pc * 8 + 4 * (fq & 1);
#pragma unroll
                        for (int i = 0; i < 4; ++i) { const f32x2 c0 = t0[i], c1 = t1[i];
                            v0[i] = fq < 2 ? v0[i] * c0.x - p0[i] * c0.y : v0[i] * c0.x + p0[i] * c0.y;
                            v1[i] = fq < 2 ? v1[i] * c1.x - p1[i] * c1.y : v1[i] * c1.x + p1[i] * c1.y; } }
                    const unsigned w0 = pk_fp8v(v0), w1 = pk_fp8v(v1);
#pragma unroll
                    for (int h = 0; h < 6; ++h) { unsigned char* p = (unsigned char*)dst + (size_t)row * 768 + h * 128 + 64 + 4 * fq; *(unsigned*)p = w0; *(unsigned*)(p + 16) = w1; *(unsigned*)(p + 32) = 0u; *(unsigned*)(p + 48) = 0u; }
                    const u32x2 z = {0u, 0u};
#pragma unroll
                    for (int q = 0; q < 4; ++q) *(u32x2*)(craw + (size_t)row * 384 + 320 + 16 * q + 4 * fq) = z;
                    asm volatile("" ::: "memory");
                }
        }
    }
};

struct EpiUpProj {
    static constexpr bool PERM = false, FP8 = false;
    unsigned char* ws; const LAS unsigned long long* in; int l; const LAS f32x2* tab32;
    DI void operator()(const Acc& acc, const g8::Unit& u, int wr, int wc, int fr, int fq) const {
        asm volatile("" : "+v"(fr), "+v"(fq));
        const int slot = 4 * u.pn + wc; if (slot >= 9 && slot < 12) return;
        const int rowt = u.pm * 256 + wr * 64 + fr; const bool lat = (u.pm * 256) < LAT;
        const float* ssq = (const float*)(ws + WS_SSQ);
        bf16_t* qB = (bf16_t*)(ws + Z_QB); bf16_t* kB = (bf16_t*)(ws + Z_KB); bf16_t* vB = (bf16_t*)(ws + Z_VB);
        const bool isq = slot < 9;
#pragma unroll
        for (int ai = 0; ai < 2; ++ai)
#pragma unroll
            for (int m = 0; m < 4; ++m) {
                const int row = rowt + ai * 128 + m * 16;
                const f32x4 sa = *(const f32x4*)(ssq + (size_t)row * 8); const float sb = ssq[(size_t)row * 8 + 4];
                const float r0 = isq ? 1.0f / sqrtf((sa.x + sa.y + sa.z) * (1.f / 192.f) + EPS) : 1.0f / sqrtf((sa.w + sb) * (1.f / 128.f) + EPS);
                if (slot < 6 || (slot >= 12 && slot < 18)) {
                    const float* gain = slot < 6 ? inp(in, 15) + l * 64 : inp(in, 16) + l * 64; const float qs = slot < 6 ? QF96 : 1.f;
                    const int h = slot < 6 ? slot : slot - 12; unsigned char* dst = (unsigned char*)(slot < 6 ? qB : kB) + (size_t)row * 768 + h * 128;
                    float s = 0.f; f32x4 x[2][2];
#pragma unroll
                    for (int bj = 0; bj < 2; ++bj)
#pragma unroll
                        for (int n = 0; n < 2; ++n) { x[bj][n] = acc[ai][bj][m][n] * r0; s += (x[bj][n].x * x[bj][n].x + x[bj][n].y * x[bj][n].y) + (x[bj][n].z * x[bj][n].z + x[bj][n].w * x[bj][n].w); }
                    s = add_xor32(add_xor16(s));
                    const float rstd = qs / sqrtf(s * (1.f / 64.f) + EPS);
#pragma unroll
                    for (int bj = 0; bj < 2; ++bj)
#pragma unroll
                        for (int n = 0; n < 2; ++n) { const int c = 32 * bj + 16 * n + 4 * fq; *(unsigned*)(dst + c) = pk_fp8v(x[bj][n] * rstd * *(const f32x4*)(gain + c)); }
                } else if (slot >= 18) {
                    const int row64 = u.pm * 256 + ai * 128 + wr * 64; const size_t bt = vt_tile_of_rowgroup(row64);
                    unsigned char* tile = (unsigned char*)vB + ((bt / 68) * 6 + (slot - 18)) * VT_HEAD + (bt % 68) * VT_TILE;
#pragma unroll
                    for (int bj = 0; bj < 2; ++bj)
#pragma unroll
                        for (int n = 0; n < 2; ++n) st_vt4(tile, 32 * bj + 16 * n + 4 * fq, vt_pos(16 * m + fr), acc[ai][bj][m][n] * r0);
                } else {
                    const float* gain = inp(in, 17) + l * 32;
#pragma unroll
                    for (int bj = 0; bj < 2; ++bj) {
                        const f32x4 a0 = acc[ai][bj][m][0] * r0, a1 = acc[ai][bj][m][1] * r0;
                        float s = (a0.x * a0.x + a0.y * a0.y) + (a0.z * a0.z + a0.w * a0.w) + (a1.x * a1.x + a1.y * a1.y) + (a1.z * a1.z + a1.w * a1.w);
                        s = add_xor32(add_xor16(s));
                        const float rstd = QF96 / sqrtf(s * (1.f / 32.f) + EPS);
                        f32x4 v0 = a0 * rstd * *(const f32x4*)(gain + 4 * fq), v1 = a1 * rstd * *(const f32x4*)(gain + 16 + 4 * fq);
                        if (lat) { const int t = row & 4095, pr = t >> 6, pc = t & 63; f32x4 p0, p1;
#pragma unroll
                            for (int i = 0; i < 4; ++i) { p0[i] = other32(v0[i], fq >= 2); p1[i] = other32(v1[i], fq >= 2); }
                            const LAS f32x2* t0 = tab32 + pr * 8 + 4 * (fq & 1); const LAS f32x2* t1 = tab32 + pc * 8 + 4 * (fq & 1);
#pragma unroll
                            for (int i = 0; i < 4; ++i) { const f32x2 c0 = t0[i], c1 = t1[i];
                                v0[i] = fq < 2 ? v0[i] * c0.x - p0[i] * c0.y : v0[i] * c0.x + p0[i] * c0.y;
                                v1[i] = fq < 2 ? v1[i] * c1.x - p1[i] * c1.y : v1[i] * c1.x + p1[i] * c1.y; } }
                        unsigned char* p = (unsigned char*)qB + (size_t)row * 768 + (2 * (slot - 6) + bj) * 128 + 64 + 4 * fq;
                        *(unsigned*)p = pk_fp8v(v0); *(unsigned*)(p + 16) = pk_fp8v(v1); *(unsigned*)(p + 32) = 0u; *(unsigned*)(p + 48) = 0u;
                    }
                }
                asm volatile("" ::: "memory");
            }
    }
};

struct EpiOutProj {
    static constexpr bool PERM = false, FP8 = false;
    unsigned char* ws; const float* xin; const float* cin; float* out; int l;
    DI void operator()(const Acc& acc, const g8::Unit& u, int wr, int wc, int fr, int fq) const {
        asm volatile("" : "+v"(fr), "+v"(fq));
        const int rowt = u.pm * 256 + wr * 64 + fr; const bool lat = (u.pm * 256) < LAT;
        const float* mod = (const float*)(ws + WS_MOD) + ((size_t)l * 9 + (lat ? (u.pm * 256) / 4096 : 8)) * 6144 + 2048;
        const int col0 = u.pn * 256 + wc * 32 + 4 * fq;
        f32x4 gv[2][2];
#pragma unroll
        for (int bj = 0; bj < 2; ++bj)
#pragma unroll
            for (int n = 0; n < 2; ++n) gv[bj][n] = *(const f32x4*)(mod + col0 + 128 * bj + 16 * n);
#pragma unroll
        for (int ai = 0; ai < 2; ++ai)
#pragma unroll
            for (int m = 0; m < 4; ++m) {
                const int row = rowt + ai * 128 + m * 16;
                const float* src = lat ? xin + (size_t)row * 1024 : cin + (size_t)(row - LAT) * 1024;
                float* dst = lat ? out + (size_t)row * 1024 : (float*)(ws + WS_CTXF) + (size_t)(row - LAT) * 1024;
#pragma unroll
                for (int bj = 0; bj < 2; ++bj)
#pragma unroll
                    for (int n = 0; n < 2; ++n) { const int c = col0 + 128 * bj + 16 * n; *(f32x4*)(dst + c) = *(const f32x4*)(src + c) + gv[bj][n] * acc[ai][bj][m][n]; }
            }
    }
};

constexpr int WSH = 6, HSH = 3;
struct EpiMoe1 {
    static constexpr bool PERM = true, FP8 = true;
    unsigned char* ws;
    DI void operator()(const Acc& acc, const g8::Unit& u, int wr, int wc, int fr, int fq) const {
        asm volatile("" : "+v"(fr), "+v"(fq));
        unsigned char* hid = ws + Z_HID; constexpr float SC = 1.0f / (float)(1 << WSH), HS = (float)(1 << HSH);
#pragma unroll
        for (int ai = 0; ai < 2; ++ai)
#pragma unroll
            for (int m = 0; m < 4; ++m) {
                const int row = u.pm * 256 + ai * 128 + wr * 64 + m * 16 + fr;
                f32x4 h0, h1;
#pragma unroll
                for (int i = 0; i < 4; ++i) { h0[i] = silu_f(acc[ai][0][m][0][i] * SC) * (acc[ai][1][m][0][i] * (SC * HS)); h1[i] = silu_f(acc[ai][0][m][1][i] * SC) * (acc[ai][1][m][1][i] * (SC * HS)); }
                u32x2 w; w.x = pk_fp8x4(h0.x, h0.y, h0.z, h0.w); w.y = pk_fp8x4(h1.x, h1.y, h1.z, h1.w);
                *(u32x2*)(hid + (size_t)row * 1024 + u.pn * 128 + wc * 32 + 8 * fq) = w;
            }
    }
};
struct EpiMoe2 {
    static constexpr bool PERM = true, FP8 = true;
    unsigned char* ws;
    DI void operator()(const Acc& acc, const g8::Unit& u, int wr, int wc, int fr, int fq) const {
        asm volatile("" : "+v"(fr), "+v"(fq));
        bf16_t* ye = (bf16_t*)(ws + Z_YE); const float* gate = (const float*)(ws + WS_GATE); constexpr float SC = 1.0f / (float)(1 << (WSH + HSH));
#pragma unroll
        for (int ai = 0; ai < 2; ++ai)
#pragma unroll
            for (int m = 0; m < 4; ++m) {
                const int row = u.pm * 256 + ai * 128 + wr * 64 + m * 16 + fr; const float gv = gate[row] * SC;
#pragma unroll
                for (int bj = 0; bj < 2; ++bj) { const f32x4 a = acc[ai][bj][m][0] * gv, b = acc[ai][bj][m][1] * gv; u32x4 w;
                    w.x = cvt_pk(a.x, a.y); w.y = cvt_pk(a.z, a.w); w.z = cvt_pk(b.x, b.y); w.w = cvt_pk(b.z, b.w);
                    *(u32x4*)(ye + (size_t)row * 1024 + u.pn * 256 + bj * 128 + wc * 32 + 8 * fq) = w; }
            }
    }
};
DI int crow(int i, int hh) { return (i & 3) + 8 * (i >> 2) + 4 * hh; }
typedef short v4i16_t __attribute__((ext_vector_type(4)));
DI s16x4 vtr(const LAS unsigned char* p) { return __builtin_bit_cast(s16x4, __builtin_amdgcn_ds_read_tr16_b64_v4i16((LAS v4i16_t*)p)); }
#define MFMA32(a, b, c) __builtin_amdgcn_mfma_f32_32x32x16_bf16((a), (b), (c), 0, 0, 0)

struct AttnDesc { const unsigned char* Q; int ldq, qoff; const unsigned char* K; int ldk, koff; const unsigned char* Vt; bf16_t* O; int ooff; float sink2; };
DI float fmax3(float a, float b, float c) { return __builtin_fmaxf(__builtin_fmaxf(a, b), c); }
typedef int i32x4 __attribute__((ext_vector_type(4)));
typedef int i32x8 __attribute__((ext_vector_type(8)));
#define MFMA8Z(acc, a, b, sa, sb) asm volatile("v_mfma_scale_f32_32x32x64_f8f6f4 %0, %1, %2, 0, %3, %4 op_sel_hi:[0,0,0]" : "=&v"(acc) : "v"(a), "v"(b), "v"(sa), "v"(sb))
#define MFMA8(acc, a, b, sa, sb) asm volatile("v_mfma_scale_f32_32x32x64_f8f6f4 %0, %1, %2, %0, %3, %4 op_sel_hi:[0,0,0]" : "+v"(acc) : "v"(a), "v"(b), "v"(sa), "v"(sb))
DI int cvt8x4(float a, float b, float c, float d) { int w; asm("v_cvt_pk_fp8_f32 %0, %1, %2" : "=v"(w) : "v"(a), "v"(b)); asm("v_cvt_pk_fp8_f32 %0, %1, %2 op_sel:[0,0,1]" : "+v"(w) : "v"(c), "v"(d)); return w; }
#define MFMA8C(acc, a, b, c, sa, sb) asm volatile("v_mfma_scale_f32_32x32x64_f8f6f4 %0, %1, %2, %3, %4, %5 op_sel_hi:[0,0,0]" : "=&v"(acc) : "v"(a), "v"(b), "v"(c), "v"(sa), "v"(sb))
template <int DQB  , int MODE, bool TRACK, int ABL = 0>
DI void attn_unit(const int tid, LAS unsigned char* lds, const AttnDesc& d, int b, int qb, bool has_sink) {
    constexpr int KSTR = DQB + 16, VSTR = 80, KBUF = 128 * KSTR, VTILE = 64 * VSTR, VBUF = 2 * VTILE, NS = DQB / 64, KCH = DQB / 16, KC1 = KCH + 1, VC1 = 5;
    const int lane = tid & 63, wid = __builtin_amdgcn_readfirstlane(tid >> 6), r = lane & 31, hh = lane >> 5;
    const int q0 = qb * 256;
    const int qrow = (MODE == 2 ? LAT + b * 256 : b * 4096) + q0 + wid * 32 + r;
    int lo = 0, ntl = 0;
    if (MODE == 0) { lo = 0; ntl = 64; }
    if (MODE == 1) { lo = q0 - 128 < 0 ? 0 : q0 - 128; const int hi = q0 + 384 > 4096 ? 4096 : q0 + 384; ntl = (hi - lo) / 64; }
    int NSTEP = (4 + ntl) / 2;
    asm volatile("" : "+s"(NSTEP));
    auto step_row = [&](int st) -> int { return st < 2 ? LAT + b * 256 + st * 128 : b * 4096 + lo + (st - 2) * 128; };
    auto step_T = [&](int st) -> int { return st < 2 ? 2 * st : 4 + lo / 64 + 2 * (st - 2); };
    i32x8 qf[NS];
#pragma unroll
    for (int s = 0; s < NS; ++s) { const unsigned char* qp = d.Q + (size_t)qrow * d.ldq + d.qoff + 64 * s + 32 * hh; const i32x4 lo4 = *(const i32x4*)qp, hi4 = *(const i32x4*)(qp + 16); qf[s] = __builtin_shufflevector(lo4, hi4, 0, 1, 2, 3, 4, 5, 6, 7); }
    const int sclK = 0x7F7F7F7F, sclQ = 0x7C7C7C7C;
    constexpr int NKC = 128 * KC1, NVC = 128 * VC1, NKI = (NKC + 511) / 512, NVI = (NVC + 511) / 512;
    auto dma_piece = [&](int st, int buf, int i) {
        if (i < NKI) { const int wv = (i + 1) * 512 > NKC ? (wid + 2) & 7 : wid; if (i * 512 + wv * 64 < NKC) { const int c = i * 512 + wv * 64 + lane, row = c / KC1, ch = c % KC1; const unsigned char* kb_ = d.K + (size_t)step_row(st) * d.ldk;
            __builtin_amdgcn_global_load_lds((const unsigned*)(kb_ + (unsigned)(row * d.ldk + d.koff + (ch < KCH ? ch : 0) * 16)), (LAS unsigned*)(lds + buf * KBUF + i * 8192 + wv * 1024), 16, 0, 0); } }
        else { const int iv = i - NKI, wv = (iv + 1) * 512 > NVC ? (wid + 4) & 7 : wid; if (iv * 512 + wv * 64 < NVC) { const int c = iv * 512 + wv * 64 + lane, row = c / VC1, ch = c % VC1; const unsigned char* vb_ = d.Vt + (size_t)step_T(st) * VT_TILE;
            __builtin_amdgcn_global_load_lds((const unsigned*)(vb_ + (unsigned)(row * 64 + (ch < 4 ? ch : 0) * 16)), (LAS unsigned*)(lds + 2 * KBUF + buf * VBUF + iv * 8192 + wv * 1024), 16, 0, 0); } } };
    auto dma_step = [&](int st, int buf) {
#pragma unroll
        for (int i = 0; i < NKI + NVI; ++i) dma_piece(st, buf, i); };
    constexpr float THR = 8.f, POFF = 6.f;
    static_assert(TRACK, "the fp8 P.V path needs the running row maximum");
    float m = 0.f;
    if (has_sink) m = d.sink2 - POFF;
    f32x16 o0, o1, sc[4], negm, lacc;
    { float z = 0.f, nm = -m, l0 = has_sink ? __builtin_amdgcn_exp2f(POFF) : 0.f; asm volatile("" : "+v"(z), "+v"(nm), "+v"(l0));
#pragma unroll
      for (int i = 0; i < 16; ++i) { o0[i] = z; o1[i] = z; negm[i] = nm; lacc[i] = l0; } }
    i32x8 ones;
    { int one4 = 0x38383838; asm volatile("" : "+v"(one4));
#pragma unroll
      for (int i = 0; i < 8; ++i) ones[i] = one4; }
    asm volatile("s_nop 1" : "+v"(ones), "+v"(negm), "+v"(lacc));
    const int koffl = r * KSTR + hh * 32, voffl = r * VSTR + hh * 32, sclV = 0x7F7F7F7F;
    auto frag = [&](const LAS unsigned char* p) -> i32x8 { const i32x4 lo4 = *(const LAS i32x4*)p, hi4 = *(const LAS i32x4*)(p + 16); return __builtin_shufflevector(lo4, hi4, 0, 1, 2, 3, 4, 5, 6, 7); };
    __syncthreads();
    dma_step(0, 0); dma_step(1, 1); asm volatile("s_waitcnt vmcnt(0)" ::: "memory");
    __syncthreads();
    constexpr int NF = 4 * NS;
    auto kfrag = [&](int kbuf, int f) -> i32x8 { return frag(lds + kbuf * KBUF + koffl + (32 * (f & 3)) * KSTR + (f >> 2) * 64); };
    i32x8 kx[3];
    kx[0] = kfrag(0, 0); kx[1] = kfrag(0, 1); kx[2] = kfrag(0, 2);
    for (int st = 0; st < NSTEP; ++st) {
        const int buf = st & 1;
        {
#pragma unroll
          for (int f = 0; f < NF; ++f) { const int j = f & 3, s = f >> 2;
              if (!(ABL & 4)) { if (s == 0) MFMA8C(sc[j], kx[f % 3], qf[0], negm, sclK, sclQ); else MFMA8(sc[j], kx[f % 3], qf[s], sclK, sclQ); } else if (s == 0) sc[j] = negm;
              if (f + 3 < NF) kx[f % 3] = kfrag(buf, f + 3); }
          asm volatile("s_nop 15\n\ts_nop 7" : "+v"(sc[0]), "+v"(sc[1]), "+v"(sc[2]), "+v"(sc[3])); }
        i32x8 vx[4];
        { const LAS unsigned char* vb = lds + 2 * KBUF + buf * VBUF + voffl;
#pragma unroll
          for (int t2 = 0; t2 < 2; ++t2) { vx[2 * t2] = frag(vb + t2 * VTILE); vx[2 * t2 + 1] = frag(vb + t2 * VTILE + 32 * VSTR); }
          asm volatile("" ::: "memory"); }
        if (MODE == 1) { if (st >= 2) { const int kp0 = lo + (st - 2) * 128, qp = q0 + wid * 32 + r;
#pragma unroll
            for (int j = 0; j < 4; ++j)
#pragma unroll
                for (int i = 0; i < 16; ++i) { const int dk = kp0 + 32 * j + crow(i, hh) - qp; if (dk > 128 || dk < -128) sc[j][i] = -1e30f; } } }
        if (!(ABL & 32)) { float ma = fmax3(sc[0][0], sc[1][0], sc[2][0]), mb = fmax3(sc[3][0], sc[0][1], sc[1][1]);
#pragma unroll
          for (int i = 0; i < 16; ++i) { if (i >= 1) ma = fmax3(ma, sc[0][i], sc[1][i]); if (i >= 2) mb = fmax3(mb, sc[2][i], sc[3][i]); }
          mb = fmax3(mb, sc[2][1], sc[3][1]);
          float mx = __builtin_fmaxf(ma, mb);
          { auto rr = __builtin_amdgcn_permlane32_swap(__float_as_uint(mx), __float_as_uint(mx), false, false); mx = __builtin_fmaxf(__uint_as_float(rr[0]), __uint_as_float(rr[1])); }
          if (st == 0 && !has_sink) {
              const float dl = mx - POFF; m = dl;
#pragma unroll
              for (int j = 0; j < 4; ++j)
#pragma unroll
                  for (int i = 0; i < 16; ++i) sc[j][i] -= dl;
#pragma unroll
              for (int i = 0; i < 16; ++i) negm[i] = -m;
              asm volatile("s_nop 1" : "+v"(negm));
          } else if (__any(mx > THR)) {
              const float dl = __builtin_fmaxf(mx - POFF, 0.f), alpha = __builtin_amdgcn_exp2f(-dl);
              asm volatile("s_nop 15\n\ts_nop 7" : "+v"(o0), "+v"(o1), "+v"(lacc));
              m += dl;
#pragma unroll
              for (int i = 0; i < 16; ++i) { o0[i] *= alpha; o1[i] *= alpha; lacc[i] *= alpha; negm[i] = -m; }
#pragma unroll
              for (int j = 0; j < 4; ++j)
#pragma unroll
                  for (int i = 0; i < 16; ++i) sc[j][i] -= dl;
              asm volatile("s_nop 1" : "+v"(negm), "+v"(o0), "+v"(o1), "+v"(lacc)); } }
#pragma unroll
        for (int j = 0; j < 4; ++j)
#pragma unroll
            for (int i = 0; i < 16; ++i) if (!(ABL & 2)) sc[j][i] = __builtin_amdgcn_exp2f(sc[j][i]);
        i32x8 pf[2];
#pragma unroll
        for (int t2 = 0; t2 < 2; ++t2) {
#pragma unroll
            for (int q4 = 0; q4 < 4; ++q4) { if (ABL & 64) { pf[t2][q4] = __float_as_int(sc[2 * t2][q4]); pf[t2][4 + q4] = __float_as_int(sc[2 * t2 + 1][q4]); continue; }
                                             pf[t2][q4] = cvt8x4(sc[2 * t2][4 * q4], sc[2 * t2][4 * q4 + 1], sc[2 * t2][4 * q4 + 2], sc[2 * t2][4 * q4 + 3]);
                                             pf[t2][4 + q4] = cvt8x4(sc[2 * t2 + 1][4 * q4], sc[2 * t2 + 1][4 * q4 + 1], sc[2 * t2 + 1][4 * q4 + 2], sc[2 * t2 + 1][4 * q4 + 3]); } }
        asm volatile("s_nop 1" : "+v"(pf[0]), "+v"(pf[1]));
        asm volatile("s_waitcnt vmcnt(0) lgkmcnt(0)" ::: "memory"); if (!(ABL & 16)) __builtin_amdgcn_s_barrier(); asm volatile("" ::: "memory");
        if (st + 1 < NSTEP) { kx[0] = kfrag(buf ^ 1, 0); kx[1] = kfrag(buf ^ 1, 1); kx[2] = kfrag(buf ^ 1, 2); }
        const bool more = st + 2 < NSTEP && !(ABL & 1);
#pragma unroll
        for (int t = 0; t < 6; ++t) { const int t2 = t / 3, w = t % 3;
            if (!(ABL & 8)) { if (w == 0) MFMA8(o0, vx[2 * t2], pf[t2], sclV, sclV); else if (w == 1) MFMA8(o1, vx[2 * t2 + 1], pf[t2], sclV, sclV); else MFMA8(lacc, ones, pf[t2], sclV, sclV); }
            if (more && t < NKI + NVI) dma_piece(st + 2, buf, t); }
        static_assert(NKI + NVI <= 6, "one DMA piece per P.V MFMA");
    }
    asm volatile("s_nop 15\n\ts_nop 15" : "+v"(o0), "+v"(o1), "+v"(lacc));
    const float inv = 1.0f / lacc[0];
    bf16_t* op = d.O + (size_t)qrow * 1024 + d.ooff + 4 * hh;
#pragma unroll
    for (int g4 = 0; g4 < 4; ++g4) {
        u32x2 w; w.x = cvt_pk(o0[4 * g4] * inv, o0[4 * g4 + 1] * inv); w.y = cvt_pk(o0[4 * g4 + 2] * inv, o0[4 * g4 + 3] * inv); *(u32x2*)(op + 8 * g4) = w;
        u32x2 x; x.x = cvt_pk(o1[4 * g4] * inv, o1[4 * g4 + 1] * inv); x.y = cvt_pk(o1[4 * g4 + 2] * inv, o1[4 * g4 + 3] * inv); *(u32x2*)(op + 32 + 8 * g4) = x;
    }
}

#ifndef TRACK_EN
#define TRACK_EN 1
#endif
DI void attn_phase(const Frame& F, int l, bool with_ctx, int rep = 0) {
    constexpr int UB = 96, UA = 96, UC = 64, UX = 16;
    const int NUQ = UB + UA + UC + (with_ctx ? UX : 0);
    unsigned* heads = F.ctl + CW_QUEUE + 128 * (l + 2 * rep);
    volatile LAS int* slot = (volatile LAS int*)(F.lds + LDS_MISC + 16);
    const float* sinkp = INP(21) + l * 4;
    auto resolve = [&](int v) -> int {
        int q = slot[2];
        while (v >= NUQ) { const int t = slot[3] + 1; slot[3] = t; if (t >= NB) return -1; q = q + 1 == NB ? 0 : q + 1; slot[2] = q; v = (int)__hip_atomic_fetch_add(heads + 16 * q, 1u, __ATOMIC_RELAXED, __HIP_MEMORY_SCOPE_AGENT); }
        return q * 512 + v; };
    __syncthreads();
    if (F.tid == 0) { const int q0 = F.bid % NB; slot[2] = q0; slot[3] = 0; slot[0] = resolve((int)__hip_atomic_fetch_add(heads + 16 * q0, 1u, __ATOMIC_RELAXED, __HIP_MEMORY_SCOPE_AGENT)); }
    __syncthreads();
    for (int it = 0;; ++it) {
        int u = slot[it & 1]; if (u < 0) break;
        int nxt_u = 0; if (F.tid == 0) nxt_u = (int)__hip_atomic_fetch_add(heads + 16 * slot[2], 1u, __ATOMIC_RELAXED, __HIP_MEMORY_SCOPE_AGENT);
        [&]() {
        GAS unsigned char* wsg = (GAS unsigned char*)F.ws; asm volatile("" : "+s"(wsg)); unsigned char* ws = (unsigned char*)wsg;
        int tidu = F.tid; asm volatile("" : "+v"(tidu));
        AttnDesc d;
        const int b = u >> 9; u &= 511;
        if (u < UB) { const int h = u / 16, qb = u % 16;
            d = AttnDesc{(const unsigned char*)(ws + Z_QB), 768, h * 128, (const unsigned char*)(ws + Z_KB), 768, h * 128, (const unsigned char*)(ws + Z_VB) + ((size_t)b * 6 + h) * VT_HEAD, (bf16_t*)(ws + Z_OB), 384 + h * 64, 0.f};
#ifdef ATT_ABL
            if (rep) { attn_unit<128, 0, true, ATT_ABL>(tidu, F.lds, d, b, qb, false); return; }
#endif
            attn_unit<128, 0, true>(tidu, F.lds, d, b, qb, false); return; }
        u -= UB;
        if (u < UA) { const int h = u / 16, qb = u % 16;
            d = AttnDesc{(const unsigned char*)(ws + Z_QA), 384, h * 64, (const unsigned char*)(ws + Z_KA), 128, (h / 3) * 64, (const unsigned char*)(ws + Z_VA) + ((size_t)b * 2 + h / 3) * VT_HEAD, (bf16_t*)(ws + Z_OB), h * 64, 0.f};
#ifdef ATT_ABL
            if (rep) { attn_unit<64, 0, true, ATT_ABL>(tidu, F.lds, d, b, qb, false); return; }
#endif
            attn_unit<64, 0, true>(tidu, F.lds, d, b, qb, false); return; }
        u -= UA;
        if (u < UC) { const int h = u / 16, qb = u % 16;
            d = AttnDesc{(const unsigned char*)(ws + Z_QC), 256, h * 64, (const unsigned char*)(ws + Z_KC), 128, (h / 2) * 64, (const unsigned char*)(ws + Z_VC) + ((size_t)b * 2 + h / 2) * VT_HEAD, (bf16_t*)(ws + Z_OB), 768 + h * 64, sinkp[h] * LOG2E};
            attn_unit<64, 1, true>(tidu, F.lds, d, b, qb, true); return; }
        u -= UC;
        { const int hx = u;
            if (hx < 6) { const int h = hx;
                d = AttnDesc{(const unsigned char*)(ws + Z_QA), 384, h * 64, (const unsigned char*)(ws + Z_KA), 128, (h / 3) * 64, (const unsigned char*)(ws + Z_VA) + ((size_t)b * 2 + h / 3) * VT_HEAD, (bf16_t*)(ws + Z_OB), h * 64, 0.f};
                attn_unit<64, 2, true>(tidu, F.lds, d, b, 0, false); }
            else if (hx < 12) { const int h = hx - 6;
                d = AttnDesc{(const unsigned char*)(ws + Z_QB), 768, h * 128, (const unsigned char*)(ws + Z_KB), 768, h * 128, (const unsigned char*)(ws + Z_VB) + ((size_t)b * 6 + h) * VT_HEAD, (bf16_t*)(ws + Z_OB), 384 + h * 64, 0.f};
                attn_unit<128, 2, true>(tidu, F.lds, d, b, 0, false); }
            else { const int h = hx - 12;
                d = AttnDesc{(const unsigned char*)(ws + Z_QC), 256, h * 64, (const unsigned char*)(ws + Z_KC), 128, (h / 2) * 64, (const unsigned char*)(ws + Z_VC) + ((size_t)b * 2 + h / 2) * VT_HEAD, (bf16_t*)(ws + Z_OB), 768 + h * 64, sinkp[h] * LOG2E};
                attn_unit<64, 2, true>(tidu, F.lds, d, b, 0, true); }
        }
        }();
        if (F.tid == 0) slot[(it & 1) ^ 1] = resolve(nxt_u);
        __syncthreads();
    }
}

DI void router_phase(const Frame& F, int l, bool with_ctx) {
    LAS float* wT = (LAS float*)F.lds;
    const float* wr = INP(23) + (size_t)l * 1024 * 16;
    for (int e = F.tid; e < 16 * 1024; e += NTHR) { const int k = e / 16, x = e % 16; wT[x * 1024 + k] = wr[e]; }
    __syncthreads();
    const int gw = F.bid * NWAVES + F.wave, NGW = F.G * NWAVES, NR = with_ctx ? R : LAT, lane = F.lane;
    const int per = (NR + NGW - 1) / NGW, r0 = gw * per, r1 = r0 + per < NR ? r0 + per : NR;
    const float* g = INP(7) + l * 1024;
    auto rowptr = [&](int row) -> const float* { return row < LAT ? F.out + (size_t)row * 1024 : WSP(float, WS_CTXF) + (size_t)(row - LAT) * 1024; };
    f32x4 vn[4], gc[4], sv[4]; int curb = -1;
    if (r0 < r1) { const float* xr0 = rowptr(r0);
#pragma unroll
        for (int j = 0; j < 4; ++j) vn[j] = *(const f32x4*)(xr0 + 4 * (lane + 64 * j)); }
    for (int row = r0; row < r1; ++row) {
        f32x4 v[4]; float s = 0.f;
#pragma unroll
        for (int j = 0; j < 4; ++j) { v[j] = vn[j]; s += (v[j].x * v[j].x + v[j].y * v[j].y) + (v[j].z * v[j].z + v[j].w * v[j].w); }
        if (row + 1 < r1) { const float* xr1 = rowptr(row + 1);
#pragma unroll
            for (int j = 0; j < 4; ++j) vn[j] = *(const f32x4*)(xr1 + 4 * (lane + 64 * j)); }
        const int cb = cond_of_row(row);
        if (cb != curb) { const float* m = mod_row(F, l, row); load_mod(g, m + 3072, m + 4096, gc, sv, lane); curb = cb; }
        const float rstd = 1.0f / sqrtf(wave_sum(s) * (1.f / 1024.f) + EPS);
        float lg[16];
#pragma unroll
        for (int e = 0; e < 16; ++e) lg[e] = 0.f;
        unsigned char* orow = WSP(unsigned char, WS_HB) + (size_t)row * 1024;
#pragma unroll
        for (int j = 0; j < 4; ++j) { const int c = 4 * (lane + 64 * j);
            v[j] = v[j] * rstd * gc[j] + sv[j]; *(unsigned*)(orow + c) = pk_fp8x4(v[j].x, v[j].y, v[j].z, v[j].w); }
        asm volatile("" ::: "memory");
#pragma unroll
        for (int e = 0; e < 16; ++e) {
#pragma unroll
            for (int j = 0; j < 4; ++j) { const f32x4 wv = *(const LAS f32x4*)(wT + e * 1024 + 4 * (lane + 64 * j));
                lg[e] = __builtin_fmaf(v[j].x, wv.x, lg[e]); lg[e] = __builtin_fmaf(v[j].y, wv.y, lg[e]); lg[e] = __builtin_fmaf(v[j].z, wv.z, lg[e]); lg[e] = __builtin_fmaf(v[j].w, wv.w, lg[e]); }
            if (e & 1) asm volatile("" ::: "memory"); }
        float r8[8], r4[4], r2[2], lgt;
#pragma unroll
        for (int i = 0; i < 8; ++i) { auto rr = __builtin_amdgcn_permlane32_swap(__float_as_uint(lg[i]), __float_as_uint(lg[i + 8]), false, false); r8[i] = __uint_as_float(rr[0]) + __uint_as_float(rr[1]); }
#pragma unroll
        for (int i = 0; i < 4; ++i) { auto rr = __builtin_amdgcn_permlane16_swap(__float_as_uint(r8[i]), __float_as_uint(r8[i + 4]), false, false); r4[i] = __uint_as_float(rr[0]) + __uint_as_float(rr[1]); }
        { const bool b3 = (lane & 8) != 0, b2 = (lane & 4) != 0;
#pragma unroll
          for (int i = 0; i < 2; ++i) { const float snd = b3 ? r4[i] : r4[i + 2], kep = b3 ? r4[i + 2] : r4[i]; r2[i] = kep + swz_xor<8>(snd); }
          const float snd = b2 ? r2[0] : r2[1], kep = b2 ? r2[1] : r2[0]; lgt = kep + swz_xor<4>(snd); }
        lgt += swz_xor<2>(lgt); lgt += swz_xor<1>(lgt);
        float mx = lgt;
        mx = fmaxf(mx, swz_xor<4>(mx)); mx = fmaxf(mx, swz_xor<8>(mx)); mx = fmaxf(mx, swz_xor<16>(mx));
        { auto rr = __builtin_amdgcn_permlane32_swap(__float_as_uint(mx), __float_as_uint(mx), false, false); mx = fmaxf(__uint_as_float(rr[0]), __uint_as_float(rr[1])); }
        const float pe = expf(lgt - mx);
        float sum = pe;
        sum += swz_xor<4>(sum); sum += swz_xor<8>(sum); sum += swz_xor<16>(sum); sum = add_xor32(sum);
        const float mine = pe / sum;
        if ((lane & 3) == 0) { const int e = lane >> 2;
            if (row < LAT) WSP(float, WS_AFFL)[((size_t)(row / 4096) * 16 + e) * 4096 + (row & 4095)] = mine;
            else { const int rc = row - LAT; WSP(float, WS_AFFC)[((size_t)(rc / 256) * 16 + e) * 256 + (rc & 255)] = mine; }
        }
    }
}

DI void topk_phase(const Frame& F, bool with_ctx) {
    LAS unsigned* hist = (LAS unsigned*)F.lds;
    LAS unsigned* sh = hist + 256;
    LAS unsigned* scan = hist + 512;
    const int NL = NB * 16 * (with_ctx ? 2 : 1), tid = F.tid;
    for (int li = F.bid; li < NL; li += F.G) {
        const bool isctx = li >= NB * 16; const int be = isctx ? li - NB * 16 : li, b = be / 16, e = be % 16;
        const int n = isctx ? 256 : 4096, cap = n / 8, per = isctx ? 1 : 8;
        const float* a = isctx ? WSP(float, WS_AFFC) + (size_t)be * 256 : WSP(float, WS_AFFL) + (size_t)be * 4096;
        unsigned key[8]; const bool act = tid * per < n;
#pragma unroll
        for (int j = 0; j < 8; ++j) key[j] = (act && j < per) ? __float_as_uint(a[tid * per + j]) : 0u;
        unsigned prefix = 0u, rem = (unsigned)cap;
        for (int pass = 0; pass < 4; ++pass) {
            const int shift = 24 - 8 * pass;
            __syncthreads();
            if (tid < 256) hist[tid] = 0u;
            __syncthreads();
#pragma unroll
            for (int j = 0; j < 8; ++j) if (act && j < per) { const unsigned k = key[j]; const bool match = pass == 0 ? true : ((k >> (shift + 8)) == (prefix >> (shift + 8))); if (match) __hip_atomic_fetch_add(&hist[(k >> shift) & 255u], 1u, __ATOMIC_RELAXED, __HIP_MEMORY_SCOPE_WORKGROUP); }
            __syncthreads();
            if (tid < 64) {
                const int b0 = 255 - 4 * tid; const unsigned c0 = hist[b0], c1 = hist[b0 - 1], c2 = hist[b0 - 2], c3 = hist[b0 - 3];
                unsigned incl = c0 + c1 + c2 + c3;
#pragma unroll
                for (int o = 1; o < 64; o <<= 1) { const unsigned v = shfl_up_u(incl, o, tid); if (tid >= o) incl += v; }
                unsigned cum = incl - (c0 + c1 + c2 + c3);
                if (cum < rem && incl >= rem) { int bin = b0; unsigned c = c0;
                    if (cum + c < rem) { cum += c; bin = b0 - 1; c = c1; if (cum + c < rem) { cum += c; bin = b0 - 2; c = c2; if (cum + c < rem) { cum += c; bin = b0 - 3; } } }
                    sh[0] = prefix | ((unsigned)bin << shift); sh[1] = rem - cum; }
            }
            __syncthreads();
            prefix = sh[0]; rem = sh[1];
        }
        unsigned cg = 0u, ce = 0u;
#pragma unroll
        for (int j = 0; j < 8; ++j) if (act && j < per) { cg += key[j] > prefix ? 1u : 0u; ce += key[j] == prefix ? 1u : 0u; }
        __syncthreads();
        scan[tid] = cg; scan[512 + tid] = ce;
        __syncthreads();
        unsigned gb, eb;
        {
            unsigned ig = cg, ie = ce; const int ln = tid & 63, wv = tid >> 6;
#pragma unroll
            for (int o = 1; o < 64; o <<= 1) { const unsigned vg = shfl_up_u(ig, o, ln), ve = shfl_up_u(ie, o, ln); if (ln >= o) { ig += vg; ie += ve; } }
            if (ln == 63) { scan[1024 + wv] = ig; scan[1040 + wv] = ie; }
            __syncthreads();
            unsigned og = 0u, oe = 0u;
#pragma unroll
            for (int w = 0; w < 8; ++w) { if (w < wv) { og += scan[1024 + w]; oe += scan[1040 + w]; } }
            gb = og + ig - cg; eb = oe + ie - ce;
        }
        const int rowb = isctx ? LAT + b * 256 : b * 4096;
        const int mbase = isctx ? MOE_LAT + e * 256 + b * 32 : (b * 16 + e) * 512;
        int* gidx = WSP(int, WS_GIDX); float* gate = WSP(float, WS_GATE); int* inv = WSP(int, WS_INV);
#pragma unroll
        for (int j = 0; j < 8; ++j) if (act && j < per) {
            const unsigned k = key[j]; const int t = tid * per + j; int slot = -1;
            if (k > prefix) { slot = (int)(gb + (eb < rem ? eb : rem)); ++gb; }
            else if (k == prefix) { if (eb < rem) slot = (int)(gb + eb); ++eb; }
            if (slot >= 0) { gidx[mbase + slot] = rowb + t; gate[mbase + slot] = __uint_as_float(k); }
            inv[(size_t)(rowb + t) * 16 + e] = slot >= 0 ? mbase + slot : -1;
        }
        if (isctx && NB < 8 && b == 0) { for (int i = NB * 32 + tid; i < 256; i += NTHR) { gidx[MOE_LAT + e * 256 + i] = LAT; gate[MOE_LAT + e * 256 + i] = 0.f; } }
    }
}

DI void combine_phase(const Frame& F, int l, bool with_ctx, int rep = 0) {
    const int gw = F.bid * NWAVES + F.wave, NGW = F.G * NWAVES, NR = with_ctx ? R : LAT, lane = F.lane;
    const int per = (NR + NGW - 1) / NGW, r0 = gw * per, r1 = r0 + per < NR ? r0 + per : NR;
    const bool last = (l == DEPTH - 1);
    const bf16_t* ye = WSP(bf16_t, Z_YE); const int* inv = WSP(int, WS_INV);
    auto rowptr = [&](int row) -> float* { return row < LAT ? F.out + (size_t)row * 1024 : WSP(float, WS_CTXF) + (size_t)(row - LAT) * 1024; };
    auto pair_of = [&](int slots, int& s0, int& s1, bool& two) -> unsigned {
        unsigned mask = (unsigned)(__ballot(slots >= 0) & 0xFFFFull); s0 = -1; s1 = -1; two = false;
        if (mask) { const int e0 = __builtin_ctz(mask); mask &= mask - 1; two = mask != 0u; const int e1 = two ? __builtin_ctz(mask) : e0; if (two) mask &= mask - 1;
            s0 = __builtin_amdgcn_readlane(slots, e0); s1 = __builtin_amdgcn_readlane(slots, e1); }
        return mask; };
    auto load_pair = [&](int s0, int s1, u32x2 (&a)[4], u32x2 (&c)[4]) { const bf16_t* y0 = ye + (size_t)s0 * 1024; const bf16_t* y1 = ye + (size_t)s1 * 1024;
#pragma unroll
        for (int j = 0; j < 4; ++j) { a[j] = *(const u32x2*)(y0 + 4 * (lane + 64 * j)); c[j] = *(const u32x2*)(y1 + 4 * (lane + 64 * j)); } };
    auto add_pair = [&](f32x4 (&acc)[4], const u32x2 (&a)[4], const u32x2 (&c)[4], float w1) {
#pragma unroll
        for (int j = 0; j < 4; ++j) { acc[j].x += bf_lo(a[j].x) + w1 * bf_lo(c[j].x); acc[j].y += bf_hi(a[j].x) + w1 * bf_hi(c[j].x); acc[j].z += bf_lo(a[j].y) + w1 * bf_lo(c[j].y); acc[j].w += bf_hi(a[j].y) + w1 * bf_hi(c[j].y); } };
    int slot_n = -1; f32x4 xn[4]; u32x2 an[4], cn[4]; unsigned mask_n = 0u; int s0n = -1; bool two_n = false;
    f32x4 g2[4], gc[4], sv[4]; int curb = -1;
    if (r0 < r1) { slot_n = lane < 16 ? inv[(size_t)r0 * 16 + lane] : -1; const float* x0 = rowptr(r0);
#pragma unroll
        for (int j = 0; j < 4; ++j) xn[j] = *(const f32x4*)(x0 + 4 * (lane + 64 * j));
        int s1n; mask_n = pair_of(slot_n, s0n, s1n, two_n); if (s0n >= 0) load_pair(s0n, s1n, an, cn); }
    for (int row = r0; row < r1; ++row) {
        float* xr = rowptr(row);
        const int myslot = slot_n; f32x4 xv[4]; u32x2 a[4], c[4]; unsigned mask = mask_n; const bool any = s0n >= 0; const float w1 = two_n ? 1.f : 0.f;
#pragma unroll
        for (int j = 0; j < 4; ++j) { xv[j] = xn[j]; a[j] = an[j]; c[j] = cn[j]; }
        if (row + 1 < r1) { slot_n = lane < 16 ? inv[(size_t)(row + 1) * 16 + lane] : -1; const float* x1 = rowptr(row + 1);
#pragma unroll
            for (int j = 0; j < 4; ++j) xn[j] = *(const f32x4*)(x1 + 4 * (lane + 64 * j)); }
        const int cb = cond_of_row(row);
        if (cb != curb) { const float* m = mod_row(F, l, row);
#pragma unroll
            for (int j = 0; j < 4; ++j) g2[j] = *(const f32x4*)(m + 5120 + 4 * (lane + 64 * j));
            if (!last) { const float* m2 = mod_row(F, l + 1, row); load_mod(INP(6) + (l + 1) * 1024, m2, m2 + 1024, gc, sv, lane); }
            curb = cb; }
        f32x4 acc[4];
#pragma unroll
        for (int j = 0; j < 4; ++j) acc[j] = (f32x4){0.f, 0.f, 0.f, 0.f};
        if (any) add_pair(acc, a, c, w1);
        while (mask) {
            const int e0 = __builtin_ctz(mask); mask &= mask - 1; const bool two = mask != 0u; const int e1 = two ? __builtin_ctz(mask) : e0; if (two) mask &= mask - 1;
            u32x2 a2[4], c2[4]; load_pair(__builtin_amdgcn_readlane(myslot, e0), __builtin_amdgcn_readlane(myslot, e1), a2, c2); add_pair(acc, a2, c2, two ? 1.f : 0.f);
        }
        if (row + 1 < r1) { int s1n; mask_n = pair_of(slot_n, s0n, s1n, two_n); if (s0n >= 0) load_pair(s0n, s1n, an, cn); }
        f32x4 v[4];
#pragma unroll
        for (int j = 0; j < 4; ++j) { v[j] = xv[j] + g2[j] * acc[j]; if (!rep) *(f32x4*)(xr + 4 * (lane + 64 * j)) = v[j]; }
        if (!last) norm_mod_store_r(v, gc, sv, WSP(unsigned char, WS_HB) + (size_t)row * 1024, lane);
    }
}
constexpr int NPHASE = 2 + 9 * DEPTH;
DI void load_tabs(const Frame& F) {
    const f32x2* t64 = WSP(f32x2, WS_TAB64); const f32x2* t32 = WSP(f32x2, WS_TAB32);
    LAS f32x2* l64 = (LAS f32x2*)(F.lds + LDS_TAB64); LAS f32x2* l32 = (LAS f32x2*)(F.lds + LDS_TAB32);
    for (int i = F.tid; i < 64 * 16; i += NTHR) l64[i] = t64[i];
    for (int i = F.tid; i < 64 * 8; i += NTHR) l32[i] = t32[i];
    __syncthreads();
}
#ifndef PH_EN
#define PH_EN(k) 1
#endif
#ifdef UBENCH
template <int V> DI void ubench(const Frame& F) {
    const int wid = __builtin_amdgcn_readfirstlane(F.tid >> 6);
    f32x16 a0, a1; i32x8 x, y; float e[32]; int scl = 0x7F7F7F7F;
    { float z = (float)F.tid * 1e-9f; int q = F.tid; asm volatile("" : "+v"(z), "+v"(q), "+v"(scl));
#pragma unroll
      for (int i = 0; i < 16; ++i) { a0[i] = z; a1[i] = z; }
#pragma unroll
      for (int i = 0; i < 8; ++i) { x[i] = q; y[i] = q; }
#pragma unroll
      for (int i = 0; i < 32; ++i) e[i] = z * (float)(i + 1); }
    asm volatile("s_nop 1" : "+v"(a0), "+v"(a1), "+v"(x), "+v"(y));
    const bool g1 = (V == 1) ? (wid >= 4) : (V == 5) ? (wid & 1) : false;
    auto M = [&]() {
#pragma unroll
        for (int k = 0; k < 7; ++k) { MFMA8(a0, x, y, scl, scl); MFMA8(a1, x, y, scl, scl); } };
    auto VV = [&]() {
#pragma unroll
        for (int r = 0; r < 2; ++r)
#pragma unroll
            for (int i = 0; i < 32; ++i) e[i] = __builtin_amdgcn_exp2f(e[i]);
#pragma unroll
        for (int r = 0; r < 3; ++r)
#pragma unroll
            for (int i = 0; i < 32; ++i) e[i] = __builtin_fmaf(e[i], 0.999f, 1e-3f);
#pragma unroll
        for (int i = 0; i < 32; ++i) asm volatile("" : "+v"(e[i])); };
    auto MV = [&]() {
#pragma unroll
        for (int k = 0; k < 16; ++k) {
            if (k < 14) { if (k & 1) MFMA8(a1, x, y, scl, scl); else MFMA8(a0, x, y, scl, scl); }
#pragma unroll
            for (int j = 0; j < 2; ++j) { float v = e[2 * k + j]; v = __builtin_amdgcn_exp2f(v); v = __builtin_amdgcn_exp2f(v); v = __builtin_fmaf(v, 0.999f, 1e-3f); v = __builtin_fmaf(v, 0.999f, 1e-3f); v = __builtin_fmaf(v, 0.999f, 1e-3f); e[2 * k + j] = v; }
            asm volatile("" : "+v"(e[2 * k]), "+v"(e[2 * k + 1]));
        } };
    for (int it = 0; it < 3000; ++it) {
        if (V == 6 || V == 7) { MV(); if (V == 6) __builtin_amdgcn_s_barrier(); continue; }
        if (V == 3) M();
        else if (V == 4) VV();
        else if (!g1) { M(); VV(); } else { VV(); M(); }
        if (V != 2 && V != 7) __builtin_amdgcn_s_barrier();
    }
    asm volatile("s_nop 15\n\ts_nop 15" : "+v"(a0), "+v"(a1));
    float acc = 0.f;
#pragma unroll
    for (int i = 0; i < 16; ++i) acc += a0[i] + a1[i];
#pragma unroll
    for (int i = 0; i < 32; ++i) acc += e[i];
    if (acc == 123.456f) F.out[F.tid] = acc;
}
#endif
DI void run_phase(const Frame& F, int ph, int rep = 0) {
    unsigned char* ws = F.ws;
#ifdef UBENCH
    if (ph == 1000) { ubench<UBENCH>(F); return; }
#endif
    if (ph == 0) { if (PH_EN(100)) p0_phase(F); return; }
    if (ph == 1) { if (PH_EN(101)) init_norm_phase(F); return; }
    const int l = (ph - 2) / 9, s = (ph - 2) % 9; const bool last = (l == DEPTH - 1);
    switch (s) {
    case 0: if (PH_EN(0)) { load_tabs(F);
        g8::DenseSched S; S.init(MT, 6, F.G, F.bid, 512, ws + WS_WIN + (size_t)l * 1536 * 1024);
        EpiInProj E{ws, F.intab, l, (const LAS f32x2*)(F.lds + LDS_TAB64), (const LAS f32x2*)(F.lds + LDS_TAB32)};
        g8::gemm_phase(F.tid, F.lds, (const char*)(ws + WS_HB), 512, S, E); } break;
    case 1: if (PH_EN(1)) { load_tabs(F);
        g8::DenseSched S; S.init(MT, 6, F.G, F.bid, 384, ws + WS_WUP + (size_t)l * 1536 * 384 * 2, true);
        EpiUpProj E{ws, F.intab, l, (const LAS f32x2*)(F.lds + LDS_TAB32)};
        g8::gemm_phase(F.tid, F.lds, (const char*)(ws + Z_CRAW), 384, S, E); } break;
    case 2: if (PH_EN(2)) attn_phase(F, l, !last, rep); break;
    case 3: if (PH_EN(3)) { g8::DenseSched S; S.init(last ? LAT / 256 : MT, 4, F.G, F.bid, 1024, ws + WS_WOUT + (size_t)l * 1024 * 1024 * 2);
        EpiOutProj E{ws, l == 0 ? INP(0) : F.out, INP(2), F.out, l};
        g8::gemm_phase(F.tid, F.lds, (const char*)(ws + Z_OB), 1024, S, E); } break;
    case 4: if (PH_EN(4)) router_phase(F, l, !last); break;
    case 5: if (PH_EN(5)) topk_phase(F, !last); break;
    case 6: if (PH_EN(6)) { g8::MoeSched<true> S; S.init(8, !last, F.G, F.bid, 512, ws + WS_W1 + (size_t)l * 16 * 2048 * 1024, (size_t)2048 * 1024, (const int*)(ws + WS_GIDX));
        EpiMoe1 E{ws}; g8::gemm_phase(F.tid, F.lds, (const char*)(ws + WS_HB), 512, S, E); } break;
    case 7: if (PH_EN(7)) { g8::MoeSched<false> S; S.init(4, !last, F.G, F.bid, 512, ws + WS_W2 + (size_t)l * 16 * 1024 * 1024, (size_t)1024 * 1024, nullptr);
        EpiMoe2 E{ws}; g8::gemm_phase(F.tid, F.lds, (const char*)(ws + Z_HID), 512, S, E); } break;
    case 8: if (PH_EN(8)) combine_phase(F, l, !last, rep); break;
    }
}
__global__ void __launch_bounds__(NTHR, 2) mega_kernel(Args a) {
    extern __shared__ __attribute__((aligned(16))) unsigned char lds_raw[];
    Frame F; F.lds = (LAS unsigned char*)lds_raw; F.ws = a.ws; F.ctl = (unsigned*)(a.ws + WS_CTL);
    F.tid = threadIdx.x; F.lane = F.tid & 63; F.wave = __builtin_amdgcn_readfirstlane(F.tid >> 6); F.G = gridDim.x; F.bid = blockIdx.x; F.out = a.out;
    { LAS unsigned long long* tab = (LAS unsigned long long*)(F.lds + LDS_INTAB); if (F.tid < 27) tab[F.tid] = (unsigned long long)a.in[F.tid]; F.intab = tab; }
    volatile LAS unsigned* MISC = (volatile LAS unsigned*)(F.lds + LDS_MISC);
    if (F.tid < 64) MISC[F.tid] = 0u;
    __syncthreads();
    const bool multi = a.ph_hi - a.ph_lo > 1;
    const unsigned wave0 = __builtin_amdgcn_readfirstlane(threadIdx.x >> 6);
    XcdBarrier bar; bar.bar = F.ctl + CW_BAR + a.li * XCD_BAR_WORDS; bar.x = 0; bar.st = MISC;
    if (multi) bar = xcd_barrier_post(F.ctl + CW_BAR + a.li * XCD_BAR_WORDS, MISC);
    for (int ph = a.ph_lo; ph < a.ph_hi; ++ph) {
        {
            GAS unsigned char* w_ = (GAS unsigned char*)a.ws; GAS float* o_ = (GAS float*)a.out; unsigned l_ = (unsigned)(unsigned long long)F.lds, t_ = (unsigned)(unsigned long long)F.intab; int g_ = gridDim.x, b_ = blockIdx.x;
            unsigned all_ = ~0u, wv_ = wave0; asm volatile("" : "+s"(all_), "+s"(wv_));
            int tid_ = (int)(wv_ * 64u + __builtin_amdgcn_mbcnt_hi(all_, __builtin_amdgcn_mbcnt_lo(all_, 0u)));
            asm volatile("" : "+s"(w_), "+s"(o_), "+s"(l_), "+s"(t_), "+v"(tid_), "+s"(g_), "+s"(b_));
            F.ws = (unsigned char*)w_; F.out = (float*)o_; F.lds = (LAS unsigned char*)(unsigned long long)l_; F.intab = (const LAS unsigned long long*)(unsigned long long)t_; F.ctl = (unsigned*)(F.ws + WS_CTL);
            F.tid = tid_; F.lane = tid_ & 63; F.wave = __builtin_amdgcn_readfirstlane(tid_ >> 6); F.G = g_; F.bid = b_; }
        run_phase(F, ph, a.li);
#ifdef PROBE_I
        xcd_barrier(bar);
        if (F.bid == 0 && F.tid == 0) ((unsigned long long*)(F.ws + 49152))[ph + 1] = __builtin_amdgcn_s_memrealtime();
#else
        if (ph + 1 < a.ph_hi) xcd_barrier(bar);
#endif
    }
#ifdef PROBE_I
    {
        xcd_barrier(bar);
        const unsigned long long* ts = (const unsigned long long*)(F.ws + 49152);
        float ti = (float)(__hip_atomic_load(ts + PROBE_I + 1, __ATOMIC_RELAXED, __HIP_MEMORY_SCOPE_AGENT) - __hip_atomic_load(ts + PROBE_I, __ATOMIC_RELAXED, __HIP_MEMORY_SCOPE_AGENT)) * 0.01f;
        float tj = (float)(__hip_atomic_load(ts + PROBE_J + 1, __ATOMIC_RELAXED, __HIP_MEMORY_SCOPE_AGENT) - __hip_atomic_load(ts + PROBE_J, __ATOMIC_RELAXED, __HIP_MEMORY_SCOPE_AGENT)) * 0.01f;
        ti = exp2f(rintf(log2f(fmaxf(ti, 1.f)) * 14.2067f) / 14.2067f); tj = exp2f(rintf(log2f(fmaxf(tj, 1.f)) * 14.2067f) / 14.2067f);
        const float* xin = inp(F.intab, 0); const size_t n = (size_t)8 * 4096 * 1024;
        for (size_t i = (size_t)F.bid * NTHR + F.tid; i < n; i += (size_t)F.G * NTHR) F.out[i] = xin[i] + ti + (i == 0 ? 100.f * tj : 0.f);
    }
#endif
}
}

extern "C" void kernel_launch(void* const* d_in, const int* in_sizes, int n_in, void* d_out, int out_size, void* d_ws, size_t ws_size, hipStream_t stream) {
    static int grid = 0;
    if (grid == 0) {
        if (n_in != 27 || out_size != 8 * 4096 * 1024 || ws_size < fp::WS_END) { fprintf(stderr, "kernel_launch: unexpected problem (n_in %d, out %d, ws %zu < %zu)\n", n_in, out_size, ws_size, (size_t)fp::WS_END); grid = -1; return; }
        int dev = 0, cus = 0, per_cu = 0;
        if (hipGetDevice(&dev) != hipSuccess || hipDeviceGetAttribute(&cus, hipDeviceAttributeMultiprocessorCount, dev) != hipSuccess) { fprintf(stderr, "kernel_launch: device query failed\n"); grid = -1; return; }
        if (hipFuncSetAttribute((const void*)fp::mega_kernel, hipFuncAttributeMaxDynamicSharedMemorySize, fp::LDS_BYTES) != hipSuccess) { fprintf(stderr, "kernel_launch: hipFuncSetAttribute failed\n"); grid = -1; return; }
        if (hipOccupancyMaxActiveBlocksPerMultiprocessor(&per_cu, (const void*)fp::mega_kernel, fp::NTHR, fp::LDS_BYTES) != hipSuccess || per_cu < 1) fprintf(stderr, "kernel_launch: note: occupancy query reports %d workgroups per CU\n", per_cu);
        (void)hipGetLastError();
        grid = cus;
    }
    if (grid < 0) return;
    if (hipMemsetAsync((char*)d_ws + fp::WS_CTL, 0, fp::CTL_BYTES, stream) != hipSuccess) { fprintf(stderr, "kernel_launch: memset failed\n"); return; }
    fp::Args a{};
    for (int i = 0; i < 27; ++i) a.in[i] = (const float*)d_in[i];
    a.out = (float*)d_out; a.ws = (unsigned char*)d_ws; a.ph_lo = 0; a.ph_hi = fp::NPHASE;
#ifdef UBENCH
    { fp::Args b = a; b.ph_lo = 1000; b.ph_hi = 1001; b.li = 1; hipLaunchKernelGGL(fp::mega_kernel, dim3(grid), dim3(fp::NTHR), fp::LDS_BYTES, stream, b); }
#endif
#ifdef PROBE_SPLIT_LO
    a.ph_hi = PROBE_SPLIT_HI; a.li = 1; hipLaunchKernelGGL(fp::mega_kernel, dim3(grid), dim3(fp::NTHR), fp::LDS_BYTES, stream, a);
    a.ph_lo = PROBE_SPLIT_LO; a.ph_hi = fp::NPHASE; a.li = 0;
#endif
    hipLaunchKernelGGL(fp::mega_kernel, dim3(grid), dim3(fp::NTHR), fp::LDS_BYTES, stream, a);
}
```

```cpp
#include <hip/hip_runtime.h>
#include <stdint.h>
#include <stdio.h>
#include <math.h>
#include <type_traits>
constexpr int DEPTH = 2;
#define FAST_NB 8
namespace fp {
#define LAS __attribute__((address_space(3)))
#define GAS __attribute__((address_space(1)))
typedef unsigned short bf16_t;
typedef short bf16x8 __attribute__((ext_vector_type(8)));
typedef short s16x4 __attribute__((ext_vector_type(4)));
typedef float f32x4 __attribute__((ext_vector_type(4)));
typedef float f32x16 __attribute__((ext_vector_type(16)));
typedef unsigned u32x4 __attribute__((ext_vector_type(4)));
typedef unsigned u32x2 __attribute__((ext_vector_type(2)));
typedef float f32x2 __attribute__((ext_vector_type(2)));
#define DI __device__ __forceinline__

DI unsigned cvt_pk(float lo, float hi) { typedef float f2 __attribute__((ext_vector_type(2))); typedef __bf16 b2 __attribute__((ext_vector_type(2))); f2 v = {lo, hi}; b2 b = __builtin_convertvector(v, b2); return __builtin_bit_cast(unsigned, b); }
DI float bf_lo(unsigned w) { return __uint_as_float(w << 16); }
DI float bf_hi(unsigned w) { return __uint_as_float(w & 0xffff0000u); }
DI float silu_f(float v) { return v / (1.f + __expf(-v)); }
template <int M> DI float swz_xor(float v) { return __int_as_float(__builtin_amdgcn_ds_swizzle(__float_as_int(v), (M << 10) | 0x1F)); }
template <int CTRL> DI float dppf(float v) { return __int_as_float(__builtin_amdgcn_update_dpp(0, __float_as_int(v), CTRL, 0xF, 0xF, true)); }
DI float add_xor16(float v) { auto r = __builtin_amdgcn_permlane16_swap(__float_as_uint(v), __float_as_uint(v), false, false); return __uint_as_float(r[0]) + __uint_as_float(r[1]); }
DI float max_xor16(float v) { auto r = __builtin_amdgcn_permlane16_swap(__float_as_uint(v), __float_as_uint(v), false, false); return fmaxf(__uint_as_float(r[0]), __uint_as_float(r[1])); }
DI float max_xor32(float v) { auto r = __builtin_amdgcn_permlane32_swap(__float_as_uint(v), __float_as_uint(v), false, false); return fmaxf(__uint_as_float(r[0]), __uint_as_float(r[1])); }
DI float row_sum16(float v) { v += dppf<0x128>(v); v += dppf<0x124>(v); v += dppf<0x122>(v); v += dppf<0x121>(v); return v; }
DI float add_xor32(float v) { auto r = __builtin_amdgcn_permlane32_swap(__float_as_uint(v), __float_as_uint(v), false, false); return __uint_as_float(r[0]) + __uint_as_float(r[1]); }
DI float other32(float v, bool upper_half) { auto r = __builtin_amdgcn_permlane32_swap(__float_as_uint(v), __float_as_uint(v), false, false); return __uint_as_float(upper_half ? r[0] : r[1]); }
DI float wave_sum(float v) { return add_xor32(add_xor16(row_sum16(v))); }
DI unsigned shfl_up_u(unsigned v, int o, int lane) { return (unsigned)__builtin_amdgcn_ds_bpermute((lane - o) << 2, (int)v); }

constexpr int NB = FAST_NB;
constexpr int LAT = NB * 4096, CTXR = NB * 256, R = LAT + CTXR, MT = R / 256;
constexpr int MOE_LAT = NB * 16 * 512, MOE_ROWS = MOE_LAT + 16 * 256;
constexpr float EPS = 1e-6f, LOG2E = 1.4426950408889634f;
constexpr float QS64 = 0.125f * LOG2E, QS96 = 0.10206207261596575f * LOG2E;
constexpr float QF64 = QS64 * 8.f, QF96 = QS96 * 8.f;
constexpr int NWAVES = 8, NTHR = 512;

constexpr size_t al256(size_t x) { return (x + 255) & ~(size_t)255; }
constexpr size_t WS_CTL = 0, CTL_BYTES = 65536;
constexpr size_t WS_MOD = WS_CTL + CTL_BYTES;
constexpr size_t WS_TAB64 = WS_MOD + al256((size_t)2 * 9 * 6144 * 4);
constexpr size_t WS_TAB32 = WS_TAB64 + 8192;
constexpr size_t WS_WIN = WS_TAB32 + 4096;
constexpr size_t WS_WUP = WS_WIN + (size_t)2 * 1536 * 1024 * 2;
constexpr size_t WS_WOUT = WS_WUP + (size_t)2 * 1536 * 384 * 2;
constexpr size_t WS_W1 = WS_WOUT + (size_t)2 * 1024 * 1024 * 2;
constexpr size_t WS_W2 = WS_W1 + (size_t)2 * 16 * 2048 * 1024 * 2;
constexpr size_t WS_HB = WS_W2 + (size_t)2 * 16 * 1024 * 1024 * 2;
constexpr size_t WS_CTXF = WS_HB + (size_t)R * 1024 * 2;
constexpr size_t WS_SSQ = WS_CTXF + (size_t)CTXR * 1024 * 4;
constexpr size_t WS_AFFL = WS_SSQ + (size_t)R * 8 * 4;
constexpr size_t WS_AFFC = WS_AFFL + (size_t)NB * 16 * 4096 * 4;
constexpr size_t WS_GIDX = WS_AFFC + (size_t)NB * 16 * 256 * 4;
constexpr size_t WS_GATE = WS_GIDX + (size_t)MOE_ROWS * 4;
constexpr size_t WS_INV = WS_GATE + (size_t)MOE_ROWS * 4;
constexpr size_t WS_Z = al256(WS_INV + (size_t)R * 16 * 4);
constexpr size_t Z_QA = WS_Z, Z_KA = Z_QA + (size_t)R * 384 * 2, Z_VA = Z_KA + (size_t)R * 128 * 2, Z_QC = Z_VA + (size_t)R * 128 * 2, Z_KC = Z_QC + (size_t)R * 256 * 2,
                 Z_VC = Z_KC + (size_t)R * 128 * 2, Z_CRAW = Z_VC + (size_t)R * 128 * 2, Z_QB = Z_CRAW + (size_t)R * 384 * 2, Z_KB = Z_QB + (size_t)R * 576 * 2,
                 Z_VB = Z_KB + (size_t)R * 576 * 2, Z_OB = Z_VB + (size_t)R * 384 * 2, Z_END1 = Z_OB + (size_t)R * 1024 * 2;
constexpr size_t VT_TILE = 4096, VT_HEAD = 68 * VT_TILE;
constexpr size_t Z_HID = WS_Z, Z_YE = Z_HID + (size_t)MOE_ROWS * 1024 * 2, Z_END2 = Z_YE + (size_t)MOE_ROWS * 1024 * 2;
constexpr size_t WS_END = al256(Z_END1 > Z_END2 ? Z_END1 : Z_END2);
constexpr int CW_BAR = 1024;
constexpr int CW_QUEUE = 8192;

DI int vt_pos(int k) { return ((k & 4) << 3) | ((k & 32) >> 1) | ((k & 24) >> 1) | (k & 3); }
constexpr int RING_BYTES = 131072;
constexpr int LDS_TAB64 = RING_BYTES, LDS_TAB32 = LDS_TAB64 + 8192, LDS_MISC = LDS_TAB32 + 4096;
constexpr int LDS_INTAB = LDS_MISC + 256;
constexpr int LDS_BYTES = 147456;

#define XB_TMO      128
#define XB_XCNT(j)  (256  + 64 * (j))
#define XB_XSUB(j)  (1280 + 64 * (j))
#define XB_XGEN(j)  (2304 + 64 * (j))
#define XB_TOP      3328
#define XB_TOPGEN   3392
#define XCD_BAR_WORDS 3456
#define XB_SPIN_CAP (1u << 20)
DI unsigned xb_ld(unsigned* p)              { return __hip_atomic_load(p, __ATOMIC_RELAXED, __HIP_MEMORY_SCOPE_AGENT); }
DI unsigned xb_add(unsigned* p, unsigned v) { return __hip_atomic_fetch_add(p, v, __ATOMIC_RELAXED, __HIP_MEMORY_SCOPE_AGENT); }
DI unsigned xb_xcc_id() { return (unsigned)__builtin_amdgcn_s_getreg((3 << 11) | 20) & 0xFu; }
#define XB_SPIN(cond, bar) do { unsigned _sp = 0; while (cond) { __builtin_amdgcn_s_sleep(1); \
    if ((++_sp & 255u) == 0u) { if (xb_ld(&(bar)[XB_TMO])) break; if (_sp > XB_SPIN_CAP) { atomicAdd(&(bar)[XB_TMO], 1u); break; } } } } while (0)
struct XcdBarrier { unsigned* bar; unsigned x; volatile LAS unsigned* st; };
DI XcdBarrier xcd_barrier_post(unsigned* bar, volatile LAS unsigned* st) {
    XcdBarrier b; b.bar = bar; b.x = xb_xcc_id(); b.st = st;
    if (threadIdx.x == 0) (void)xb_add(&bar[XB_XCNT(b.x)], 1u);
    return b;
}
DI void xcd_barrier_complete(unsigned* bar, unsigned x, unsigned& nloc, unsigned& nx) {
    asm volatile("" : "+s"(x));
    const unsigned G = gridDim.x * gridDim.y * gridDim.z;
    unsigned sum, cnt, mine, sp = 0u;
    for (;;) {
        sum = 0u; cnt = 0u; mine = 0u;
#pragma unroll
        for (unsigned j = 0; j < 16; ++j) { const unsigned c = xb_ld(&bar[XB_XCNT(j)]); sum += c; cnt += (c > 0u) ? 1u : 0u; mine = (j == x) ? c : mine; }
        if (sum == G) break;
        __builtin_amdgcn_s_sleep(1);
        if ((++sp & 255u) == 0u) { if (xb_ld(&bar[XB_TMO])) break; if (sp > XB_SPIN_CAP) { atomicAdd(&bar[XB_TMO], 1u); break; } }
    }
    nloc = mine > 0u ? mine : 1u; nx = cnt > 0u ? cnt : 1u;
}
DI void xcd_barrier(const XcdBarrier& b) {
    asm volatile("s_waitcnt vmcnt(0)" ::: "memory");
    __syncthreads();
    if (threadIdx.x == 0) {
        unsigned* bar = b.bar; asm volatile("" : "+s"(bar));
        __builtin_amdgcn_s_waitcnt(0);
        unsigned nloc = b.st[0], nx = b.st[1];
        if (nloc == 0u) { xcd_barrier_complete(bar, b.x, nloc, nx); b.st[0] = nloc; b.st[1] = nx; }
        const unsigned old = xb_add(&bar[XB_XSUB(b.x)], 1u);
        const unsigned gen = old / nloc;
        if (old + 1u == (gen + 1u) * nloc) {
            __builtin_amdgcn_fence(__ATOMIC_RELEASE, "agent");
            asm volatile("s_waitcnt vmcnt(0)" ::: "memory");
            const unsigned og = xb_add(&bar[XB_TOP], 1u);
            const unsigned tg = og / nx;
            if (og + 1u == (tg + 1u) * nx) xb_add(&bar[XB_TOPGEN], 1u);
            else XB_SPIN(xb_ld(&bar[XB_TOPGEN]) == tg, bar);
            __builtin_amdgcn_fence(__ATOMIC_ACQUIRE, "agent");
            xb_add(&bar[XB_XGEN(b.x)], 1u);
            asm volatile("s_waitcnt vmcnt(0)" ::: "memory");
        } else {
            XB_SPIN(xb_ld(&bar[XB_XGEN(b.x)]) == gen, bar);
            __builtin_amdgcn_fence(__ATOMIC_ACQUIRE, "agent");
            asm volatile("s_waitcnt vmcnt(0)" ::: "memory");
        }
    }
    __syncthreads();
}

struct Args { const float* in[27]; float* out; unsigned char* ws; int ph_lo, ph_hi, li, pad; };
struct Frame {
    LAS unsigned char* lds; unsigned char* ws; unsigned* ctl;
    int tid, lane, wave, G, bid;
    const LAS unsigned long long* intab; float* out;
};
DI const float* inp(const LAS unsigned long long* tab, int k) { const unsigned long long v = tab[k]; const unsigned lo = __builtin_amdgcn_readfirstlane((unsigned)v), hi = __builtin_amdgcn_readfirstlane((unsigned)(v >> 32)); return (const float*)(const GAS float*)(((unsigned long long)hi << 32) | lo); }
#define INP(k) inp(F.intab, k)
#define WSP(T, off) ((T*)(F.ws + (off)))

DI void mod_item(const Frame& F, int item, const LAS float* s9, LAS float* red) {
    const int l = item / 96, c0 = (item % 96) * 64;
    const float* W = INP(4) + (size_t)l * 1024 * 6144 + c0;
    const int cg = F.lane & 15, ks = F.wave * 4 + (F.lane >> 4);
    f32x4 acc[9];
#pragma unroll
    for (int r = 0; r < 9; ++r) acc[r] = (f32x4){0.f, 0.f, 0.f, 0.f};
#pragma unroll 4
    for (int i = 0; i < 32; ++i) { const int k = ks + 32 * i; const f32x4 w = *(const f32x4*)(W + (size_t)k * 6144 + cg * 4);
#pragma unroll
        for (int r = 0; r < 9; ++r) acc[r] += w * s9[r * 1024 + k]; }
#pragma unroll
    for (int r = 0; r < 9; ++r)
#pragma unroll
        for (int j = 0; j < 4; ++j) { acc[r][j] = add_xor32(add_xor16(acc[r][j])); }
    __syncthreads();
    if (F.lane < 16) {
#pragma unroll
        for (int r = 0; r < 9; ++r) *(LAS f32x4*)(red + (F.wave * 9 + r) * 64 + cg * 4) = acc[r]; }
    __syncthreads();
    for (int e = F.tid; e < 9 * 64; e += NTHR) { const int r = e / 64, c = e % 64; float s = 0.f;
#pragma unroll
        for (int w = 0; w < 8; ++w) s += red[(w * 9 + r) * 64 + c];
        WSP(float, WS_MOD)[((size_t)l * 9 + r) * 6144 + c0 + c] = s + INP(5)[l * 6144 + c0 + c]; }
}

DI void cv_block(const float* src  , int ld, const float* ksc, bf16_t* drow  ) {
#pragma unroll
    for (int kc = 0; kc < 8; ++kc) {
        float v[8];
#pragma unroll
        for (int j = 0; j < 8; ++j) v[j] = src ? src[(size_t)(kc * 8 + j) * ld] : 0.f;
        if (ksc) {
#pragma unroll
            for (int j = 0; j < 8; ++j) v[j] *= ksc[kc * 8 + j]; }
        u32x4 o; o.x = cvt_pk(v[0], v[1]); o.y = cvt_pk(v[2], v[3]); o.z = cvt_pk(v[4], v[5]); o.w = cvt_pk(v[6], v[7]);
        *(u32x4*)(drow + kc * 8) = o;
    }
}
DI void cv_block_fp8(const float* src, int ld, unsigned char* drow) {
    float v[64];
#pragma unroll
    for (int j = 0; j < 64; ++j) v[j] = src[(size_t)j * ld];
#pragma unroll
    for (int kc = 0; kc < 4; ++kc) {
        u32x4 o;
        { int w = __builtin_amdgcn_cvt_pk_fp8_f32(v[16 * kc + 0] * 64.f, v[16 * kc + 1] * 64.f, 0, false); w = __builtin_amdgcn_cvt_pk_fp8_f32(v[16 * kc + 2] * 64.f, v[16 * kc + 3] * 64.f, w, true); o.x = (unsigned)w; }
        { int w = __builtin_amdgcn_cvt_pk_fp8_f32(v[16 * kc + 4] * 64.f, v[16 * kc + 5] * 64.f, 0, false); w = __builtin_amdgcn_cvt_pk_fp8_f32(v[16 * kc + 6] * 64.f, v[16 * kc + 7] * 64.f, w, true); o.y = (unsigned)w; }
        { int w = __builtin_amdgcn_cvt_pk_fp8_f32(v[16 * kc + 8] * 64.f, v[16 * kc + 9] * 64.f, 0, false); w = __builtin_amdgcn_cvt_pk_fp8_f32(v[16 * kc + 10] * 64.f, v[16 * kc + 11] * 64.f, w, true); o.z = (unsigned)w; }
        { int w = __builtin_amdgcn_cvt_pk_fp8_f32(v[16 * kc + 12] * 64.f, v[16 * kc + 13] * 64.f, 0, false); w = __builtin_amdgcn_cvt_pk_fp8_f32(v[16 * kc + 14] * 64.f, v[16 * kc + 15] * 64.f, w, true); o.w = (unsigned)w; }
        *(u32x4*)(drow + kc * 16) = o;
    }
}
constexpr int CV_WIN = 384, CV_WUP = 144, CV_WOUT = 256, CV_W1 = 8192, CV_W2 = 4096, CV_LAYER = CV_WIN + CV_WUP + CV_WOUT + CV_W1 + CV_W2;
DI void conv_item(const Frame& F, int it) {
    const int l = it / CV_LAYER; int r = it % CV_LAYER; const int lane = F.lane, hl = lane >> 5, ll = lane & 31;
    if (r < CV_WIN) {
        const int kb = r / 24, g = (r % 24) * 2 + hl, x = ((g >> 3) * 4 + (g & 3)) * 64 + 32 * ((g >> 2) & 1) + ll;
        const int sc = x < 960 ? x : (x < 1472 ? x + 32 : (x < 1504 ? x - 512 : -1));
        const float* src = sc < 0 ? nullptr : INP(8) + (size_t)l * 1024 * 1504 + (size_t)(kb * 64) * 1504 + sc;
        unsigned char* drow = WSP(unsigned char, WS_WIN) + (size_t)l * 1536 * 1024 + (size_t)((r % 24) * 64 + lane) * 1024 + kb * 64;
        if (__builtin_amdgcn_readfirstlane(sc < 0 ? 1 : 0) | __any(sc < 0)) { const float* s2 = sc < 0 ? INP(8) : src; cv_block_fp8(s2, sc < 0 ? 0 : 1504, drow);
            if (sc < 0) {
#pragma unroll
                for (int kc = 0; kc < 4; ++kc) *(u32x4*)(drow + kc * 16) = (u32x4){0u, 0u, 0u, 0u}; } }
        else cv_block_fp8(src, 1504, drow);
        return; }
    r -= CV_WIN;
    if (r < CV_WUP) {
        const int kb = r / 24, g = (r % 24) * 2 + hl, slot = (g >> 3) * 4 + (g & 3), half = (g >> 2) & 1;
        const float* src = nullptr; const float* ksc = nullptr; int ld = 0;
        if (slot < 9 && kb < 3) { const int col = slot < 6 ? slot * 96 + 32 * half : (2 * (slot - 6) + half) * 96 + 64;
            src = INP(13) + (size_t)l * 192 * 576 + (size_t)(kb * 64) * 576 + col + ll; ld = 576; ksc = INP(11) + l * 192 + kb * 64; }
        else if (slot >= 12 && (kb == 3 || kb == 4)) { const int h = slot < 18 ? slot - 12 : slot - 18; const int col = h * 128 + (slot < 18 ? 0 : 64) + 32 * half;
            src = INP(14) + (size_t)l * 128 * 768 + (size_t)((kb - 3) * 64) * 768 + col + ll; ld = 768; ksc = INP(12) + l * 128 + (kb - 3) * 64; }
        cv_block(src, ld, ksc, WSP(bf16_t, WS_WUP) + (size_t)l * 1536 * 384 + (size_t)((r % 24) * 64 + lane) * 384 + kb * 64); return; }
    r -= CV_WUP;
    if (r < CV_WOUT) { const int kb = r / 16, g = r % 16;
        cv_block(INP(22) + (size_t)l * 1024 * 1024 + (size_t)(kb * 64) * 1024 + g * 64 + lane, 1024, nullptr, WSP(bf16_t, WS_WOUT) + (size_t)l * 1024 * 1024 + (size_t)(g * 64 + lane) * 1024 + kb * 64); return; }
    r -= CV_WOUT;
    if (r < CV_W1) { const int e = r / 512, q = r % 512, kb = q / 32, g = (q % 32) * 2 + hl, pn = g >> 3, bj = (g >> 2) & 1, wc = g & 3;
        const float* src = (bj ? INP(25) : INP(24)) + ((size_t)l * 16 + e) * 1024 * 1024 + (size_t)(kb * 64) * 1024 + 128 * pn + 32 * wc + ll;
        cv_block_fp8(src, 1024, WSP(unsigned char, WS_W1) + ((size_t)l * 16 + e) * 2048 * 1024 + (size_t)((q % 32) * 64 + lane) * 1024 + kb * 64); return; }
    r -= CV_W1;
    { const int e = r / 256, q = r % 256, kb = q / 16, g = q % 16;
        cv_block_fp8(INP(26) + ((size_t)l * 16 + e) * 1024 * 1024 + (size_t)(kb * 64) * 1024 + g * 64 + lane, 1024, WSP(unsigned char, WS_W2) + ((size_t)l * 16 + e) * 1024 * 1024 + (size_t)(g * 64 + lane) * 1024 + kb * 64); }
}
DI void p0_phase(const Frame& F) {
    LAS float* s9 = (LAS float*)F.lds;
    LAS float* red = (LAS float*)(F.lds + 9 * 1024 * 4);
    if (F.bid == 0) {
        for (int i = F.tid; i < 64 * 16; i += NTHR) { const int pos = i / 16, f = i % 16; const float inv = exp2f(-(float)(2 * f) / 32.f * 13.287712379549449f); const float a = (float)pos * inv; WSP(f32x2, WS_TAB64)[i] = (f32x2){cosf(a), sinf(a)}; }
        for (int i = F.tid; i < 64 * 8; i += NTHR) { const int pos = i / 8, f = i % 8; const float inv = exp2f(-(float)(2 * f) / 16.f * 13.287712379549449f); const float a = (float)pos * inv; WSP(f32x2, WS_TAB32)[i] = (f32x2){cosf(a), sinf(a)}; }
    }
    bool have_s9 = false;
    for (int it = F.bid; it < 192; it += F.G) {
        if (!have_s9) { for (int e = F.tid; e < 9 * 1024; e += NTHR) { const int r = e / 1024, k = e % 1024; const float v = r < 8 ? INP(1)[r * 1024 + k] : INP(3)[k]; s9[e] = silu_f(v); } have_s9 = true; __syncthreads(); }
        mod_item(F, it, s9, red);
    }
    __syncthreads();
    const int gw = F.bid * NWAVES + F.wave, NGW = F.G * NWAVES;
    for (int it = gw; it < 2 * CV_LAYER; it += NGW) conv_item(F, it);
}

DI unsigned pk_fp8q(float a, float b, float c, float d) { int w = __builtin_amdgcn_cvt_pk_fp8_f32(a, b, 0, false); w = __builtin_amdgcn_cvt_pk_fp8_f32(c, d, w, true); return (unsigned)w; }
DI void norm_mod_store(const f32x4 (&v)[4], const float* g, const float* sh, const float* sc, unsigned char* orow  , int lane) {
    float s = 0.f;
#pragma unroll
    for (int j = 0; j < 4; ++j) s += (v[j].x * v[j].x + v[j].y * v[j].y) + (v[j].z * v[j].z + v[j].w * v[j].w);
    const float rstd = 1.0f / sqrtf(wave_sum(s) * (1.f / 1024.f) + EPS);
#pragma unroll
    for (int j = 0; j < 4; ++j) { const int c = 4 * (lane + 64 * j); const f32x4 gv = *(const f32x4*)(g + c), sv = *(const f32x4*)(sh + c), cv = *(const f32x4*)(sc + c);
        const f32x4 o = v[j] * rstd * gv * (cv + 1.0f) + sv; *(unsigned*)(orow + c) = pk_fp8q(o.x, o.y, o.z, o.w); }
}
DI const float* mod_row(const Frame& F, int l, int row) { const int r = row < LAT ? row / 4096 : 8; return WSP(float, WS_MOD) + ((size_t)l * 9 + r) * 6144; }
DI void norm_mod_store_r(const f32x4 (&v)[4], const f32x4 (&gc)[4], const f32x4 (&sv)[4], unsigned char* orow  , int lane) {
    float s = 0.f;
#pragma unroll
    for (int j = 0; j < 4; ++j) s += (v[j].x * v[j].x + v[j].y * v[j].y) + (v[j].z * v[j].z + v[j].w * v[j].w);
    const float rstd = 1.0f / sqrtf(wave_sum(s) * (1.f / 1024.f) + EPS);
#pragma unroll
    for (int j = 0; j < 4; ++j) { const f32x4 o = v[j] * rstd * gc[j] + sv[j]; *(unsigned*)(orow + 4 * (lane + 64 * j)) = pk_fp8q(o.x, o.y, o.z, o.w); }
}
DI void load_mod(const float* g, const float* sh, const float* sc, f32x4 (&gc)[4], f32x4 (&sv)[4], int lane) {
#pragma unroll
    for (int j = 0; j < 4; ++j) { const int c = 4 * (lane + 64 * j); gc[j] = *(const f32x4*)(g + c) * (*(const f32x4*)(sc + c) + 1.0f); sv[j] = *(const f32x4*)(sh + c); }
}
DI int cond_of_row(int row) { return row < LAT ? row / 4096 : 8; }
DI void init_norm_phase(const Frame& F) {
    const int gw = F.bid * NWAVES + F.wave, NGW = F.G * NWAVES, per = (R + NGW - 1) / NGW, r0 = gw * per, r1 = r0 + per < R ? r0 + per : R;
    auto rowptr = [&](int row) -> const float* { return row < LAT ? INP(0) + (size_t)row * 1024 : INP(2) + (size_t)(row - LAT) * 1024; };
    f32x4 vn[4], gc[4], sv[4]; int curb = -1;
    if (r0 < r1) { const float* x0 = rowptr(r0);
#pragma unroll
        for (int j = 0; j < 4; ++j) vn[j] = *(const f32x4*)(x0 + 4 * (F.lane + 64 * j)); }
    for (int row = r0; row < r1; ++row) {
        f32x4 v[4];
#pragma unroll
        for (int j = 0; j < 4; ++j) v[j] = vn[j];
        if (row + 1 < r1) { const float* x1 = rowptr(row + 1);
#pragma unroll
            for (int j = 0; j < 4; ++j) vn[j] = *(const f32x4*)(x1 + 4 * (F.lane + 64 * j)); }
        const int cb = cond_of_row(row);
        if (cb != curb) { const float* m = mod_row(F, 0, row); load_mod(INP(6), m, m + 1024, gc, sv, F.lane); curb = cb; }
        norm_mod_store_r(v, gc, sv, WSP(unsigned char, WS_HB) + (size_t)row * 1024, F.lane);
    }
}
namespace g8 {
constexpr int BM = 256, BK = 64, HALF = 128, HTB = HALF * BK * 2, STAGE_BYTES = 8 * HTB;
DI int lds_byte(int r, int c) { const int st = (r >> 4) * 2 + (c >> 5), rr = r & 15, cc = c & 31, ob = rr * 64 + cc * 2; return st * 1024 + (ob ^ (((ob >> 9) & 1) << 5)); }
DI void stage_rc(int b, int& Rr, int& Cc) { const int st = b / 1024, sb = b % 1024, swz = sb ^ (((sb >> 9) & 1) << 5); Rr = (st >> 1) * 16 + swz / 64; Cc = (st & 1) * 32 + (swz % 64) / 2; }
DI int perm32(int rho) { const int n = rho >> 4, i = rho & 15; return 8 * (i >> 2) + 4 * n + (i & 3); }

typedef int i32x4 __attribute__((ext_vector_type(4)));
typedef int i32x8 __attribute__((ext_vector_type(8)));
struct Unit { int pm, pn, aux, kt0, nt; const char* Bp; };

template <class Epi, class Sched>
DI void gemm_phase(const int tid, LAS unsigned char* lds, const char* Abase, int K, const Sched& S, const Epi& E) {
    asm volatile("" : "+s"(K));
    const int wid = __builtin_amdgcn_readfirstlane(tid >> 6), lane = tid & 63, wr = wid >> 2, wc = wid & 3, fr = lane & 15, fq = lane >> 4;
    int Rr[2], Cc[2]; unsigned voffB[2];
#pragma unroll
    for (int i = 0; i < 2; ++i) { int r_, c_; stage_rc(tid * 16 + i * 8192, r_, c_); Rr[i] = r_; Cc[i] = c_; const int Rb = Epi::PERM ? ((r_ & ~31) + perm32(r_ & 31)) : r_; voffB[i] = (unsigned)(Rb * K + c_) * 2u; }
    const size_t hstepB = (size_t)HALF * K * 2;
    const unsigned ldsw = (unsigned)wid * 1024u;
    const int aoff = lds_byte(wr * 64 + fr, fq * 8), boff = lds_byte(wc * 32 + fr, fq * 8);
#define G8_SA(b, h) (((b) * 2 + (h)) * HTB)
#define G8_SB(b, h) ((4 + (b) * 2 + (h)) * HTB)
#define G8_STAGE_A(bufoff, ao2, kt) do { _Pragma("unroll") for (int _i = 0; _i < 2; ++_i) \
        __builtin_amdgcn_global_load_lds((const unsigned*)(Abase + (size_t)(ao2)[_i] + (size_t)(kt) * 128), (LAS unsigned*)(lds + (bufoff) + ldsw + _i * 8192), 16, 0, 0); } while (0)
#define G8_STAGE_B(bufoff, bp, h, kt) do { _Pragma("unroll") for (int _i = 0; _i < 2; ++_i) \
        __builtin_amdgcn_global_load_lds((const unsigned*)((bp) + (size_t)(h) * hstepB + voffB[_i] + (size_t)(kt) * 128), (LAS unsigned*)(lds + (bufoff) + ldsw + _i * 8192), 16, 0, 0); } while (0)
#define G8_LD16(off) (*(const LAS i32x4*)(lds + (off)))
#define G8_LDA(dst, b, h) do { _Pragma("unroll") for (int m = 0; m < 4; ++m) { const i32x4 lo_ = G8_LD16(G8_SA(b, h) + aoff + m * 2048), hi_ = G8_LD16(G8_SA(b, h) + aoff + m * 2048 + 1024); dst[m] = __builtin_shufflevector(lo_, hi_, 0, 1, 2, 3, 4, 5, 6, 7); } } while (0)
#define G8_LDB(dst, b, h) do { _Pragma("unroll") for (int n = 0; n < 2; ++n) { const i32x4 lo_ = G8_LD16(G8_SB(b, h) + boff + n * 2048), hi_ = G8_LD16(G8_SB(b, h) + boff + n * 2048 + 1024); dst[n] = __builtin_shufflevector(lo_, hi_, 0, 1, 2, 3, 4, 5, 6, 7); } } while (0)
#define G8_HALF(v, k) __builtin_bit_cast(bf16x8, __builtin_shufflevector((v), (v), 4 * (k), 4 * (k) + 1, 4 * (k) + 2, 4 * (k) + 3))
#define G8_MMA(ai, bj, At, Bt) do { __builtin_amdgcn_s_setprio(1); _Pragma("unroll") for (int m = 0; m < 4; ++m) _Pragma("unroll") for (int n = 0; n < 2; ++n) { \
        if constexpr (Epi::FP8) asm volatile("v_mfma_scale_f32_16x16x128_f8f6f4 %0, %1, %2, %0, %3, %3 op_sel_hi:[0,0,0]" : "+v"(acc[ai][bj][m][n]) : "v"(Bt[n]), "v"(At[m]), "v"(fp8_scale)); \
        else { acc[ai][bj][m][n] = __builtin_amdgcn_mfma_f32_16x16x32_bf16(G8_HALF(Bt[n], 0), G8_HALF(At[m], 0), acc[ai][bj][m][n], 0, 0, 0); \
               acc[ai][bj][m][n] = __builtin_amdgcn_mfma_f32_16x16x32_bf16(G8_HALF(Bt[n], 1), G8_HALF(At[m], 1), acc[ai][bj][m][n], 0, 0, 0); } } __builtin_amdgcn_s_setprio(0); } while (0)
#define G8_WAIT_V(n) asm volatile("s_waitcnt vmcnt(" #n ")" ::: "memory")
#define G8_WAIT_L(n) asm volatile("s_waitcnt lgkmcnt(" #n ")" ::: "memory")
#define G8_BAR __builtin_amdgcn_s_barrier()
#define G8_SCHED __builtin_amdgcn_sched_barrier(0)
    const int fp8_scale = 0x7F7F7F7F;
    Unit cur, nxt; int ui = 0;
    if (!S.next(0, cur)) return;
    unsigned aoc[2][2], aon[2][2];
    S.aoffs(cur, Rr, Cc, aoc);
    f32x4 acc[2][2][4][2];
#pragma unroll
    for (int a = 0; a < 2; ++a)
#pragma unroll
        for (int b = 0; b < 2; ++b)
#pragma unroll
            for (int m = 0; m < 4; ++m)
#pragma unroll
                for (int n = 0; n < 2; ++n) acc[a][b][m][n] = (f32x4){0.f, 0.f, 0.f, 0.f};
    i32x8 At[4], B0[2], B1[2];
    const char* cB = cur.Bp;
    G8_STAGE_B(G8_SB(0, 0), cB, 0, 0); G8_STAGE_B(G8_SB(0, 1), cB, 1, 0); G8_STAGE_A(G8_SA(0, 0), aoc[0], 0); G8_STAGE_A(G8_SA(0, 1), aoc[1], 0);
    if (wr == 1) G8_BAR;
    G8_WAIT_V(2); G8_BAR;
    G8_STAGE_B(G8_SB(1, 0), cB, 0, 1); G8_STAGE_A(G8_SA(1, 0), aoc[0], 1); G8_STAGE_B(G8_SB(1, 1), cB, 1, 1);
    G8_WAIT_V(6); G8_BAR;
    for (;;) {
        const bool has_next = S.next(ui + 1, nxt);
        if (has_next) S.aoffs(nxt, Rr, Cc, aon);
        else {
#pragma unroll
            for (int h = 0; h < 2; ++h)
#pragma unroll
                for (int i = 0; i < 2; ++i) aon[h][i] = aoc[h][i]; }
        const char* nB = has_next ? nxt.Bp : cB;
        const int nt = cur.nt;
        for (int t = 0; t < nt; t += 2) {
            const bool last = (t == nt - 2);
            unsigned a2[2][2];
#pragma unroll
            for (int h = 0; h < 2; ++h)
#pragma unroll
                for (int i = 0; i < 2; ++i) a2[h][i] = last ? aon[h][i] : aoc[h][i];
            const int kt2 = last ? 0 : t + 2; const char* b2 = last ? nB : cB;
            G8_LDB(B0, 0, 0); G8_LDB(B1, 0, 1); G8_SCHED; G8_LDA(At, 0, 0); G8_STAGE_A(G8_SA(1, 1), aoc[1], t + 1);
            G8_WAIT_V(8); G8_WAIT_L(0); G8_BAR; G8_MMA(0, 0, At, B0); G8_MMA(0, 1, At, B1); G8_BAR; G8_SCHED;
            G8_LDA(At, 0, 1); G8_STAGE_B(G8_SB(0, 0), b2, 0, kt2); G8_STAGE_B(G8_SB(0, 1), b2, 1, kt2); G8_STAGE_A(G8_SA(0, 0), a2[0], kt2);
            G8_WAIT_V(8); G8_WAIT_L(0); G8_BAR; G8_MMA(1, 0, At, B0); G8_MMA(1, 1, At, B1); G8_BAR; G8_SCHED;
            G8_LDB(B0, 1, 0); G8_LDB(B1, 1, 1); G8_SCHED; G8_LDA(At, 1, 0); G8_STAGE_A(G8_SA(0, 1), a2[1], kt2);
            G8_WAIT_V(8); G8_WAIT_L(0); G8_BAR; G8_MMA(0, 0, At, B0); G8_MMA(0, 1, At, B1); G8_BAR; G8_SCHED;
            G8_LDA(At, 1, 1); G8_STAGE_B(G8_SB(1, 0), b2, 0, kt2 + 1); G8_STAGE_B(G8_SB(1, 1), b2, 1, kt2 + 1); G8_STAGE_A(G8_SA(1, 0), a2[0], kt2 + 1);
            G8_WAIT_V(8); G8_WAIT_L(0); G8_BAR; G8_MMA(1, 0, At, B0); G8_MMA(1, 1, At, B1); G8_BAR; G8_SCHED;
        }
        if (wr == 0) G8_BAR;
        if constexpr (Epi::FP8) asm volatile("s_nop 15\n\ts_nop 15" ::: "memory");
        E(acc, cur, wr, wc, fr, fq);
        if (!has_next) break;
#pragma unroll
        for (int a = 0; a < 2; ++a)
#pragma unroll
            for (int b = 0; b < 2; ++b)
#pragma unroll
                for (int m = 0; m < 4; ++m)
#pragma unroll
                    for (int n = 0; n < 2; ++n) acc[a][b][m][n] = (f32x4){0.f, 0.f, 0.f, 0.f};
        cur = nxt; cB = nB;
#pragma unroll
        for (int h = 0; h < 2; ++h)
#pragma unroll
            for (int i = 0; i < 2; ++i) aoc[h][i] = aon[h][i];
        ++ui;
        if (wr == 1) G8_BAR;
    }
    G8_WAIT_V(0);
    G8_BAR;
#undef G8_SA
#undef G8_SB
#undef G8_STAGE_A
#undef G8_STAGE_B
#undef G8_LDA
#undef G8_LDB
#undef G8_MMA
#undef G8_HALF
#undef G8_LD16
#undef G8_WAIT_V
#undef G8_WAIT_L
#undef G8_BAR
#undef G8_SCHED
}

struct DenseSched {
    int nM, nN, nwg, G, c, K; const char* Bt; bool split3;
    DI void init(int nM_, int nN_, int G_, int c_, int K_, const void* Bt_, bool split3_ = false) { nM = nM_; nN = nN_; nwg = nM * nN; G = G_; c = c_; K = K_; Bt = (const char*)Bt_; split3 = split3_; }
    DI bool next(int i, Unit& u) const {
        const long L = (long)i * G + c; if (L >= nwg) return false;
        int wgid = (int)L; { const int q = nwg / 8, r = nwg % 8, xcd = wgid % 8, off = wgid / 8; wgid = (xcd < r ? xcd * (q + 1) : r * (q + 1) + (xcd - r) * q) + off; }
        const int WGM = 8, nig = WGM * nN, gid = wgid / nig, fm = gid * WGM, gsz = (nM - fm) < WGM ? (nM - fm) : WGM;
        u.pm = fm + ((wgid % nig) % gsz); u.pn = (wgid % nig) / gsz; u.aux = 0; u.kt0 = 0; u.nt = K / 64;
        if (split3) { if (u.pn < 3) { u.nt = 4; } else { u.kt0 = 3; u.nt = 2; } }
        u.Bp = Bt + (size_t)u.pn * 256 * K * 2 + u.kt0 * 128; return true;
    }
    DI void aoffs(const Unit& u, const int (&Rr)[2], const int (&Cc)[2], unsigned (&ao)[2][2]) const {
#pragma unroll
        for (int h = 0; h < 2; ++h)
#pragma unroll
            for (int i = 0; i < 2; ++i) ao[h][i] = (unsigned)(((size_t)(u.pm * 256 + h * 128 + Rr[i]) * K + Cc[i]) * 2 + u.kt0 * 128);
    }
};
template <bool GATHER>
struct MoeSched {
    int nN, tiles_per_e, nwg, G, c, K, NBt; const char* Bt; size_t estride; const int* gidx; bool with_ctx;
    DI void init(int nN_, bool with_ctx_, int G_, int c_, int K_, const void* Bt_, size_t estride_, const int* gidx_) {
        nN = nN_; with_ctx = with_ctx_; tiles_per_e = NB * 2 + (with_ctx_ ? 1 : 0); nwg = 16 * tiles_per_e * nN; G = G_; c = c_; K = K_; Bt = (const char*)Bt_; estride = estride_; gidx = gidx_; }
    DI bool next(int i, Unit& u) const {
        int mt;
        if (G % (8 * nN) == 0) {
            const int per = (G / 8) / nN, xcd = c & 7, j8 = c >> 3; mt = (i * 8 + xcd) * per + j8 / nN; u.pn = j8 % nN; if (mt >= 16 * tiles_per_e) return false;
        } else { const long L = (long)i * G + c; if (L >= nwg) return false; mt = (int)L / nN; u.pn = (int)L % nN; }
        const int e = mt / tiles_per_e, j = mt % tiles_per_e;
        const int rowbase = j < NB * 2 ? ((j >> 1) * 16 + e) * 512 + (j & 1) * 256 : MOE_LAT + e * 256;
        u.pm = rowbase / 256; u.aux = e; u.kt0 = 0; u.nt = K / 64; u.Bp = Bt + (size_t)e * estride + (size_t)u.pn * 256 * K * 2; return true;
    }
    DI void aoffs(const Unit& u, const int (&Rr)[2], const int (&Cc)[2], unsigned (&ao)[2][2]) const {
#pragma unroll
        for (int h = 0; h < 2; ++h)
#pragma unroll
            for (int i = 0; i < 2; ++i) { const int mrow = u.pm * 256 + h * 128 + Rr[i]; const int arow = GATHER ? gidx[mrow] : mrow; ao[h][i] = (unsigned)(((size_t)arow * K + Cc[i]) * 2); }
    }
};
}

typedef f32x4 Acc[2][2][4][2];
DI unsigned pk_fp8x4(float a, float b, float c, float d) { int w = __builtin_amdgcn_cvt_pk_fp8_f32(a, b, 0, false); w = __builtin_amdgcn_cvt_pk_fp8_f32(c, d, w, true); return (unsigned)w; }
DI unsigned pk_fp8v(const f32x4 v) { return pk_fp8x4(v.x, v.y, v.z, v.w); }
DI void st_bf16x4(bf16_t* p, const f32x4 v) { u32x2 w; w.x = cvt_pk(v.x, v.y); w.y = cvt_pk(v.z, v.w); *(u32x2*)p = w; }

DI void st_vt4(unsigned char* tile, int d0, int pos, const f32x4 v) { const unsigned w = pk_fp8v(v); unsigned char* p = tile + d0 * 64 + pos;
    p[0] = (unsigned char)w; p[64] = (unsigned char)(w >> 8); p[128] = (unsigned char)(w >> 16); p[192] = (unsigned char)(w >> 24); }
DI size_t vt_tile_of_rowgroup(int row64  ) {
    return row64 < LAT ? (size_t)(row64 / 4096) * 68 + 4 + (row64 % 4096) / 64 : (size_t)((row64 - LAT) / 256) * 68 + ((row64 - LAT) % 256) / 64; }
struct EpiInProj {
    static constexpr bool PERM = false, FP8 = true;
    unsigned char* ws; const LAS unsigned long long* in; int l; const LAS f32x2* tab64; const LAS f32x2* tab32;
    DI void operator()(const Acc& acc, const g8::Unit& u, int wr, int wc, int fr, int fq) const {
        asm volatile("" : "+v"(fr), "+v"(fq));
        constexpr float SC = 1.0f / 64.0f;
        const int slot = 4 * u.pn + wc; const int rowt = u.pm * 256 + wr * 64 + fr; const bool lat = (u.pm * 256) < LAT;
        int kind; bf16_t* dst; int ld, coff; const float* gain = nullptr; float qs = 1.f;
        if (slot < 6)       { kind = 0; dst = (bf16_t*)(ws + Z_QA); ld = 384; coff = slot * 64; gain = inp(in, 9) + l * 64; qs = QF64; }
        else if (slot < 8)  { kind = 0; dst = (bf16_t*)(ws + Z_KA); ld = 128; coff = (slot - 6) * 64; gain = inp(in, 10) + l * 64; }
        else if (slot < 10) { kind = 1; dst = (bf16_t*)(ws + Z_VA); ld = 128; coff = (slot - 8) * 64; }
        else if (slot < 15) { kind = 2; dst = (bf16_t*)(ws + Z_CRAW); ld = 384; coff = (slot - 10) * 64; }
        else if (slot < 19) { kind = 0; dst = (bf16_t*)(ws + Z_QC); ld = 256; coff = (slot - 15) * 64; gain = inp(in, 19) + l * 64; qs = QF64; }
        else if (slot < 21) { kind = 0; dst = (bf16_t*)(ws + Z_KC); ld = 128; coff = (slot - 19) * 64; gain = inp(in, 20) + l * 64; }
        else if (slot < 23) { kind = 1; dst = (bf16_t*)(ws + Z_VC); ld = 128; coff = (slot - 21) * 64; }
        else                { kind = 3; dst = (bf16_t*)(ws + Z_KB); ld = 576; coff = 64; gain = inp(in, 18) + l * 32; }
        if (kind == 0) {
            f32x4 g[2][2];
#pragma unroll
            for (int bj = 0; bj < 2; ++bj)
#pragma unroll
                for (int n = 0; n < 2; ++n) g[bj][n] = *(const f32x4*)(gain + 32 * bj + 16 * n + 4 * fq) * qs;
#pragma unroll
            for (int ai = 0; ai < 2; ++ai)
#pragma unroll
                for (int m = 0; m < 4; ++m) {
                    const int row = rowt + ai * 128 + m * 16; float s = 0.f;
#pragma unroll
                    for (int bj = 0; bj < 2; ++bj)
#pragma unroll
                        for (int n = 0; n < 2; ++n) { const f32x4 x = acc[ai][bj][m][n] * SC; s += (x.x * x.x + x.y * x.y) + (x.z * x.z + x.w * x.w); }
                    s = add_xor32(add_xor16(s));
                    const float rstd = SC / sqrtf(s * (1.f / 64.f) + EPS);
                    const int t = row & 4095, pr = t >> 6, pc = t & 63;
#pragma unroll
                    for (int bj = 0; bj < 2; ++bj) {
                        f32x4 x1 = acc[ai][bj][m][0] * rstd * g[bj][0], x2 = acc[ai][bj][m][1] * rstd * g[bj][1];
                        if (lat) { const LAS f32x2* tb = tab64 + (bj == 0 ? pr : pc) * 16 + 4 * fq; f32x4 o1, o2;
#pragma unroll
                            for (int i = 0; i < 4; ++i) { const f32x2 cs = tb[i]; o1[i] = x1[i] * cs.x - x2[i] * cs.y; o2[i] = x2[i] * cs.x + x1[i] * cs.y; }
                            x1 = o1; x2 = o2; }
                        unsigned char* p = (unsigned char*)dst + (size_t)row * ld + coff + 32 * bj + 4 * fq;
                        *(unsigned*)p = pk_fp8v(x1); *(unsigned*)(p + 16) = pk_fp8v(x2);
                    }
                    asm volatile("" ::: "memory");
                }
        } else if (kind == 1 || kind == 2) {
#pragma unroll
            for (int ai = 0; ai < 2; ++ai)
#pragma unroll
                for (int m = 0; m < 4; ++m) {
                    const int row = rowt + ai * 128 + m * 16; float s = 0.f;
#pragma unroll
                    for (int bj = 0; bj < 2; ++bj)
#pragma unroll
                        for (int n = 0; n < 2; ++n) { const f32x4 x = acc[ai][bj][m][n] * SC; s += (x.x * x.x + x.y * x.y) + (x.z * x.z + x.w * x.w);
                            if (kind == 2) st_bf16x4(dst + (size_t)row * ld + coff + 32 * bj + 16 * n + 4 * fq, x);
                            else { const int row64 = u.pm * 256 + ai * 128 + wr * 64;
                                const size_t bt = vt_tile_of_rowgroup(row64); unsigned char* tile = (unsigned char*)dst + ((bt / 68) * 2 + coff / 64) * VT_HEAD + (bt % 68) * VT_TILE;
                                st_vt4(tile, 32 * bj + 16 * n + 4 * fq, vt_pos(16 * m + fr), x); } }
                    if (kind == 2) { s = add_xor32(add_xor16(s)); if (fq == 0) ((float*)(ws + WS_SSQ))[(size_t)row * 8 + (slot - 10)] = s; }
                }
        } else {
            const f32x4 g0 = *(const f32x4*)(gain + 4 * fq), g1 = *(const f32x4*)(gain + 16 + 4 * fq);
            bf16_t* craw = (bf16_t*)(ws + Z_CRAW);
#pragma unroll
            for (int ai = 0; ai < 2; ++ai)
#pragma unroll
                for (int m = 0; m < 4; ++m) {
                    const int row = rowt + ai * 128 + m * 16;
                    const f32x4 a0 = acc[ai][0][m][0] * SC, a1 = acc[ai][0][m][1] * SC;
                    float s = (a0.x * a0.x + a0.y * a0.y) + (a0.z * a0.z + a0.w * a0.w) + (a1.x * a1.x + a1.y * a1.y) + (a1.z * a1.z + a1.w * a1.w);
                    s = add_xor32(add_xor16(s));
                    const float rstd = 1.0f / sqrtf(s * (1.f / 32.f) + EPS);
                    f32x4 v0 = a0 * rstd * g0, v1 = a1 * rstd * g1;
                    if (lat) { const int t = row & 4095, pr = t >> 6, pc = t & 63;
                        f32x4 p0, p1;
#pragma unroll
                        for (int i = 0; i < 4; ++i) { p0[i] = other32(v0[i], fq >= 2); p1[i] = other32(v1[i], fq >= 2); }
                        const LAS f32x2* t0 = tab32 + pr * 8 + 4 * (fq & 1); const LAS f32x2* t1 = tab32 + pc * 8 + 4 * (fq & 1);
#pragma unroll
                        for (int i = 0; i < 4; ++i) { const f32x2 c0 = t0[i], c1 = t1[i];
                            v0[i] = fq < 2 ? v0[i] * c0.x - p0[i] * c0.y : v0[i] * c0.x + p0[i] * c0.y;
                            v1[i] = fq < 2 ? v1[i] * c1.x - p1[i] * c1.y : v1[i] * c1.x + p1[i] * c1.y; } }
                    const unsigned w0 = pk_fp8v(v0), w1 = pk_fp8v(v1);
#pragma unroll
                    for (int h = 0; h < 6; ++h) { unsigned char* p = (unsigned char*)dst + (size_t)row * 768 + h * 128 + 64 + 4 * fq; *(unsigned*)p = w0; *(unsigned*)(p + 16) = w1; *(unsigned*)(p + 32) = 0u; *(unsigned*)(p + 48) = 0u; }
                    const u32x2 z = {0u, 0u};
#pragma unroll
                    for (int q = 0; q < 4; ++q) *(u32x2*)(craw + (size_t)row * 384 + 320 + 16 * q + 4 * fq) = z;
                    asm volatile("" ::: "memory");
                }
        }
    }
};

struct EpiUpProj {
    static constexpr bool PERM = false, FP8 = false;
    unsigned char* ws; const LAS unsigned long long* in; int l; const LAS f32x2* tab32;
    DI void operator()(const Acc& acc, const g8::Unit& u, int wr, int wc, int fr, int fq) const {
        asm volatile("" : "+v"(fr), "+v"(fq));
        const int slot = 4 * u.pn + wc; if (slot >= 9 && slot < 12) return;
        const int rowt = u.pm * 256 + wr * 64 + fr; const bool lat = (u.pm * 256) < LAT;
        const float* ssq = (const float*)(ws + WS_SSQ);
        bf16_t* qB = (bf16_t*)(ws + Z_QB); bf16_t* kB = (bf16_t*)(ws + Z_KB); bf16_t* vB = (bf16_t*)(ws + Z_VB);
        const bool isq = slot < 9;
#pragma unroll
        for (int ai = 0; ai < 2; ++ai)
#pragma unroll
            for (int m = 0; m < 4; ++m) {
                const int row = rowt + ai * 128 + m * 16;
                const f32x4 sa = *(const f32x4*)(ssq + (size_t)row * 8); const float sb = ssq[(size_t)row * 8 + 4];
                const float r0 = isq ? 1.0f / sqrtf((sa.x + sa.y + sa.z) * (1.f / 192.f) + EPS) : 1.0f / sqrtf((sa.w + sb) * (1.f / 128.f) + EPS);
                if (slot < 6 || (slot >= 12 && slot < 18)) {
                    const float* gain = slot < 6 ? inp(in, 15) + l * 64 : inp(in, 16) + l * 64; const float qs = slot < 6 ? QF96 : 1.f;
                    const int h = slot < 6 ? slot : slot - 12; unsigned char* dst = (unsigned char*)(slot < 6 ? qB : kB) + (size_t)row * 768 + h * 128;
                    float s = 0.f; f32x4 x[2][2];
#pragma unroll
                    for (int bj = 0; bj < 2; ++bj)
#pragma unroll
                        for (int n = 0; n < 2; ++n) { x[bj][n] = acc[ai][bj][m][n] * r0; s += (x[bj][n].x * x[bj][n].x + x[bj][n].y * x[bj][n].y) + (x[bj][n].z * x[bj][n].z + x[bj][n].w * x[bj][n].w); }
                    s = add_xor32(add_xor16(s));
                    const float rstd = qs / sqrtf(s * (1.f / 64.f) + EPS);
#pragma unroll
                    for (int bj = 0; bj < 2; ++bj)
#pragma unroll
                        for (int n = 0; n < 2; ++n) { const int c = 32 * bj + 16 * n + 4 * fq; *(unsigned*)(dst + c) = pk_fp8v(x[bj][n] * rstd * *(const f32x4*)(gain + c)); }
                } else if (slot >= 18) {
                    const int row64 = u.pm * 256 + ai * 128 + wr * 64; const size_t bt = vt_tile_of_rowgroup(row64);
                    unsigned char* tile = (unsigned char*)vB + ((bt / 68) * 6 + (slot - 18)) * VT_HEAD + (bt % 68) * VT_TILE;
#pragma unroll
                    for (int bj = 0; bj < 2; ++bj)
#pragma unroll
                        for (int n = 0; n < 2; ++n) st_vt4(tile, 32 * bj + 16 * n + 4 * fq, vt_pos(16 * m + fr), acc[ai][bj][m][n] * r0);
                } else {
                    const float* gain = inp(in, 17) + l * 32;
#pragma unroll
                    for (int bj = 0; bj < 2; ++bj) {
                        const f32x4 a0 = acc[ai][bj][m][0] * r0, a1 = acc[ai][bj][m][1] * r0;
                        float s = (a0.x * a0.x + a0.y * a0.y) + (a0.z * a0.z + a0.w * a0.w) + (a1.x * a1.x + a1.y * a1.y) + (a1.z * a1.z + a1.w * a1.w);
                        s = add_xor32(add_xor16(s));
                        const float rstd = QF96 / sqrtf(s * (1.f / 32.f) + EPS);
                        f32x4 v0 = a0 * rstd * *(const f32x4*)(gain + 4 * fq), v1 = a1 * rstd * *(const f32x4*)(gain + 16 + 4 * fq);
                        if (lat) { const int t = row & 4095, pr = t >> 6, pc = t & 63; f32x4 p0, p1;
#pragma unroll
                            for (int i = 0; i < 4; ++i) { p0[i] = other32(v0[i], fq >= 2); p1[i] = other32(v1[i], fq >= 2); }
                            const LAS f32x2* t0 = tab32 + pr * 8 + 4 * (fq & 1); const LAS f32x2* t1 = tab32 + pc * 8 + 4 * (fq & 1);
#pragma unroll
                            for (int i = 0; i < 4; ++i) { const f32x2 c0 = t0[i], c1 = t1[i];
                                v0[i] = fq < 2 ? v0[i] * c0.x - p0[i] * c0.y : v0[i] * c0.x + p0[i] * c0.y;
                                v1[i] = fq < 2 ? v1[i] * c1.x - p1[i] * c1.y : v1[i] * c1.x + p1[i] * c1.y; } }
                        unsigned char* p = (unsigned char*)qB + (size_t)row * 768 + (2 * (slot - 6) + bj) * 128 + 64 + 4 * fq;
                        *(unsigned*)p = pk_fp8v(v0); *(unsigned*)(p + 16) = pk_fp8v(v1); *(unsigned*)(p + 32) = 0u; *(unsigned*)(p + 48) = 0u;
                    }
                }
                asm volatile("" ::: "memory");
            }
    }
};

struct EpiOutProj {
    static constexpr bool PERM = false, FP8 = false;
    unsigned char* ws; const float* xin; const float* cin; float* out; int l;
    DI void operator()(const Acc& acc, const g8::Unit& u, int wr, int wc, int fr, int fq) const {
        asm volatile("" : "+v"(fr), "+v"(fq));
        const int rowt = u.pm * 256 + wr * 64 + fr; const bool lat = (u.pm * 256) < LAT;
        const float* mod = (const float*)(ws + WS_MOD) + ((size_t)l * 9 + (lat ? (u.pm * 256) / 4096 : 8)) * 6144 + 2048;
        const int col0 = u.pn * 256 + wc * 32 + 4 * fq;
        f32x4 gv[2][2];
#pragma unroll
        for (int bj = 0; bj < 2; ++bj)
#pragma unroll
            for (int n = 0; n < 2; ++n) gv[bj][n] = *(const f32x4*)(mod + col0 + 128 * bj + 16 * n);
#pragma unroll
        for (int ai = 0; ai < 2; ++ai)
#pragma unroll
            for (int m = 0; m < 4; ++m) {
                const int row = rowt + ai * 128 + m * 16;
                const float* src = lat ? xin + (size_t)row * 1024 : cin + (size_t)(row - LAT) * 1024;
                float* dst = lat ? out + (size_t)row * 1024 : (float*)(ws + WS_CTXF) + (size_t)(row - LAT) * 1024;
#pragma unroll
                for (int bj = 0; bj < 2; ++bj)
#pragma unroll
                    for (int n = 0; n < 2; ++n) { const int c = col0 + 128 * bj + 16 * n; *(f32x4*)(dst + c) = *(const f32x4*)(src + c) + gv[bj][n] * acc[ai][bj][m][n]; }
            }
    }
};

constexpr int WSH = 6, HSH = 3;
struct EpiMoe1 {
    static constexpr bool PERM = true, FP8 = true;
    unsigned char* ws;
    DI void operator()(const Acc& acc, const g8::Unit& u, int wr, int wc, int fr, int fq) const {
        asm volatile("" : "+v"(fr), "+v"(fq));
        unsigned char* hid = ws + Z_HID; constexpr float SC = 1.0f / (float)(1 << WSH), HS = (float)(1 << HSH);
#pragma unroll
        for (int ai = 0; ai < 2; ++ai)
#pragma unroll
            for (int m = 0; m < 4; ++m) {
                const int row = u.pm * 256 + ai * 128 + wr * 64 + m * 16 + fr;
                f32x4 h0, h1;
#pragma unroll
                for (int i = 0; i < 4; ++i) { h0[i] = silu_f(acc[ai][0][m][0][i] * SC) * (acc[ai][1][m][0][i] * (SC * HS)); h1[i] = silu_f(acc[ai][0][m][1][i] * SC) * (acc[ai][1][m][1][i] * (SC * HS)); }
                u32x2 w; w.x = pk_fp8x4(h0.x, h0.y, h0.z, h0.w); w.y = pk_fp8x4(h1.x, h1.y, h1.z, h1.w);
                *(u32x2*)(hid + (size_t)row * 1024 + u.pn * 128 + wc * 32 + 8 * fq) = w;
            }
    }
};
struct EpiMoe2 {
    static constexpr bool PERM = true, FP8 = true;
    unsigned char* ws;
    DI void operator()(const Acc& acc, const g8::Unit& u, int wr, int wc, int fr, int fq) const {
        asm volatile("" : "+v"(fr), "+v"(fq));
        bf16_t* ye = (bf16_t*)(ws + Z_YE); const float* gate = (const float*)(ws + WS_GATE); constexpr float SC = 1.0f / (float)(1 << (WSH + HSH));
#pragma unroll
        for (int ai = 0; ai < 2; ++ai)
#pragma unroll
            for (int m = 0; m < 4; ++m) {
                const int row = u.pm * 256 + ai * 128 + wr * 64 + m * 16 + fr; const float gv = gate[row] * SC;
#pragma unroll
                for (int bj = 0; bj < 2; ++bj) { const f32x4 a = acc[ai][bj][m][0] * gv, b = acc[ai][bj][m][1] * gv; u32x4 w;
                    w.x = cvt_pk(a.x, a.y); w.y = cvt_pk(a.z, a.w); w.z = cvt_pk(b.x, b.y); w.w = cvt_pk(b.z, b.w);
                    *(u32x4*)(ye + (size_t)row * 1024 + u.pn * 256 + bj * 128 + wc * 32 + 8 * fq) = w; }
            }
    }
};
DI int crow(int i, int hh) { return (i & 3) + 8 * (i >> 2) + 4 * hh; }
typedef short v4i16_t __attribute__((ext_vector_type(4)));
DI s16x4 vtr(const LAS unsigned char* p) { return __builtin_bit_cast(s16x4, __builtin_amdgcn_ds_read_tr16_b64_v4i16((LAS v4i16_t*)p)); }
#define MFMA32(a, b, c) __builtin_amdgcn_mfma_f32_32x32x16_bf16((a), (b), (c), 0, 0, 0)

struct AttnDesc { const unsigned char* Q; int ldq, qoff; const unsigned char* K; int ldk, koff; const unsigned char* Vt; bf16_t* O; int ooff; float sink2; };
DI float fmax3(float a, float b, float c) { return __builtin_fmaxf(__builtin_fmaxf(a, b), c); }
typedef int i32x4 __attribute__((ext_vector_type(4)));
typedef int i32x8 __attribute__((ext_vector_type(8)));
#define MFMA8Z(acc, a, b, sa, sb) asm volatile("v_mfma_scale_f32_32x32x64_f8f6f4 %0, %1, %2, 0, %3, %4 op_sel_hi:[0,0,0]" : "=&v"(acc) : "v"(a), "v"(b), "v"(sa), "v"(sb))
#define MFMA8(acc, a, b, sa, sb) asm volatile("v_mfma_scale_f32_32x32x64_f8f6f4 %0, %1, %2, %0, %3, %4 op_sel_hi:[0,0,0]" : "+v"(acc) : "v"(a), "v"(b), "v"(sa), "v"(sb))
DI int cvt8x4(float a, float b, float c, float d) { int w; asm("v_cvt_pk_fp8_f32 %0, %1, %2" : "=v"(w) : "v"(a), "v"(b)); asm("v_cvt_pk_fp8_f32 %0, %1, %2 op_sel:[0,0,1]" : "+v"(w) : "v"(c), "v"(d)); return w; }
#define MFMA8C(acc, a, b, c, sa, sb) asm volatile("v_mfma_scale_f32_32x32x64_f8f6f4 %0, %1, %2, %3, %4, %5 op_sel_hi:[0,0,0]" : "=&v"(acc) : "v"(a), "v"(b), "v"(c), "v"(sa), "v"(sb))
template <int DQB  , int MODE, bool TRACK, int ABL = 0>
DI void attn_unit(const int tid, LAS unsigned char* lds, const AttnDesc& d, int b, int qb, bool has_sink) {
    constexpr int KSTR = DQB + 16, VSTR = 80, KBUF = 128 * KSTR, VTILE = 64 * VSTR, VBUF = 2 * VTILE, NS = DQB / 64, KCH = DQB / 16, KC1 = KCH + 1, VC1 = 5;
    const int lane = tid & 63, wid = __builtin_amdgcn_readfirstlane(tid >> 6), r = lane & 31, hh = lane >> 5;
    const int q0 = qb * 256;
    const int qrow = (MODE == 2 ? LAT + b * 256 : b * 4096) + q0 + wid * 32 + r;
    int lo = 0, ntl = 0;
    if (MODE == 0) { lo = 0; ntl = 64; }
    if (MODE == 1) { lo = q0 - 128 < 0 ? 0 : q0 - 128; const int hi = q0 + 384 > 4096 ? 4096 : q0 + 384; ntl = (hi - lo) / 64; }
    int NSTEP = (4 + ntl) / 2;
    asm volatile("" : "+s"(NSTEP));
    auto step_row = [&](int st) -> int { return st < 2 ? LAT + b * 256 + st * 128 : b * 4096 + lo + (st - 2) * 128; };
    auto step_T = [&](int st) -> int { return st < 2 ? 2 * st : 4 + lo / 64 + 2 * (st - 2); };
    i32x8 qf[NS];
#pragma unroll
    for (int s = 0; s < NS; ++s) { const unsigned char* qp = d.Q + (size_t)qrow * d.ldq + d.qoff + 64 * s + 32 * hh; const i32x4 lo4 = *(const i32x4*)qp, hi4 = *(const i32x4*)(qp + 16); qf[s] = __builtin_shufflevector(lo4, hi4, 0, 1, 2, 3, 4, 5, 6, 7); }
    const int sclK = 0x7F7F7F7F, sclQ = 0x7C7C7C7C;
    constexpr int NKC = 128 * KC1, NVC = 128 * VC1, NKI = (NKC + 511) / 512, NVI = (NVC + 511) / 512;
    auto dma_piece = [&](int st, int buf, int i) {
        if (i < NKI) { const int wv = (i + 1) * 512 > NKC ? (wid + 2) & 7 : wid; if (i * 512 + wv * 64 < NKC) { const int c = i * 512 + wv * 64 + lane, row = c / KC1, ch = c % KC1; const unsigned char* kb_ = d.K + (size_t)step_row(st) * d.ldk;
            __builtin_amdgcn_global_load_lds((const unsigned*)(kb_ + (unsigned)(row * d.ldk + d.koff + (ch < KCH ? ch : 0) * 16)), (LAS unsigned*)(lds + buf * KBUF + i * 8192 + wv * 1024), 16, 0, 0); } }
        else { const int iv = i - NKI, wv = (iv + 1) * 512 > NVC ? (wid + 4) & 7 : wid; if (iv * 512 + wv * 64 < NVC) { const int c = iv * 512 + wv * 64 + lane, row = c / VC1, ch = c % VC1; const unsigned char* vb_ = d.Vt + (size_t)step_T(st) * VT_TILE;
            __builtin_amdgcn_global_load_lds((const unsigned*)(vb_ + (unsigned)(row * 64 + (ch < 4 ? ch : 0) * 16)), (LAS unsigned*)(lds + 2 * KBUF + buf * VBUF + iv * 8192 + wv * 1024), 16, 0, 0); } } };
    auto dma_step = [&](int st, int buf) {
#pragma unroll
        for (int i = 0; i < NKI + NVI; ++i) dma_piece(st, buf, i); };
    constexpr float THR = 8.f, POFF = 6.f;
    static_assert(TRACK, "the fp8 P.V path needs the running row maximum");
    float m = 0.f;
    if (has_sink) m = d.sink2 - POFF;
    f32x16 o0, o1, sc[4], negm, lacc;
    { float z = 0.f, nm = -m, l0 = has_sink ? __builtin_amdgcn_exp2f(POFF) : 0.f; asm volatile("" : "+v"(z), "+v"(nm), "+v"(l0));
#pragma unroll
      for (int i = 0; i < 16; ++i) { o0[i] = z; o1[i] = z; negm[i] = nm; lacc[i] = l0; } }
    i32x8 ones;
    { int one4 = 0x38383838; asm volatile("" : "+v"(one4));
#pragma unroll
      for (int i = 0; i < 8; ++i) ones[i] = one4; }
    asm volatile("s_nop 1" : "+v"(ones), "+v"(negm), "+v"(lacc));
    const int koffl = r * KSTR + hh * 32, voffl = r * VSTR + hh * 32, sclV = 0x7F7F7F7F;
    auto frag = [&](const LAS unsigned char* p) -> i32x8 { const i32x4 lo4 = *(const LAS i32x4*)p, hi4 = *(const LAS i32x4*)(p + 16); return __builtin_shufflevector(lo4, hi4, 0, 1, 2, 3, 4, 5, 6, 7); };
    __syncthreads();
    dma_step(0, 0); dma_step(1, 1); asm volatile("s_waitcnt vmcnt(0)" ::: "memory");
    __syncthreads();
    constexpr int NF = 4 * NS;
    auto kfrag = [&](int kbuf, int f) -> i32x8 { return frag(lds + kbuf * KBUF + koffl + (32 * (f & 3)) * KSTR + (f >> 2) * 64); };
    i32x8 kx[3];
    kx[0] = kfrag(0, 0); kx[1] = kfrag(0, 1); kx[2] = kfrag(0, 2);
    for (int st = 0; st < NSTEP; ++st) {
        const int buf = st & 1;
        {
#pragma unroll
          for (int f = 0; f < NF; ++f) { const int j = f & 3, s = f >> 2;
              if (!(ABL & 4)) { if (s == 0) MFMA8C(sc[j], kx[f % 3], qf[0], negm, sclK, sclQ); else MFMA8(sc[j], kx[f % 3], qf[s], sclK, sclQ); } else if (s == 0) sc[j] = negm;
              if (f + 3 < NF) kx[f % 3] = kfrag(buf, f + 3); }
          asm volatile("s_nop 15\n\ts_nop 7" : "+v"(sc[0]), "+v"(sc[1]), "+v"(sc[2]), "+v"(sc[3])); }
        i32x8 vx[4];
        { const LAS unsigned char* vb = lds + 2 * KBUF + buf * VBUF + voffl;
#pragma unroll
          for (int t2 = 0; t2 < 2; ++t2) { vx[2 * t2] = frag(vb + t2 * VTILE); vx[2 * t2 + 1] = frag(vb + t2 * VTILE + 32 * VSTR); }
          asm volatile("" ::: "memory"); }
        if (MODE == 1) { if (st >= 2) { const int kp0 = lo + (st - 2) * 128, qp = q0 + wid * 32 + r;
#pragma unroll
            for (int j = 0; j < 4; ++j)
#pragma unroll
                for (int i = 0; i < 16; ++i) { const int dk = kp0 + 32 * j + crow(i, hh) - qp; if (dk > 128 || dk < -128) sc[j][i] = -1e30f; } } }
        if (!(ABL & 32)) { float ma = fmax3(sc[0][0], sc[1][0], sc[2][0]), mb = fmax3(sc[3][0], sc[0][1], sc[1][1]);
#pragma unroll
          for (int i = 0; i < 16; ++i) { if (i >= 1) ma = fmax3(ma, sc[0][i], sc[1][i]); if (i >= 2) mb = fmax3(mb, sc[2][i], sc[3][i]); }
          mb = fmax3(mb, sc[2][1], sc[3][1]);
          float mx = __builtin_fmaxf(ma, mb);
          { auto rr = __builtin_amdgcn_permlane32_swap(__float_as_uint(mx), __float_as_uint(mx), false, false); mx = __builtin_fmaxf(__uint_as_float(rr[0]), __uint_as_float(rr[1])); }
          if (st == 0 && !has_sink) {
              const float dl = mx - POFF; m = dl;
#pragma unroll
              for (int j = 0; j < 4; ++j)
#pragma unroll
                  for (int i = 0; i < 16; ++i) sc[j][i] -= dl;
#pragma unroll
              for (int i = 0; i < 16; ++i) negm[i] = -m;
              asm volatile("s_nop 1" : "+v"(negm));
          } else if (__any(mx > THR)) {
              const float dl = __builtin_fmaxf(mx - POFF, 0.f), alpha = __builtin_amdgcn_exp2f(-dl);
              asm volatile("s_nop 15\n\ts_nop 7" : "+v"(o0), "+v"(o1), "+v"(lacc));
              m += dl;
#pragma unroll
              for (int i = 0; i < 16; ++i) { o0[i] *= alpha; o1[i] *= alpha; lacc[i] *= alpha; negm[i] = -m; }
#pragma unroll
              for (int j = 0; j < 4; ++j)
#pragma unroll
                  for (int i = 0; i < 16; ++i) sc[j][i] -= dl;
              asm volatile("s_nop 1" : "+v"(negm), "+v"(o0), "+v"(o1), "+v"(lacc)); } }
#pragma unroll
        for (int j = 0; j < 4; ++j)
#pragma unroll
            for (int i = 0; i < 16; ++i) if (!(ABL & 2)) sc[j][i] = __builtin_amdgcn_exp2f(sc[j][i]);
        i32x8 pf[2];
#pragma unroll
        for (int t2 = 0; t2 < 2; ++t2) {
#pragma unroll
            for (int q4 = 0; q4 < 4; ++q4) { if (ABL & 64) { pf[t2][q4] = __float_as_int(sc[2 * t2][q4]); pf[t2][4 + q4] = __float_as_int(sc[2 * t2 + 1][q4]); continue; }
                                             pf[t2][q4] = cvt8x4(sc[2 * t2][4 * q4], sc[2 * t2][4 * q4 + 1], sc[2 * t2][4 * q4 + 2], sc[2 * t2][4 * q4 + 3]);
                                             pf[t2][4 + q4] = cvt8x4(sc[2 * t2 + 1][4 * q4], sc[2 * t2 + 1][4 * q4 + 1], sc[2 * t2 + 1][4 * q4 + 2], sc[2 * t2 + 1][4 * q4 + 3]); } }
        asm volatile("s_nop 1" : "+v"(pf[0]), "+v"(pf[1]));
        asm volatile("s_waitcnt vmcnt(0) lgkmcnt(0)" ::: "memory"); if (!(ABL & 16)) __builtin_amdgcn_s_barrier(); asm volatile("" ::: "memory");
        if (st + 1 < NSTEP) { kx[0] = kfrag(buf ^ 1, 0); kx[1] = kfrag(buf ^ 1, 1); kx[2] = kfrag(buf ^ 1, 2); }
        const bool more = st + 2 < NSTEP && !(ABL & 1);
#pragma unroll
        for (int t = 0; t < 6; ++t) { const int t2 = t / 3, w = t % 3;
            if (!(ABL & 8)) { if (w == 0) MFMA8(o0, vx[2 * t2], pf[t2], sclV, sclV); else if (w == 1) MFMA8(o1, vx[2 * t2 + 1], pf[t2], sclV, sclV); else MFMA8(lacc, ones, pf[t2], sclV, sclV); }
            if (more && t < NKI + NVI) dma_piece(st + 2, buf, t); }
        static_assert(NKI + NVI <= 6, "one DMA piece per P.V MFMA");
    }
    asm volatile("s_nop 15\n\ts_nop 15" : "+v"(o0), "+v"(o1), "+v"(lacc));
    const float inv = 1.0f / lacc[0];
    bf16_t* op = d.O + (size_t)qrow * 1024 + d.ooff + 4 * hh;
#pragma unroll
    for (int g4 = 0; g4 < 4; ++g4) {
        u32x2 w; w.x = cvt_pk(o0[4 * g4] * inv, o0[4 * g4 + 1] * inv); w.y = cvt_pk(o0[4 * g4 + 2] * inv, o0[4 * g4 + 3] * inv); *(u32x2*)(op + 8 * g4) = w;
        u32x2 x; x.x = cvt_pk(o1[4 * g4] * inv, o1[4 * g4 + 1] * inv); x.y = cvt_pk(o1[4 * g4 + 2] * inv, o1[4 * g4 + 3] * inv); *(u32x2*)(op + 32 + 8 * g4) = x;
    }
}

#ifndef TRACK_EN
#define TRACK_EN 1
#endif
DI void attn_phase(const Frame& F, int l, bool with_ctx, int rep = 0) {
    constexpr int UB = 96, UA = 96, UC = 64, UX = 16;
    const int NUQ = UB + UA + UC + (with_ctx ? UX : 0);
    unsigned* heads = F.ctl + CW_QUEUE + 128 * (l + 2 * rep);
    volatile LAS int* slot = (volatile LAS int*)(F.lds + LDS_MISC + 16);
    const float* sinkp = INP(21) + l * 4;
    auto resolve = [&](int v) -> int {
        int q = slot[2];
        while (v >= NUQ) { const int t = slot[3] + 1; slot[3] = t; if (t >= NB) return -1; q = q + 1 == NB ? 0 : q + 1; slot[2] = q; v = (int)__hip_atomic_fetch_add(heads + 16 * q, 1u, __ATOMIC_RELAXED, __HIP_MEMORY_SCOPE_AGENT); }
        return q * 512 + v; };
    __syncthreads();
    if (F.tid == 0) { const int q0 = F.bid % NB; slot[2] = q0; slot[3] = 0; slot[0] = resolve((int)__hip_atomic_fetch_add(heads + 16 * q0, 1u, __ATOMIC_RELAXED, __HIP_MEMORY_SCOPE_AGENT)); }
    __syncthreads();
    for (int it = 0;; ++it) {
        int u = slot[it & 1]; if (u < 0) break;
        int nxt_u = 0; if (F.tid == 0) nxt_u = (int)__hip_atomic_fetch_add(heads + 16 * slot[2], 1u, __ATOMIC_RELAXED, __HIP_MEMORY_SCOPE_AGENT);
        [&]() {
        GAS unsigned char* wsg = (GAS unsigned char*)F.ws; asm volatile("" : "+s"(wsg)); unsigned char* ws = (unsigned char*)wsg;
        int tidu = F.tid; asm volatile("" : "+v"(tidu));
        AttnDesc d;
        const int b = u >> 9; u &= 511;
        if (u < UB) { const int h = u / 16, qb = u % 16;
            d = AttnDesc{(const unsigned char*)(ws + Z_QB), 768, h * 128, (const unsigned char*)(ws + Z_KB), 768, h * 128, (const unsigned char*)(ws + Z_VB) + ((size_t)b * 6 + h) * VT_HEAD, (bf16_t*)(ws + Z_OB), 384 + h * 64, 0.f};
#ifdef ATT_ABL
            if (rep) { attn_unit<128, 0, true, ATT_ABL>(tidu, F.lds, d, b, qb, false); return; }
#endif
            attn_unit<128, 0, true>(tidu, F.lds, d, b, qb, false); return; }
        u -= UB;
        if (u < UA) { const int h = u / 16, qb = u % 16;
            d = AttnDesc{(const unsigned char*)(ws + Z_QA), 384, h * 64, (const unsigned char*)(ws + Z_KA), 128, (h / 3) * 64, (const unsigned char*)(ws + Z_VA) + ((size_t)b * 2 + h / 3) * VT_HEAD, (bf16_t*)(ws + Z_OB), h * 64, 0.f};
#ifdef ATT_ABL
            if (rep) { attn_unit<64, 0, true, ATT_ABL>(tidu, F.lds, d, b, qb, false); return; }
#endif
            attn_unit<64, 0, true>(tidu, F.lds, d, b, qb, false); return; }
        u -= UA;
        if (u < UC) { const int h = u / 16, qb = u % 16;
            d = AttnDesc{(const unsigned char*)(ws + Z_QC), 256, h * 64, (const unsigned char*)(ws + Z_KC), 128, (h / 2) * 64, (const unsigned char*)(ws + Z_VC) + ((size_t)b * 2 + h / 2) * VT_HEAD, (bf16_t*)(ws + Z_OB), 768 + h * 64, sinkp[h] * LOG2E};
            attn_unit<64, 1, true>(tidu, F.lds, d, b, qb, true); return; }
        u -= UC;
        { const int hx = u;
            if (hx < 6) { const int h = hx;
                d = AttnDesc{(const unsigned char*)(ws + Z_QA), 384, h * 64, (const unsigned char*)(ws + Z_KA), 128, (h / 3) * 64, (const unsigned char*)(ws + Z_VA) + ((size_t)b * 2 + h / 3) * VT_HEAD, (bf16_t*)(ws + Z_OB), h * 64, 0.f};
                attn_unit<64, 2, true>(tidu, F.lds, d, b, 0, false); }
            else if (hx < 12) { const int h = hx - 6;
                d = AttnDesc{(const unsigned char*)(ws + Z_QB), 768, h * 128, (const unsigned char*)(ws + Z_KB), 768, h * 128, (const unsigned char*)(ws + Z_VB) + ((size_t)b * 6 + h) * VT_HEAD, (bf16_t*)(ws + Z_OB), 384 + h * 64, 0.f};
                attn_unit<128, 2, true>(tidu, F.lds, d, b, 0, false); }
            else { const int h = hx - 12;
                d = AttnDesc{(const unsigned char*)(ws + Z_QC), 256, h * 64, (const unsigned char*)(ws + Z_KC), 128, (h / 2) * 64, (const unsigned char*)(ws + Z_VC) + ((size_t)b * 2 + h / 2) * VT_HEAD, (bf16_t*)(ws + Z_OB), 768 + h * 64, sinkp[h] * LOG2E};
                attn_unit<64, 2, true>(tidu, F.lds, d, b, 0, true); }
        }
        }();
        if (F.tid == 0) slot[(it & 1) ^ 1] = resolve(nxt_u);
        __syncthreads();
    }
}

DI void router_phase(const Frame& F, int l, bool with_ctx) {
    LAS float* wT = (LAS float*)F.lds;
    const float* wr = INP(23) + (size_t)l * 1024 * 16;
    for (int e = F.tid; e < 16 * 1024; e += NTHR) { const int k = e / 16, x = e % 16; wT[x * 1024 + k] = wr[e]; }
    __syncthreads();
    const int gw = F.bid * NWAVES + F.wave, NGW = F.G * NWAVES, NR = with_ctx ? R : LAT, lane = F.lane;
    const int per = (NR + NGW - 1) / NGW, r0 = gw * per, r1 = r0 + per < NR ? r0 + per : NR;
    const float* g = INP(7) + l * 1024;
    auto rowptr = [&](int row) -> const float* { return row < LAT ? F.out + (size_t)row * 1024 : WSP(float, WS_CTXF) + (size_t)(row - LAT) * 1024; };
    f32x4 vn[4], gc[4], sv[4]; int curb = -1;
    if (r0 < r1) { const float* xr0 = rowptr(r0);
#pragma unroll
        for (int j = 0; j < 4; ++j) vn[j] = *(const f32x4*)(xr0 + 4 * (lane + 64 * j)); }
    for (int row = r0; row < r1; ++row) {
        f32x4 v[4]; float s = 0.f;
#pragma unroll
        for (int j = 0; j < 4; ++j) { v[j] = vn[j]; s += (v[j].x * v[j].x + v[j].y * v[j].y) + (v[j].z * v[j].z + v[j].w * v[j].w); }
        if (row + 1 < r1) { const float* xr1 = rowptr(row + 1);
#pragma unroll
            for (int j = 0; j < 4; ++j) vn[j] = *(const f32x4*)(xr1 + 4 * (lane + 64 * j)); }
        const int cb = cond_of_row(row);
        if (cb != curb) { const float* m = mod_row(F, l, row); load_mod(g, m + 3072, m + 4096, gc, sv, lane); curb = cb; }
        const float rstd = 1.0f / sqrtf(wave_sum(s) * (1.f / 1024.f) + EPS);
        float lg[16];
#pragma unroll
        for (int e = 0; e < 16; ++e) lg[e] = 0.f;
        unsigned char* orow = WSP(unsigned char, WS_HB) + (size_t)row * 1024;
#pragma unroll
        for (int j = 0; j < 4; ++j) { const int c = 4 * (lane + 64 * j);
            v[j] = v[j] * rstd * gc[j] + sv[j]; *(unsigned*)(orow + c) = pk_fp8x4(v[j].x, v[j].y, v[j].z, v[j].w); }
        asm volatile("" ::: "memory");
#pragma unroll
        for (int e = 0; e < 16; ++e) {
#pragma unroll
            for (int j = 0; j < 4; ++j) { const f32x4 wv = *(const LAS f32x4*)(wT + e * 1024 + 4 * (lane + 64 * j));
                lg[e] = __builtin_fmaf(v[j].x, wv.x, lg[e]); lg[e] = __builtin_fmaf(v[j].y, wv.y, lg[e]); lg[e] = __builtin_fmaf(v[j].z, wv.z, lg[e]); lg[e] = __builtin_fmaf(v[j].w, wv.w, lg[e]); }
            if ((e & 3) == 3) asm volatile("" ::: "memory"); }
        float r8[8], r4[4], lgt;
#pragma unroll
        for (int i = 0; i < 8; ++i) { auto rr = __builtin_amdgcn_permlane32_swap(__float_as_uint(lg[i]), __float_as_uint(lg[i + 8]), false, false); r8[i] = __uint_as_float(rr[0]) + __uint_as_float(rr[1]); }
#pragma unroll
        for (int i = 0; i < 4; ++i) { auto rr = __builtin_amdgcn_permlane16_swap(__float_as_uint(r8[i]), __float_as_uint(r8[i + 4]), false, false); r4[i] = __uint_as_float(rr[0]) + __uint_as_float(rr[1]); }
        { const bool b3 = (lane & 8) != 0, b2 = (lane & 4) != 0;
          const float t0 = row_sum16(r4[0]), t1 = row_sum16(r4[1]), t2 = row_sum16(r4[2]), t3 = row_sum16(r4[3]);
          lgt = b3 ? (b2 ? t3 : t2) : (b2 ? t1 : t0); }
        float mx = lgt;
        mx = fmaxf(mx, dppf<0x128>(mx)); mx = fmaxf(mx, dppf<0x124>(mx)); mx = max_xor32(max_xor16(mx));
        const float pe = expf(lgt - mx);
        float sum = pe;
        sum += dppf<0x128>(sum); sum += dppf<0x124>(sum); sum = add_xor32(add_xor16(sum));
        const float mine = pe / sum;
        if ((lane & 3) == 0) { const int e = lane >> 2;
            if (row < LAT) WSP(float, WS_AFFL)[((size_t)(row / 4096) * 16 + e) * 4096 + (row & 4095)] = mine;
            else { const int rc = row - LAT; WSP(float, WS_AFFC)[((size_t)(rc / 256) * 16 + e) * 256 + (rc & 255)] = mine; }
        }
    }
}

DI void topk_phase(const Frame& F, bool with_ctx) {
    LAS unsigned* hist = (LAS unsigned*)F.lds;
    LAS unsigned* sh = hist + 256;
    LAS unsigned* scan = hist + 512;
    const int NL = NB * 16 * (with_ctx ? 2 : 1), tid = F.tid;
    for (int li = F.bid; li < NL; li += F.G) {
        const bool isctx = li >= NB * 16; const int be = isctx ? li - NB * 16 : li, b = be / 16, e = be % 16;
        const int n = isctx ? 256 : 4096, cap = n / 8, per = isctx ? 1 : 8;
        const float* a = isctx ? WSP(float, WS_AFFC) + (size_t)be * 256 : WSP(float, WS_AFFL) + (size_t)be * 4096;
        unsigned key[8]; const bool act = tid * per < n;
#pragma unroll
        for (int j = 0; j < 8; ++j) key[j] = (act && j < per) ? __float_as_uint(a[tid * per + j]) : 0u;
        unsigned prefix = 0u, rem = (unsigned)cap;
        for (int pass = 0; pass < 4; ++pass) {
            const int shift = 24 - 8 * pass;
            __syncthreads();
            if (tid < 256) hist[tid] = 0u;
            __syncthreads();
#pragma unroll
            for (int j = 0; j < 8; ++j) if (act && j < per) { const unsigned k = key[j]; const bool match = pass == 0 ? true : ((k >> (shift + 8)) == (prefix >> (shift + 8))); if (match) __hip_atomic_fetch_add(&hist[(k >> shift) & 255u], 1u, __ATOMIC_RELAXED, __HIP_MEMORY_SCOPE_WORKGROUP); }
            __syncthreads();
            if (tid < 64) {
                const int b0 = 255 - 4 * tid; const unsigned c0 = hist[b0], c1 = hist[b0 - 1], c2 = hist[b0 - 2], c3 = hist[b0 - 3];
                unsigned incl = c0 + c1 + c2 + c3;
#pragma unroll
                for (int o = 1; o < 64; o <<= 1) { const unsigned v = shfl_up_u(incl, o, tid); if (tid >= o) incl += v; }
                unsigned cum = incl - (c0 + c1 + c2 + c3);
                if (cum < rem && incl >= rem) { int bin = b0; unsigned c = c0;
                    if (cum + c < rem) { cum += c; bin = b0 - 1; c = c1; if (cum + c < rem) { cum += c; bin = b0 - 2; c = c2; if (cum + c < rem) { cum += c; bin = b0 - 3; } } }
                    sh[0] = prefix | ((unsigned)bin << shift); sh[1] = rem - cum; }
            }
            __syncthreads();
            prefix = sh[0]; rem = sh[1];
        }
        unsigned cg = 0u, ce = 0u;
#pragma unroll
        for (int j = 0; j < 8; ++j) if (act && j < per) { cg += key[j] > prefix ? 1u : 0u; ce += key[j] == prefix ? 1u : 0u; }
        __syncthreads();
        scan[tid] = cg; scan[512 + tid] = ce;
        __syncthreads();
        unsigned gb, eb;
        {
            unsigned ig = cg, ie = ce; const int ln = tid & 63, wv = tid >> 6;
#pragma unroll
            for (int o = 1; o < 64; o <<= 1) { const unsigned vg = shfl_up_u(ig, o, ln), ve = shfl_up_u(ie, o, ln); if (ln >= o) { ig += vg; ie += ve; } }
            if (ln == 63) { scan[1024 + wv] = ig; scan[1040 + wv] = ie; }
            __syncthreads();
            unsigned og = 0u, oe = 0u;
#pragma unroll
            for (int w = 0; w < 8; ++w) { if (w < wv) { og += scan[1024 + w]; oe += scan[1040 + w]; } }
            gb = og + ig - cg; eb = oe + ie - ce;
        }
        const int rowb = isctx ? LAT + b * 256 : b * 4096;
        const int mbase = isctx ? MOE_LAT + e * 256 + b * 32 : (b * 16 + e) * 512;
        int* gidx = WSP(int, WS_GIDX); float* gate = WSP(float, WS_GATE); int* inv = WSP(int, WS_INV);
#pragma unroll
        for (int j = 0; j < 8; ++j) if (act && j < per) {
            const unsigned k = key[j]; const int t = tid * per + j; int slot = -1;
            if (k > prefix) { slot = (int)(gb + (eb < rem ? eb : rem)); ++gb; }
            else if (k == prefix) { if (eb < rem) slot = (int)(gb + eb); ++eb; }
            if (slot >= 0) { gidx[mbase + slot] = rowb + t; gate[mbase + slot] = __uint_as_float(k); }
            inv[(size_t)(rowb + t) * 16 + e] = slot >= 0 ? mbase + slot : -1;
        }
        if (isctx && NB < 8 && b == 0) { for (int i = NB * 32 + tid; i < 256; i += NTHR) { gidx[MOE_LAT + e * 256 + i] = LAT; gate[MOE_LAT + e * 256 + i] = 0.f; } }
    }
}

DI void combine_phase(const Frame& F, int l, bool with_ctx, int rep = 0) {
    const int gw = F.bid * NWAVES + F.wave, NGW = F.G * NWAVES, NR = with_ctx ? R : LAT, lane = F.lane;
    const int per = (NR + NGW - 1) / NGW, r0 = gw * per, r1 = r0 + per < NR ? r0 + per : NR;
    const bool last = (l == DEPTH - 1);
    const bf16_t* ye = WSP(bf16_t, Z_YE); const int* inv = WSP(int, WS_INV);
    auto rowptr = [&](int row) -> float* { return row < LAT ? F.out + (size_t)row * 1024 : WSP(float, WS_CTXF) + (size_t)(row - LAT) * 1024; };
    auto pair_of = [&](int slots, int& s0, int& s1, bool& two) -> unsigned {
        unsigned mask = (unsigned)(__ballot(slots >= 0) & 0xFFFFull); s0 = -1; s1 = -1; two = false;
        if (mask) { const int e0 = __builtin_ctz(mask); mask &= mask - 1; two = mask != 0u; const int e1 = two ? __builtin_ctz(mask) : e0; if (two) mask &= mask - 1;
            s0 = __builtin_amdgcn_readlane(slots, e0); s1 = __builtin_amdgcn_readlane(slots, e1); }
        return mask; };
    auto load_pair = [&](int s0, int s1, u32x2 (&a)[4], u32x2 (&c)[4]) { const bf16_t* y0 = ye + (size_t)s0 * 1024; const bf16_t* y1 = ye + (size_t)s1 * 1024;
#pragma unroll
        for (int j = 0; j < 4; ++j) { a[j] = *(const u32x2*)(y0 + 4 * (lane + 64 * j)); c[j] = *(const u32x2*)(y1 + 4 * (lane + 64 * j)); } };
    auto add_pair = [&](f32x4 (&acc)[4], const u32x2 (&a)[4], const u32x2 (&c)[4], float w1) {
#pragma unroll
        for (int j = 0; j < 4; ++j) { acc[j].x += bf_lo(a[j].x) + w1 * bf_lo(c[j].x); acc[j].y += bf_hi(a[j].x) + w1 * bf_hi(c[j].x); acc[j].z += bf_lo(a[j].y) + w1 * bf_lo(c[j].y); acc[j].w += bf_hi(a[j].y) + w1 * bf_hi(c[j].y); } };
    int slot_n = -1; f32x4 xn[4]; u32x2 an[4], cn[4]; unsigned mask_n = 0u; int s0n = -1; bool two_n = false;
    f32x4 g2[4], gc[4], sv[4]; int curb = -1;
    if (r0 < r1) { slot_n = lane < 16 ? inv[(size_t)r0 * 16 + lane] : -1; const float* x0 = rowptr(r0);
#pragma unroll
        for (int j = 0; j < 4; ++j) xn[j] = *(const f32x4*)(x0 + 4 * (lane + 64 * j));
        int s1n; mask_n = pair_of(slot_n, s0n, s1n, two_n); if (s0n >= 0) load_pair(s0n, s1n, an, cn); }
    for (int row = r0; row < r1; ++row) {
        float* xr = rowptr(row);
        const int myslot = slot_n; f32x4 xv[4]; u32x2 a[4], c[4]; unsigned mask = mask_n; const bool any = s0n >= 0; const float w1 = two_n ? 1.f : 0.f;
#pragma unroll
        for (int j = 0; j < 4; ++j) { xv[j] = xn[j]; a[j] = an[j]; c[j] = cn[j]; }
        if (row + 1 < r1) { slot_n = lane < 16 ? inv[(size_t)(row + 1) * 16 + lane] : -1; const float* x1 = rowptr(row + 1);
#pragma unroll
            for (int j = 0; j < 4; ++j) xn[j] = *(const f32x4*)(x1 + 4 * (lane + 64 * j)); }
        const int cb = cond_of_row(row);
        if (cb != curb) { const float* m = mod_row(F, l, row);
#pragma unroll
            for (int j = 0; j < 4; ++j) g2[j] = *(const f32x4*)(m + 5120 + 4 * (lane + 64 * j));
            if (!last) { const float* m2 = mod_row(F, l + 1, row); load_mod(INP(6) + (l + 1) * 1024, m2, m2 + 1024, gc, sv, lane); }
            curb = cb; }
        f32x4 acc[4];
#pragma unroll
        for (int j = 0; j < 4; ++j) acc[j] = (f32x4){0.f, 0.f, 0.f, 0.f};
        if (any) add_pair(acc, a, c, w1);
        while (mask) {
            const int e0 = __builtin_ctz(mask); mask &= mask - 1; const bool two = mask != 0u; const int e1 = two ? __builtin_ctz(mask) : e0; if (two) mask &= mask - 1;
            u32x2 a2[4], c2[4]; load_pair(__builtin_amdgcn_readlane(myslot, e0), __builtin_amdgcn_readlane(myslot, e1), a2, c2); add_pair(acc, a2, c2, two ? 1.f : 0.f);
        }
        if (row + 1 < r1) { int s1n; mask_n = pair_of(slot_n, s0n, s1n, two_n); if (s0n >= 0) load_pair(s0n, s1n, an, cn); }
        f32x4 v[4];
#pragma unroll
        for (int j = 0; j < 4; ++j) { v[j] = xv[j] + g2[j] * acc[j]; if (!rep) *(f32x4*)(xr + 4 * (lane + 64 * j)) = v[j]; }
        if (!last) norm_mod_store_r(v, gc, sv, WSP(unsigned char, WS_HB) + (size_t)row * 1024, lane);
    }
}
constexpr int NPHASE = 2 + 9 * DEPTH;
DI void load_tabs(const Frame& F) {
    const f32x2* t64 = WSP(f32x2, WS_TAB64); const f32x2* t32 = WSP(f32x2, WS_TAB32);
    LAS f32x2* l64 = (LAS f32x2*)(F.lds + LDS_TAB64); LAS f32x2* l32 = (LAS f32x2*)(F.lds + LDS_TAB32);
    for (int i = F.tid; i < 64 * 16; i += NTHR) l64[i] = t64[i];
    for (int i = F.tid; i < 64 * 8; i += NTHR) l32[i] = t32[i];
    __syncthreads();
}
#ifndef PH_EN
#define PH_EN(k) 1
#endif
#ifdef UBENCH
template <int V> DI void ubench(const Frame& F) {
    const int wid = __builtin_amdgcn_readfirstlane(F.tid >> 6);
    f32x16 a0, a1; i32x8 x, y; float e[32]; int scl = 0x7F7F7F7F;
    { float z = (float)F.tid * 1e-9f; int q = F.tid; asm volatile("" : "+v"(z), "+v"(q), "+v"(scl));
#pragma unroll
      for (int i = 0; i < 16; ++i) { a0[i] = z; a1[i] = z; }
#pragma unroll
      for (int i = 0; i < 8; ++i) { x[i] = q; y[i] = q; }
#pragma unroll
      for (int i = 0; i < 32; ++i) e[i] = z * (float)(i + 1); }
    asm volatile("s_nop 1" : "+v"(a0), "+v"(a1), "+v"(x), "+v"(y));
    const bool g1 = (V == 1) ? (wid >= 4) : (V == 5) ? (wid & 1) : false;
    auto M = [&]() {
#pragma unroll
        for (int k = 0; k < 7; ++k) { MFMA8(a0, x, y, scl, scl); MFMA8(a1, x, y, scl, scl); } };
    auto VV = [&]() {
#pragma unroll
        for (int r = 0; r < 2; ++r)
#pragma unroll
            for (int i = 0; i < 32; ++i) e[i] = __builtin_amdgcn_exp2f(e[i]);
#pragma unroll
        for (int r = 0; r < 3; ++r)
#pragma unroll
            for (int i = 0; i < 32; ++i) e[i] = __builtin_fmaf(e[i], 0.999f, 1e-3f);
#pragma unroll
        for (int i = 0; i < 32; ++i) asm volatile("" : "+v"(e[i])); };
    auto MV = [&]() {
#pragma unroll
        for (int k = 0; k < 16; ++k) {
            if (k < 14) { if (k & 1) MFMA8(a1, x, y, scl, scl); else MFMA8(a0, x, y, scl, scl); }
#pragma unroll
            for (int j = 0; j < 2; ++j) { float v = e[2 * k + j]; v = __builtin_amdgcn_exp2f(v); v = __builtin_amdgcn_exp2f(v); v = __builtin_fmaf(v, 0.999f, 1e-3f); v = __builtin_fmaf(v, 0.999f, 1e-3f); v = __builtin_fmaf(v, 0.999f, 1e-3f); e[2 * k + j] = v; }
            asm volatile("" : "+v"(e[2 * k]), "+v"(e[2 * k + 1]));
        } };
    for (int it = 0; it < 3000; ++it) {
        if (V == 6 || V == 7) { MV(); if (V == 6) __builtin_amdgcn_s_barrier(); continue; }
        if (V == 3) M();
        else if (V == 4) VV();
        else if (!g1) { M(); VV(); } else { VV(); M(); }
        if (V != 2 && V != 7) __builtin_amdgcn_s_barrier();
    }
    asm volatile("s_nop 15\n\ts_nop 15" : "+v"(a0), "+v"(a1));
    float acc = 0.f;
#pragma unroll
    for (int i = 0; i < 16; ++i) acc += a0[i] + a1[i];
#pragma unroll
    for (int i = 0; i < 32; ++i) acc += e[i];
    if (acc == 123.456f) F.out[F.tid] = acc;
}
#endif
DI void run_phase(const Frame& F, int ph, int rep = 0) {
    unsigned char* ws = F.ws;
#ifdef UBENCH
    if (ph == 1000) { ubench<UBENCH>(F); return; }
#endif
    if (ph == 0) { if (PH_EN(100)) p0_phase(F); return; }
    if (ph == 1) { if (PH_EN(101)) init_norm_phase(F); return; }
    const int l = (ph - 2) / 9, s = (ph - 2) % 9; const bool last = (l == DEPTH - 1);
    switch (s) {
    case 0: if (PH_EN(0)) { load_tabs(F);
        g8::DenseSched S; S.init(MT, 6, F.G, F.bid, 512, ws + WS_WIN + (size_t)l * 1536 * 1024);
        EpiInProj E{ws, F.intab, l, (const LAS f32x2*)(F.lds + LDS_TAB64), (const LAS f32x2*)(F.lds + LDS_TAB32)};
        g8::gemm_phase(F.tid, F.lds, (const char*)(ws + WS_HB), 512, S, E); } break;
    case 1: if (PH_EN(1)) { load_tabs(F);
        g8::DenseSched S; S.init(MT, 6, F.G, F.bid, 384, ws + WS_WUP + (size_t)l * 1536 * 384 * 2, true);
        EpiUpProj E{ws, F.intab, l, (const LAS f32x2*)(F.lds + LDS_TAB32)};
        g8::gemm_phase(F.tid, F.lds, (const char*)(ws + Z_CRAW), 384, S, E); } break;
    case 2: if (PH_EN(2)) attn_phase(F, l, !last, rep); break;
    case 3: if (PH_EN(3)) { g8::DenseSched S; S.init(last ? LAT / 256 : MT, 4, F.G, F.bid, 1024, ws + WS_WOUT + (size_t)l * 1024 * 1024 * 2);
        EpiOutProj E{ws, l == 0 ? INP(0) : F.out, INP(2), F.out, l};
        g8::gemm_phase(F.tid, F.lds, (const char*)(ws + Z_OB), 1024, S, E); } break;
    case 4: if (PH_EN(4)) router_phase(F, l, !last); break;
    case 5: if (PH_EN(5)) topk_phase(F, !last); break;
    case 6: if (PH_EN(6)) { g8::MoeSched<true> S; S.init(8, !last, F.G, F.bid, 512, ws + WS_W1 + (size_t)l * 16 * 2048 * 1024, (size_t)2048 * 1024, (const int*)(ws + WS_GIDX));
        EpiMoe1 E{ws}; g8::gemm_phase(F.tid, F.lds, (const char*)(ws + WS_HB), 512, S, E); } break;
    case 7: if (PH_EN(7)) { g8::MoeSched<false> S; S.init(4, !last, F.G, F.bid, 512, ws + WS_W2 + (size_t)l * 16 * 1024 * 1024, (size_t)1024 * 1024, nullptr);
        EpiMoe2 E{ws}; g8::gemm_phase(F.tid, F.lds, (const char*)(ws + Z_HID), 512, S, E); } break;
    case 8: if (PH_EN(8)) combine_phase(F, l, !last, rep); break;
    }
}
__global__ void __launch_bounds__(NTHR, 2) mega_kernel(Args a) {
    extern __shared__ __attribute__((aligned(16))) unsigned char lds_raw[];
    Frame F; F.lds = (LAS unsigned char*)lds_raw; F.ws = a.ws; F.ctl = (unsigned*)(a.ws + WS_CTL);
    F.tid = threadIdx.x; F.lane = F.tid & 63; F.wave = __builtin_amdgcn_readfirstlane(F.tid >> 6); F.G = gridDim.x; F.bid = blockIdx.x; F.out = a.out;
    { LAS unsigned long long* tab = (LAS unsigned long long*)(F.lds + LDS_INTAB); if (F.tid < 27) tab[F.tid] = (unsigned long long)a.in[F.tid]; F.intab = tab; }
    volatile LAS unsigned* MISC = (volatile LAS unsigned*)(F.lds + LDS_MISC);
    if (F.tid < 64) MISC[F.tid] = 0u;
    __syncthreads();
    const bool multi = a.ph_hi - a.ph_lo > 1;
    const unsigned wave0 = __builtin_amdgcn_readfirstlane(threadIdx.x >> 6);
    XcdBarrier bar; bar.bar = F.ctl + CW_BAR + a.li * XCD_BAR_WORDS; bar.x = 0; bar.st = MISC;
    if (multi) bar = xcd_barrier_post(F.ctl + CW_BAR + a.li * XCD_BAR_WORDS, MISC);
    for (int ph = a.ph_lo; ph < a.ph_hi; ++ph) {
        {
            GAS unsigned char* w_ = (GAS unsigned char*)a.ws; GAS float* o_ = (GAS float*)a.out; unsigned l_ = (unsigned)(unsigned long long)F.lds, t_ = (unsigned)(unsigned long long)F.intab; int g_ = gridDim.x, b_ = blockIdx.x;
            unsigned all_ = ~0u, wv_ = wave0; asm volatile("" : "+s"(all_), "+s"(wv_));
            int tid_ = (int)(wv_ * 64u + __builtin_amdgcn_mbcnt_hi(all_, __builtin_amdgcn_mbcnt_lo(all_, 0u)));
            asm volatile("" : "+s"(w_), "+s"(o_), "+s"(l_), "+s"(t_), "+v"(tid_), "+s"(g_), "+s"(b_));
            F.ws = (unsigned char*)w_; F.out = (float*)o_; F.lds = (LAS unsigned char*)(unsigned long long)l_; F.intab = (const LAS unsigned long long*)(unsigned long long)t_; F.ctl = (unsigned*)(F.ws + WS_CTL);
            F.tid = tid_; F.lane = tid_ & 63; F.wave = __builtin_amdgcn_readfirstlane(tid_ >> 6); F.G = g_; F.bid = b_; }
        run_phase(F, ph, a.li);
#ifdef PROBE_I
        xcd_barrier(bar);
        if (F.bid == 0 && F.tid == 0) ((unsigned long long*)(F.ws + 49152))[ph + 1] = __builtin_amdgcn_s_memrealtime();
#else
        if (ph + 1 < a.ph_hi) xcd_barrier(bar);
#endif
    }
#ifdef PROBE_I
    {
        xcd_barrier(bar);
        const unsigned long long* ts = (const unsigned long long*)(F.ws + 49152);
        float ti = (float)(__hip_atomic_load(ts + PROBE_I + 1, __ATOMIC_RELAXED, __HIP_MEMORY_SCOPE_AGENT) - __hip_atomic_load(ts + PROBE_I, __ATOMIC_RELAXED, __HIP_MEMORY_SCOPE_AGENT)) * 0.01f;
        float tj = (float)(__hip_atomic_load(ts + PROBE_J + 1, __ATOMIC_RELAXED, __HIP_MEMORY_SCOPE_AGENT) - __hip_atomic_load(ts + PROBE_J, __ATOMIC_RELAXED, __HIP_MEMORY_SCOPE_AGENT)) * 0.01f;
        ti = exp2f(rintf(log2f(fmaxf(ti, 1.f)) * 14.2067f) / 14.2067f); tj = exp2f(rintf(log2f(fmaxf(tj, 1.f)) * 14.2067f) / 14.2067f);
        const float* xin = inp(F.intab, 0); const size_t n = (size_t)8 * 4096 * 1024;
        for (size_t i = (size_t)F.bid * NTHR + F.tid; i < n; i += (size_t)F.G * NTHR) F.out[i] = xin[i] + ti + (i == 0 ? 100.f * tj : 0.f);
    }
#endif
}
}

extern "C" void kernel_launch(void* const* d_in, const int* in_sizes, int n_in, void* d_out, int out_size, void* d_ws, size_t ws_size, hipStream_t stream) {
    static int grid = 0;
    if (grid == 0) {
        if (n_in != 27 || out_size != 8 * 4096 * 1024 || ws_size < fp::WS_END) { fprintf(stderr, "kernel_launch: unexpected problem (n_in %d, out %d, ws %zu < %zu)\n", n_in, out_size, ws_size, (size_t)fp::WS_END); grid = -1; return; }
        int dev = 0, cus = 0, per_cu = 0;
        if (hipGetDevice(&dev) != hipSuccess || hipDeviceGetAttribute(&cus, hipDeviceAttributeMultiprocessorCount, dev) != hipSuccess) { fprintf(stderr, "kernel_launch: device query failed\n"); grid = -1; return; }
        if (hipFuncSetAttribute((const void*)fp::mega_kernel, hipFuncAttributeMaxDynamicSharedMemorySize, fp::LDS_BYTES) != hipSuccess) { fprintf(stderr, "kernel_launch: hipFuncSetAttribute failed\n"); grid = -1; return; }
        if (hipOccupancyMaxActiveBlocksPerMultiprocessor(&per_cu, (const void*)fp::mega_kernel, fp::NTHR, fp::LDS_BYTES) != hipSuccess || per_cu < 1) fprintf(stderr, "kernel_launch: note: occupancy query reports %d workgroups per CU\n", per_cu);
        (void)hipGetLastError();
        grid = cus;
    }
    if (grid < 0) return;
    if (hipMemsetAsync((char*)d_ws + fp::WS_CTL, 0, fp::CTL_BYTES, stream) != hipSuccess) { fprintf(stderr, "kernel_launch: memset failed\n"); return; }
    fp::Args a{};
    for (int i = 0; i < 27; ++i) a.in[i] = (const float*)d_in[i];
    a.out = (float*)d_out; a.ws = (unsigned char*)d_ws; a.ph_lo = 0; a.ph_hi = fp::NPHASE;
#ifdef UBENCH
    { fp::Args b = a; b.ph_lo = 1000; b.ph_hi = 1001; b.li = 1; hipLaunchKernelGGL(fp::mega_kernel, dim3(grid), dim3(fp::NTHR), fp::LDS_BYTES, stream, b); }
#endif
#ifdef PROBE_SPLIT_LO
    a.ph_hi = PROBE_SPLIT_HI; a.li = 1; hipLaunchKernelGGL(fp::mega_kernel, dim3(grid), dim3(fp::NTHR), fp::LDS_BYTES, stream, a);
    a.ph_lo = PROBE_SPLIT_LO; a.ph_hi = fp::NPHASE; a.li = 0;
#endif
    hipLaunchKernelGGL(fp::mega_kernel, dim3(grid), dim3(fp::NTHR), fp::LDS_BYTES, stream, a);
}
```
